# Optimizing an MI355X kernel written in HIP

```python
import math
import jax, jax.numpy as jnp
from jax import lax
import numpy as np

D_MODEL = 1024
BATCH = 8
SEQ = 2048
DEPTH = 4

D_MIX = D_MODEL
ATTN_WIDTH = D_MIX // 2
N_SB_HEADS = 8
SB_HEAD_DIM = ATTN_WIDTH // N_SB_HEADS
POOL_WINDOWS = (2, 4, 8, 16)
N_POOL_GROUPS = len(POOL_WINDOWS)
POOL_WIDTH = D_MIX // 4
POOL_GROUP_DIM = POOL_WIDTH // N_POOL_GROUPS
CONV_WIDTH = D_MIX - ATTN_WIDTH - POOL_WIDTH
CONV_KERNEL = 31
IN_COLS = 3 * ATTN_WIDTH + POOL_WIDTH + 2 * CONV_WIDTH
Q_BLOCK = 128

D_FF = 2816
N_EXPERTS = 8
TOP_K = 2
N_DENSE = (DEPTH + 1) // 2
N_MOE = DEPTH // 2

RMS_EPS = 1e-6
LN_EPS = 1e-5

kernel_name = "hybrid_sbattn_pool_conformer_moe"


def rmsnorm(x, g):
    x32 = x.astype(jnp.float32)
    y = x32 * lax.rsqrt(jnp.mean(x32 * x32, axis=-1, keepdims=True) + RMS_EPS)
    return (y * g.astype(jnp.float32)).astype(x.dtype)


def layernorm(x, g, b):
    x32 = x.astype(jnp.float32)
    mu = jnp.mean(x32, axis=-1, keepdims=True)
    xc = x32 - mu
    var = jnp.mean(xc * xc, axis=-1, keepdims=True)
    y = xc * lax.rsqrt(var + LN_EPS)
    return (y * g.astype(jnp.float32) + b.astype(jnp.float32)).astype(x.dtype)


def _sb_block(qb, k_pre, v_pre, q_start):
    scale = 1.0 / math.sqrt(SB_HEAD_DIM)
    z = jnp.einsum('bqhd,bkhd->bhqk', qb, k_pre).astype(jnp.float32) * scale
    t_idx = q_start + jnp.arange(qb.shape[1])
    s_idx = jnp.arange(k_pre.shape[1])
    mask = s_idx[None, :] < t_idx[:, None]
    log_1m_beta = jnp.where(mask, jax.nn.log_sigmoid(-z), 0.0)
    rest = lax.cumsum(log_1m_beta, axis=3, reverse=True) - log_1m_beta
    w = jnp.where(mask, jnp.exp(jax.nn.log_sigmoid(z) + rest), 0.0)
    return jnp.einsum('bhqk,bkhd->bqhd', w.astype(v_pre.dtype), v_pre)


def stick_breaking_attention(q, k, v):
    S = q.shape[1]
    outs = []
    for start in range(0, S, Q_BLOCK):
        end = start + Q_BLOCK
        outs.append(_sb_block(q[:, start:end], k[:, :end], v[:, :end], start))
    return jnp.concatenate(outs, axis=1)


def multiscale_pool(u, w_pool, pool_scale):
    B, S, _ = u.shape
    ug = u.reshape(B, S, N_POOL_GROUPS, POOL_GROUP_DIM).astype(jnp.float32)
    csum = jnp.cumsum(ug, axis=1)
    pos = jnp.arange(S)
    outs = []
    for g, win in enumerate(POOL_WINDOWS):
        cg = csum[:, :, g]
        shifted = jnp.pad(cg, ((0, 0), (win, 0), (0, 0)))[:, :S]
        count = jnp.minimum(pos + 1, win).astype(jnp.float32)
        outs.append((cg - shifted) / count[None, :, None] - ug[:, :, g])
    y = jnp.stack(outs, axis=2).astype(u.dtype)
    y = jnp.einsum('bsgc,gcd->bsgd', y, w_pool).reshape(B, S, POOL_WIDTH)
    return y * pool_scale


def conformer_conv(val, gate, conv_w, conv_b, ln_g, ln_b):
    u = val * jax.nn.sigmoid(gate)
    y = lax.conv_general_dilated(
        u, conv_w[:, None, :].astype(u.dtype), window_strides=(1,),
        padding=[(CONV_KERNEL - 1, 0)],
        dimension_numbers=('NWC', 'WIO', 'NWC'),
        feature_group_count=CONV_WIDTH) + conv_b
    y = layernorm(y, ln_g, ln_b)
    return jax.nn.silu(y)


def hybrid_mixer(h, w_in, pool_w, pool_scale, conv_w, conv_b, ln_g, ln_b, gn_g, w_out):
    B, S, _ = h.shape
    p = h @ w_in
    a0 = ATTN_WIDTH
    q, k, v, u_pool, c_val, c_gate = jnp.split(
        p, [a0, 2 * a0, 3 * a0, 3 * a0 + POOL_WIDTH, 3 * a0 + POOL_WIDTH + CONV_WIDTH], axis=-1)
    shp = (B, S, N_SB_HEADS, SB_HEAD_DIM)
    o_a = stick_breaking_attention(q.reshape(shp), k.reshape(shp), v.reshape(shp)).reshape(B, S, ATTN_WIDTH)
    o_b = multiscale_pool(u_pool, pool_w, pool_scale)
    o_c = conformer_conv(c_val, c_gate, conv_w, conv_b, ln_g, ln_b)
    g_a, g_b, g_c = jnp.split(gn_g, [ATTN_WIDTH, ATTN_WIDTH + POOL_WIDTH])
    o = jnp.concatenate([rmsnorm(o_a, g_a), rmsnorm(o_b, g_b), rmsnorm(o_c, g_c)], axis=-1)
    return o @ w_out


def swiglu(h, w_gate, w_up, w_down):
    return (jax.nn.silu(h @ w_gate) * (h @ w_up)) @ w_down


def moe_swiglu(h, w_router, w_gate, w_up, w_down):
    B, S, D = h.shape
    t = h.reshape(B * S, D)
    logits = (t @ w_router).astype(jnp.float32)
    top_v, top_i = lax.top_k(logits, TOP_K)
    gates = jax.nn.softmax(top_v, axis=-1)
    combine = jnp.sum(jax.nn.one_hot(top_i, N_EXPERTS, dtype=jnp.float32) * gates[..., None], axis=1)
    combine = combine.astype(h.dtype)
    out = jnp.zeros_like(t)
    for e in range(N_EXPERTS):
        out = out + combine[:, e:e + 1] * swiglu(t, w_gate[e], w_up[e], w_down[e])
    return out.reshape(B, S, D)


def setup_inputs(seed: int = 0) -> dict:
    key = jax.random.key(seed)
    ks = jax.random.split(key, 24)
    f32 = jnp.float32

    def nrm(k, shape, scale):
        return jax.random.normal(k, shape, f32) * scale

    def gain(k, shape):
        return 1.0 + 0.02 * jax.random.normal(k, shape, f32)

    return {
        "x": nrm(ks[0], (BATCH, SEQ, D_MODEL), 1.0),
        "attn_norm_g": gain(ks[1], (DEPTH, D_MODEL)),
        "w_in": nrm(ks[2], (DEPTH, D_MODEL, IN_COLS), D_MODEL ** -0.5),
        "pool_w": nrm(ks[3], (DEPTH, N_POOL_GROUPS, POOL_GROUP_DIM, POOL_GROUP_DIM), POOL_GROUP_DIM ** -0.5),
        "pool_scale": gain(ks[4], (DEPTH, POOL_WIDTH)),
        "conv_w": nrm(ks[5], (DEPTH, CONV_KERNEL, CONV_WIDTH), CONV_KERNEL ** -0.5),
        "conv_b": nrm(ks[6], (DEPTH, CONV_WIDTH), 0.02),
        "conv_ln_g": gain(ks[7], (DEPTH, CONV_WIDTH)),
        "conv_ln_b": nrm(ks[8], (DEPTH, CONV_WIDTH), 0.02),
        "group_norm_g": gain(ks[9], (DEPTH, D_MIX)),
        "w_out": nrm(ks[10], (DEPTH, D_MIX, D_MODEL), D_MIX ** -0.5),
        "ffn_norm_g": gain(ks[11], (DEPTH, D_MODEL)),
        "dense_w_gate": nrm(ks[12], (N_DENSE, D_MODEL, D_FF), D_MODEL ** -0.5),
        "dense_w_up": nrm(ks[13], (N_DENSE, D_MODEL, D_FF), D_MODEL ** -0.5),
        "dense_w_down": nrm(ks[14], (N_DENSE, D_FF, D_MODEL), D_FF ** -0.5),
        "router_w": nrm(ks[15], (N_MOE, D_MODEL, N_EXPERTS), D_MODEL ** -0.5),
        "moe_w_gate": nrm(ks[16], (N_MOE, N_EXPERTS, D_MODEL, D_FF), D_MODEL ** -0.5),
        "moe_w_up": nrm(ks[17], (N_MOE, N_EXPERTS, D_MODEL, D_FF), D_MODEL ** -0.5),
        "moe_w_down": nrm(ks[18], (N_MOE, N_EXPERTS, D_FF, D_MODEL), D_FF ** -0.5),
        "final_norm_g": gain(ks[19], (D_MODEL,)),
    }


def reference(x, attn_norm_g, w_in, pool_w, pool_scale, conv_w, conv_b, conv_ln_g, conv_ln_b,
              group_norm_g, w_out, ffn_norm_g, dense_w_gate, dense_w_up, dense_w_down,
              router_w, moe_w_gate, moe_w_up, moe_w_down, final_norm_g):
    for l in range(DEPTH):
        h = rmsnorm(x, attn_norm_g[l])
        x = x + hybrid_mixer(h, w_in[l], pool_w[l], pool_scale[l], conv_w[l], conv_b[l],
                             conv_ln_g[l], conv_ln_b[l], group_norm_g[l], w_out[l])
        h = rmsnorm(x, ffn_norm_g[l])
        if l % 2 == 0:
            i = l // 2
            x = x + swiglu(h, dense_w_gate[i], dense_w_up[i], dense_w_down[i])
        else:
            i = l // 2
            x = x + moe_swiglu(h, router_w[i], moe_w_gate[i], moe_w_up[i], moe_w_down[i])
    return rmsnorm(x, final_norm_g)
```

```cpp
#include <hip/hip_runtime.h>
#include <cstdio>
#include <cstdint>
#include <cmath>
#define MK_ONE_LAUNCH 0
namespace pg8 {
#define PG8_LAS __attribute__((address_space(3)))
typedef unsigned short bf16_t;
typedef short bf16x8 __attribute__((ext_vector_type(8)));
typedef float f32x4 __attribute__((ext_vector_type(4)));
typedef unsigned u32x4 __attribute__((ext_vector_type(4)));
constexpr int BM = 256, BK = 64, HALF = 128, HTB = HALF * BK * 2  , STAGE_BYTES = 8 * HTB, NXCD = 8, WGM = 8;

__host__ __device__ __forceinline__ int lds_byte(int r, int c) { const int st = (r >> 4) * 2 + (c >> 5), rr = r & 15, cc = c & 31, ob = rr * 64 + cc * 2; return st * 1024 + (ob ^ (((ob >> 9) & 1) << 5)); }
__host__ __device__ __forceinline__ void stage_rc(int b, int& R, int& C) { const int st = b / 1024, sb = b % 1024, swz = sb ^ (((sb >> 9) & 1) << 5); R = (st >> 1) * 16 + swz / 64; C = (st & 1) * 32 + (swz % 64) / 2; }
__host__ __device__ __forceinline__ int perm32(int rho) { const int n = rho >> 4, i = rho & 15; return 8 * (i >> 2) + 4 * n + (i & 3); }

struct Unit { int pm, pn, e; };
struct Gemm { const bf16_t* A; const bf16_t* Bt; int M, N, K; size_t estride; };

struct StaticOrder {
    int nM, nN, nwg, G, c;
    __host__ __device__ void init(int M, int N, int G_, int c_) { nM = M / BM; nN = N / BM; nwg = nM * nN; G = G_; c = c_; }
    __host__ __device__ bool next(int i, Unit& u) const {
        const long L = (long)i * G + c; if (L >= nwg) return false;
        int wgid = (int)L; { const int q = nwg / NXCD, r = nwg % NXCD, xcd = wgid % NXCD, off = wgid / NXCD; wgid = (xcd < r ? xcd * (q + 1) : r * (q + 1) + (xcd - r) * q) + off; }
        const int nig = WGM * nN, gid = wgid / nig, fm = gid * WGM, gsz = (nM - fm) < WGM ? (nM - fm) : WGM;
        u.pm = fm + ((wgid % nig) % gsz); u.pn = (wgid % nig) / gsz; u.e = 0; return true;
    }
    __device__ __forceinline__ void a_ready(const Unit&) const {}
    __device__ __forceinline__ void done(const Unit&) const {}
};

__device__ __forceinline__ unsigned cvt_pk_bf16(float lo, float hi) { unsigned r; asm volatile("v_cvt_pk_bf16_f32 %0, %1, %2" : "=v"(r) : "v"(lo), "v"(hi)); return r; }
typedef float f32x2 __attribute__((ext_vector_type(2)));
__device__ __forceinline__ f32x2 gelu_pk(f32x2 v) {
    const f32x2 av = __builtin_elementwise_abs(v), d = av * 0.2316418882f + 1.0f;
    f32x2 t; t.x = __builtin_amdgcn_rcpf(d.x); t.y = __builtin_amdgcn_rcpf(d.y);
    f32x2 q = t * 0.5307027145f + (-0.7265760135f); q = q * t + 0.7107068705f; q = q * t + (-0.142248368f); q = q * t + 0.127414796f; q = q * t;
    const f32x2 s = (v * v) * (-0.72134752044f);
    f32x2 e; e.x = __builtin_amdgcn_exp2f(s.x); e.y = __builtin_amdgcn_exp2f(s.y);
    const f32x2 m = v * (q * e), r = v - m;
    f32x2 o; o.x = v.x < 0.f ? m.x : r.x; o.y = v.y < 0.f ? m.y : r.y; return o;
}

template <int ACT  > struct EpiBf16 {
    static constexpr bool PERM = true, AFTER_DRAIN = false; static_assert(ACT == 0 || ACT == 1, "EpiBf16: ACT is 0 (none) or 1 (gelu_pk)");
    bf16_t* O; int ldc; const float* bias; int split_cols; size_t split_stride; float scale0;
    __device__ __forceinline__ void operator()(const f32x4 (&acc)[2][2][4][2], const Unit& u, int wr, int wc, int fr, int fq) const {
        const int row0 = u.pm * BM + wr * 64 + fr; int colt = u.pn * BM; bf16_t* base = O;
        float sc = 1.f; if (split_cols) { const int t = colt / split_cols; base += (size_t)t * split_stride; colt -= t * split_cols; if (t == 0) sc = scale0; }
        const int col0 = colt + wc * 32 + 8 * fq, bcol0 = u.pn * BM + wc * 32 + 8 * fq;
        f32x4 bv[2][2];
#pragma unroll
        for (int bj = 0; bj < 2; ++bj)
#pragma unroll
            for (int n = 0; n < 2; ++n) bv[bj][n] = bias ? *(const f32x4*)(bias + bcol0 + bj * HALF + 4 * n) : (f32x4){0.f, 0.f, 0.f, 0.f};
#pragma unroll
        for (int ai = 0; ai < 2; ++ai)
#pragma unroll
            for (int m = 0; m < 4; ++m) { bf16_t* rowp = base + (size_t)(row0 + ai * HALF + m * 16) * ldc + col0;
#pragma unroll
                for (int bj = 0; bj < 2; ++bj) { f32x4 v0 = acc[ai][bj][m][0] + bv[bj][0], v1 = acc[ai][bj][m][1] + bv[bj][1];
                    if (ACT == 1) { f32x2 a = gelu_pk((f32x2){v0[0], v0[1]}), b = gelu_pk((f32x2){v0[2], v0[3]}), c = gelu_pk((f32x2){v1[0], v1[1]}), d = gelu_pk((f32x2){v1[2], v1[3]});
                        v0 = (f32x4){a.x, a.y, b.x, b.y}; v1 = (f32x4){c.x, c.y, d.x, d.y}; }
                    v0 = v0 * sc; v1 = v1 * sc; u32x4 w; w.x = cvt_pk_bf16(v0[0], v0[1]); w.y = cvt_pk_bf16(v0[2], v0[3]); w.z = cvt_pk_bf16(v1[0], v1[1]); w.w = cvt_pk_bf16(v1[2], v1[3]);
                    *(u32x4*)(rowp + bj * HALF) = w; } }
    }
};
struct EpiResid {
    static constexpr bool PERM = false, AFTER_DRAIN = false;
    float* X; int ldc;
    __device__ __forceinline__ void operator()(const f32x4 (&acc)[2][2][4][2], const Unit& u, int wr, int wc, int fr, int fq) const {
        const int row0 = u.pm * BM + wr * 64 + fr, col0 = u.pn * BM + wc * 32 + 4 * fq;
#pragma unroll
        for (int ai = 0; ai < 2; ++ai)
#pragma unroll
            for (int m = 0; m < 4; ++m) { float* rowp = X + (size_t)(row0 + ai * HALF + m * 16) * ldc + col0;
                f32x4 old[2][2];
#pragma unroll
                for (int bj = 0; bj < 2; ++bj)
#pragma unroll
                    for (int n = 0; n < 2; ++n) old[bj][n] = *(const f32x4*)(rowp + bj * HALF + n * 16);
#pragma unroll
                for (int bj = 0; bj < 2; ++bj)
#pragma unroll
                    for (int n = 0; n < 2; ++n) *(f32x4*)(rowp + bj * HALF + n * 16) = old[bj][n] + acc[ai][bj][m][n];
                asm volatile("" ::: "memory"); }
    }
};
__device__ __forceinline__ float silu_mul(float g, float u) { return g * __builtin_amdgcn_rcpf(1.0f + __builtin_amdgcn_exp2f(g * -1.4426950408889634f)) * u; }
struct EpiSwiGLU {
    static constexpr bool PERM = true, AFTER_DRAIN = false;
    bf16_t* O; int ldc;
    __device__ __forceinline__ void operator()(const f32x4 (&acc)[2][2][4][2], const Unit& u, int wr, int wc, int fr, int fq) const {
        const int row0 = u.pm * BM + wr * 64 + fr, col0 = u.pn * HALF + wc * 32 + 8 * fq;
#pragma unroll
        for (int ai = 0; ai < 2; ++ai)
#pragma unroll
            for (int m = 0; m < 4; ++m) { bf16_t* rowp = O + (size_t)(row0 + ai * HALF + m * 16) * ldc + col0;
                const f32x4 g0 = acc[ai][0][m][0], g1 = acc[ai][0][m][1], u0 = acc[ai][1][m][0], u1 = acc[ai][1][m][1];
                u32x4 w;
                w.x = cvt_pk_bf16(silu_mul(g0[0], u0[0]), silu_mul(g0[1], u0[1])); w.y = cvt_pk_bf16(silu_mul(g0[2], u0[2]), silu_mul(g0[3], u0[3]));
                w.z = cvt_pk_bf16(silu_mul(g1[0], u1[0]), silu_mul(g1[1], u1[1])); w.w = cvt_pk_bf16(silu_mul(g1[2], u1[2]), silu_mul(g1[3], u1[3]));
                *(u32x4*)rowp = w; }
    }
};
struct GroupedOrder {
    int nM, nN, nwg, G, c; int t1, t2, t3, t4, t5, t6, t7;
    __device__ __forceinline__ void init(const int (&toff)[9], int N, int G_, int c_) { nM = toff[8]; nN = N / BM; nwg = nM * nN; G = G_; c = c_;
        t1 = toff[1]; t2 = toff[2]; t3 = toff[3]; t4 = toff[4]; t5 = toff[5]; t6 = toff[6]; t7 = toff[7]; }
    __device__ __forceinline__ bool next(int i, Unit& u) const {
        const long L = (long)i * G + c; if (L >= nwg) return false;
        int wgid = (int)L; { const int q = nwg / NXCD, r = nwg % NXCD, xcd = wgid % NXCD, off = wgid / NXCD; wgid = (xcd < r ? xcd * (q + 1) : r * (q + 1) + (xcd - r) * q) + off; }
        const int nig = WGM * nN, gid = wgid / nig, fm = gid * WGM, gsz = (nM - fm) < WGM ? (nM - fm) : WGM;
        u.pm = fm + ((wgid % nig) % gsz); u.pn = (wgid % nig) / gsz;
        u.e = (u.pm >= t1) + (u.pm >= t2) + (u.pm >= t3) + (u.pm >= t4) + (u.pm >= t5) + (u.pm >= t6) + (u.pm >= t7); return true;
    }
    __device__ __forceinline__ void a_ready(const Unit&) const {}
    __device__ __forceinline__ void done(const Unit&) const {}
};
template <class Epi, class Sched, bool ALIGN_EPI = false, bool SP2 = false>
__device__ __forceinline__ void gemm_phase(PG8_LAS unsigned char* lds, const Gemm g, const Sched& S, const Epi& E) {
    int tid_ = threadIdx.x; asm volatile("" : "+v"(tid_));
    const int tid = tid_, wid = __builtin_amdgcn_readfirstlane(tid >> 6), lane = tid & 63, wr = wid >> 2, wc = wid & 3, fr = lane & 15, fq = lane >> 4;
    const int K = g.K, nt = K / BK;
    unsigned voffA[2], voffB[2];
#pragma unroll
    for (int i = 0; i < 2; ++i) { int R, C; stage_rc(tid * 16 + i * 8192, R, C); const int Rb = Epi::PERM ? ((R & ~31) + perm32(R & 31)) : R;
        voffA[i] = (unsigned)(R * K + C) * 2u; voffB[i] = (unsigned)(Rb * K + C) * 2u; }
    const size_t kstep = (size_t)(BK * 2);
    const size_t hstep = (size_t)HALF * K * 2;
    const size_t tstep = 2 * hstep;
    const unsigned ldsw = (unsigned)wid * 1024u;
    const int aoff = lds_byte(wr * 64 + fr, fq * 8), boff = lds_byte(wc * 32 + fr, fq * 8);
#define PG8_SA(b, h) (((b) * 2 + (h)) * HTB)
#define PG8_SB(b, h) ((4 + (b) * 2 + (h)) * HTB)
#define PG8_STAGE(bufoff, gbase, voff) do { _Pragma("unroll") for (int _i = 0; _i < 2; ++_i) \
        __builtin_amdgcn_global_load_lds((const unsigned*)((const char*)(gbase) + (voff)[_i]), (PG8_LAS unsigned*)(lds + (bufoff) + ldsw + _i * 8192), 16, 0, 0); } while (0)
#define PG8_LDA(dst, b, h) do { _Pragma("unroll") for (int m = 0; m < 4; ++m) _Pragma("unroll") for (int k = 0; k < 2; ++k) dst[m][k] = *(const PG8_LAS bf16x8*)(lds + PG8_SA(b, h) + aoff + m * 2048 + k * 1024); } while (0)
#define PG8_LDB(dst, b, h) do { _Pragma("unroll") for (int n = 0; n < 2; ++n) _Pragma("unroll") for (int k = 0; k < 2; ++k) dst[n][k] = *(const PG8_LAS bf16x8*)(lds + PG8_SB(b, h) + boff + n * 2048 + k * 1024); } while (0)
#define PG8_MMA(ai, bj, At, Bt) do { __builtin_amdgcn_s_setprio(1); _Pragma("unroll") for (int m = 0; m < 4; ++m) _Pragma("unroll") for (int n = 0; n < 2; ++n) _Pragma("unroll") for (int k = 0; k < 2; ++k) \
        acc[ai][bj][m][n] = __builtin_amdgcn_mfma_f32_16x16x32_bf16(Bt[n][k], At[m][k], acc[ai][bj][m][n], 0, 0, 0); __builtin_amdgcn_s_setprio(0); } while (0)
#define PG8_WAIT_V(n) asm volatile("s_waitcnt vmcnt(" #n ")" ::: "memory")
#define PG8_WAIT_L(n) asm volatile("s_waitcnt lgkmcnt(" #n ")" ::: "memory")
#define PG8_BAR __builtin_amdgcn_s_barrier()
#define PG8_SCHED __builtin_amdgcn_sched_barrier(0)
    Unit cur, nxt; int ui = 0;
    if (!S.next(0, cur)) return;
    f32x4 acc[2][2][4][2];
#pragma unroll
    for (int a = 0; a < 2; ++a)
#pragma unroll
        for (int b = 0; b < 2; ++b)
#pragma unroll
            for (int m = 0; m < 4; ++m)
#pragma unroll
                for (int n = 0; n < 2; ++n) acc[a][b][m][n] = (f32x4){0.f, 0.f, 0.f, 0.f};
    bf16x8 At[4][2], B0[2][2], B1[2][2];
    const char* cA = (const char*)g.A + (size_t)cur.pm * tstep; const char* cB = (const char*)g.Bt + (size_t)cur.e * g.estride + (size_t)cur.pn * tstep;
    S.a_ready(cur);
    if constexpr (SP2) {
        PG8_STAGE(PG8_SB(0, 0), cB, voffB); PG8_STAGE(PG8_SB(0, 1), cB + hstep, voffB); PG8_STAGE(PG8_SA(0, 0), cA, voffA); PG8_STAGE(PG8_SA(0, 1), cA + hstep, voffA);
        if (wr == 1) PG8_BAR;
        PG8_WAIT_V(2); PG8_BAR;
        PG8_STAGE(PG8_SB(1, 0), cB + kstep, voffB); PG8_STAGE(PG8_SA(1, 0), cA + kstep, voffA); PG8_STAGE(PG8_SB(1, 1), cB + hstep + kstep, voffB);
        PG8_WAIT_V(6); PG8_BAR;
    } else {
        PG8_STAGE(PG8_SB(0, 0), cB, voffB); PG8_STAGE(PG8_SA(0, 0), cA, voffA); PG8_STAGE(PG8_SB(0, 1), cB + hstep, voffB); PG8_STAGE(PG8_SA(0, 1), cA + hstep, voffA);
        if (wr == 1) PG8_BAR;
        PG8_WAIT_V(4); PG8_BAR;
        PG8_STAGE(PG8_SB(1, 0), cB + kstep, voffB); PG8_STAGE(PG8_SA(1, 0), cA + kstep, voffA); PG8_STAGE(PG8_SB(1, 1), cB + hstep + kstep, voffB);
        PG8_WAIT_V(6); PG8_BAR;
    }
    for (;;) {
        const bool has_next = S.next(ui + 1, nxt);
        const char* nA = has_next ? (const char*)g.A + (size_t)nxt.pm * tstep : cA; const char* nB = has_next ? (const char*)g.Bt + (size_t)nxt.e * g.estride + (size_t)nxt.pn * tstep : cB;
        for (int t = 0; t < nt; t += 2) {
            const bool last = (t == nt - 2);
            const char* a1 = cA + (size_t)(t + 1) * kstep;
            const char* a2 = last ? nA : cA + (size_t)(t + 2) * kstep; const char* b2 = last ? nB : cB + (size_t)(t + 2) * kstep;
            const char* a3 = a2 + kstep; const char* b3 = b2 + kstep;
            if (last && has_next) S.a_ready(nxt);
            if constexpr (SP2) {
            PG8_LDB(B0, 0, 0); PG8_LDB(B1, 0, 1); PG8_SCHED; PG8_LDA(At, 0, 0); PG8_STAGE(PG8_SA(1, 1), a1 + hstep, voffA);
            PG8_WAIT_V(8); PG8_WAIT_L(0); PG8_BAR; PG8_MMA(0, 0, At, B0); PG8_MMA(0, 1, At, B1); PG8_BAR; PG8_SCHED;
            PG8_LDA(At, 0, 1); PG8_STAGE(PG8_SB(0, 0), b2, voffB); PG8_STAGE(PG8_SB(0, 1), b2 + hstep, voffB); PG8_STAGE(PG8_SA(0, 0), a2, voffA);
            PG8_WAIT_V(8); PG8_WAIT_L(0); PG8_BAR; PG8_MMA(1, 0, At, B0); PG8_MMA(1, 1, At, B1); PG8_BAR; PG8_SCHED;
            PG8_LDB(B0, 1, 0); PG8_LDB(B1, 1, 1); PG8_SCHED; PG8_LDA(At, 1, 0); PG8_STAGE(PG8_SA(0, 1), a2 + hstep, voffA);
            PG8_WAIT_V(8); PG8_WAIT_L(0); PG8_BAR; PG8_MMA(0, 0, At, B0); PG8_MMA(0, 1, At, B1); PG8_BAR; PG8_SCHED;
            PG8_LDA(At, 1, 1); PG8_STAGE(PG8_SB(1, 0), b3, voffB); PG8_STAGE(PG8_SB(1, 1), b3 + hstep, voffB); PG8_STAGE(PG8_SA(1, 0), a3, voffA);
            PG8_WAIT_V(8); PG8_WAIT_L(0); PG8_BAR; PG8_MMA(1, 0, At, B0); PG8_MMA(1, 1, At, B1); PG8_BAR; PG8_SCHED;
            } else {
            PG8_LDB(B0, 0, 0); PG8_SCHED; PG8_LDA(At, 0, 0); PG8_STAGE(PG8_SA(1, 1), a1 + hstep, voffA);
            PG8_WAIT_L(8); PG8_BAR; PG8_WAIT_L(0); PG8_MMA(0, 0, At, B0); PG8_BAR; PG8_SCHED;
            PG8_LDB(B1, 0, 1); PG8_STAGE(PG8_SB(0, 0), b2, voffB);
            PG8_BAR; PG8_WAIT_L(0); PG8_MMA(0, 1, At, B1); PG8_BAR;
            PG8_LDA(At, 0, 1); PG8_STAGE(PG8_SA(0, 0), a2, voffA);
            PG8_BAR; PG8_WAIT_L(0); PG8_MMA(1, 0, At, B0); PG8_BAR; PG8_SCHED;
            PG8_STAGE(PG8_SB(0, 1), b2 + hstep, voffB);
            PG8_WAIT_V(6); PG8_BAR; PG8_MMA(1, 1, At, B1); PG8_BAR;
            PG8_LDB(B0, 1, 0); PG8_SCHED; PG8_LDA(At, 1, 0); PG8_STAGE(PG8_SA(0, 1), a2 + hstep, voffA);
            PG8_WAIT_L(8); PG8_BAR; PG8_WAIT_L(0); PG8_MMA(0, 0, At, B0); PG8_BAR; PG8_SCHED;
            PG8_LDB(B1, 1, 1); PG8_STAGE(PG8_SB(1, 0), b3, voffB);
            PG8_BAR; PG8_WAIT_L(0); PG8_MMA(0, 1, At, B1); PG8_BAR;
            PG8_LDA(At, 1, 1); PG8_STAGE(PG8_SA(1, 0), a3, voffA);
            PG8_BAR; PG8_WAIT_L(0); PG8_MMA(1, 0, At, B0); PG8_BAR; PG8_SCHED;
            PG8_STAGE(PG8_SB(1, 1), b3 + hstep, voffB);
            PG8_WAIT_V(6); PG8_BAR; PG8_MMA(1, 1, At, B1); PG8_BAR;
            }
        }
        if constexpr (ALIGN_EPI) { if (wr == 0) PG8_BAR; }
        if constexpr (!Epi::AFTER_DRAIN) { E(acc, cur, wr, wc, fr, fq); S.done(cur); }
        if (!has_next) break;
#pragma unroll
        for (int a = 0; a < 2; ++a)
#pragma unroll
            for (int b = 0; b < 2; ++b)
#pragma unroll
                for (int m = 0; m < 4; ++m)
#pragma unroll
                    for (int n = 0; n < 2; ++n) acc[a][b][m][n] = (f32x4){0.f, 0.f, 0.f, 0.f};
        cur = nxt; cA = nA; cB = nB; ++ui;
        if constexpr (ALIGN_EPI) { if (wr == 1) PG8_BAR; }
    }
    PG8_WAIT_V(0);
    if constexpr (!ALIGN_EPI) { if (wr == 0) PG8_BAR; }
    PG8_BAR;
    if constexpr (Epi::AFTER_DRAIN) { E.fused(acc, cur, wr, wc, fr, fq, lds, wid, lane); S.done(cur); }
#undef PG8_SA
#undef PG8_SB
#undef PG8_STAGE
#undef PG8_LDA
#undef PG8_LDB
#undef PG8_MMA
#undef PG8_WAIT_V
#undef PG8_WAIT_L
#undef PG8_BAR
#undef PG8_SCHED
}
}
#define GAS __attribute__((address_space(1)))
#define LAS __attribute__((address_space(3)))
typedef unsigned short bf16;
typedef unsigned v4u __attribute__((ext_vector_type(4)));
typedef float f32x4 __attribute__((ext_vector_type(4)));
typedef short bf16x8 __attribute__((ext_vector_type(8)));
typedef GAS unsigned gu32;
typedef GAS unsigned long long gu64;
#define RLX_AGENT __ATOMIC_RELAXED, __HIP_MEMORY_SCOPE_AGENT
#define LDS_WAIT() asm volatile("s_waitcnt lgkmcnt(0)" ::: "memory")
#define VM_WAIT() asm volatile("s_waitcnt vmcnt(0)" ::: "memory")
__device__ __forceinline__ unsigned long long rt() { return __builtin_amdgcn_s_memrealtime(); }
__device__ __forceinline__ unsigned f2bf(float f) { unsigned u = __builtin_bit_cast(unsigned, f); return (u + 0x7fffu + ((u >> 16) & 1u)) >> 16; }
__device__ __forceinline__ unsigned pk2(float lo, float hi) { return f2bf(lo) | (f2bf(hi) << 16); }

#define XB_TMO      128
#define XB_XCNT(j)  (256  + 64 * (j))
#define XB_XSUB(j)  (1280 + 64 * (j))
#define XB_XGEN(j)  (2304 + 64 * (j))
#define XB_TOP      3328
#define XB_TOPGEN   3392
#define XCD_BAR_WORDS 3456
#define XB_SPIN_CAP (1u << 18)

__device__ __forceinline__ unsigned xb_ld(unsigned* p)              { return __hip_atomic_load(p, __ATOMIC_RELAXED, __HIP_MEMORY_SCOPE_AGENT); }
__device__ __forceinline__ unsigned xb_add(unsigned* p, unsigned v) { return __hip_atomic_fetch_add(p, v, __ATOMIC_RELAXED, __HIP_MEMORY_SCOPE_AGENT); }
__device__ __forceinline__ unsigned xb_xcc_id() { return (unsigned)__builtin_amdgcn_s_getreg((3 << 11) | 20) & 0xFu; }
#define XB_SPIN(cond, bar) do { unsigned _sp = 0; while (cond) { __builtin_amdgcn_s_sleep(1); \
    if ((++_sp & 255u) == 0u) { if (xb_ld(&(bar)[XB_TMO])) break; if (_sp > XB_SPIN_CAP) { atomicAdd(&(bar)[XB_TMO], 1u); break; } } } } while (0)

struct XcdBarrier {
    unsigned* bar; unsigned x;
    volatile LAS unsigned* st;
};

__device__ __forceinline__ XcdBarrier xcd_barrier_post(unsigned* bar, volatile LAS unsigned* st) {
    XcdBarrier b; b.bar = bar; b.x = xb_xcc_id(); b.st = st;
    if (threadIdx.x == 0) (void)xb_add(&bar[XB_XCNT(b.x)], 1u);
    return b;
}
__device__ __forceinline__ void xcd_barrier_complete(unsigned* bar, unsigned x, unsigned& nloc, unsigned& nx) {
    const unsigned G = gridDim.x * gridDim.y * gridDim.z;
    unsigned sum, cnt, mine, sp = 0u;
    for (;;) {
        sum = 0u; cnt = 0u; mine = 0u;
#pragma unroll
        for (unsigned j = 0; j < 16; ++j) { const unsigned c = xb_ld(&bar[XB_XCNT(j)]); sum += c; cnt += (c > 0u) ? 1u : 0u; mine = (j == x) ? c : mine; }
        if (sum == G) break;
        __builtin_amdgcn_s_sleep(1);
        if ((++sp & 255u) == 0u) { if (xb_ld(&bar[XB_TMO])) break; if (sp > XB_SPIN_CAP) { atomicAdd(&bar[XB_TMO], 1u); break; } }
    }
    nloc = mine > 0u ? mine : 1u; nx = cnt > 0u ? cnt : 1u;
}

__device__ __forceinline__ void xcd_barrier(const XcdBarrier& b) {
    asm volatile("s_waitcnt vmcnt(0)" ::: "memory");
    __syncthreads();
    if (threadIdx.x == 0) {
        unsigned* bar = b.bar;
        __builtin_amdgcn_s_waitcnt(0);
        unsigned nloc = b.st[0], nx = b.st[1];
        if (nloc == 0u) { xcd_barrier_complete(bar, b.x, nloc, nx); b.st[0] = nloc; b.st[1] = nx; }
        const unsigned old = xb_add(&bar[XB_XSUB(b.x)], 1u);
        const unsigned gen = old / nloc;
        if (old + 1u == (gen + 1u) * nloc) {
            __builtin_amdgcn_fence(__ATOMIC_RELEASE, "agent");
            asm volatile("s_waitcnt vmcnt(0)" ::: "memory");
            const unsigned og = xb_add(&bar[XB_TOP], 1u);
            const unsigned tg = og / nx;
            if (og + 1u == (tg + 1u) * nx) xb_add(&bar[XB_TOPGEN], 1u);
            else XB_SPIN(xb_ld(&bar[XB_TOPGEN]) == tg, bar);
            __builtin_amdgcn_fence(__ATOMIC_ACQUIRE, "agent");
            xb_add(&bar[XB_XGEN(b.x)], 1u);
            asm volatile("s_waitcnt vmcnt(0)" ::: "memory");
        } else {
            XB_SPIN(xb_ld(&bar[XB_XGEN(b.x)]) == gen, bar);
            __builtin_amdgcn_fence(__ATOMIC_ACQUIRE, "agent");
            asm volatile("s_waitcnt vmcnt(0)" ::: "memory");
        }
    }
    __syncthreads();
}
constexpr int NWAVES = 8;
constexpr int BATCH = 8, SEQ = 2048, D = 1024, T = BATCH * SEQ, DEPTH = 4;
constexpr int NH = 8, HD = 64, AW = 512, PW = 256, CW = 256, INC = 2304, CK = 31;
constexpr int FF = 2816, NE = 8, NGU = 2 * FF;
constexpr int MAXSLOT = 2 * T + NE * 256;
constexpr float RMS_EPS = 1e-6f, LN_EPS = 1e-5f;
constexpr float QSCALE = 0.125f * 1.4426950408889634f;
constexpr float W_EXIT = -150.0f;
constexpr int PQ = 0, PK = 512, PV = 1024, PPOOL = 1536, PCV = 1792, PCG = 2048;
enum { I_X = 0, I_ANG, I_WIN, I_POOLW, I_POOLS, I_CONVW, I_CONVB, I_LNG, I_LNB, I_GNG, I_WOUT, I_FNG, I_DWG, I_DWU, I_DWD, I_RW, I_MWG, I_MWU, I_MWD, I_FING, N_IN };

constexpr size_t MiB = 1u << 20;
constexpr size_t WS_CTL = 0, CTL_ZERO_BYTES = 1 * MiB;
constexpr size_t WS_TOKE = 1 * MiB, WS_TOKR = WS_TOKE + 128 * 1024, WS_TOKG = WS_TOKR + 128 * 1024, WS_TOKS = WS_TOKG + 128 * 1024;
constexpr size_t WS_WIN = 4 * MiB;
constexpr size_t WS_WOUT = 22 * MiB;
constexpr size_t WS_WGUD = 30 * MiB;
constexpr size_t WS_WDD = 52 * MiB;
constexpr size_t WS_WGUM = 64 * MiB;
constexpr size_t WS_WDM = 240 * MiB;
constexpr size_t WS_X = 328 * MiB;
constexpr size_t WS_XN = 392 * MiB;
constexpr size_t WS_P = 424 * MiB;
constexpr size_t WS_O = 496 * MiB;
constexpr size_t WS_ACT = 424 * MiB;
constexpr size_t WS_AP = 611 * MiB;
constexpr size_t WS_END = 679 * MiB;
static_assert(WS_WIN + (size_t)4 * INC * D * 2 <= WS_WOUT && WS_WOUT + (size_t)4 * D * D * 2 <= WS_WGUD && WS_WGUD + (size_t)2 * NGU * D * 2 <= WS_WDD && WS_WDD + (size_t)2 * D * FF * 2 <= WS_WGUM, "ws map 1");
static_assert(WS_WGUM + (size_t)16 * NGU * D * 2 <= WS_WDM && WS_WDM + (size_t)16 * D * FF * 2 <= WS_X && WS_X + (size_t)T * D * 4 <= WS_XN && WS_XN + (size_t)T * D * 2 <= WS_P, "ws map 2");
static_assert(WS_P + (size_t)T * INC * 2 <= WS_O && WS_O + (size_t)T * D * 2 <= WS_AP && WS_ACT + (size_t)MAXSLOT * FF * 2 <= WS_AP && WS_AP + (size_t)MAXSLOT * D * 2 <= WS_END, "ws map 3");
constexpr int CW_TMO = 0, CW_CODE = 1;
constexpr int CW_BAR = 4096;
constexpr int CW_MOE = 8192;

constexpr int RING_OFF = 0, RING_BYTES = 131072;
constexpr int LDSCTL_OFF = RING_BYTES, MISC_OFF = LDSCTL_OFF + 320;
constexpr int LDS_BYTES = 147456;
typedef unsigned u32x2 __attribute__((ext_vector_type(2)));
struct Frame {
    LAS unsigned char* lds;
    volatile LAS unsigned* MISC;
    int vcu, G;
};
__device__ __forceinline__ int opaque_tid() { int t = threadIdx.x; asm volatile("" : "+v"(t)); return t; }
#define PHASE_IDS() const int tid = opaque_tid(), lane = tid & 63, wave = __builtin_amdgcn_readfirstlane(tid >> 6); (void)tid; (void)lane; (void)wave
template <int I> __device__ __forceinline__ const float* inp() { const float* p; asm volatile("s_load_dwordx2 %0, %1, %2\n\ts_waitcnt lgkmcnt(0)" : "=&s"(p) : "s"(__builtin_amdgcn_kernarg_segment_ptr()), "n"(I * 8)); return p; }
#define INP(i) inp<(i)>()
#define OUTPTR() ((float*)const_cast<float*>(inp<N_IN>()))
#define WSPTR() ((unsigned char*)const_cast<float*>(inp<N_IN + 1>()))
#define CTLPTR() ((gu32*)WSPTR())
__device__ __forceinline__ float bf2f(bf16 b) { return __uint_as_float((unsigned)b << 16); }
__device__ __forceinline__ float bflo(unsigned w) { return __uint_as_float(w << 16); }
__device__ __forceinline__ float bfhi(unsigned w) { return __uint_as_float(w & 0xffff0000u); }
__device__ __forceinline__ float wave_sum(float v) {
#pragma unroll
    for (int o = 1; o < 64; o <<= 1) v += __shfl_xor(v, o);
    return v;
}
__device__ __forceinline__ void fail_word(unsigned code) {
    if (threadIdx.x == 0) { gu32* ctl = CTLPTR(); unsigned expect = 0u; __hip_atomic_compare_exchange_strong((unsigned*)(ctl + CW_CODE), &expect, code, __ATOMIC_RELAXED, __ATOMIC_RELAXED, __HIP_MEMORY_SCOPE_AGENT);
        __hip_atomic_store(ctl + CW_TMO, 1u, RLX_AGENT); }
}

__device__ __forceinline__ void transpose_item(const float* W, int K, int N, bf16* WT, int mode, int nscale, LAS float* scr, int item, int lane) {
    const int nblk = N / 32, kb = item / nblk, nb = item % nblk, k0 = 64 * kb, n0 = 32 * nb;
#pragma unroll 8
    for (int i = 0; i < 32; ++i) { const int kk = 2 * i + (lane >> 5); scr[kk * 33 + (lane & 31)] = W[(size_t)(k0 + kk) * N + n0 + (lane & 31)]; }
    LDS_WAIT(); asm volatile("" ::: "memory");
    const int r0 = (mode == 0) ? n0 : (256 * (n0 >> 7) + (n0 & 127) + (mode == 2 ? 128 : 0));
    const float sc = (n0 < nscale) ? QSCALE : 1.0f;
    const int c = lane & 7;
#pragma unroll
    for (int j = 0; j < 4; ++j) { const int n = (lane >> 3) + 8 * j; const LAS float* s = scr + (8 * c) * 33 + n;
        v4u o; o.x = pk2(s[0 * 33] * sc, s[1 * 33] * sc); o.y = pk2(s[2 * 33] * sc, s[3 * 33] * sc); o.z = pk2(s[4 * 33] * sc, s[5 * 33] * sc); o.w = pk2(s[6 * 33] * sc, s[7 * 33] * sc);
        *(GAS v4u*)(WT + (size_t)(r0 + n) * K + k0 + 8 * c) = o; }
    LDS_WAIT(); asm volatile("" ::: "memory");
}
__device__ __forceinline__ void p0_weights(Frame& F) {
    PHASE_IDS(); unsigned char* const ws = WSPTR();
    LAS float* scr = (LAS float*)(F.lds + RING_OFF + wave * 16384);
    const int gw = F.vcu * NWAVES + wave, NGW = F.G * NWAVES;
    constexpr int I_IN = (D / 64) * (INC / 32), I_OUT = (D / 64) * (D / 32), I_GU = (D / 64) * (FF / 32), I_DN = (FF / 64) * (D / 32);
    constexpr int N0 = 4 * I_IN, N1 = N0 + 4 * I_OUT, N2 = N1 + 2 * I_GU, N3 = N2 + 2 * I_GU, N4 = N3 + 2 * I_DN, N5 = N4 + 16 * I_GU, N6 = N5 + 16 * I_GU, N7 = N6 + 16 * I_DN;
    bf16* const win = (bf16*)(ws + WS_WIN); bf16* const wout = (bf16*)(ws + WS_WOUT); bf16* const wgud = (bf16*)(ws + WS_WGUD); bf16* const wdd = (bf16*)(ws + WS_WDD);
    bf16* const wgum = (bf16*)(ws + WS_WGUM); bf16* const wdm = (bf16*)(ws + WS_WDM);
    for (int it = gw; it < N7; it += NGW) {
        if (it < N0) { const int l = it / I_IN, r = it % I_IN; transpose_item(INP(I_WIN) + (size_t)l * D * INC, D, INC, win + (size_t)l * INC * D, 0, 512, scr, r, lane); }
        else if (it < N1) { const int q = it - N0, l = q / I_OUT, r = q % I_OUT; transpose_item(INP(I_WOUT) + (size_t)l * D * D, D, D, wout + (size_t)l * D * D, 0, 0, scr, r, lane); }
        else if (it < N2) { const int q = it - N1, l = q / I_GU, r = q % I_GU; transpose_item(INP(I_DWG) + (size_t)l * D * FF, D, FF, wgud + (size_t)l * NGU * D, 1, 0, scr, r, lane); }
        else if (it < N3) { const int q = it - N2, l = q / I_GU, r = q % I_GU; transpose_item(INP(I_DWU) + (size_t)l * D * FF, D, FF, wgud + (size_t)l * NGU * D, 2, 0, scr, r, lane); }
        else if (it < N4) { const int q = it - N3, l = q / I_DN, r = q % I_DN; transpose_item(INP(I_DWD) + (size_t)l * FF * D, FF, D, wdd + (size_t)l * D * FF, 0, 0, scr, r, lane); }
        else if (it < N5) { const int q = it - N4, l = q / I_GU, r = q % I_GU; transpose_item(INP(I_MWG) + (size_t)l * D * FF, D, FF, wgum + (size_t)l * NGU * D, 1, 0, scr, r, lane); }
        else if (it < N6) { const int q = it - N5, l = q / I_GU, r = q % I_GU; transpose_item(INP(I_MWU) + (size_t)l * D * FF, D, FF, wgum + (size_t)l * NGU * D, 2, 0, scr, r, lane); }
        else { const int q = it - N6, l = q / I_DN, r = q % I_DN; transpose_item(INP(I_MWD) + (size_t)l * FF * D, FF, D, wdm + (size_t)l * D * FF, 0, 0, scr, r, lane); }
    }
}

struct RowArgs { const float* xsrc; float* xws; const float* gain; bf16* xn; float* out; const bf16* yp; const float* wr; gu32* gcur;
                 int* tok_e; int* tok_r; float* tok_g; const int* tok_s; };
template <int MODE>
__device__ __forceinline__ void row_phase(Frame& F, const RowArgs& A) {
    constexpr bool COMBINE = MODE & 1, ROUTER = (MODE & 2) != 0, FINAL = (MODE & 4) != 0, COPYIN = (MODE & 8) != 0;
    LAS int* s_cnt = (LAS int*)(F.lds + RING_OFF);
    LAS int* s_base = s_cnt + 8;
    LAS int* s_e = s_cnt + 16;
    LAS int* s_rk = s_e + 128;
    LAS float* s_g = (LAS float*)(s_rk + 128);
    PHASE_IDS();
    if (ROUTER) { if (tid < 16) s_cnt[tid] = 0; __syncthreads(); }
#pragma unroll 1
    for (int i = 0; i < 8; ++i) {
        const int rl = wave * 8 + i, m = F.vcu * 64 + rl;
        const GAS f32x4* xr = (const GAS f32x4*)(A.xsrc + (size_t)m * D) + lane;
        f32x4 v[4];
#pragma unroll
        for (int j = 0; j < 4; ++j) v[j] = xr[64 * j];
        if (COMBINE) {
            const int s0 = A.tok_s[2 * m], s1 = A.tok_s[2 * m + 1]; const float g0 = A.tok_g[2 * m], g1 = A.tok_g[2 * m + 1];
            const GAS u32x2* y0 = (const GAS u32x2*)(A.yp + (size_t)s0 * D) + lane; const GAS u32x2* y1 = (const GAS u32x2*)(A.yp + (size_t)s1 * D) + lane;
#pragma unroll
            for (int j = 0; j < 4; ++j) { const u32x2 a = y0[64 * j], b = y1[64 * j];
                v[j].x += g0 * bflo(a.x) + g1 * bflo(b.x); v[j].y += g0 * bfhi(a.x) + g1 * bfhi(b.x); v[j].z += g0 * bflo(a.y) + g1 * bflo(b.y); v[j].w += g0 * bfhi(a.y) + g1 * bfhi(b.y); }
        }
        if (COMBINE || COPYIN) { GAS f32x4* xw = (GAS f32x4*)(A.xws + (size_t)m * D) + lane;
#pragma unroll
            for (int j = 0; j < 4; ++j) xw[64 * j] = v[j]; }
        float ss = 0.f;
#pragma unroll
        for (int j = 0; j < 4; ++j) ss += (v[j].x * v[j].x + v[j].y * v[j].y) + (v[j].z * v[j].z + v[j].w * v[j].w);
        const float rstd = 1.0f / sqrtf(wave_sum(ss) * (1.0f / D) + RMS_EPS);
        const GAS f32x4* gr = (const GAS f32x4*)A.gain + lane;
#pragma unroll
        for (int j = 0; j < 4; ++j) v[j] = v[j] * rstd * gr[64 * j];
        if (FINAL) { GAS f32x4* o = (GAS f32x4*)(A.out + (size_t)m * D) + lane;
#pragma unroll
            for (int j = 0; j < 4; ++j) o[64 * j] = v[j]; }
        else { GAS u32x2* o = (GAS u32x2*)(A.xn + (size_t)m * D) + lane;
#pragma unroll
            for (int j = 0; j < 4; ++j) o[64 * j] = (u32x2){pk2(v[j].x, v[j].y), pk2(v[j].z, v[j].w)}; }
        if (ROUTER) {
            float lg[8];
#pragma unroll
            for (int e = 0; e < 8; ++e) lg[e] = 0.f;
#pragma unroll
            for (int j = 0; j < 4; ++j)
#pragma unroll
                for (int q = 0; q < 4; ++q) { const GAS f32x4* w = (const GAS f32x4*)(A.wr + (size_t)(256 * j + 4 * lane + q) * 8); const f32x4 w0 = w[0], w1 = w[1]; const float h = v[j][q];
                    lg[0] += h * w0.x; lg[1] += h * w0.y; lg[2] += h * w0.z; lg[3] += h * w0.w; lg[4] += h * w1.x; lg[5] += h * w1.y; lg[6] += h * w1.z; lg[7] += h * w1.w; }
#pragma unroll
            for (int e = 0; e < 8; ++e) lg[e] = wave_sum(lg[e]);
            int e1 = 0; float v1 = lg[0];
#pragma unroll
            for (int e = 1; e < 8; ++e) if (lg[e] > v1) { v1 = lg[e]; e1 = e; }
            int e2 = -1; float v2 = -INFINITY;
#pragma unroll
            for (int e = 0; e < 8; ++e) if (e != e1 && (e2 < 0 || lg[e] > v2)) { v2 = lg[e]; e2 = e; }
            const float g1 = 1.0f / (1.0f + __expf(v2 - v1)), g2 = 1.0f - g1;
            if (lane == 0) { const int r1 = atomicAdd((int*)(s_cnt + e1), 1), r2 = atomicAdd((int*)(s_cnt + e2), 1);
                s_e[2 * rl] = e1; s_e[2 * rl + 1] = e2; s_rk[2 * rl] = r1; s_rk[2 * rl + 1] = r2; s_g[2 * rl] = g1; s_g[2 * rl + 1] = g2; }
        }
    }
    if (ROUTER) {
        __syncthreads();
        if (tid < 8) s_base[tid] = (int)__hip_atomic_fetch_add(A.gcur + 64 * tid, (unsigned)s_cnt[tid], RLX_AGENT);
        __syncthreads();
        if (tid < 128) { const int m2 = F.vcu * 128 + tid; const int e = s_e[tid]; A.tok_e[m2] = e; A.tok_r[m2] = s_base[e] + s_rk[tid]; A.tok_g[m2] = s_g[tid]; }
        __syncthreads();
    }
}

__device__ __forceinline__ void load_toff(gu32* gcur, int (&cnt)[8], int (&toff)[9]) {
    toff[0] = 0;
#pragma unroll
    for (int e = 0; e < 8; ++e) { cnt[e] = (int)__builtin_amdgcn_readfirstlane(__hip_atomic_load(gcur + 64 * e, RLX_AGENT)); toff[e + 1] = toff[e] + ((cnt[e] + 255) >> 8); }
}
__device__ __forceinline__ void gather_phase(Frame& F, gu32* gcur, const bf16* xn, bf16* ap, const int* tok_e, const int* tok_r, int* tok_s) {
    PHASE_IDS();
    int cnt[8], toff[9]; load_toff(gcur, cnt, toff);
#pragma unroll 1
    for (int i = 0; i < 8; ++i) {
        const int m = F.vcu * 64 + wave * 8 + i;
        const GAS v4u* src = (const GAS v4u*)(xn + (size_t)m * D) + lane; const v4u a = src[0], b = src[64];
#pragma unroll
        for (int k = 0; k < 2; ++k) {
            const int e = tok_e[2 * m + k], r = tok_r[2 * m + k];
            int base = 0;
#pragma unroll
            for (int q = 0; q < 8; ++q) base = (e == q) ? toff[q] : base;
            const int slot = base * 256 + r;
            if (lane == 0) tok_s[2 * m + k] = slot;
            GAS v4u* dst = (GAS v4u*)(ap + (size_t)slot * D) + lane; dst[0] = a; dst[64] = b;
        }
    }
    const int gw = F.vcu * NWAVES + wave, NGW = F.G * NWAVES;
#pragma unroll
    for (int e = 0; e < 8; ++e) {
        for (int r = toff[e] * 256 + cnt[e] + gw; r < toff[e + 1] * 256; r += NGW) { GAS v4u* dst = (GAS v4u*)(ap + (size_t)r * D) + lane; dst[0] = (v4u){0u, 0u, 0u, 0u}; dst[64] = (v4u){0u, 0u, 0u, 0u}; }
    }
}

__device__ __forceinline__ void attn_simple(Frame& F, const bf16* P, bf16* O, const float* ga) {
    PHASE_IDS();
    const int gw = F.vcu * NWAVES + wave, NGW = F.G * NWAVES;
    for (int tg = gw; tg < T / 8; tg += NGW) {
        const int h = lane & 7, tl = lane >> 3, row = tg * 8 + tl, s = row % SEQ;
        float q[64], o[64];
        { const v4u* qp = (const v4u*)(P + (size_t)row * INC + PQ + h * 64);
#pragma unroll
          for (int i = 0; i < 8; ++i) { const v4u w = qp[i]; q[8 * i] = bflo(w.x); q[8 * i + 1] = bfhi(w.x); q[8 * i + 2] = bflo(w.y); q[8 * i + 3] = bfhi(w.y); q[8 * i + 4] = bflo(w.z); q[8 * i + 5] = bfhi(w.z); q[8 * i + 6] = bflo(w.w); q[8 * i + 7] = bfhi(w.w); } }
#pragma unroll
        for (int d = 0; d < 64; ++d) o[d] = 0.f;
        float carry = 0.f;
        for (int j = s - 1; j >= 0; --j) {
            const v4u* kp = (const v4u*)(P + (size_t)(row - s + j) * INC + PK + h * 64); const v4u* vp = (const v4u*)(P + (size_t)(row - s + j) * INC + PV + h * 64);
            float z = 0.f;
#pragma unroll
            for (int i = 0; i < 8; ++i) { const v4u w = kp[i];
                z += q[8 * i] * bflo(w.x) + q[8 * i + 1] * bfhi(w.x) + q[8 * i + 2] * bflo(w.y) + q[8 * i + 3] * bfhi(w.y) + q[8 * i + 4] * bflo(w.z) + q[8 * i + 5] * bfhi(w.z) + q[8 * i + 6] * bflo(w.w) + q[8 * i + 7] * bfhi(w.w); }
            const float sp = fmaxf(z, 0.f) + __builtin_amdgcn_logf(1.0f + __builtin_amdgcn_exp2f(-fabsf(z)));
            carry -= sp;
            const float w = __builtin_amdgcn_exp2f(z + carry);
#pragma unroll
            for (int i = 0; i < 8; ++i) { const v4u x = vp[i];
                o[8 * i] += w * bflo(x.x); o[8 * i + 1] += w * bfhi(x.x); o[8 * i + 2] += w * bflo(x.y); o[8 * i + 3] += w * bfhi(x.y); o[8 * i + 4] += w * bflo(x.z); o[8 * i + 5] += w * bfhi(x.z); o[8 * i + 6] += w * bflo(x.w); o[8 * i + 7] += w * bfhi(x.w); }
            if (carry < W_EXIT) break;
        }
        float ss = 0.f;
#pragma unroll
        for (int d = 0; d < 64; ++d) ss += o[d] * o[d];
        ss += __shfl_xor(ss, 1); ss += __shfl_xor(ss, 2); ss += __shfl_xor(ss, 4);
        const float rstd = 1.0f / sqrtf(ss * (1.0f / AW) + RMS_EPS);
        const f32x4* gp = (const f32x4*)(ga + h * 64); v4u* op = (v4u*)(O + (size_t)row * D + h * 64);
#pragma unroll
        for (int i = 0; i < 8; ++i) { const f32x4 g0 = gp[2 * i], g1 = gp[2 * i + 1]; v4u w;
            w.x = pk2(o[8 * i] * rstd * g0.x, o[8 * i + 1] * rstd * g0.y); w.y = pk2(o[8 * i + 2] * rstd * g0.z, o[8 * i + 3] * rstd * g0.w);
            w.z = pk2(o[8 * i + 4] * rstd * g1.x, o[8 * i + 5] * rstd * g1.y); w.w = pk2(o[8 * i + 6] * rstd * g1.z, o[8 * i + 7] * rstd * g1.w); op[i] = w; }
    }
}
struct PcArgs { const bf16* P; bf16* O; const float* poolw; const float* pools; const float* convw; const float* convb; const float* lng; const float* lnb; const float* gng; };
__device__ __forceinline__ void poolconv_phase(Frame& F, const PcArgs& A) {
    LAS float* ybuf = (LAS float*)(F.lds + RING_OFF);
    LAS float* obuf = ybuf + 32 * 256;
    LAS float* ubuf = obuf + 32 * 256;
    PHASE_IDS();
    const bf16* P = A.P;
    for (int u = F.vcu; u < T / 32; u += F.G) {
        const int row0 = u * 32, s0 = row0 % SEQ;
        { const int ch = tid & 255, g = ch >> 6, win = 2 << g;
#pragma unroll 1
          for (int i = 0; i < 16; ++i) { const int tl = (tid >> 8) + 2 * i, s = s0 + tl, cnt = (s + 1 < win) ? s + 1 : win;
              float sum = 0.f; for (int k = 0; k < cnt; ++k) sum += bf2f(P[(size_t)(row0 + tl - k) * INC + PPOOL + ch]);
              ybuf[tl * 256 + ch] = sum / (float)cnt - bf2f(P[(size_t)(row0 + tl) * INC + PPOOL + ch]); }
#pragma unroll 1
          for (int rr = (tid >> 8); rr < 62; rr += 2) { const int s = s0 - 30 + rr; float uv = 0.f;
              if (s >= 0) { const size_t r = (size_t)(row0 - 30 + rr) * INC; const float val = bf2f(P[r + PCV + ch]), gt = bf2f(P[r + PCG + ch]); uv = val / (1.0f + __expf(-gt)); }
              ubuf[rr * 256 + ch] = uv; } }
        __syncthreads();
        { const int col = tid & 255, g = col >> 6, d = col & 63; float acc[16];
#pragma unroll
          for (int i = 0; i < 16; ++i) acc[i] = 0.f;
          const float* wp = A.poolw + (size_t)g * 64 * 64 + d;
#pragma unroll 4
          for (int c = 0; c < 64; ++c) { const float w = wp[c * 64];
#pragma unroll
              for (int i = 0; i < 16; ++i) acc[i] += ybuf[((tid >> 8) + 2 * i) * 256 + g * 64 + c] * w; }
          const float ps = A.pools[col];
#pragma unroll
          for (int i = 0; i < 16; ++i) obuf[((tid >> 8) + 2 * i) * 256 + col] = acc[i] * ps; }
        __syncthreads();
        { const f32x4 gb = *(const f32x4*)(A.gng + AW + 4 * lane);
#pragma unroll
          for (int tk = 0; tk < 4; ++tk) { const int tl = 4 * wave + tk; const f32x4 v = *(const LAS f32x4*)(obuf + tl * 256 + 4 * lane);
              const float ss = wave_sum((v.x * v.x + v.y * v.y) + (v.z * v.z + v.w * v.w)); const float rstd = 1.0f / sqrtf(ss * (1.0f / PW) + RMS_EPS);
              *(u32x2*)(A.O + (size_t)(row0 + tl) * D + AW + 4 * lane) = (u32x2){pk2(v.x * rstd * gb.x, v.y * rstd * gb.y), pk2(v.z * rstd * gb.z, v.w * rstd * gb.w)}; } }
        { f32x4 acc[4]; const f32x4 cb = *(const f32x4*)(A.convb + 4 * lane);
#pragma unroll
          for (int tk = 0; tk < 4; ++tk) acc[tk] = cb;
#pragma unroll 1
          for (int j = 0; j < CK; ++j) { const f32x4 w4 = *(const f32x4*)(A.convw + (size_t)j * CW + 4 * lane);
#pragma unroll
              for (int tk = 0; tk < 4; ++tk) { const f32x4 u4 = *(const LAS f32x4*)(ubuf + (4 * wave + tk + j) * 256 + 4 * lane); acc[tk] += w4 * u4; } }
          const f32x4 lg = *(const f32x4*)(A.lng + 4 * lane), lb = *(const f32x4*)(A.lnb + 4 * lane), gc = *(const f32x4*)(A.gng + AW + PW + 4 * lane);
#pragma unroll
          for (int tk = 0; tk < 4; ++tk) { const int tl = 4 * wave + tk; f32x4 v = acc[tk];
              const float mean = wave_sum((v.x + v.y) + (v.z + v.w)) * (1.0f / CW); v = v - mean;
              const float var = wave_sum((v.x * v.x + v.y * v.y) + (v.z * v.z + v.w * v.w)) * (1.0f / CW); const float rs = 1.0f / sqrtf(var + LN_EPS);
              v = v * rs * lg + lb;
              v.x = v.x / (1.0f + __expf(-v.x)); v.y = v.y / (1.0f + __expf(-v.y)); v.z = v.z / (1.0f + __expf(-v.z)); v.w = v.w / (1.0f + __expf(-v.w));
              const float ss = wave_sum((v.x * v.x + v.y * v.y) + (v.z * v.z + v.w * v.w)); const float rstd = 1.0f / sqrtf(ss * (1.0f / CW) + RMS_EPS);
              *(u32x2*)(A.O + (size_t)(row0 + tl) * D + AW + PW + 4 * lane) = (u32x2){pk2(v.x * rstd * gc.x, v.y * rstd * gc.y), pk2(v.z * rstd * gc.z, v.w * rstd * gc.w)}; } }
        __syncthreads();
    }
}
constexpr int NPH = 1 + 8 * DEPTH;
struct Args { const float* in[N_IN]; float* out; unsigned char* ws; int ph_lo, ph_hi; };
__global__ void __launch_bounds__(NWAVES * 64, 2) fwd(Args args) {
    extern __shared__ __attribute__((aligned(16))) unsigned char lds[];
    Frame F;
    F.lds = (LAS unsigned char*)lds;
    F.MISC = (volatile LAS unsigned*)(F.lds + MISC_OFF);
    F.G = gridDim.x; { const int bx = blockIdx.x; F.vcu = (F.G % 8 == 0) ? (bx % 8) * (F.G / 8) + bx / 8 : bx; }
    for (int u = threadIdx.x; u < (LDS_BYTES - LDSCTL_OFF) / 4; u += NWAVES * 64) ((LAS unsigned*)(F.lds + LDSCTL_OFF))[u] = 0u;
    __syncthreads();
    const int lo = args.ph_lo, hi = args.ph_hi;
    XcdBarrier bar; bar.bar = (unsigned*)(CTLPTR() + CW_BAR); bar.x = 0; bar.st = nullptr;
    if (hi - lo > 1) bar = xcd_barrier_post((unsigned*)(CTLPTR() + CW_BAR), F.MISC + 8);
#define IN(k) (lo <= (k) && (k) < hi)
#define SEAM(k) do { if ((k) + 1 < hi) xcd_barrier(bar); } while (0)
#define X ((float*)(ws + WS_X))
#define XN ((bf16*)(ws + WS_XN))
#define P ((bf16*)(ws + WS_P))
#define O ((bf16*)(ws + WS_O))
#define ACT ((bf16*)(ws + WS_ACT))
#define AP ((bf16*)(ws + WS_AP))
#define TOK_E ((int*)(ws + WS_TOKE))
#define TOK_R ((int*)(ws + WS_TOKR))
#define TOK_G ((float*)(ws + WS_TOKG))
#define TOK_S ((int*)(ws + WS_TOKS))
    if (F.G != 256) { fail_word(0x7f0u); return; }

    if (IN(0)) {
        unsigned char* const ws = WSPTR();
        p0_weights(F);
        RowArgs A{}; A.xsrc = INP(I_X); A.xws = X; A.gain = INP(I_ANG); A.xn = XN;
        row_phase<8>(F, A);
        SEAM(0);
    }
#pragma unroll 1
    for (int l = 0; l < DEPTH; ++l) {
        const int pb = 1 + 8 * l, li = l >> 1; const bool moe = (l & 1) != 0;
        if (IN(pb + 0)) {
            unsigned char* const ws = WSPTR();
            pg8::Gemm g{XN, (const bf16*)(ws + WS_WIN) + (size_t)l * INC * D, T, INC, D, 0}; pg8::StaticOrder S; S.init(T, INC, F.G, (int)blockIdx.x);
            pg8::EpiBf16<0> E{P, INC, nullptr, 0, 0, 1.f};
            pg8::gemm_phase<pg8::EpiBf16<0>, pg8::StaticOrder, true, true>(F.lds + RING_OFF, g, S, E);
            SEAM(pb + 0);
        }
        if (IN(pb + 1)) {
            unsigned char* const ws = WSPTR();
            attn_simple(F, P, O, INP(I_GNG) + (size_t)l * D);
            PcArgs A{P, O, INP(I_POOLW) + (size_t)l * 4 * 64 * 64, INP(I_POOLS) + (size_t)l * PW, INP(I_CONVW) + (size_t)l * CK * CW, INP(I_CONVB) + (size_t)l * CW,
                     INP(I_LNG) + (size_t)l * CW, INP(I_LNB) + (size_t)l * CW, INP(I_GNG) + (size_t)l * D};
            poolconv_phase(F, A);
            SEAM(pb + 1);
        }
        if (IN(pb + 2)) {
            unsigned char* const ws = WSPTR();
            pg8::Gemm g{O, (const bf16*)(ws + WS_WOUT) + (size_t)l * D * D, T, D, D, 0}; pg8::StaticOrder S; S.init(T, D, F.G, (int)blockIdx.x);
            pg8::EpiResid E{X, D};
            pg8::gemm_phase<pg8::EpiResid, pg8::StaticOrder, true, true>(F.lds + RING_OFF, g, S, E);
            SEAM(pb + 2);
        }
        if (IN(pb + 3)) {
            unsigned char* const ws = WSPTR();
            RowArgs A{}; A.xsrc = X; A.xws = X; A.gain = INP(I_FNG) + (size_t)l * D; A.xn = XN;
            if (moe) { A.wr = INP(I_RW) + (size_t)li * D * NE; A.gcur = CTLPTR() + CW_MOE + li * 1024; A.tok_e = TOK_E; A.tok_r = TOK_R; A.tok_g = TOK_G; row_phase<2>(F, A); }
            else row_phase<0>(F, A);
            SEAM(pb + 3);
        }
        if (moe) {
            if (IN(pb + 4)) { unsigned char* const ws = WSPTR(); gu32* const gcur = CTLPTR() + CW_MOE + li * 1024; gather_phase(F, gcur, XN, AP, TOK_E, TOK_R, TOK_S); SEAM(pb + 4); }
            if (IN(pb + 5)) {
                unsigned char* const ws = WSPTR(); gu32* const gcur = CTLPTR() + CW_MOE + li * 1024;
                int cnt[8], toff[9]; load_toff(gcur, cnt, toff);
                pg8::Gemm g{AP, (const bf16*)(ws + WS_WGUM) + (size_t)li * NE * NGU * D, 0, NGU, D, (size_t)NGU * D * 2}; pg8::GroupedOrder S; S.init(toff, NGU, F.G, (int)blockIdx.x);
                pg8::EpiSwiGLU E{ACT, FF};
                pg8::gemm_phase<pg8::EpiSwiGLU, pg8::GroupedOrder, true, true>(F.lds + RING_OFF, g, S, E);
                SEAM(pb + 5);
            }
            if (IN(pb + 6)) {
                unsigned char* const ws = WSPTR(); gu32* const gcur = CTLPTR() + CW_MOE + li * 1024;
                int cnt[8], toff[9]; load_toff(gcur, cnt, toff);
                pg8::Gemm g{ACT, (const bf16*)(ws + WS_WDM) + (size_t)li * NE * D * FF, 0, D, FF, (size_t)D * FF * 2}; pg8::GroupedOrder S; S.init(toff, D, F.G, (int)blockIdx.x);
                pg8::EpiBf16<0> E{AP, D, nullptr, 0, 0, 1.f};
                pg8::gemm_phase<pg8::EpiBf16<0>, pg8::GroupedOrder, true, true>(F.lds + RING_OFF, g, S, E);
                SEAM(pb + 6);
            }
        } else {
            if (IN(pb + 5)) {
                unsigned char* const ws = WSPTR();
                pg8::Gemm g{XN, (const bf16*)(ws + WS_WGUD) + (size_t)li * NGU * D, T, NGU, D, 0}; pg8::StaticOrder S; S.init(T, NGU, F.G, (int)blockIdx.x);
                pg8::EpiSwiGLU E{ACT, FF};
                pg8::gemm_phase<pg8::EpiSwiGLU, pg8::StaticOrder, true, true>(F.lds + RING_OFF, g, S, E);
                SEAM(pb + 5);
            }
            if (IN(pb + 6)) {
                unsigned char* const ws = WSPTR();
                pg8::Gemm g{ACT, (const bf16*)(ws + WS_WDD) + (size_t)li * D * FF, T, D, FF, 0}; pg8::StaticOrder S; S.init(T, D, F.G, (int)blockIdx.x);
                pg8::EpiResid E{X, D};
                pg8::gemm_phase<pg8::EpiResid, pg8::StaticOrder, true, true>(F.lds + RING_OFF, g, S, E);
                SEAM(pb + 6);
            }
        }
        if (IN(pb + 7)) {
            unsigned char* const ws = WSPTR();
            RowArgs A{}; A.xsrc = X; A.xws = X; A.xn = XN; A.out = OUTPTR(); A.yp = AP; A.tok_g = TOK_G; A.tok_s = TOK_S;
            A.gain = (l == DEPTH - 1) ? INP(I_FING) : INP(I_ANG) + (size_t)(l + 1) * D;
            if (l == DEPTH - 1) row_phase<5>(F, A);
            else if (moe) row_phase<1>(F, A);
            else row_phase<0>(F, A);
            SEAM(pb + 7);
        }
    }
#undef IN
#undef SEAM
#undef X
#undef XN
#undef P
#undef O
#undef ACT
#undef AP
#undef TOK_E
#undef TOK_R
#undef TOK_G
#undef TOK_S
}

#ifndef MK_ONE_LAUNCH
#define MK_ONE_LAUNCH 0
#endif
extern "C" void kernel_launch(void* const* d_in, const int* in_sizes, int n_in, void* d_out, int out_size, void* d_ws, size_t ws_size, hipStream_t stream) {
    static int grid = 0;
    if (grid == 0) {
        if (n_in != N_IN || in_sizes[0] != T * D || out_size != T * D || ws_size < WS_END) { fprintf(stderr, "kernel_launch: unexpected problem shape (n_in %d, in0 %d, out %d, ws %zu); nothing launched\n", n_in, n_in > 0 ? in_sizes[0] : -1, out_size, ws_size); grid = -1; return; }
        if (hipFuncSetAttribute((const void*)fwd, hipFuncAttributeMaxDynamicSharedMemorySize, LDS_BYTES) != hipSuccess) { fprintf(stderr, "kernel_launch: hipFuncSetAttribute failed; nothing launched\n"); grid = -1; return; }
        int per_cu = 0;
        if (hipOccupancyMaxActiveBlocksPerMultiprocessor(&per_cu, (const void*)fwd, NWAVES * 64, LDS_BYTES) != hipSuccess || per_cu < 1)
            fprintf(stderr, "kernel_launch: note: occupancy query reports %d workgroups per CU\n", per_cu);
        (void)hipGetLastError();
        grid = 256;
    }
    if (grid < 0) return;
    if (hipMemsetAsync((char*)d_ws + WS_CTL, 0, CTL_ZERO_BYTES, stream) != hipSuccess) { fprintf(stderr, "kernel_launch: hipMemsetAsync failed; nothing launched\n"); return; }
    Args a{};
    for (int i = 0; i < N_IN; ++i) a.in[i] = (const float*)d_in[i];
    a.out = (float*)d_out; a.ws = (unsigned char*)d_ws;
#if MK_ONE_LAUNCH
    a.ph_lo = 0; a.ph_hi = NPH;
    hipLaunchKernelGGL(fwd, dim3(grid), dim3(NWAVES * 64), LDS_BYTES, stream, a);
#else
    for (int p = 0; p < NPH; ++p) {
        if (p > 0 && ((p - 1) & 7) == 4 && ((((p - 1) >> 3) & 1) == 0)) continue;
        a.ph_lo = p; a.ph_hi = p + 1;
        hipLaunchKernelGGL(fwd, dim3(grid), dim3(NWAVES * 64), LDS_BYTES, stream, a);
    }
#endif
    const hipError_t le = hipPeekAtLastError();
    if (le != hipSuccess) fprintf(stderr, "kernel_launch: launch failed: %s\n", hipGetErrorName(le));
}
```

```cpp
#include <hip/hip_runtime.h>
#include <cstdio>
#include <cstdint>
#include <cmath>
#define MK_ONE_LAUNCH 1
namespace pg8 {
#define PG8_LAS __attribute__((address_space(3)))
typedef unsigned short bf16_t;
typedef short bf16x8 __attribute__((ext_vector_type(8)));
typedef float f32x4 __attribute__((ext_vector_type(4)));
typedef unsigned u32x4 __attribute__((ext_vector_type(4)));
constexpr int BM = 256, BK = 64, HALF = 128, HTB = HALF * BK * 2  , STAGE_BYTES = 8 * HTB, NXCD = 8, WGM = 8;

__host__ __device__ __forceinline__ int lds_byte(int r, int c) { const int st = (r >> 4) * 2 + (c >> 5), rr = r & 15, cc = c & 31, ob = rr * 64 + cc * 2; return st * 1024 + (ob ^ (((ob >> 9) & 1) << 5)); }
__host__ __device__ __forceinline__ void stage_rc(int b, int& R, int& C) { const int st = b / 1024, sb = b % 1024, swz = sb ^ (((sb >> 9) & 1) << 5); R = (st >> 1) * 16 + swz / 64; C = (st & 1) * 32 + (swz % 64) / 2; }
__host__ __device__ __forceinline__ int perm32(int rho) { const int n = rho >> 4, i = rho & 15; return 8 * (i >> 2) + 4 * n + (i & 3); }

struct Unit { int pm, pn, e; };
struct Gemm { const bf16_t* A; const bf16_t* Bt; int M, N, K; size_t estride; };

struct StaticOrder {
    int nM, nN, nwg, G, c;
    __host__ __device__ void init(int M, int N, int G_, int c_) { nM = M / BM; nN = N / BM; nwg = nM * nN; G = G_; c = c_; }
    __host__ __device__ bool next(int i, Unit& u) const {
        const long L = (long)i * G + c; if (L >= nwg) return false;
        int wgid = (int)L; { const int q = nwg / NXCD, r = nwg % NXCD, xcd = wgid % NXCD, off = wgid / NXCD; wgid = (xcd < r ? xcd * (q + 1) : r * (q + 1) + (xcd - r) * q) + off; }
        const int nig = WGM * nN, gid = wgid / nig, fm = gid * WGM, gsz = (nM - fm) < WGM ? (nM - fm) : WGM;
        u.pm = fm + ((wgid % nig) % gsz); u.pn = (wgid % nig) / gsz; u.e = 0; return true;
    }
    __device__ __forceinline__ void a_ready(const Unit&) const {}
    __device__ __forceinline__ void done(const Unit&) const {}
};

__device__ __forceinline__ unsigned cvt_pk_bf16(float lo, float hi) { unsigned r; asm volatile("v_cvt_pk_bf16_f32 %0, %1, %2" : "=v"(r) : "v"(lo), "v"(hi)); return r; }
typedef float f32x2 __attribute__((ext_vector_type(2)));
__device__ __forceinline__ f32x2 gelu_pk(f32x2 v) {
    const f32x2 av = __builtin_elementwise_abs(v), d = av * 0.2316418882f + 1.0f;
    f32x2 t; t.x = __builtin_amdgcn_rcpf(d.x); t.y = __builtin_amdgcn_rcpf(d.y);
    f32x2 q = t * 0.5307027145f + (-0.7265760135f); q = q * t + 0.7107068705f; q = q * t + (-0.142248368f); q = q * t + 0.127414796f; q = q * t;
    const f32x2 s = (v * v) * (-0.72134752044f);
    f32x2 e; e.x = __builtin_amdgcn_exp2f(s.x); e.y = __builtin_amdgcn_exp2f(s.y);
    const f32x2 m = v * (q * e), r = v - m;
    f32x2 o; o.x = v.x < 0.f ? m.x : r.x; o.y = v.y < 0.f ? m.y : r.y; return o;
}

template <int ACT  > struct EpiBf16 {
    static constexpr bool PERM = true, AFTER_DRAIN = false; static_assert(ACT == 0 || ACT == 1, "EpiBf16: ACT is 0 (none) or 1 (gelu_pk)");
    bf16_t* O; int ldc; const float* bias; int split_cols; size_t split_stride; float scale0;
    __device__ __forceinline__ void operator()(const f32x4 (&acc)[2][2][4][2], const Unit& u, int wr, int wc, int fr, int fq) const {
        const int row0 = u.pm * BM + wr * 64 + fr; int colt = u.pn * BM; bf16_t* base = O;
        float sc = 1.f; if (split_cols) { const int t = colt / split_cols; base += (size_t)t * split_stride; colt -= t * split_cols; if (t == 0) sc = scale0; }
        const int col0 = colt + wc * 32 + 8 * fq, bcol0 = u.pn * BM + wc * 32 + 8 * fq;
        f32x4 bv[2][2];
#pragma unroll
        for (int bj = 0; bj < 2; ++bj)
#pragma unroll
            for (int n = 0; n < 2; ++n) bv[bj][n] = bias ? *(const f32x4*)(bias + bcol0 + bj * HALF + 4 * n) : (f32x4){0.f, 0.f, 0.f, 0.f};
#pragma unroll
        for (int ai = 0; ai < 2; ++ai)
#pragma unroll
            for (int m = 0; m < 4; ++m) { bf16_t* rowp = base + (size_t)(row0 + ai * HALF + m * 16) * ldc + col0;
#pragma unroll
                for (int bj = 0; bj < 2; ++bj) { f32x4 v0 = acc[ai][bj][m][0] + bv[bj][0], v1 = acc[ai][bj][m][1] + bv[bj][1];
                    if (ACT == 1) { f32x2 a = gelu_pk((f32x2){v0[0], v0[1]}), b = gelu_pk((f32x2){v0[2], v0[3]}), c = gelu_pk((f32x2){v1[0], v1[1]}), d = gelu_pk((f32x2){v1[2], v1[3]});
                        v0 = (f32x4){a.x, a.y, b.x, b.y}; v1 = (f32x4){c.x, c.y, d.x, d.y}; }
                    v0 = v0 * sc; v1 = v1 * sc; u32x4 w; w.x = cvt_pk_bf16(v0[0], v0[1]); w.y = cvt_pk_bf16(v0[2], v0[3]); w.z = cvt_pk_bf16(v1[0], v1[1]); w.w = cvt_pk_bf16(v1[2], v1[3]);
                    *(u32x4*)(rowp + bj * HALF) = w; } }
    }
};
struct EpiResid {
    static constexpr bool PERM = false, AFTER_DRAIN = false;
    float* X; int ldc;
    __device__ __forceinline__ void operator()(const f32x4 (&acc)[2][2][4][2], const Unit& u, int wr, int wc, int fr, int fq) const {
        const int row0 = u.pm * BM + wr * 64 + fr, col0 = u.pn * BM + wc * 32 + 4 * fq;
#pragma unroll
        for (int ai = 0; ai < 2; ++ai)
#pragma unroll
            for (int m = 0; m < 4; ++m) { float* rowp = X + (size_t)(row0 + ai * HALF + m * 16) * ldc + col0;
                f32x4 old[2][2];
#pragma unroll
                for (int bj = 0; bj < 2; ++bj)
#pragma unroll
                    for (int n = 0; n < 2; ++n) old[bj][n] = *(const f32x4*)(rowp + bj * HALF + n * 16);
#pragma unroll
                for (int bj = 0; bj < 2; ++bj)
#pragma unroll
                    for (int n = 0; n < 2; ++n) *(f32x4*)(rowp + bj * HALF + n * 16) = old[bj][n] + acc[ai][bj][m][n];
                asm volatile("" ::: "memory"); }
    }
};
__device__ __forceinline__ float silu_mul(float g, float u) { return g * __builtin_amdgcn_rcpf(1.0f + __builtin_amdgcn_exp2f(g * -1.4426950408889634f)) * u; }
struct EpiSwiGLU {
    static constexpr bool PERM = true, AFTER_DRAIN = false;
    bf16_t* O; int ldc;
    __device__ __forceinline__ void operator()(const f32x4 (&acc)[2][2][4][2], const Unit& u, int wr, int wc, int fr, int fq) const {
        const int row0 = u.pm * BM + wr * 64 + fr, col0 = u.pn * HALF + wc * 32 + 8 * fq;
#pragma unroll
        for (int ai = 0; ai < 2; ++ai)
#pragma unroll
            for (int m = 0; m < 4; ++m) { bf16_t* rowp = O + (size_t)(row0 + ai * HALF + m * 16) * ldc + col0;
                const f32x4 g0 = acc[ai][0][m][0], g1 = acc[ai][0][m][1], u0 = acc[ai][1][m][0], u1 = acc[ai][1][m][1];
                u32x4 w;
                w.x = cvt_pk_bf16(silu_mul(g0[0], u0[0]), silu_mul(g0[1], u0[1])); w.y = cvt_pk_bf16(silu_mul(g0[2], u0[2]), silu_mul(g0[3], u0[3]));
                w.z = cvt_pk_bf16(silu_mul(g1[0], u1[0]), silu_mul(g1[1], u1[1])); w.w = cvt_pk_bf16(silu_mul(g1[2], u1[2]), silu_mul(g1[3], u1[3]));
                *(u32x4*)rowp = w; }
    }
};
struct GroupedOrder {
    int nM, nN, nwg, G, c; int t1, t2, t3, t4, t5, t6, t7;
    __device__ __forceinline__ void init(const int (&toff)[9], int N, int G_, int c_) { nM = toff[8]; nN = N / BM; nwg = nM * nN; G = G_; c = c_;
        t1 = toff[1]; t2 = toff[2]; t3 = toff[3]; t4 = toff[4]; t5 = toff[5]; t6 = toff[6]; t7 = toff[7]; }
    __device__ __forceinline__ bool next(int i, Unit& u) const {
        const long L = (long)i * G + c; if (L >= nwg) return false;
        int wgid = (int)L; { const int q = nwg / NXCD, r = nwg % NXCD, xcd = wgid % NXCD, off = wgid / NXCD; wgid = (xcd < r ? xcd * (q + 1) : r * (q + 1) + (xcd - r) * q) + off; }
        const int nig = WGM * nN, gid = wgid / nig, fm = gid * WGM, gsz = (nM - fm) < WGM ? (nM - fm) : WGM;
        u.pm = fm + ((wgid % nig) % gsz); u.pn = (wgid % nig) / gsz;
        u.e = (u.pm >= t1) + (u.pm >= t2) + (u.pm >= t3) + (u.pm >= t4) + (u.pm >= t5) + (u.pm >= t6) + (u.pm >= t7); return true;
    }
    __device__ __forceinline__ void a_ready(const Unit&) const {}
    __device__ __forceinline__ void done(const Unit&) const {}
};
template <class Epi, class Sched, bool ALIGN_EPI = false, bool SP2 = false>
__device__ __forceinline__ void gemm_phase(PG8_LAS unsigned char* lds, const Gemm g, const Sched& S, const Epi& E) {
    int tid_ = threadIdx.x; asm volatile("" : "+v"(tid_));
    const int tid = tid_, wid = __builtin_amdgcn_readfirstlane(tid >> 6), lane = tid & 63, wr = wid >> 2, wc = wid & 3, fr = lane & 15, fq = lane >> 4;
    const int K = g.K, nt = K / BK;
    unsigned voffA[2], voffB[2];
#pragma unroll
    for (int i = 0; i < 2; ++i) { int R, C; stage_rc(tid * 16 + i * 8192, R, C); const int Rb = Epi::PERM ? ((R & ~31) + perm32(R & 31)) : R;
        voffA[i] = (unsigned)(R * K + C) * 2u; voffB[i] = (unsigned)(Rb * K + C) * 2u; }
    const size_t kstep = (size_t)(BK * 2);
    const size_t hstep = (size_t)HALF * K * 2;
    const size_t tstep = 2 * hstep;
    const unsigned ldsw = (unsigned)wid * 1024u;
    const int aoff = lds_byte(wr * 64 + fr, fq * 8), boff = lds_byte(wc * 32 + fr, fq * 8);
#define PG8_SA(b, h) (((b) * 2 + (h)) * HTB)
#define PG8_SB(b, h) ((4 + (b) * 2 + (h)) * HTB)
#define PG8_STAGE(bufoff, gbase, voff) do { _Pragma("unroll") for (int _i = 0; _i < 2; ++_i) \
        __builtin_amdgcn_global_load_lds((const unsigned*)((const char*)(gbase) + (voff)[_i]), (PG8_LAS unsigned*)(lds + (bufoff) + ldsw + _i * 8192), 16, 0, 0); } while (0)
#define PG8_LDA(dst, b, h) do { _Pragma("unroll") for (int m = 0; m < 4; ++m) _Pragma("unroll") for (int k = 0; k < 2; ++k) dst[m][k] = *(const PG8_LAS bf16x8*)(lds + PG8_SA(b, h) + aoff + m * 2048 + k * 1024); } while (0)
#define PG8_LDB(dst, b, h) do { _Pragma("unroll") for (int n = 0; n < 2; ++n) _Pragma("unroll") for (int k = 0; k < 2; ++k) dst[n][k] = *(const PG8_LAS bf16x8*)(lds + PG8_SB(b, h) + boff + n * 2048 + k * 1024); } while (0)
#define PG8_MMA(ai, bj, At, Bt) do { __builtin_amdgcn_s_setprio(1); _Pragma("unroll") for (int m = 0; m < 4; ++m) _Pragma("unroll") for (int n = 0; n < 2; ++n) _Pragma("unroll") for (int k = 0; k < 2; ++k) \
        acc[ai][bj][m][n] = __builtin_amdgcn_mfma_f32_16x16x32_bf16(Bt[n][k], At[m][k], acc[ai][bj][m][n], 0, 0, 0); __builtin_amdgcn_s_setprio(0); } while (0)
#define PG8_WAIT_V(n) asm volatile("s_waitcnt vmcnt(" #n ")" ::: "memory")
#define PG8_WAIT_L(n) asm volatile("s_waitcnt lgkmcnt(" #n ")" ::: "memory")
#define PG8_BAR __builtin_amdgcn_s_barrier()
#define PG8_SCHED __builtin_amdgcn_sched_barrier(0)
    Unit cur, nxt; int ui = 0;
    if (!S.next(0, cur)) return;
    f32x4 acc[2][2][4][2];
#pragma unroll
    for (int a = 0; a < 2; ++a)
#pragma unroll
        for (int b = 0; b < 2; ++b)
#pragma unroll
            for (int m = 0; m < 4; ++m)
#pragma unroll
                for (int n = 0; n < 2; ++n) acc[a][b][m][n] = (f32x4){0.f, 0.f, 0.f, 0.f};
    bf16x8 At[4][2], B0[2][2], B1[2][2];
    const char* cA = (const char*)g.A + (size_t)cur.pm * tstep; const char* cB = (const char*)g.Bt + (size_t)cur.e * g.estride + (size_t)cur.pn * tstep;
    S.a_ready(cur);
    if constexpr (SP2) {
        PG8_STAGE(PG8_SB(0, 0), cB, voffB); PG8_STAGE(PG8_SB(0, 1), cB + hstep, voffB); PG8_STAGE(PG8_SA(0, 0), cA, voffA); PG8_STAGE(PG8_SA(0, 1), cA + hstep, voffA);
        if (wr == 1) PG8_BAR;
        PG8_WAIT_V(2); PG8_BAR;
        PG8_STAGE(PG8_SB(1, 0), cB + kstep, voffB); PG8_STAGE(PG8_SA(1, 0), cA + kstep, voffA); PG8_STAGE(PG8_SB(1, 1), cB + hstep + kstep, voffB);
        PG8_WAIT_V(6); PG8_BAR;
    } else {
        PG8_STAGE(PG8_SB(0, 0), cB, voffB); PG8_STAGE(PG8_SA(0, 0), cA, voffA); PG8_STAGE(PG8_SB(0, 1), cB + hstep, voffB); PG8_STAGE(PG8_SA(0, 1), cA + hstep, voffA);
        if (wr == 1) PG8_BAR;
        PG8_WAIT_V(4); PG8_BAR;
        PG8_STAGE(PG8_SB(1, 0), cB + kstep, voffB); PG8_STAGE(PG8_SA(1, 0), cA + kstep, voffA); PG8_STAGE(PG8_SB(1, 1), cB + hstep + kstep, voffB);
        PG8_WAIT_V(6); PG8_BAR;
    }
    for (;;) {
        const bool has_next = S.next(ui + 1, nxt);
        const char* nA = has_next ? (const char*)g.A + (size_t)nxt.pm * tstep : cA; const char* nB = has_next ? (const char*)g.Bt + (size_t)nxt.e * g.estride + (size_t)nxt.pn * tstep : cB;
        for (int t = 0; t < nt; t += 2) {
            const bool last = (t == nt - 2);
            const char* a1 = cA + (size_t)(t + 1) * kstep;
            const char* a2 = last ? nA : cA + (size_t)(t + 2) * kstep; const char* b2 = last ? nB : cB + (size_t)(t + 2) * kstep;
            const char* a3 = a2 + kstep; const char* b3 = b2 + kstep;
            if (last && has_next) S.a_ready(nxt);
            if constexpr (SP2) {
            PG8_LDB(B0, 0, 0); PG8_LDB(B1, 0, 1); PG8_SCHED; PG8_LDA(At, 0, 0); PG8_STAGE(PG8_SA(1, 1), a1 + hstep, voffA);
            PG8_WAIT_V(8); PG8_WAIT_L(0); PG8_BAR; PG8_MMA(0, 0, At, B0); PG8_MMA(0, 1, At, B1); PG8_BAR; PG8_SCHED;
            PG8_LDA(At, 0, 1); PG8_STAGE(PG8_SB(0, 0), b2, voffB); PG8_STAGE(PG8_SB(0, 1), b2 + hstep, voffB); PG8_STAGE(PG8_SA(0, 0), a2, voffA);
            PG8_WAIT_V(8); PG8_WAIT_L(0); PG8_BAR; PG8_MMA(1, 0, At, B0); PG8_MMA(1, 1, At, B1); PG8_BAR; PG8_SCHED;
            PG8_LDB(B0, 1, 0); PG8_LDB(B1, 1, 1); PG8_SCHED; PG8_LDA(At, 1, 0); PG8_STAGE(PG8_SA(0, 1), a2 + hstep, voffA);
            PG8_WAIT_V(8); PG8_WAIT_L(0); PG8_BAR; PG8_MMA(0, 0, At, B0); PG8_MMA(0, 1, At, B1); PG8_BAR; PG8_SCHED;
            PG8_LDA(At, 1, 1); PG8_STAGE(PG8_SB(1, 0), b3, voffB); PG8_STAGE(PG8_SB(1, 1), b3 + hstep, voffB); PG8_STAGE(PG8_SA(1, 0), a3, voffA);
            PG8_WAIT_V(8); PG8_WAIT_L(0); PG8_BAR; PG8_MMA(1, 0, At, B0); PG8_MMA(1, 1, At, B1); PG8_BAR; PG8_SCHED;
            } else {
            PG8_LDB(B0, 0, 0); PG8_SCHED; PG8_LDA(At, 0, 0); PG8_STAGE(PG8_SA(1, 1), a1 + hstep, voffA);
            PG8_WAIT_L(8); PG8_BAR; PG8_WAIT_L(0); PG8_MMA(0, 0, At, B0); PG8_BAR; PG8_SCHED;
            PG8_LDB(B1, 0, 1); PG8_STAGE(PG8_SB(0, 0), b2, voffB);
            PG8_BAR; PG8_WAIT_L(0); PG8_MMA(0, 1, At, B1); PG8_BAR;
            PG8_LDA(At, 0, 1); PG8_STAGE(PG8_SA(0, 0), a2, voffA);
            PG8_BAR; PG8_WAIT_L(0); PG8_MMA(1, 0, At, B0); PG8_BAR; PG8_SCHED;
            PG8_STAGE(PG8_SB(0, 1), b2 + hstep, voffB);
            PG8_WAIT_V(6); PG8_BAR; PG8_MMA(1, 1, At, B1); PG8_BAR;
            PG8_LDB(B0, 1, 0); PG8_SCHED; PG8_LDA(At, 1, 0); PG8_STAGE(PG8_SA(0, 1), a2 + hstep, voffA);
            PG8_WAIT_L(8); PG8_BAR; PG8_WAIT_L(0); PG8_MMA(0, 0, At, B0); PG8_BAR; PG8_SCHED;
            PG8_LDB(B1, 1, 1); PG8_STAGE(PG8_SB(1, 0), b3, voffB);
            PG8_BAR; PG8_WAIT_L(0); PG8_MMA(0, 1, At, B1); PG8_BAR;
            PG8_LDA(At, 1, 1); PG8_STAGE(PG8_SA(1, 0), a3, voffA);
            PG8_BAR; PG8_WAIT_L(0); PG8_MMA(1, 0, At, B0); PG8_BAR; PG8_SCHED;
            PG8_STAGE(PG8_SB(1, 1), b3 + hstep, voffB);
            PG8_WAIT_V(6); PG8_BAR; PG8_MMA(1, 1, At, B1); PG8_BAR;
            }
        }
        if constexpr (ALIGN_EPI) { if (wr == 0) PG8_BAR; }
        if constexpr (!Epi::AFTER_DRAIN) { E(acc, cur, wr, wc, fr, fq); S.done(cur); }
        if (!has_next) break;
#pragma unroll
        for (int a = 0; a < 2; ++a)
#pragma unroll
            for (int b = 0; b < 2; ++b)
#pragma unroll
                for (int m = 0; m < 4; ++m)
#pragma unroll
                    for (int n = 0; n < 2; ++n) acc[a][b][m][n] = (f32x4){0.f, 0.f, 0.f, 0.f};
        cur = nxt; cA = nA; cB = nB; ++ui;
        if constexpr (ALIGN_EPI) { if (wr == 1) PG8_BAR; }
    }
    PG8_WAIT_V(0);
    if constexpr (!ALIGN_EPI) { if (wr == 0) PG8_BAR; }
    PG8_BAR;
    if constexpr (Epi::AFTER_DRAIN) { E.fused(acc, cur, wr, wc, fr, fq, lds, wid, lane); S.done(cur); }
#undef PG8_SA
#undef PG8_SB
#undef PG8_STAGE
#undef PG8_LDA
#undef PG8_LDB
#undef PG8_MMA
#undef PG8_WAIT_V
#undef PG8_WAIT_L
#undef PG8_BAR
#undef PG8_SCHED
}
}
#define GAS __attribute__((address_space(1)))
#define LAS __attribute__((address_space(3)))
typedef unsigned short bf16;
typedef unsigned v4u __attribute__((ext_vector_type(4)));
typedef float f32x4 __attribute__((ext_vector_type(4)));
typedef short bf16x8 __attribute__((ext_vector_type(8)));
typedef GAS unsigned gu32;
typedef GAS unsigned long long gu64;
#define RLX_AGENT __ATOMIC_RELAXED, __HIP_MEMORY_SCOPE_AGENT
#define LDS_WAIT() asm volatile("s_waitcnt lgkmcnt(0)" ::: "memory")
#define VM_WAIT() asm volatile("s_waitcnt vmcnt(0)" ::: "memory")
__device__ __forceinline__ unsigned long long rt() { return __builtin_amdgcn_s_memrealtime(); }
__device__ __forceinline__ unsigned f2bf(float f) { unsigned u = __builtin_bit_cast(unsigned, f); return (u + 0x7fffu + ((u >> 16) & 1u)) >> 16; }
__device__ __forceinline__ unsigned pk2(float lo, float hi) { return f2bf(lo) | (f2bf(hi) << 16); }

#define XB_TMO      128
#define XB_XCNT(j)  (256  + 64 * (j))
#define XB_XSUB(j)  (1280 + 64 * (j))
#define XB_XGEN(j)  (2304 + 64 * (j))
#define XB_TOP      3328
#define XB_TOPGEN   3392
#define XCD_BAR_WORDS 3456
#define XB_SPIN_CAP (1u << 18)

__device__ __forceinline__ unsigned xb_ld(unsigned* p)              { return __hip_atomic_load(p, __ATOMIC_RELAXED, __HIP_MEMORY_SCOPE_AGENT); }
__device__ __forceinline__ unsigned xb_add(unsigned* p, unsigned v) { return __hip_atomic_fetch_add(p, v, __ATOMIC_RELAXED, __HIP_MEMORY_SCOPE_AGENT); }
__device__ __forceinline__ unsigned xb_xcc_id() { return (unsigned)__builtin_amdgcn_s_getreg((3 << 11) | 20) & 0xFu; }
#define XB_SPIN(cond, bar) do { unsigned _sp = 0; while (cond) { __builtin_amdgcn_s_sleep(1); \
    if ((++_sp & 255u) == 0u) { if (xb_ld(&(bar)[XB_TMO])) break; if (_sp > XB_SPIN_CAP) { atomicAdd(&(bar)[XB_TMO], 1u); break; } } } } while (0)

struct XcdBarrier {
    unsigned* bar; unsigned x;
    volatile LAS unsigned* st;
};

__device__ __forceinline__ XcdBarrier xcd_barrier_post(unsigned* bar, volatile LAS unsigned* st) {
    XcdBarrier b; b.bar = bar; b.x = xb_xcc_id(); b.st = st;
    if (threadIdx.x == 0) (void)xb_add(&bar[XB_XCNT(b.x)], 1u);
    return b;
}
__device__ __forceinline__ void xcd_barrier_complete(unsigned* bar, unsigned x, unsigned& nloc, unsigned& nx) {
    const unsigned G = gridDim.x * gridDim.y * gridDim.z;
    unsigned sum, cnt, mine, sp = 0u;
    for (;;) {
        sum = 0u; cnt = 0u; mine = 0u;
#pragma unroll
        for (unsigned j = 0; j < 16; ++j) { const unsigned c = xb_ld(&bar[XB_XCNT(j)]); sum += c; cnt += (c > 0u) ? 1u : 0u; mine = (j == x) ? c : mine; }
        if (sum == G) break;
        __builtin_amdgcn_s_sleep(1);
        if ((++sp & 255u) == 0u) { if (xb_ld(&bar[XB_TMO])) break; if (sp > XB_SPIN_CAP) { atomicAdd(&bar[XB_TMO], 1u); break; } }
    }
    nloc = mine > 0u ? mine : 1u; nx = cnt > 0u ? cnt : 1u;
}

__device__ __forceinline__ void xcd_barrier(const XcdBarrier& b) {
    asm volatile("s_waitcnt vmcnt(0)" ::: "memory");
    __syncthreads();
    if (threadIdx.x == 0) {
        unsigned* bar = b.bar;
        __builtin_amdgcn_s_waitcnt(0);
        unsigned nloc = b.st[0], nx = b.st[1];
        if (nloc == 0u) { xcd_barrier_complete(bar, b.x, nloc, nx); b.st[0] = nloc; b.st[1] = nx; }
        const unsigned old = xb_add(&bar[XB_XSUB(b.x)], 1u);
        const unsigned gen = old / nloc;
        if (old + 1u == (gen + 1u) * nloc) {
            __builtin_amdgcn_fence(__ATOMIC_RELEASE, "agent");
            asm volatile("s_waitcnt vmcnt(0)" ::: "memory");
            const unsigned og = xb_add(&bar[XB_TOP], 1u);
            const unsigned tg = og / nx;
            if (og + 1u == (tg + 1u) * nx) xb_add(&bar[XB_TOPGEN], 1u);
            else XB_SPIN(xb_ld(&bar[XB_TOPGEN]) == tg, bar);
            __builtin_amdgcn_fence(__ATOMIC_ACQUIRE, "agent");
            xb_add(&bar[XB_XGEN(b.x)], 1u);
            asm volatile("s_waitcnt vmcnt(0)" ::: "memory");
        } else {
            XB_SPIN(xb_ld(&bar[XB_XGEN(b.x)]) == gen, bar);
            __builtin_amdgcn_fence(__ATOMIC_ACQUIRE, "agent");
            asm volatile("s_waitcnt vmcnt(0)" ::: "memory");
        }
    }
    __syncthreads();
}
constexpr int NWAVES = 8;
constexpr int BATCH = 8, SEQ = 2048, D = 1024, T = BATCH * SEQ, DEPTH = 4;
constexpr int NH = 8, HD = 64, AW = 512, PW = 256, CW = 256, INC = 2304, CK = 31;
constexpr int FF = 2816, NE = 8, NGU = 2 * FF;
constexpr int MAXSLOT = 2 * T + NE * 256;
constexpr float RMS_EPS = 1e-6f, LN_EPS = 1e-5f;
constexpr float QSCALE = 0.125f * 1.4426950408889634f;
constexpr float W_EXIT = -150.0f;
constexpr int PQ = 0, PK = 512, PV = 1024, PPOOL = 1536, PCV = 1792, PCG = 2048;
enum { I_X = 0, I_ANG, I_WIN, I_POOLW, I_POOLS, I_CONVW, I_CONVB, I_LNG, I_LNB, I_GNG, I_WOUT, I_FNG, I_DWG, I_DWU, I_DWD, I_RW, I_MWG, I_MWU, I_MWD, I_FING, N_IN };

constexpr size_t MiB = 1u << 20;
constexpr size_t WS_CTL = 0, CTL_ZERO_BYTES = 1 * MiB;
constexpr size_t WS_TOKE = 1 * MiB, WS_TOKR = WS_TOKE + 128 * 1024, WS_TOKG = WS_TOKR + 128 * 1024, WS_TOKS = WS_TOKG + 128 * 1024;
constexpr size_t WS_WIN = 4 * MiB;
constexpr size_t WS_WOUT = 22 * MiB;
constexpr size_t WS_WGUD = 30 * MiB;
constexpr size_t WS_WDD = 52 * MiB;
constexpr size_t WS_WGUM = 64 * MiB;
constexpr size_t WS_WDM = 240 * MiB;
constexpr size_t WS_X = 328 * MiB;
constexpr size_t WS_XN = 392 * MiB;
constexpr size_t WS_P = 424 * MiB;
constexpr size_t WS_O = 496 * MiB;
constexpr size_t WS_ACT = 424 * MiB;
constexpr size_t WS_AP = 611 * MiB;
constexpr size_t WS_END = 679 * MiB;
static_assert(WS_WIN + (size_t)4 * INC * D * 2 <= WS_WOUT && WS_WOUT + (size_t)4 * D * D * 2 <= WS_WGUD && WS_WGUD + (size_t)2 * NGU * D * 2 <= WS_WDD && WS_WDD + (size_t)2 * D * FF * 2 <= WS_WGUM, "ws map 1");
static_assert(WS_WGUM + (size_t)16 * NGU * D * 2 <= WS_WDM && WS_WDM + (size_t)16 * D * FF * 2 <= WS_X && WS_X + (size_t)T * D * 4 <= WS_XN && WS_XN + (size_t)T * D * 2 <= WS_P, "ws map 2");
static_assert(WS_P + (size_t)T * INC * 2 <= WS_O && WS_O + (size_t)T * D * 2 <= WS_AP && WS_ACT + (size_t)MAXSLOT * FF * 2 <= WS_AP && WS_AP + (size_t)MAXSLOT * D * 2 <= WS_END, "ws map 3");
constexpr int CW_TMO = 0, CW_CODE = 1;
constexpr int CW_BAR = 4096;
constexpr int CW_MOE = 8192;

constexpr int RING_OFF = 0, RING_BYTES = 131072;
constexpr int LDSCTL_OFF = RING_BYTES, MISC_OFF = LDSCTL_OFF + 320;
constexpr int LDS_BYTES = 147456;
typedef unsigned u32x2 __attribute__((ext_vector_type(2)));
struct Frame {
    LAS unsigned char* lds;
    volatile LAS unsigned* MISC;
    int vcu, G;
};
__device__ __forceinline__ int opaque_tid() { int t = threadIdx.x; asm volatile("" : "+v"(t)); return t; }
#define PHASE_IDS() const int tid = opaque_tid(), lane = tid & 63, wave = __builtin_amdgcn_readfirstlane(tid >> 6); (void)tid; (void)lane; (void)wave
template <int I> __device__ __forceinline__ const float* inp() { const float* p; asm volatile("s_load_dwordx2 %0, %1, %2\n\ts_waitcnt lgkmcnt(0)" : "=&s"(p) : "s"(__builtin_amdgcn_kernarg_segment_ptr()), "n"(I * 8)); return p; }
#define INP(i) inp<(i)>()
#define OUTPTR() ((float*)const_cast<float*>(inp<N_IN>()))
#define WSPTR() ((unsigned char*)const_cast<float*>(inp<N_IN + 1>()))
#define CTLPTR() ((gu32*)WSPTR())
__device__ __forceinline__ float bf2f(bf16 b) { return __uint_as_float((unsigned)b << 16); }
__device__ __forceinline__ float bflo(unsigned w) { return __uint_as_float(w << 16); }
__device__ __forceinline__ float bfhi(unsigned w) { return __uint_as_float(w & 0xffff0000u); }
__device__ __forceinline__ float wave_sum(float v) {
#pragma unroll
    for (int o = 1; o < 64; o <<= 1) v += __shfl_xor(v, o);
    return v;
}
__device__ __forceinline__ void fail_word(unsigned code) {
    if (threadIdx.x == 0) { gu32* ctl = CTLPTR(); unsigned expect = 0u; __hip_atomic_compare_exchange_strong((unsigned*)(ctl + CW_CODE), &expect, code, __ATOMIC_RELAXED, __ATOMIC_RELAXED, __HIP_MEMORY_SCOPE_AGENT);
        __hip_atomic_store(ctl + CW_TMO, 1u, RLX_AGENT); }
}

__device__ __forceinline__ void transpose_item(const float* W, int K, int N, bf16* WT, int mode, int nscale, LAS float* scr, int item, int lane) {
    const int nblk = N / 32, kb = item / nblk, nb = item % nblk, k0 = 64 * kb, n0 = 32 * nb;
#pragma unroll 8
    for (int i = 0; i < 32; ++i) { const int kk = 2 * i + (lane >> 5); scr[kk * 33 + (lane & 31)] = W[(size_t)(k0 + kk) * N + n0 + (lane & 31)]; }
    LDS_WAIT(); asm volatile("" ::: "memory");
    const int r0 = (mode == 0) ? n0 : (256 * (n0 >> 7) + (n0 & 127) + (mode == 2 ? 128 : 0));
    const float sc = (n0 < nscale) ? QSCALE : 1.0f;
    const int c = lane & 7;
#pragma unroll
    for (int j = 0; j < 4; ++j) { const int n = (lane >> 3) + 8 * j; const LAS float* s = scr + (8 * c) * 33 + n;
        v4u o; o.x = pk2(s[0 * 33] * sc, s[1 * 33] * sc); o.y = pk2(s[2 * 33] * sc, s[3 * 33] * sc); o.z = pk2(s[4 * 33] * sc, s[5 * 33] * sc); o.w = pk2(s[6 * 33] * sc, s[7 * 33] * sc);
        *(GAS v4u*)(WT + (size_t)(r0 + n) * K + k0 + 8 * c) = o; }
    LDS_WAIT(); asm volatile("" ::: "memory");
}
__device__ __forceinline__ void p0_weights(Frame& F) {
    PHASE_IDS(); unsigned char* const ws = WSPTR();
    LAS float* scr = (LAS float*)(F.lds + RING_OFF + wave * 16384);
    const int gw = F.vcu * NWAVES + wave, NGW = F.G * NWAVES;
    constexpr int I_IN = (D / 64) * (INC / 32), I_OUT = (D / 64) * (D / 32), I_GU = (D / 64) * (FF / 32), I_DN = (FF / 64) * (D / 32);
    constexpr int N0 = 4 * I_IN, N1 = N0 + 4 * I_OUT, N2 = N1 + 2 * I_GU, N3 = N2 + 2 * I_GU, N4 = N3 + 2 * I_DN, N5 = N4 + 16 * I_GU, N6 = N5 + 16 * I_GU, N7 = N6 + 16 * I_DN;
    bf16* const win = (bf16*)(ws + WS_WIN); bf16* const wout = (bf16*)(ws + WS_WOUT); bf16* const wgud = (bf16*)(ws + WS_WGUD); bf16* const wdd = (bf16*)(ws + WS_WDD);
    bf16* const wgum = (bf16*)(ws + WS_WGUM); bf16* const wdm = (bf16*)(ws + WS_WDM);
    for (int it = gw; it < N7; it += NGW) {
        if (it < N0) { const int l = it / I_IN, r = it % I_IN; transpose_item(INP(I_WIN) + (size_t)l * D * INC, D, INC, win + (size_t)l * INC * D, 0, 512, scr, r, lane); }
        else if (it < N1) { const int q = it - N0, l = q / I_OUT, r = q % I_OUT; transpose_item(INP(I_WOUT) + (size_t)l * D * D, D, D, wout + (size_t)l * D * D, 0, 0, scr, r, lane); }
        else if (it < N2) { const int q = it - N1, l = q / I_GU, r = q % I_GU; transpose_item(INP(I_DWG) + (size_t)l * D * FF, D, FF, wgud + (size_t)l * NGU * D, 1, 0, scr, r, lane); }
        else if (it < N3) { const int q = it - N2, l = q / I_GU, r = q % I_GU; transpose_item(INP(I_DWU) + (size_t)l * D * FF, D, FF, wgud + (size_t)l * NGU * D, 2, 0, scr, r, lane); }
        else if (it < N4) { const int q = it - N3, l = q / I_DN, r = q % I_DN; transpose_item(INP(I_DWD) + (size_t)l * FF * D, FF, D, wdd + (size_t)l * D * FF, 0, 0, scr, r, lane); }
        else if (it < N5) { const int q = it - N4, l = q / I_GU, r = q % I_GU; transpose_item(INP(I_MWG) + (size_t)l * D * FF, D, FF, wgum + (size_t)l * NGU * D, 1, 0, scr, r, lane); }
        else if (it < N6) { const int q = it - N5, l = q / I_GU, r = q % I_GU; transpose_item(INP(I_MWU) + (size_t)l * D * FF, D, FF, wgum + (size_t)l * NGU * D, 2, 0, scr, r, lane); }
        else { const int q = it - N6, l = q / I_DN, r = q % I_DN; transpose_item(INP(I_MWD) + (size_t)l * FF * D, FF, D, wdm + (size_t)l * D * FF, 0, 0, scr, r, lane); }
    }
}

struct RowArgs { const float* xsrc; float* xws; const float* gain; bf16* xn; float* out; const bf16* yp; const float* wr; gu32* gcur;
                 int* tok_e; int* tok_r; float* tok_g; const int* tok_s; };
template <int MODE>
__device__ __forceinline__ void row_phase(Frame& F, const RowArgs& A) {
    constexpr bool COMBINE = MODE & 1, ROUTER = (MODE & 2) != 0, FINAL = (MODE & 4) != 0, COPYIN = (MODE & 8) != 0;
    LAS int* s_cnt = (LAS int*)(F.lds + RING_OFF);
    LAS int* s_base = s_cnt + 8;
    LAS int* s_e = s_cnt + 16;
    LAS int* s_rk = s_e + 128;
    LAS float* s_g = (LAS float*)(s_rk + 128);
    PHASE_IDS();
    if (ROUTER) { if (tid < 16) s_cnt[tid] = 0; __syncthreads(); }
#pragma unroll 1
    for (int i = 0; i < 8; ++i) {
        const int rl = wave * 8 + i, m = F.vcu * 64 + rl;
        const GAS f32x4* xr = (const GAS f32x4*)(A.xsrc + (size_t)m * D) + lane;
        f32x4 v[4];
#pragma unroll
        for (int j = 0; j < 4; ++j) v[j] = xr[64 * j];
        if (COMBINE) {
            const int s0 = A.tok_s[2 * m], s1 = A.tok_s[2 * m + 1]; const float g0 = A.tok_g[2 * m], g1 = A.tok_g[2 * m + 1];
            const GAS u32x2* y0 = (const GAS u32x2*)(A.yp + (size_t)s0 * D) + lane; const GAS u32x2* y1 = (const GAS u32x2*)(A.yp + (size_t)s1 * D) + lane;
#pragma unroll
            for (int j = 0; j < 4; ++j) { const u32x2 a = y0[64 * j], b = y1[64 * j];
                v[j].x += g0 * bflo(a.x) + g1 * bflo(b.x); v[j].y += g0 * bfhi(a.x) + g1 * bfhi(b.x); v[j].z += g0 * bflo(a.y) + g1 * bflo(b.y); v[j].w += g0 * bfhi(a.y) + g1 * bfhi(b.y); }
        }
        if (COMBINE || COPYIN) { GAS f32x4* xw = (GAS f32x4*)(A.xws + (size_t)m * D) + lane;
#pragma unroll
            for (int j = 0; j < 4; ++j) xw[64 * j] = v[j]; }
        float ss = 0.f;
#pragma unroll
        for (int j = 0; j < 4; ++j) ss += (v[j].x * v[j].x + v[j].y * v[j].y) + (v[j].z * v[j].z + v[j].w * v[j].w);
        const float rstd = 1.0f / sqrtf(wave_sum(ss) * (1.0f / D) + RMS_EPS);
        const GAS f32x4* gr = (const GAS f32x4*)A.gain + lane;
#pragma unroll
        for (int j = 0; j < 4; ++j) v[j] = v[j] * rstd * gr[64 * j];
        if (FINAL) { GAS f32x4* o = (GAS f32x4*)(A.out + (size_t)m * D) + lane;
#pragma unroll
            for (int j = 0; j < 4; ++j) o[64 * j] = v[j]; }
        else { GAS u32x2* o = (GAS u32x2*)(A.xn + (size_t)m * D) + lane;
#pragma unroll
            for (int j = 0; j < 4; ++j) o[64 * j] = (u32x2){pk2(v[j].x, v[j].y), pk2(v[j].z, v[j].w)}; }
        if (ROUTER) {
            float lg[8];
#pragma unroll
            for (int e = 0; e < 8; ++e) lg[e] = 0.f;
#pragma unroll
            for (int j = 0; j < 4; ++j)
#pragma unroll
                for (int q = 0; q < 4; ++q) { const GAS f32x4* w = (const GAS f32x4*)(A.wr + (size_t)(256 * j + 4 * lane + q) * 8); const f32x4 w0 = w[0], w1 = w[1]; const float h = v[j][q];
                    lg[0] += h * w0.x; lg[1] += h * w0.y; lg[2] += h * w0.z; lg[3] += h * w0.w; lg[4] += h * w1.x; lg[5] += h * w1.y; lg[6] += h * w1.z; lg[7] += h * w1.w; }
#pragma unroll
            for (int e = 0; e < 8; ++e) lg[e] = wave_sum(lg[e]);
            int e1 = 0; float v1 = lg[0];
#pragma unroll
            for (int e = 1; e < 8; ++e) if (lg[e] > v1) { v1 = lg[e]; e1 = e; }
            int e2 = -1; float v2 = -INFINITY;
#pragma unroll
            for (int e = 0; e < 8; ++e) if (e != e1 && (e2 < 0 || lg[e] > v2)) { v2 = lg[e]; e2 = e; }
            const float g1 = 1.0f / (1.0f + __expf(v2 - v1)), g2 = 1.0f - g1;
            if (lane == 0) { const int r1 = atomicAdd((int*)(s_cnt + e1), 1), r2 = atomicAdd((int*)(s_cnt + e2), 1);
                s_e[2 * rl] = e1; s_e[2 * rl + 1] = e2; s_rk[2 * rl] = r1; s_rk[2 * rl + 1] = r2; s_g[2 * rl] = g1; s_g[2 * rl + 1] = g2; }
        }
    }
    if (ROUTER) {
        __syncthreads();
        if (tid < 8) s_base[tid] = (int)__hip_atomic_fetch_add(A.gcur + 64 * tid, (unsigned)s_cnt[tid], RLX_AGENT);
        __syncthreads();
        if (tid < 128) { const int m2 = F.vcu * 128 + tid; const int e = s_e[tid]; A.tok_e[m2] = e; A.tok_r[m2] = s_base[e] + s_rk[tid]; A.tok_g[m2] = s_g[tid]; }
        __syncthreads();
    }
}

__device__ __forceinline__ void load_toff(gu32* gcur, int (&cnt)[8], int (&toff)[9]) {
    toff[0] = 0;
#pragma unroll
    for (int e = 0; e < 8; ++e) { cnt[e] = (int)__builtin_amdgcn_readfirstlane(__hip_atomic_load(gcur + 64 * e, RLX_AGENT)); toff[e + 1] = toff[e] + ((cnt[e] + 255) >> 8); }
}
__device__ __forceinline__ void gather_phase(Frame& F, gu32* gcur, const bf16* xn, bf16* ap, const int* tok_e, const int* tok_r, int* tok_s) {
    PHASE_IDS();
    int cnt[8], toff[9]; load_toff(gcur, cnt, toff);
#pragma unroll 1
    for (int i = 0; i < 8; ++i) {
        const int m = F.vcu * 64 + wave * 8 + i;
        const GAS v4u* src = (const GAS v4u*)(xn + (size_t)m * D) + lane; const v4u a = src[0], b = src[64];
#pragma unroll
        for (int k = 0; k < 2; ++k) {
            const int e = tok_e[2 * m + k], r = tok_r[2 * m + k];
            int base = 0;
#pragma unroll
            for (int q = 0; q < 8; ++q) base = (e == q) ? toff[q] : base;
            const int slot = base * 256 + r;
            if (lane == 0) tok_s[2 * m + k] = slot;
            GAS v4u* dst = (GAS v4u*)(ap + (size_t)slot * D) + lane; dst[0] = a; dst[64] = b;
        }
    }
    const int gw = F.vcu * NWAVES + wave, NGW = F.G * NWAVES;
#pragma unroll
    for (int e = 0; e < 8; ++e) {
        for (int r = toff[e] * 256 + cnt[e] + gw; r < toff[e + 1] * 256; r += NGW) { GAS v4u* dst = (GAS v4u*)(ap + (size_t)r * D) + lane; dst[0] = (v4u){0u, 0u, 0u, 0u}; dst[64] = (v4u){0u, 0u, 0u, 0u}; }
    }
}

__device__ __forceinline__ void attn_simple(Frame& F, const bf16* P, bf16* O, const float* ga) {
    PHASE_IDS();
    const int gw = F.vcu * NWAVES + wave, NGW = F.G * NWAVES;
    for (int tg = gw; tg < T / 8; tg += NGW) {
        const int h = lane & 7, tl = lane >> 3, row = tg * 8 + tl, s = row % SEQ;
        float q[64], o[64];
        { const v4u* qp = (const v4u*)(P + (size_t)row * INC + PQ + h * 64);
#pragma unroll
          for (int i = 0; i < 8; ++i) { const v4u w = qp[i]; q[8 * i] = bflo(w.x); q[8 * i + 1] = bfhi(w.x); q[8 * i + 2] = bflo(w.y); q[8 * i + 3] = bfhi(w.y); q[8 * i + 4] = bflo(w.z); q[8 * i + 5] = bfhi(w.z); q[8 * i + 6] = bflo(w.w); q[8 * i + 7] = bfhi(w.w); } }
#pragma unroll
        for (int d = 0; d < 64; ++d) o[d] = 0.f;
        float carry = 0.f;
        for (int j = s - 1; j >= 0; --j) {
            const v4u* kp = (const v4u*)(P + (size_t)(row - s + j) * INC + PK + h * 64); const v4u* vp = (const v4u*)(P + (size_t)(row - s + j) * INC + PV + h * 64);
            float z = 0.f;
#pragma unroll
            for (int i = 0; i < 8; ++i) { const v4u w = kp[i];
                z += q[8 * i] * bflo(w.x) + q[8 * i + 1] * bfhi(w.x) + q[8 * i + 2] * bflo(w.y) + q[8 * i + 3] * bfhi(w.y) + q[8 * i + 4] * bflo(w.z) + q[8 * i + 5] * bfhi(w.z) + q[8 * i + 6] * bflo(w.w) + q[8 * i + 7] * bfhi(w.w); }
            const float sp = fmaxf(z, 0.f) + __builtin_amdgcn_logf(1.0f + __builtin_amdgcn_exp2f(-fabsf(z)));
            carry -= sp;
            const float w = __builtin_amdgcn_exp2f(z + carry);
#pragma unroll
            for (int i = 0; i < 8; ++i) { const v4u x = vp[i];
                o[8 * i] += w * bflo(x.x); o[8 * i + 1] += w * bfhi(x.x); o[8 * i + 2] += w * bflo(x.y); o[8 * i + 3] += w * bfhi(x.y); o[8 * i + 4] += w * bflo(x.z); o[8 * i + 5] += w * bfhi(x.z); o[8 * i + 6] += w * bflo(x.w); o[8 * i + 7] += w * bfhi(x.w); }
            if (carry < W_EXIT) break;
        }
        float ss = 0.f;
#pragma unroll
        for (int d = 0; d < 64; ++d) ss += o[d] * o[d];
        ss += __shfl_xor(ss, 1); ss += __shfl_xor(ss, 2); ss += __shfl_xor(ss, 4);
        const float rstd = 1.0f / sqrtf(ss * (1.0f / AW) + RMS_EPS);
        const f32x4* gp = (const f32x4*)(ga + h * 64); v4u* op = (v4u*)(O + (size_t)row * D + h * 64);
#pragma unroll
        for (int i = 0; i < 8; ++i) { const f32x4 g0 = gp[2 * i], g1 = gp[2 * i + 1]; v4u w;
            w.x = pk2(o[8 * i] * rstd * g0.x, o[8 * i + 1] * rstd * g0.y); w.y = pk2(o[8 * i + 2] * rstd * g0.z, o[8 * i + 3] * rstd * g0.w);
            w.z = pk2(o[8 * i + 4] * rstd * g1.x, o[8 * i + 5] * rstd * g1.y); w.w = pk2(o[8 * i + 6] * rstd * g1.z, o[8 * i + 7] * rstd * g1.w); op[i] = w; }
    }
}
struct PcArgs { const bf16* P; bf16* O; const float* poolw; const float* pools; const float* convw; const float* convb; const float* lng; const float* lnb; const float* gng; };
__device__ __forceinline__ void poolconv_phase(Frame& F, const PcArgs& A) {
    LAS float* ybuf = (LAS float*)(F.lds + RING_OFF);
    LAS float* obuf = ybuf + 32 * 256;
    LAS float* ubuf = obuf + 32 * 256;
    PHASE_IDS();
    const bf16* P = A.P;
    for (int u = F.vcu; u < T / 32; u += F.G) {
        const int row0 = u * 32, s0 = row0 % SEQ;
        { const int ch = tid & 255, g = ch >> 6, win = 2 << g;
#pragma unroll 1
          for (int i = 0; i < 16; ++i) { const int tl = (tid >> 8) + 2 * i, s = s0 + tl, cnt = (s + 1 < win) ? s + 1 : win;
              float sum = 0.f; for (int k = 0; k < cnt; ++k) sum += bf2f(P[(size_t)(row0 + tl - k) * INC + PPOOL + ch]);
              ybuf[tl * 256 + ch] = sum / (float)cnt - bf2f(P[(size_t)(row0 + tl) * INC + PPOOL + ch]); }
#pragma unroll 1
          for (int rr = (tid >> 8); rr < 62; rr += 2) { const int s = s0 - 30 + rr; float uv = 0.f;
              if (s >= 0) { const size_t r = (size_t)(row0 - 30 + rr) * INC; const float val = bf2f(P[r + PCV + ch]), gt = bf2f(P[r + PCG + ch]); uv = val / (1.0f + __expf(-gt)); }
              ubuf[rr * 256 + ch] = uv; } }
        __syncthreads();
        { const int col = tid & 255, g = col >> 6, d = col & 63; float acc[16];
#pragma unroll
          for (int i = 0; i < 16; ++i) acc[i] = 0.f;
          const float* wp = A.poolw + (size_t)g * 64 * 64 + d;
#pragma unroll 4
          for (int c = 0; c < 64; ++c) { const float w = wp[c * 64];
#pragma unroll
              for (int i = 0; i < 16; ++i) acc[i] += ybuf[((tid >> 8) + 2 * i) * 256 + g * 64 + c] * w; }
          const float ps = A.pools[col];
#pragma unroll
          for (int i = 0; i < 16; ++i) obuf[((tid >> 8) + 2 * i) * 256 + col] = acc[i] * ps; }
        __syncthreads();
        { const f32x4 gb = *(const f32x4*)(A.gng + AW + 4 * lane);
#pragma unroll
          for (int tk = 0; tk < 4; ++tk) { const int tl = 4 * wave + tk; const f32x4 v = *(const LAS f32x4*)(obuf + tl * 256 + 4 * lane);
              const float ss = wave_sum((v.x * v.x + v.y * v.y) + (v.z * v.z + v.w * v.w)); const float rstd = 1.0f / sqrtf(ss * (1.0f / PW) + RMS_EPS);
              *(u32x2*)(A.O + (size_t)(row0 + tl) * D + AW + 4 * lane) = (u32x2){pk2(v.x * rstd * gb.x, v.y * rstd * gb.y), pk2(v.z * rstd * gb.z, v.w * rstd * gb.w)}; } }
        { f32x4 acc[4]; const f32x4 cb = *(const f32x4*)(A.convb + 4 * lane);
#pragma unroll
          for (int tk = 0; tk < 4; ++tk) acc[tk] = cb;
#pragma unroll 1
          for (int j = 0; j < CK; ++j) { const f32x4 w4 = *(const f32x4*)(A.convw + (size_t)j * CW + 4 * lane);
#pragma unroll
              for (int tk = 0; tk < 4; ++tk) { const f32x4 u4 = *(const LAS f32x4*)(ubuf + (4 * wave + tk + j) * 256 + 4 * lane); acc[tk] += w4 * u4; } }
          const f32x4 lg = *(const f32x4*)(A.lng + 4 * lane), lb = *(const f32x4*)(A.lnb + 4 * lane), gc = *(const f32x4*)(A.gng + AW + PW + 4 * lane);
#pragma unroll
          for (int tk = 0; tk < 4; ++tk) { const int tl = 4 * wave + tk; f32x4 v = acc[tk];
              const float mean = wave_sum((v.x + v.y) + (v.z + v.w)) * (1.0f / CW); v = v - mean;
              const float var = wave_sum((v.x * v.x + v.y * v.y) + (v.z * v.z + v.w * v.w)) * (1.0f / CW); const float rs = 1.0f / sqrtf(var + LN_EPS);
              v = v * rs * lg + lb;
              v.x = v.x / (1.0f + __expf(-v.x)); v.y = v.y / (1.0f + __expf(-v.y)); v.z = v.z / (1.0f + __expf(-v.z)); v.w = v.w / (1.0f + __expf(-v.w));
              const float ss = wave_sum((v.x * v.x + v.y * v.y) + (v.z * v.z + v.w * v.w)); const float rstd = 1.0f / sqrtf(ss * (1.0f / CW) + RMS_EPS);
              *(u32x2*)(A.O + (size_t)(row0 + tl) * D + AW + PW + 4 * lane) = (u32x2){pk2(v.x * rstd * gc.x, v.y * rstd * gc.y), pk2(v.z * rstd * gc.z, v.w * rstd * gc.w)}; } }
        __syncthreads();
    }
}
constexpr int NPH = 1 + 8 * DEPTH;
struct Args { const float* in[N_IN]; float* out; unsigned char* ws; int ph_lo, ph_hi; };
__global__ void __launch_bounds__(NWAVES * 64, 2) fwd(Args args) {
    extern __shared__ __attribute__((aligned(16))) unsigned char lds[];
    Frame F;
    F.lds = (LAS unsigned char*)lds;
    F.MISC = (volatile LAS unsigned*)(F.lds + MISC_OFF);
    F.G = gridDim.x; { const int bx = blockIdx.x; F.vcu = (F.G % 8 == 0) ? (bx % 8) * (F.G / 8) + bx / 8 : bx; }
    for (int u = threadIdx.x; u < (LDS_BYTES - LDSCTL_OFF) / 4; u += NWAVES * 64) ((LAS unsigned*)(F.lds + LDSCTL_OFF))[u] = 0u;
    __syncthreads();
    const int lo = args.ph_lo, hi = args.ph_hi;
    XcdBarrier bar; bar.bar = (unsigned*)(CTLPTR() + CW_BAR); bar.x = 0; bar.st = nullptr;
    if (hi - lo > 1) bar = xcd_barrier_post((unsigned*)(CTLPTR() + CW_BAR), F.MISC + 8);
#define IN(k) (lo <= (k) && (k) < hi)
#define SEAM(k) do { if ((k) + 1 < hi) xcd_barrier(bar); } while (0)
#define X ((float*)(ws + WS_X))
#define XN ((bf16*)(ws + WS_XN))
#define P ((bf16*)(ws + WS_P))
#define O ((bf16*)(ws + WS_O))
#define ACT ((bf16*)(ws + WS_ACT))
#define AP ((bf16*)(ws + WS_AP))
#define TOK_E ((int*)(ws + WS_TOKE))
#define TOK_R ((int*)(ws + WS_TOKR))
#define TOK_G ((float*)(ws + WS_TOKG))
#define TOK_S ((int*)(ws + WS_TOKS))
    if (F.G != 256) { fail_word(0x7f0u); return; }

    if (IN(0)) {
        unsigned char* const ws = WSPTR();
        p0_weights(F);
        RowArgs A{}; A.xsrc = INP(I_X); A.xws = X; A.gain = INP(I_ANG); A.xn = XN;
        row_phase<8>(F, A);
        SEAM(0);
    }
#pragma unroll 1
    for (int l = 0; l < DEPTH; ++l) {
        const int pb = 1 + 8 * l, li = l >> 1; const bool moe = (l & 1) != 0;
        if (IN(pb + 0)) {
            unsigned char* const ws = WSPTR();
            pg8::Gemm g{XN, (const bf16*)(ws + WS_WIN) + (size_t)l * INC * D, T, INC, D, 0}; pg8::StaticOrder S; S.init(T, INC, F.G, (int)blockIdx.x);
            pg8::EpiBf16<0> E{P, INC, nullptr, 0, 0, 1.f};
            pg8::gemm_phase<pg8::EpiBf16<0>, pg8::StaticOrder, true, true>(F.lds + RING_OFF, g, S, E);
            SEAM(pb + 0);
        }
        if (IN(pb + 1)) {
            unsigned char* const ws = WSPTR();
            attn_simple(F, P, O, INP(I_GNG) + (size_t)l * D);
            PcArgs A{P, O, INP(I_POOLW) + (size_t)l * 4 * 64 * 64, INP(I_POOLS) + (size_t)l * PW, INP(I_CONVW) + (size_t)l * CK * CW, INP(I_CONVB) + (size_t)l * CW,
                     INP(I_LNG) + (size_t)l * CW, INP(I_LNB) + (size_t)l * CW, INP(I_GNG) + (size_t)l * D};
            poolconv_phase(F, A);
            SEAM(pb + 1);
        }
        if (IN(pb + 2)) {
            unsigned char* const ws = WSPTR();
            pg8::Gemm g{O, (const bf16*)(ws + WS_WOUT) + (size_t)l * D * D, T, D, D, 0}; pg8::StaticOrder S; S.init(T, D, F.G, (int)blockIdx.x);
            pg8::EpiResid E{X, D};
            pg8::gemm_phase<pg8::EpiResid, pg8::StaticOrder, true, true>(F.lds + RING_OFF, g, S, E);
            SEAM(pb + 2);
        }
        if (IN(pb + 3)) {
            unsigned char* const ws = WSPTR();
            RowArgs A{}; A.xsrc = X; A.xws = X; A.gain = INP(I_FNG) + (size_t)l * D; A.xn = XN;
            if (moe) { A.wr = INP(I_RW) + (size_t)li * D * NE; A.gcur = CTLPTR() + CW_MOE + li * 1024; A.tok_e = TOK_E; A.tok_r = TOK_R; A.tok_g = TOK_G; row_phase<2>(F, A); }
            else row_phase<0>(F, A);
            SEAM(pb + 3);
        }
        if (moe) {
            if (IN(pb + 4)) { unsigned char* const ws = WSPTR(); gu32* const gcur = CTLPTR() + CW_MOE + li * 1024; gather_phase(F, gcur, XN, AP, TOK_E, TOK_R, TOK_S); SEAM(pb + 4); }
            if (IN(pb + 5)) {
                unsigned char* const ws = WSPTR(); gu32* const gcur = CTLPTR() + CW_MOE + li * 1024;
                int cnt[8], toff[9]; load_toff(gcur, cnt, toff);
                pg8::Gemm g{AP, (const bf16*)(ws + WS_WGUM) + (size_t)li * NE * NGU * D, 0, NGU, D, (size_t)NGU * D * 2}; pg8::GroupedOrder S; S.init(toff, NGU, F.G, (int)blockIdx.x);
                pg8::EpiSwiGLU E{ACT, FF};
                pg8::gemm_phase<pg8::EpiSwiGLU, pg8::GroupedOrder, true, true>(F.lds + RING_OFF, g, S, E);
                SEAM(pb + 5);
            }
            if (IN(pb + 6)) {
                unsigned char* const ws = WSPTR(); gu32* const gcur = CTLPTR() + CW_MOE + li * 1024;
                int cnt[8], toff[9]; load_toff(gcur, cnt, toff);
                pg8::Gemm g{ACT, (const bf16*)(ws + WS_WDM) + (size_t)li * NE * D * FF, 0, D, FF, (size_t)D * FF * 2}; pg8::GroupedOrder S; S.init(toff, D, F.G, (int)blockIdx.x);
                pg8::EpiBf16<0> E{AP, D, nullptr, 0, 0, 1.f};
                pg8::gemm_phase<pg8::EpiBf16<0>, pg8::GroupedOrder, true, true>(F.lds + RING_OFF, g, S, E);
                SEAM(pb + 6);
            }
        } else {
            if (IN(pb + 5)) {
                unsigned char* const ws = WSPTR();
                pg8::Gemm g{XN, (const bf16*)(ws + WS_WGUD) + (size_t)li * NGU * D, T, NGU, D, 0}; pg8::StaticOrder S; S.init(T, NGU, F.G, (int)blockIdx.x);
                pg8::EpiSwiGLU E{ACT, FF};
                pg8::gemm_phase<pg8::EpiSwiGLU, pg8::StaticOrder, true, true>(F.lds + RING_OFF, g, S, E);
                SEAM(pb + 5);
            }
            if (IN(pb + 6)) {
                unsigned char* const ws = WSPTR();
                pg8::Gemm g{ACT, (const bf16*)(ws + WS_WDD) + (size_t)li * D * FF, T, D, FF, 0}; pg8::StaticOrder S; S.init(T, D, F.G, (int)blockIdx.x);
                pg8::EpiResid E{X, D};
                pg8::gemm_phase<pg8::EpiResid, pg8::StaticOrder, true, true>(F.lds + RING_OFF, g, S, E);
                SEAM(pb + 6);
            }
        }
        if (IN(pb + 7)) {
            unsigned char* const ws = WSPTR();
            RowArgs A{}; A.xsrc = X; A.xws = X; A.xn = XN; A.out = OUTPTR(); A.yp = AP; A.tok_g = TOK_G; A.tok_s = TOK_S;
            A.gain = (l == DEPTH - 1) ? INP(I_FING) : INP(I_ANG) + (size_t)(l + 1) * D;
            if (l == DEPTH - 1) row_phase<5>(F, A);
            else if (moe) row_phase<1>(F, A);
            else row_phase<0>(F, A);
            SEAM(pb + 7);
        }
    }
#undef IN
#undef SEAM
#undef X
#undef XN
#undef P
#undef O
#undef ACT
#undef AP
#undef TOK_E
#undef TOK_R
#undef TOK_G
#undef TOK_S
}

#ifndef MK_ONE_LAUNCH
#define MK_ONE_LAUNCH 0
#endif
extern "C" void kernel_launch(void* const* d_in, const int* in_sizes, int n_in, void* d_out, int out_size, void* d_ws, size_t ws_size, hipStream_t stream) {
    static int grid = 0;
    if (grid == 0) {
        if (n_in != N_IN || in_sizes[0] != T * D || out_size != T * D || ws_size < WS_END) { fprintf(stderr, "kernel_launch: unexpected problem shape (n_in %d, in0 %d, out %d, ws %zu); nothing launched\n", n_in, n_in > 0 ? in_sizes[0] : -1, out_size, ws_size); grid = -1; return; }
        if (hipFuncSetAttribute((const void*)fwd, hipFuncAttributeMaxDynamicSharedMemorySize, LDS_BYTES) != hipSuccess) { fprintf(stderr, "kernel_launch: hipFuncSetAttribute failed; nothing launched\n"); grid = -1; return; }
        int per_cu = 0;
        if (hipOccupancyMaxActiveBlocksPerMultiprocessor(&per_cu, (const void*)fwd, NWAVES * 64, LDS_BYTES) != hipSuccess || per_cu < 1)
            fprintf(stderr, "kernel_launch: note: occupancy query reports %d workgroups per CU\n", per_cu);
        (void)hipGetLastError();
        grid = 256;
    }
    if (grid < 0) return;
    if (hipMemsetAsync((char*)d_ws + WS_CTL, 0, CTL_ZERO_BYTES, stream) != hipSuccess) { fprintf(stderr, "kernel_launch: hipMemsetAsync failed; nothing launched\n"); return; }
    Args a{};
    for (int i = 0; i < N_IN; ++i) a.in[i] = (const float*)d_in[i];
    a.out = (float*)d_out; a.ws = (unsigned char*)d_ws;
#if MK_ONE_LAUNCH
    a.ph_lo = 0; a.ph_hi = NPH;
    hipLaunchKernelGGL(fwd, dim3(grid), dim3(NWAVES * 64), LDS_BYTES, stream, a);
#else
    for (int p = 0; p < NPH; ++p) {
        if (p > 0 && ((p - 1) & 7) == 4 && ((((p - 1) >> 3) & 1) == 0)) continue;
        a.ph_lo = p; a.ph_hi = p + 1;
        hipLaunchKernelGGL(fwd, dim3(grid), dim3(NWAVES * 64), LDS_BYTES, stream, a);
    }
#endif
    const hipError_t le = hipPeekAtLastError();
    if (le != hipSuccess) fprintf(stderr, "kernel_launch: launch failed: %s\n", hipGetErrorName(le));
}
```

```cpp
#include <hip/hip_runtime.h>
#include <cstdio>
#include <cstdint>
#include <cmath>
#define MK_ONE_LAUNCH 1
namespace pg8 {
#define PG8_LAS __attribute__((address_space(3)))
typedef unsigned short bf16_t;
typedef short bf16x8 __attribute__((ext_vector_type(8)));
typedef float f32x4 __attribute__((ext_vector_type(4)));
typedef unsigned u32x4 __attribute__((ext_vector_type(4)));
constexpr int BM = 256, BK = 64, HALF = 128, HTB = HALF * BK * 2  , STAGE_BYTES = 8 * HTB, NXCD = 8, WGM = 8;

__host__ __device__ __forceinline__ int lds_byte(int r, int c) { const int st = (r >> 4) * 2 + (c >> 5), rr = r & 15, cc = c & 31, ob = rr * 64 + cc * 2; return st * 1024 + (ob ^ (((ob >> 9) & 1) << 5)); }
__host__ __device__ __forceinline__ void stage_rc(int b, int& R, int& C) { const int st = b / 1024, sb = b % 1024, swz = sb ^ (((sb >> 9) & 1) << 5); R = (st >> 1) * 16 + swz / 64; C = (st & 1) * 32 + (swz % 64) / 2; }
__host__ __device__ __forceinline__ int perm32(int rho) { const int n = rho >> 4, i = rho & 15; return 8 * (i >> 2) + 4 * n + (i & 3); }

struct Unit { int pm, pn, e; };
struct Gemm { const bf16_t* A; const bf16_t* Bt; int M, N, K; size_t estride; };

struct StaticOrder {
    int nM, nN, nwg, G, c;
    __host__ __device__ void init(int M, int N, int G_, int c_) { nM = M / BM; nN = N / BM; nwg = nM * nN; G = G_; c = c_; }
    __host__ __device__ bool next(int i, Unit& u) const {
        const long L = (long)i * G + c; if (L >= nwg) return false;
        int wgid = (int)L; { const int q = nwg / NXCD, r = nwg % NXCD, xcd = wgid % NXCD, off = wgid / NXCD; wgid = (xcd < r ? xcd * (q + 1) : r * (q + 1) + (xcd - r) * q) + off; }
        const int nig = WGM * nN, gid = wgid / nig, fm = gid * WGM, gsz = (nM - fm) < WGM ? (nM - fm) : WGM;
        u.pm = fm + ((wgid % nig) % gsz); u.pn = (wgid % nig) / gsz; u.e = 0; return true;
    }
    __device__ __forceinline__ void a_ready(const Unit&) const {}
    __device__ __forceinline__ void done(const Unit&) const {}
};

__device__ __forceinline__ unsigned cvt_pk_bf16(float lo, float hi) { unsigned r; asm volatile("v_cvt_pk_bf16_f32 %0, %1, %2" : "=v"(r) : "v"(lo), "v"(hi)); return r; }
typedef float f32x2 __attribute__((ext_vector_type(2)));
__device__ __forceinline__ f32x2 gelu_pk(f32x2 v) {
    const f32x2 av = __builtin_elementwise_abs(v), d = av * 0.2316418882f + 1.0f;
    f32x2 t; t.x = __builtin_amdgcn_rcpf(d.x); t.y = __builtin_amdgcn_rcpf(d.y);
    f32x2 q = t * 0.5307027145f + (-0.7265760135f); q = q * t + 0.7107068705f; q = q * t + (-0.142248368f); q = q * t + 0.127414796f; q = q * t;
    const f32x2 s = (v * v) * (-0.72134752044f);
    f32x2 e; e.x = __builtin_amdgcn_exp2f(s.x); e.y = __builtin_amdgcn_exp2f(s.y);
    const f32x2 m = v * (q * e), r = v - m;
    f32x2 o; o.x = v.x < 0.f ? m.x : r.x; o.y = v.y < 0.f ? m.y : r.y; return o;
}

template <int ACT  > struct EpiBf16 {
    static constexpr bool PERM = true, AFTER_DRAIN = false; static_assert(ACT == 0 || ACT == 1, "EpiBf16: ACT is 0 (none) or 1 (gelu_pk)");
    bf16_t* O; int ldc; const float* bias; int split_cols; size_t split_stride; float scale0;
    __device__ __forceinline__ void operator()(const f32x4 (&acc)[2][2][4][2], const Unit& u, int wr, int wc, int fr, int fq) const {
        const int row0 = u.pm * BM + wr * 64 + fr; int colt = u.pn * BM; bf16_t* base = O;
        float sc = 1.f; if (split_cols) { const int t = colt / split_cols; base += (size_t)t * split_stride; colt -= t * split_cols; if (t == 0) sc = scale0; }
        const int col0 = colt + wc * 32 + 8 * fq, bcol0 = u.pn * BM + wc * 32 + 8 * fq;
        f32x4 bv[2][2];
#pragma unroll
        for (int bj = 0; bj < 2; ++bj)
#pragma unroll
            for (int n = 0; n < 2; ++n) bv[bj][n] = bias ? *(const f32x4*)(bias + bcol0 + bj * HALF + 4 * n) : (f32x4){0.f, 0.f, 0.f, 0.f};
#pragma unroll
        for (int ai = 0; ai < 2; ++ai)
#pragma unroll
            for (int m = 0; m < 4; ++m) { bf16_t* rowp = base + (size_t)(row0 + ai * HALF + m * 16) * ldc + col0;
#pragma unroll
                for (int bj = 0; bj < 2; ++bj) { f32x4 v0 = acc[ai][bj][m][0] + bv[bj][0], v1 = acc[ai][bj][m][1] + bv[bj][1];
                    if (ACT == 1) { f32x2 a = gelu_pk((f32x2){v0[0], v0[1]}), b = gelu_pk((f32x2){v0[2], v0[3]}), c = gelu_pk((f32x2){v1[0], v1[1]}), d = gelu_pk((f32x2){v1[2], v1[3]});
                        v0 = (f32x4){a.x, a.y, b.x, b.y}; v1 = (f32x4){c.x, c.y, d.x, d.y}; }
                    v0 = v0 * sc; v1 = v1 * sc; u32x4 w; w.x = cvt_pk_bf16(v0[0], v0[1]); w.y = cvt_pk_bf16(v0[2], v0[3]); w.z = cvt_pk_bf16(v1[0], v1[1]); w.w = cvt_pk_bf16(v1[2], v1[3]);
                    *(u32x4*)(rowp + bj * HALF) = w; } }
    }
};
struct EpiResid {
    static constexpr bool PERM = false, AFTER_DRAIN = false;
    float* X; int ldc;
    __device__ __forceinline__ void operator()(const f32x4 (&acc)[2][2][4][2], const Unit& u, int wr, int wc, int fr, int fq) const {
        const int row0 = u.pm * BM + wr * 64 + fr, col0 = u.pn * BM + wc * 32 + 4 * fq;
#pragma unroll
        for (int ai = 0; ai < 2; ++ai)
#pragma unroll
            for (int m = 0; m < 4; ++m) { float* rowp = X + (size_t)(row0 + ai * HALF + m * 16) * ldc + col0;
                f32x4 old[2][2];
#pragma unroll
                for (int bj = 0; bj < 2; ++bj)
#pragma unroll
                    for (int n = 0; n < 2; ++n) old[bj][n] = *(const f32x4*)(rowp + bj * HALF + n * 16);
#pragma unroll
                for (int bj = 0; bj < 2; ++bj)
#pragma unroll
                    for (int n = 0; n < 2; ++n) *(f32x4*)(rowp + bj * HALF + n * 16) = old[bj][n] + acc[ai][bj][m][n];
                asm volatile("" ::: "memory"); }
    }
};
__device__ __forceinline__ float silu_mul(float g, float u) { return g * __builtin_amdgcn_rcpf(1.0f + __builtin_amdgcn_exp2f(g * -1.4426950408889634f)) * u; }
struct EpiSwiGLU {
    static constexpr bool PERM = true, AFTER_DRAIN = false;
    bf16_t* O; int ldc;
    __device__ __forceinline__ void operator()(const f32x4 (&acc)[2][2][4][2], const Unit& u, int wr, int wc, int fr, int fq) const {
        const int row0 = u.pm * BM + wr * 64 + fr, col0 = u.pn * HALF + wc * 32 + 8 * fq;
#pragma unroll
        for (int ai = 0; ai < 2; ++ai)
#pragma unroll
            for (int m = 0; m < 4; ++m) { bf16_t* rowp = O + (size_t)(row0 + ai * HALF + m * 16) * ldc + col0;
                const f32x4 g0 = acc[ai][0][m][0], g1 = acc[ai][0][m][1], u0 = acc[ai][1][m][0], u1 = acc[ai][1][m][1];
                u32x4 w;
                w.x = cvt_pk_bf16(silu_mul(g0[0], u0[0]), silu_mul(g0[1], u0[1])); w.y = cvt_pk_bf16(silu_mul(g0[2], u0[2]), silu_mul(g0[3], u0[3]));
                w.z = cvt_pk_bf16(silu_mul(g1[0], u1[0]), silu_mul(g1[1], u1[1])); w.w = cvt_pk_bf16(silu_mul(g1[2], u1[2]), silu_mul(g1[3], u1[3]));
                *(u32x4*)rowp = w; }
    }
};
struct GroupedOrder {
    int nM, nN, nwg, G, c; int t1, t2, t3, t4, t5, t6, t7;
    __device__ __forceinline__ void init(const int (&toff)[9], int N, int G_, int c_) { nM = toff[8]; nN = N / BM; nwg = nM * nN; G = G_; c = c_;
        t1 = toff[1]; t2 = toff[2]; t3 = toff[3]; t4 = toff[4]; t5 = toff[5]; t6 = toff[6]; t7 = toff[7]; }
    __device__ __forceinline__ bool next(int i, Unit& u) const {
        const long L = (long)i * G + c; if (L >= nwg) return false;
        int wgid = (int)L; { const int q = nwg / NXCD, r = nwg % NXCD, xcd = wgid % NXCD, off = wgid / NXCD; wgid = (xcd < r ? xcd * (q + 1) : r * (q + 1) + (xcd - r) * q) + off; }
        const int nig = WGM * nN, gid = wgid / nig, fm = gid * WGM, gsz = (nM - fm) < WGM ? (nM - fm) : WGM;
        u.pm = fm + ((wgid % nig) % gsz); u.pn = (wgid % nig) / gsz;
        u.e = (u.pm >= t1) + (u.pm >= t2) + (u.pm >= t3) + (u.pm >= t4) + (u.pm >= t5) + (u.pm >= t6) + (u.pm >= t7); return true;
    }
    __device__ __forceinline__ void a_ready(const Unit&) const {}
    __device__ __forceinline__ void done(const Unit&) const {}
};
template <class Epi, class Sched, bool ALIGN_EPI = false, bool SP2 = false>
__device__ __forceinline__ void gemm_phase(PG8_LAS unsigned char* lds, const Gemm g, const Sched& S, const Epi& E) {
    int tid_ = threadIdx.x; asm volatile("" : "+v"(tid_));
    const int tid = tid_, wid = __builtin_amdgcn_readfirstlane(tid >> 6), lane = tid & 63, wr = wid >> 2, wc = wid & 3, fr = lane & 15, fq = lane >> 4;
    const int K = g.K, nt = K / BK;
    unsigned voffA[2], voffB[2];
#pragma unroll
    for (int i = 0; i < 2; ++i) { int R, C; stage_rc(tid * 16 + i * 8192, R, C); const int Rb = Epi::PERM ? ((R & ~31) + perm32(R & 31)) : R;
        voffA[i] = (unsigned)(R * K + C) * 2u; voffB[i] = (unsigned)(Rb * K + C) * 2u; }
    const size_t kstep = (size_t)(BK * 2);
    const size_t hstep = (size_t)HALF * K * 2;
    const size_t tstep = 2 * hstep;
    const unsigned ldsw = (unsigned)wid * 1024u;
    const int aoff = lds_byte(wr * 64 + fr, fq * 8), boff = lds_byte(wc * 32 + fr, fq * 8);
#define PG8_SA(b, h) (((b) * 2 + (h)) * HTB)
#define PG8_SB(b, h) ((4 + (b) * 2 + (h)) * HTB)
#define PG8_STAGE(bufoff, gbase, voff) do { _Pragma("unroll") for (int _i = 0; _i < 2; ++_i) \
        __builtin_amdgcn_global_load_lds((const unsigned*)((const char*)(gbase) + (voff)[_i]), (PG8_LAS unsigned*)(lds + (bufoff) + ldsw + _i * 8192), 16, 0, 0); } while (0)
#define PG8_LDA(dst, b, h) do { _Pragma("unroll") for (int m = 0; m < 4; ++m) _Pragma("unroll") for (int k = 0; k < 2; ++k) dst[m][k] = *(const PG8_LAS bf16x8*)(lds + PG8_SA(b, h) + aoff + m * 2048 + k * 1024); } while (0)
#define PG8_LDB(dst, b, h) do { _Pragma("unroll") for (int n = 0; n < 2; ++n) _Pragma("unroll") for (int k = 0; k < 2; ++k) dst[n][k] = *(const PG8_LAS bf16x8*)(lds + PG8_SB(b, h) + boff + n * 2048 + k * 1024); } while (0)
#define PG8_MMA(ai, bj, At, Bt) do { __builtin_amdgcn_s_setprio(1); _Pragma("unroll") for (int m = 0; m < 4; ++m) _Pragma("unroll") for (int n = 0; n < 2; ++n) _Pragma("unroll") for (int k = 0; k < 2; ++k) \
        acc[ai][bj][m][n] = __builtin_amdgcn_mfma_f32_16x16x32_bf16(Bt[n][k], At[m][k], acc[ai][bj][m][n], 0, 0, 0); __builtin_amdgcn_s_setprio(0); } while (0)
#define PG8_WAIT_V(n) asm volatile("s_waitcnt vmcnt(" #n ")" ::: "memory")
#define PG8_WAIT_L(n) asm volatile("s_waitcnt lgkmcnt(" #n ")" ::: "memory")
#define PG8_BAR __builtin_amdgcn_s_barrier()
#define PG8_SCHED __builtin_amdgcn_sched_barrier(0)
    Unit cur, nxt; int ui = 0;
    if (!S.next(0, cur)) return;
    f32x4 acc[2][2][4][2];
#pragma unroll
    for (int a = 0; a < 2; ++a)
#pragma unroll
        for (int b = 0; b < 2; ++b)
#pragma unroll
            for (int m = 0; m < 4; ++m)
#pragma unroll
                for (int n = 0; n < 2; ++n) acc[a][b][m][n] = (f32x4){0.f, 0.f, 0.f, 0.f};
    bf16x8 At[4][2], B0[2][2], B1[2][2];
    const char* cA = (const char*)g.A + (size_t)cur.pm * tstep; const char* cB = (const char*)g.Bt + (size_t)cur.e * g.estride + (size_t)cur.pn * tstep;
    S.a_ready(cur);
    if constexpr (SP2) {
        PG8_STAGE(PG8_SB(0, 0), cB, voffB); PG8_STAGE(PG8_SB(0, 1), cB + hstep, voffB); PG8_STAGE(PG8_SA(0, 0), cA, voffA); PG8_STAGE(PG8_SA(0, 1), cA + hstep, voffA);
        if (wr == 1) PG8_BAR;
        PG8_WAIT_V(2); PG8_BAR;
        PG8_STAGE(PG8_SB(1, 0), cB + kstep, voffB); PG8_STAGE(PG8_SA(1, 0), cA + kstep, voffA); PG8_STAGE(PG8_SB(1, 1), cB + hstep + kstep, voffB);
        PG8_WAIT_V(6); PG8_BAR;
    } else {
        PG8_STAGE(PG8_SB(0, 0), cB, voffB); PG8_STAGE(PG8_SA(0, 0), cA, voffA); PG8_STAGE(PG8_SB(0, 1), cB + hstep, voffB); PG8_STAGE(PG8_SA(0, 1), cA + hstep, voffA);
        if (wr == 1) PG8_BAR;
        PG8_WAIT_V(4); PG8_BAR;
        PG8_STAGE(PG8_SB(1, 0), cB + kstep, voffB); PG8_STAGE(PG8_SA(1, 0), cA + kstep, voffA); PG8_STAGE(PG8_SB(1, 1), cB + hstep + kstep, voffB);
        PG8_WAIT_V(6); PG8_BAR;
    }
    for (;;) {
        const bool has_next = S.next(ui + 1, nxt);
        const char* nA = has_next ? (const char*)g.A + (size_t)nxt.pm * tstep : cA; const char* nB = has_next ? (const char*)g.Bt + (size_t)nxt.e * g.estride + (size_t)nxt.pn * tstep : cB;
        for (int t = 0; t < nt; t += 2) {
            const bool last = (t == nt - 2);
            const char* a1 = cA + (size_t)(t + 1) * kstep;
            const char* a2 = last ? nA : cA + (size_t)(t + 2) * kstep; const char* b2 = last ? nB : cB + (size_t)(t + 2) * kstep;
            const char* a3 = a2 + kstep; const char* b3 = b2 + kstep;
            if (last && has_next) S.a_ready(nxt);
            if constexpr (SP2) {
            PG8_LDB(B0, 0, 0); PG8_LDB(B1, 0, 1); PG8_SCHED; PG8_LDA(At, 0, 0); PG8_STAGE(PG8_SA(1, 1), a1 + hstep, voffA);
            PG8_WAIT_V(8); PG8_WAIT_L(0); PG8_BAR; PG8_MMA(0, 0, At, B0); PG8_MMA(0, 1, At, B1); PG8_BAR; PG8_SCHED;
            PG8_LDA(At, 0, 1); PG8_STAGE(PG8_SB(0, 0), b2, voffB); PG8_STAGE(PG8_SB(0, 1), b2 + hstep, voffB); PG8_STAGE(PG8_SA(0, 0), a2, voffA);
            PG8_WAIT_V(8); PG8_WAIT_L(0); PG8_BAR; PG8_MMA(1, 0, At, B0); PG8_MMA(1, 1, At, B1); PG8_BAR; PG8_SCHED;
            PG8_LDB(B0, 1, 0); PG8_LDB(B1, 1, 1); PG8_SCHED; PG8_LDA(At, 1, 0); PG8_STAGE(PG8_SA(0, 1), a2 + hstep, voffA);
            PG8_WAIT_V(8); PG8_WAIT_L(0); PG8_BAR; PG8_MMA(0, 0, At, B0); PG8_MMA(0, 1, At, B1); PG8_BAR; PG8_SCHED;
            PG8_LDA(At, 1, 1); PG8_STAGE(PG8_SB(1, 0), b3, voffB); PG8_STAGE(PG8_SB(1, 1), b3 + hstep, voffB); PG8_STAGE(PG8_SA(1, 0), a3, voffA);
            PG8_WAIT_V(8); PG8_WAIT_L(0); PG8_BAR; PG8_MMA(1, 0, At, B0); PG8_MMA(1, 1, At, B1); PG8_BAR; PG8_SCHED;
            } else {
            PG8_LDB(B0, 0, 0); PG8_SCHED; PG8_LDA(At, 0, 0); PG8_STAGE(PG8_SA(1, 1), a1 + hstep, voffA);
            PG8_WAIT_L(8); PG8_BAR; PG8_WAIT_L(0); PG8_MMA(0, 0, At, B0); PG8_BAR; PG8_SCHED;
            PG8_LDB(B1, 0, 1); PG8_STAGE(PG8_SB(0, 0), b2, voffB);
            PG8_BAR; PG8_WAIT_L(0); PG8_MMA(0, 1, At, B1); PG8_BAR;
            PG8_LDA(At, 0, 1); PG8_STAGE(PG8_SA(0, 0), a2, voffA);
            PG8_BAR; PG8_WAIT_L(0); PG8_MMA(1, 0, At, B0); PG8_BAR; PG8_SCHED;
            PG8_STAGE(PG8_SB(0, 1), b2 + hstep, voffB);
            PG8_WAIT_V(6); PG8_BAR; PG8_MMA(1, 1, At, B1); PG8_BAR;
            PG8_LDB(B0, 1, 0); PG8_SCHED; PG8_LDA(At, 1, 0); PG8_STAGE(PG8_SA(0, 1), a2 + hstep, voffA);
            PG8_WAIT_L(8); PG8_BAR; PG8_WAIT_L(0); PG8_MMA(0, 0, At, B0); PG8_BAR; PG8_SCHED;
            PG8_LDB(B1, 1, 1); PG8_STAGE(PG8_SB(1, 0), b3, voffB);
            PG8_BAR; PG8_WAIT_L(0); PG8_MMA(0, 1, At, B1); PG8_BAR;
            PG8_LDA(At, 1, 1); PG8_STAGE(PG8_SA(1, 0), a3, voffA);
            PG8_BAR; PG8_WAIT_L(0); PG8_MMA(1, 0, At, B0); PG8_BAR; PG8_SCHED;
            PG8_STAGE(PG8_SB(1, 1), b3 + hstep, voffB);
            PG8_WAIT_V(6); PG8_BAR; PG8_MMA(1, 1, At, B1); PG8_BAR;
            }
        }
        if constexpr (ALIGN_EPI) { if (wr == 0) PG8_BAR; }
        if constexpr (!Epi::AFTER_DRAIN) { E(acc, cur, wr, wc, fr, fq); S.done(cur); }
        if (!has_next) break;
#pragma unroll
        for (int a = 0; a < 2; ++a)
#pragma unroll
            for (int b = 0; b < 2; ++b)
#pragma unroll
                for (int m = 0; m < 4; ++m)
#pragma unroll
                    for (int n = 0; n < 2; ++n) acc[a][b][m][n] = (f32x4){0.f, 0.f, 0.f, 0.f};
        cur = nxt; cA = nA; cB = nB; ++ui;
        if constexpr (ALIGN_EPI) { if (wr == 1) PG8_BAR; }
    }
    PG8_WAIT_V(0);
    if constexpr (!ALIGN_EPI) { if (wr == 0) PG8_BAR; }
    PG8_BAR;
    if constexpr (Epi::AFTER_DRAIN) { E.fused(acc, cur, wr, wc, fr, fq, lds, wid, lane); S.done(cur); }
#undef PG8_SA
#undef PG8_SB
#undef PG8_STAGE
#undef PG8_LDA
#undef PG8_LDB
#undef PG8_MMA
#undef PG8_WAIT_V
#undef PG8_WAIT_L
#undef PG8_BAR
#undef PG8_SCHED
}
}
#define GAS __attribute__((address_space(1)))
#define LAS __attribute__((address_space(3)))
typedef unsigned short bf16;
typedef unsigned v4u __attribute__((ext_vector_type(4)));
typedef float f32x4 __attribute__((ext_vector_type(4)));
typedef short bf16x8 __attribute__((ext_vector_type(8)));
typedef GAS unsigned gu32;
typedef GAS unsigned long long gu64;
#define RLX_AGENT __ATOMIC_RELAXED, __HIP_MEMORY_SCOPE_AGENT
#define LDS_WAIT() asm volatile("s_waitcnt lgkmcnt(0)" ::: "memory")
#define VM_WAIT() asm volatile("s_waitcnt vmcnt(0)" ::: "memory")
__device__ __forceinline__ unsigned long long rt() { return __builtin_amdgcn_s_memrealtime(); }
__device__ __forceinline__ unsigned f2bf(float f) { unsigned u = __builtin_bit_cast(unsigned, f); return (u + 0x7fffu + ((u >> 16) & 1u)) >> 16; }
__device__ __forceinline__ unsigned pk2(float lo, float hi) { return f2bf(lo) | (f2bf(hi) << 16); }

#define XB_TMO      128
#define XB_XCNT(j)  (256  + 64 * (j))
#define XB_XSUB(j)  (1280 + 64 * (j))
#define XB_XGEN(j)  (2304 + 64 * (j))
#define XB_TOP      3328
#define XB_TOPGEN   3392
#define XCD_BAR_WORDS 3456
#define XB_SPIN_CAP (1u << 18)

__device__ __forceinline__ unsigned xb_ld(unsigned* p)              { return __hip_atomic_load(p, __ATOMIC_RELAXED, __HIP_MEMORY_SCOPE_AGENT); }
__device__ __forceinline__ unsigned xb_add(unsigned* p, unsigned v) { return __hip_atomic_fetch_add(p, v, __ATOMIC_RELAXED, __HIP_MEMORY_SCOPE_AGENT); }
__device__ __forceinline__ unsigned xb_xcc_id() { return (unsigned)__builtin_amdgcn_s_getreg((3 << 11) | 20) & 0xFu; }
#define XB_SPIN(cond, bar) do { unsigned _sp = 0; while (cond) { __builtin_amdgcn_s_sleep(1); \
    if ((++_sp & 255u) == 0u) { if (xb_ld(&(bar)[XB_TMO])) break; if (_sp > XB_SPIN_CAP) { atomicAdd(&(bar)[XB_TMO], 1u); break; } } } } while (0)

struct XcdBarrier {
    unsigned* bar; unsigned x;
    volatile LAS unsigned* st;
};

__device__ __forceinline__ XcdBarrier xcd_barrier_post(unsigned* bar, volatile LAS unsigned* st) {
    XcdBarrier b; b.bar = bar; b.x = xb_xcc_id(); b.st = st;
    if (threadIdx.x == 0) (void)xb_add(&bar[XB_XCNT(b.x)], 1u);
    return b;
}
__device__ __forceinline__ void xcd_barrier_complete(unsigned* bar, unsigned x, unsigned& nloc, unsigned& nx) {
    const unsigned G = gridDim.x * gridDim.y * gridDim.z;
    unsigned sum, cnt, mine, sp = 0u;
    for (;;) {
        sum = 0u; cnt = 0u; mine = 0u;
#pragma unroll
        for (unsigned j = 0; j < 16; ++j) { const unsigned c = xb_ld(&bar[XB_XCNT(j)]); sum += c; cnt += (c > 0u) ? 1u : 0u; mine = (j == x) ? c : mine; }
        if (sum == G) break;
        __builtin_amdgcn_s_sleep(1);
        if ((++sp & 255u) == 0u) { if (xb_ld(&bar[XB_TMO])) break; if (sp > XB_SPIN_CAP) { atomicAdd(&bar[XB_TMO], 1u); break; } }
    }
    nloc = mine > 0u ? mine : 1u; nx = cnt > 0u ? cnt : 1u;
}

__device__ __forceinline__ void xcd_barrier(const XcdBarrier& b) {
    asm volatile("s_waitcnt vmcnt(0)" ::: "memory");
    __syncthreads();
    if (threadIdx.x == 0) {
        unsigned* bar = b.bar;
        __builtin_amdgcn_s_waitcnt(0);
        unsigned nloc = b.st[0], nx = b.st[1];
        if (nloc == 0u) { xcd_barrier_complete(bar, b.x, nloc, nx); b.st[0] = nloc; b.st[1] = nx; }
        const unsigned old = xb_add(&bar[XB_XSUB(b.x)], 1u);
        const unsigned gen = old / nloc;
        if (old + 1u == (gen + 1u) * nloc) {
            __builtin_amdgcn_fence(__ATOMIC_RELEASE, "agent");
            asm volatile("s_waitcnt vmcnt(0)" ::: "memory");
            const unsigned og = xb_add(&bar[XB_TOP], 1u);
            const unsigned tg = og / nx;
            if (og + 1u == (tg + 1u) * nx) xb_add(&bar[XB_TOPGEN], 1u);
            else XB_SPIN(xb_ld(&bar[XB_TOPGEN]) == tg, bar);
            __builtin_amdgcn_fence(__ATOMIC_ACQUIRE, "agent");
            xb_add(&bar[XB_XGEN(b.x)], 1u);
            asm volatile("s_waitcnt vmcnt(0)" ::: "memory");
        } else {
            XB_SPIN(xb_ld(&bar[XB_XGEN(b.x)]) == gen, bar);
            __builtin_amdgcn_fence(__ATOMIC_ACQUIRE, "agent");
            asm volatile("s_waitcnt vmcnt(0)" ::: "memory");
        }
    }
    __syncthreads();
}
constexpr int NWAVES = 8;
constexpr int BATCH = 8, SEQ = 2048, D = 1024, T = BATCH * SEQ, DEPTH = 4;
constexpr int NH = 8, HD = 64, AW = 512, PW = 256, CW = 256, INC = 2304, CK = 31;
constexpr int FF = 2816, NE = 8, NGU = 2 * FF;
constexpr int MAXSLOT = 2 * T + NE * 256;
constexpr float RMS_EPS = 1e-6f, LN_EPS = 1e-5f;
constexpr float QSCALE = 0.125f * 1.4426950408889634f;
constexpr float W_EXIT = -150.0f;
constexpr int PQ = 0, PK = 512, PV = 1024, PPOOL = 1536, PCV = 1792, PCG = 2048;
enum { I_X = 0, I_ANG, I_WIN, I_POOLW, I_POOLS, I_CONVW, I_CONVB, I_LNG, I_LNB, I_GNG, I_WOUT, I_FNG, I_DWG, I_DWU, I_DWD, I_RW, I_MWG, I_MWU, I_MWD, I_FING, N_IN };

constexpr size_t MiB = 1u << 20;
constexpr size_t WS_CTL = 0, CTL_ZERO_BYTES = 1 * MiB;
constexpr size_t WS_TOKE = 1 * MiB, WS_TOKR = WS_TOKE + 128 * 1024, WS_TOKG = WS_TOKR + 128 * 1024, WS_TOKS = WS_TOKG + 128 * 1024;
constexpr size_t WS_WIN = 4 * MiB;
constexpr size_t WS_WOUT = 22 * MiB;
constexpr size_t WS_WGUD = 30 * MiB;
constexpr size_t WS_WDD = 52 * MiB;
constexpr size_t WS_WGUM = 64 * MiB;
constexpr size_t WS_WDM = 240 * MiB;
constexpr size_t WS_X = 328 * MiB;
constexpr size_t WS_XN = 392 * MiB;
constexpr size_t WS_P = 424 * MiB;
constexpr size_t WS_O = 496 * MiB;
constexpr size_t WS_ACT = 424 * MiB;
constexpr size_t WS_AP = 611 * MiB;
constexpr size_t WS_END = 679 * MiB;
static_assert(WS_WIN + (size_t)4 * INC * D * 2 <= WS_WOUT && WS_WOUT + (size_t)4 * D * D * 2 <= WS_WGUD && WS_WGUD + (size_t)2 * NGU * D * 2 <= WS_WDD && WS_WDD + (size_t)2 * D * FF * 2 <= WS_WGUM, "ws map 1");
static_assert(WS_WGUM + (size_t)16 * NGU * D * 2 <= WS_WDM && WS_WDM + (size_t)16 * D * FF * 2 <= WS_X && WS_X + (size_t)T * D * 4 <= WS_XN && WS_XN + (size_t)T * D * 2 <= WS_P, "ws map 2");
static_assert(WS_P + (size_t)T * INC * 2 <= WS_O && WS_O + (size_t)T * D * 2 <= WS_AP && WS_ACT + (size_t)MAXSLOT * FF * 2 <= WS_AP && WS_AP + (size_t)MAXSLOT * D * 2 <= WS_END, "ws map 3");
constexpr int CW_TMO = 0, CW_CODE = 1;
constexpr int CW_BAR = 4096;
constexpr int CW_MOE = 8192;

constexpr int RING_OFF = 0, RING_BYTES = 131072;
constexpr int LDSCTL_OFF = RING_BYTES, MISC_OFF = LDSCTL_OFF + 320;
constexpr int LDS_BYTES = 147456;
typedef unsigned u32x2 __attribute__((ext_vector_type(2)));
struct Frame {
    LAS unsigned char* lds;
    volatile LAS unsigned* MISC;
    int vcu, G;
};
__device__ __forceinline__ int opaque_tid() { int t = threadIdx.x; asm volatile("" : "+v"(t)); return t; }
#define PHASE_IDS() const int tid = opaque_tid(), lane = tid & 63, wave = __builtin_amdgcn_readfirstlane(tid >> 6); (void)tid; (void)lane; (void)wave
template <int I> __device__ __forceinline__ const float* inp() { const float* p; asm volatile("s_load_dwordx2 %0, %1, %2\n\ts_waitcnt lgkmcnt(0)" : "=&s"(p) : "s"(__builtin_amdgcn_kernarg_segment_ptr()), "n"(I * 8)); return p; }
#define INP(i) inp<(i)>()
#define OUTPTR() ((float*)const_cast<float*>(inp<N_IN>()))
#define WSPTR() ((unsigned char*)const_cast<float*>(inp<N_IN + 1>()))
#define CTLPTR() ((gu32*)WSPTR())
__device__ __forceinline__ float bf2f(bf16 b) { return __uint_as_float((unsigned)b << 16); }
__device__ __forceinline__ float bflo(unsigned w) { return __uint_as_float(w << 16); }
__device__ __forceinline__ float bfhi(unsigned w) { return __uint_as_float(w & 0xffff0000u); }
__device__ __forceinline__ float wave_sum(float v) {
#pragma unroll
    for (int o = 1; o < 64; o <<= 1) v += __shfl_xor(v, o);
    return v;
}
__device__ __forceinline__ void fail_word(unsigned code) {
    if (threadIdx.x == 0) { gu32* ctl = CTLPTR(); unsigned expect = 0u; __hip_atomic_compare_exchange_strong((unsigned*)(ctl + CW_CODE), &expect, code, __ATOMIC_RELAXED, __ATOMIC_RELAXED, __HIP_MEMORY_SCOPE_AGENT);
        __hip_atomic_store(ctl + CW_TMO, 1u, RLX_AGENT); }
}

__device__ __forceinline__ void transpose_item(const float* W, int K, int N, bf16* WT, int mode, int nscale, LAS float* scr, int item, int lane) {
    const int nblk = N / 32, kb = item / nblk, nb = item % nblk, k0 = 64 * kb, n0 = 32 * nb;
#pragma unroll 8
    for (int i = 0; i < 32; ++i) { const int kk = 2 * i + (lane >> 5); scr[kk * 33 + (lane & 31)] = W[(size_t)(k0 + kk) * N + n0 + (lane & 31)]; }
    LDS_WAIT(); asm volatile("" ::: "memory");
    const int r0 = (mode == 0) ? n0 : (256 * (n0 >> 7) + (n0 & 127) + (mode == 2 ? 128 : 0));
    const float sc = (n0 < nscale) ? QSCALE : 1.0f;
    const int c = lane & 7;
#pragma unroll
    for (int j = 0; j < 4; ++j) { const int n = (lane >> 3) + 8 * j; const LAS float* s = scr + (8 * c) * 33 + n;
        v4u o; o.x = pk2(s[0 * 33] * sc, s[1 * 33] * sc); o.y = pk2(s[2 * 33] * sc, s[3 * 33] * sc); o.z = pk2(s[4 * 33] * sc, s[5 * 33] * sc); o.w = pk2(s[6 * 33] * sc, s[7 * 33] * sc);
        *(GAS v4u*)(WT + (size_t)(r0 + n) * K + k0 + 8 * c) = o; }
    LDS_WAIT(); asm volatile("" ::: "memory");
}
__device__ __forceinline__ void p0_weights(Frame& F) {
    PHASE_IDS(); unsigned char* const ws = WSPTR();
    LAS float* scr = (LAS float*)(F.lds + RING_OFF + wave * 16384);
    const int gw = F.vcu * NWAVES + wave, NGW = F.G * NWAVES;
    constexpr int I_IN = (D / 64) * (INC / 32), I_OUT = (D / 64) * (D / 32), I_GU = (D / 64) * (FF / 32), I_DN = (FF / 64) * (D / 32);
    constexpr int N0 = 4 * I_IN, N1 = N0 + 4 * I_OUT, N2 = N1 + 2 * I_GU, N3 = N2 + 2 * I_GU, N4 = N3 + 2 * I_DN, N5 = N4 + 16 * I_GU, N6 = N5 + 16 * I_GU, N7 = N6 + 16 * I_DN;
    bf16* const win = (bf16*)(ws + WS_WIN); bf16* const wout = (bf16*)(ws + WS_WOUT); bf16* const wgud = (bf16*)(ws + WS_WGUD); bf16* const wdd = (bf16*)(ws + WS_WDD);
    bf16* const wgum = (bf16*)(ws + WS_WGUM); bf16* const wdm = (bf16*)(ws + WS_WDM);
    for (int it = gw; it < N7; it += NGW) {
        if (it < N0) { const int l = it / I_IN, r = it % I_IN; transpose_item(INP(I_WIN) + (size_t)l * D * INC, D, INC, win + (size_t)l * INC * D, 0, 512, scr, r, lane); }
        else if (it < N1) { const int q = it - N0, l = q / I_OUT, r = q % I_OUT; transpose_item(INP(I_WOUT) + (size_t)l * D * D, D, D, wout + (size_t)l * D * D, 0, 0, scr, r, lane); }
        else if (it < N2) { const int q = it - N1, l = q / I_GU, r = q % I_GU; transpose_item(INP(I_DWG) + (size_t)l * D * FF, D, FF, wgud + (size_t)l * NGU * D, 1, 0, scr, r, lane); }
        else if (it < N3) { const int q = it - N2, l = q / I_GU, r = q % I_GU; transpose_item(INP(I_DWU) + (size_t)l * D * FF, D, FF, wgud + (size_t)l * NGU * D, 2, 0, scr, r, lane); }
        else if (it < N4) { const int q = it - N3, l = q / I_DN, r = q % I_DN; transpose_item(INP(I_DWD) + (size_t)l * FF * D, FF, D, wdd + (size_t)l * D * FF, 0, 0, scr, r, lane); }
        else if (it < N5) { const int q = it - N4, l = q / I_GU, r = q % I_GU; transpose_item(INP(I_MWG) + (size_t)l * D * FF, D, FF, wgum + (size_t)l * NGU * D, 1, 0, scr, r, lane); }
        else if (it < N6) { const int q = it - N5, l = q / I_GU, r = q % I_GU; transpose_item(INP(I_MWU) + (size_t)l * D * FF, D, FF, wgum + (size_t)l * NGU * D, 2, 0, scr, r, lane); }
        else { const int q = it - N6, l = q / I_DN, r = q % I_DN; transpose_item(INP(I_MWD) + (size_t)l * FF * D, FF, D, wdm + (size_t)l * D * FF, 0, 0, scr, r, lane); }
    }
}

struct RowArgs { const float* xsrc; float* xws; const float* gain; bf16* xn; float* out; const bf16* yp; const float* wr; gu32* gcur;
                 int* tok_e; int* tok_r; float* tok_g; const int* tok_s; };
template <int MODE>
__device__ __forceinline__ void row_phase(Frame& F, const RowArgs& A) {
    constexpr bool COMBINE = MODE & 1, ROUTER = (MODE & 2) != 0, FINAL = (MODE & 4) != 0, COPYIN = (MODE & 8) != 0;
    LAS int* s_cnt = (LAS int*)(F.lds + RING_OFF);
    LAS int* s_base = s_cnt + 8;
    LAS int* s_e = s_cnt + 16;
    LAS int* s_rk = s_e + 128;
    LAS float* s_g = (LAS float*)(s_rk + 128);
    PHASE_IDS();
    if (ROUTER) { if (tid < 16) s_cnt[tid] = 0; __syncthreads(); }
#pragma unroll 1
    for (int i = 0; i < 8; ++i) {
        const int rl = wave * 8 + i, m = F.vcu * 64 + rl;
        const GAS f32x4* xr = (const GAS f32x4*)(A.xsrc + (size_t)m * D) + lane;
        f32x4 v[4];
#pragma unroll
        for (int j = 0; j < 4; ++j) v[j] = xr[64 * j];
        if (COMBINE) {
            const int s0 = A.tok_s[2 * m], s1 = A.tok_s[2 * m + 1]; const float g0 = A.tok_g[2 * m], g1 = A.tok_g[2 * m + 1];
            const GAS u32x2* y0 = (const GAS u32x2*)(A.yp + (size_t)s0 * D) + lane; const GAS u32x2* y1 = (const GAS u32x2*)(A.yp + (size_t)s1 * D) + lane;
#pragma unroll
            for (int j = 0; j < 4; ++j) { const u32x2 a = y0[64 * j], b = y1[64 * j];
                v[j].x += g0 * bflo(a.x) + g1 * bflo(b.x); v[j].y += g0 * bfhi(a.x) + g1 * bfhi(b.x); v[j].z += g0 * bflo(a.y) + g1 * bflo(b.y); v[j].w += g0 * bfhi(a.y) + g1 * bfhi(b.y); }
        }
        if (COMBINE || COPYIN) { GAS f32x4* xw = (GAS f32x4*)(A.xws + (size_t)m * D) + lane;
#pragma unroll
            for (int j = 0; j < 4; ++j) xw[64 * j] = v[j]; }
        float ss = 0.f;
#pragma unroll
        for (int j = 0; j < 4; ++j) ss += (v[j].x * v[j].x + v[j].y * v[j].y) + (v[j].z * v[j].z + v[j].w * v[j].w);
        const float rstd = 1.0f / sqrtf(wave_sum(ss) * (1.0f / D) + RMS_EPS);
        const GAS f32x4* gr = (const GAS f32x4*)A.gain + lane;
#pragma unroll
        for (int j = 0; j < 4; ++j) v[j] = v[j] * rstd * gr[64 * j];
        if (FINAL) { GAS f32x4* o = (GAS f32x4*)(A.out + (size_t)m * D) + lane;
#pragma unroll
            for (int j = 0; j < 4; ++j) o[64 * j] = v[j]; }
        else { GAS u32x2* o = (GAS u32x2*)(A.xn + (size_t)m * D) + lane;
#pragma unroll
            for (int j = 0; j < 4; ++j) o[64 * j] = (u32x2){pk2(v[j].x, v[j].y), pk2(v[j].z, v[j].w)}; }
        if (ROUTER) {
            float lg[8];
#pragma unroll
            for (int e = 0; e < 8; ++e) lg[e] = 0.f;
#pragma unroll
            for (int j = 0; j < 4; ++j)
#pragma unroll
                for (int q = 0; q < 4; ++q) { const GAS f32x4* w = (const GAS f32x4*)(A.wr + (size_t)(256 * j + 4 * lane + q) * 8); const f32x4 w0 = w[0], w1 = w[1]; const float h = v[j][q];
                    lg[0] += h * w0.x; lg[1] += h * w0.y; lg[2] += h * w0.z; lg[3] += h * w0.w; lg[4] += h * w1.x; lg[5] += h * w1.y; lg[6] += h * w1.z; lg[7] += h * w1.w; }
#pragma unroll
            for (int e = 0; e < 8; ++e) lg[e] = wave_sum(lg[e]);
            int e1 = 0; float v1 = lg[0];
#pragma unroll
            for (int e = 1; e < 8; ++e) if (lg[e] > v1) { v1 = lg[e]; e1 = e; }
            int e2 = -1; float v2 = -INFINITY;
#pragma unroll
            for (int e = 0; e < 8; ++e) if (e != e1 && (e2 < 0 || lg[e] > v2)) { v2 = lg[e]; e2 = e; }
            const float g1 = 1.0f / (1.0f + __expf(v2 - v1)), g2 = 1.0f - g1;
            if (lane == 0) { const int r1 = atomicAdd((int*)(s_cnt + e1), 1), r2 = atomicAdd((int*)(s_cnt + e2), 1);
                s_e[2 * rl] = e1; s_e[2 * rl + 1] = e2; s_rk[2 * rl] = r1; s_rk[2 * rl + 1] = r2; s_g[2 * rl] = g1; s_g[2 * rl + 1] = g2; }
        }
    }
    if (ROUTER) {
        __syncthreads();
        if (tid < 8) s_base[tid] = (int)__hip_atomic_fetch_add(A.gcur + 64 * tid, (unsigned)s_cnt[tid], RLX_AGENT);
        __syncthreads();
        if (tid < 128) { const int m2 = F.vcu * 128 + tid; const int e = s_e[tid]; A.tok_e[m2] = e; A.tok_r[m2] = s_base[e] + s_rk[tid]; A.tok_g[m2] = s_g[tid]; }
        __syncthreads();
    }
}

__device__ __forceinline__ void load_toff(gu32* gcur, int (&cnt)[8], int (&toff)[9]) {
    toff[0] = 0;
#pragma unroll
    for (int e = 0; e < 8; ++e) { cnt[e] = (int)__builtin_amdgcn_readfirstlane(__hip_atomic_load(gcur + 64 * e, RLX_AGENT)); toff[e + 1] = toff[e] + ((cnt[e] + 255) >> 8); }
}
__device__ __forceinline__ void gather_phase(Frame& F, gu32* gcur, const bf16* xn, bf16* ap, const int* tok_e, const int* tok_r, int* tok_s) {
    PHASE_IDS();
    int cnt[8], toff[9]; load_toff(gcur, cnt, toff);
#pragma unroll 1
    for (int i = 0; i < 8; ++i) {
        const int m = F.vcu * 64 + wave * 8 + i;
        const GAS v4u* src = (const GAS v4u*)(xn + (size_t)m * D) + lane; const v4u a = src[0], b = src[64];
#pragma unroll
        for (int k = 0; k < 2; ++k) {
            const int e = tok_e[2 * m + k], r = tok_r[2 * m + k];
            int base = 0;
#pragma unroll
            for (int q = 0; q < 8; ++q) base = (e == q) ? toff[q] : base;
            const int slot = base * 256 + r;
            if (lane == 0) tok_s[2 * m + k] = slot;
            GAS v4u* dst = (GAS v4u*)(ap + (size_t)slot * D) + lane; dst[0] = a; dst[64] = b;
        }
    }
    const int gw = F.vcu * NWAVES + wave, NGW = F.G * NWAVES;
#pragma unroll
    for (int e = 0; e < 8; ++e) {
        for (int r = toff[e] * 256 + cnt[e] + gw; r < toff[e + 1] * 256; r += NGW) { GAS v4u* dst = (GAS v4u*)(ap + (size_t)r * D) + lane; dst[0] = (v4u){0u, 0u, 0u, 0u}; dst[64] = (v4u){0u, 0u, 0u, 0u}; }
    }
}

__device__ __forceinline__ void attn_simple(Frame& F, const bf16* P, bf16* O, const float* ga) {
    PHASE_IDS();
    const int gw = F.vcu * NWAVES + wave, NGW = F.G * NWAVES;
    for (int tg = gw; tg < T / 8; tg += NGW) {
        const int h = lane & 7, tl = lane >> 3, row = tg * 8 + tl, s = row % SEQ;
        float q[64], o[64];
        { const v4u* qp = (const v4u*)(P + (size_t)row * INC + PQ + h * 64);
#pragma unroll
          for (int i = 0; i < 8; ++i) { const v4u w = qp[i]; q[8 * i] = bflo(w.x); q[8 * i + 1] = bfhi(w.x); q[8 * i + 2] = bflo(w.y); q[8 * i + 3] = bfhi(w.y); q[8 * i + 4] = bflo(w.z); q[8 * i + 5] = bfhi(w.z); q[8 * i + 6] = bflo(w.w); q[8 * i + 7] = bfhi(w.w); } }
#pragma unroll
        for (int d = 0; d < 64; ++d) o[d] = 0.f;
        float carry = 0.f;
        for (int j = s - 1; j >= 0; --j) {
            const v4u* kp = (const v4u*)(P + (size_t)(row - s + j) * INC + PK + h * 64); const v4u* vp = (const v4u*)(P + (size_t)(row - s + j) * INC + PV + h * 64);
            float z = 0.f;
#pragma unroll
            for (int i = 0; i < 8; ++i) { const v4u w = kp[i];
                z += q[8 * i] * bflo(w.x) + q[8 * i + 1] * bfhi(w.x) + q[8 * i + 2] * bflo(w.y) + q[8 * i + 3] * bfhi(w.y) + q[8 * i + 4] * bflo(w.z) + q[8 * i + 5] * bfhi(w.z) + q[8 * i + 6] * bflo(w.w) + q[8 * i + 7] * bfhi(w.w); }
            const float sp = fmaxf(z, 0.f) + __builtin_amdgcn_logf(1.0f + __builtin_amdgcn_exp2f(-fabsf(z)));
            carry -= sp;
            const float w = __builtin_amdgcn_exp2f(z + carry);
#pragma unroll
            for (int i = 0; i < 8; ++i) { const v4u x = vp[i];
                o[8 * i] += w * bflo(x.x); o[8 * i + 1] += w * bfhi(x.x); o[8 * i + 2] += w * bflo(x.y); o[8 * i + 3] += w * bfhi(x.y); o[8 * i + 4] += w * bflo(x.z); o[8 * i + 5] += w * bfhi(x.z); o[8 * i + 6] += w * bflo(x.w); o[8 * i + 7] += w * bfhi(x.w); }
            if (carry < W_EXIT) break;
        }
        float ss = 0.f;
#pragma unroll
        for (int d = 0; d < 64; ++d) ss += o[d] * o[d];
        ss += __shfl_xor(ss, 1); ss += __shfl_xor(ss, 2); ss += __shfl_xor(ss, 4);
        const float rstd = 1.0f / sqrtf(ss * (1.0f / AW) + RMS_EPS);
        const f32x4* gp = (const f32x4*)(ga + h * 64); v4u* op = (v4u*)(O + (size_t)row * D + h * 64);
#pragma unroll
        for (int i = 0; i < 8; ++i) { const f32x4 g0 = gp[2 * i], g1 = gp[2 * i + 1]; v4u w;
            w.x = pk2(o[8 * i] * rstd * g0.x, o[8 * i + 1] * rstd * g0.y); w.y = pk2(o[8 * i + 2] * rstd * g0.z, o[8 * i + 3] * rstd * g0.w);
            w.z = pk2(o[8 * i + 4] * rstd * g1.x, o[8 * i + 5] * rstd * g1.y); w.w = pk2(o[8 * i + 6] * rstd * g1.z, o[8 * i + 7] * rstd * g1.w); op[i] = w; }
    }
}
struct PcArgs { const bf16* P; bf16* O; const float* poolw; const float* pools; const float* convw; const float* convb; const float* lng; const float* lnb; const float* gng; };
__device__ __forceinline__ void poolconv_phase(Frame& F, const PcArgs& A) {
    LAS float* ybuf = (LAS float*)(F.lds + RING_OFF);
    LAS float* obuf = ybuf + 32 * 256;
    LAS float* ubuf = obuf + 32 * 256;
    PHASE_IDS();
    const bf16* P = A.P;
    for (int u = F.vcu; u < T / 32; u += F.G) {
        const int row0 = u * 32, s0 = row0 % SEQ;
        { const int ch = tid & 255, g = ch >> 6, win = 2 << g;
#pragma unroll 1
          for (int i = 0; i < 16; ++i) { const int tl = (tid >> 8) + 2 * i, s = s0 + tl, cnt = (s + 1 < win) ? s + 1 : win;
              float sum = 0.f; for (int k = 0; k < cnt; ++k) sum += bf2f(P[(size_t)(row0 + tl - k) * INC + PPOOL + ch]);
              ybuf[tl * 256 + ch] = sum / (float)cnt - bf2f(P[(size_t)(row0 + tl) * INC + PPOOL + ch]); }
#pragma unroll 1
          for (int rr = (tid >> 8); rr < 62; rr += 2) { const int s = s0 - 30 + rr; float uv = 0.f;
              if (s >= 0) { const size_t r = (size_t)(row0 - 30 + rr) * INC; const float val = bf2f(P[r + PCV + ch]), gt = bf2f(P[r + PCG + ch]); uv = val / (1.0f + __expf(-gt)); }
              ubuf[rr * 256 + ch] = uv; } }
        __syncthreads();
        { const int col = tid & 255, g = col >> 6, d = col & 63; float acc[16];
#pragma unroll
          for (int i = 0; i < 16; ++i) acc[i] = 0.f;
          const float* wp = A.poolw + (size_t)g * 64 * 64 + d;
#pragma unroll 4
          for (int c = 0; c < 64; ++c) { const float w = wp[c * 64];
#pragma unroll
              for (int i = 0; i < 16; ++i) acc[i] += ybuf[((tid >> 8) + 2 * i) * 256 + g * 64 + c] * w; }
          const float ps = A.pools[col];
#pragma unroll
          for (int i = 0; i < 16; ++i) obuf[((tid >> 8) + 2 * i) * 256 + col] = acc[i] * ps; }
        __syncthreads();
        { const f32x4 gb = *(const f32x4*)(A.gng + AW + 4 * lane);
#pragma unroll
          for (int tk = 0; tk < 4; ++tk) { const int tl = 4 * wave + tk; const f32x4 v = *(const LAS f32x4*)(obuf + tl * 256 + 4 * lane);
              const float ss = wave_sum((v.x * v.x + v.y * v.y) + (v.z * v.z + v.w * v.w)); const float rstd = 1.0f / sqrtf(ss * (1.0f / PW) + RMS_EPS);
              *(u32x2*)(A.O + (size_t)(row0 + tl) * D + AW + 4 * lane) = (u32x2){pk2(v.x * rstd * gb.x, v.y * rstd * gb.y), pk2(v.z * rstd * gb.z, v.w * rstd * gb.w)}; } }
        { f32x4 acc[4]; const f32x4 cb = *(const f32x4*)(A.convb + 4 * lane);
#pragma unroll
          for (int tk = 0; tk < 4; ++tk) acc[tk] = cb;
#pragma unroll 1
          for (int j = 0; j < CK; ++j) { const f32x4 w4 = *(const f32x4*)(A.convw + (size_t)j * CW + 4 * lane);
#pragma unroll
              for (int tk = 0; tk < 4; ++tk) { const f32x4 u4 = *(const LAS f32x4*)(ubuf + (4 * wave + tk + j) * 256 + 4 * lane); acc[tk] += w4 * u4; } }
          const f32x4 lg = *(const f32x4*)(A.lng + 4 * lane), lb = *(const f32x4*)(A.lnb + 4 * lane), gc = *(const f32x4*)(A.gng + AW + PW + 4 * lane);
#pragma unroll
          for (int tk = 0; tk < 4; ++tk) { const int tl = 4 * wave + tk; f32x4 v = acc[tk];
              const float mean = wave_sum((v.x + v.y) + (v.z + v.w)) * (1.0f / CW); v = v - mean;
              const float var = wave_sum((v.x * v.x + v.y * v.y) + (v.z * v.z + v.w * v.w)) * (1.0f / CW); const float rs = 1.0f / sqrtf(var + LN_EPS);
              v = v * rs * lg + lb;
              v.x = v.x / (1.0f + __expf(-v.x)); v.y = v.y / (1.0f + __expf(-v.y)); v.z = v.z / (1.0f + __expf(-v.z)); v.w = v.w / (1.0f + __expf(-v.w));
              const float ss = wave_sum((v.x * v.x + v.y * v.y) + (v.z * v.z + v.w * v.w)); const float rstd = 1.0f / sqrtf(ss * (1.0f / CW) + RMS_EPS);
              *(u32x2*)(A.O + (size_t)(row0 + tl) * D + AW + PW + 4 * lane) = (u32x2){pk2(v.x * rstd * gc.x, v.y * rstd * gc.y), pk2(v.z * rstd * gc.z, v.w * rstd * gc.w)}; } }
        __syncthreads();
    }
}
typedef float f32x16 __attribute__((ext_vector_type(16)));
typedef short s16x4 __attribute__((ext_vector_type(4)));
typedef short v4i16_t __attribute__((ext_vector_type(4)));
typedef float f32x2_t __attribute__((ext_vector_type(2))); typedef __bf16 bf16x2_t __attribute__((ext_vector_type(2)));
__device__ __forceinline__ unsigned cvtpk(float lo, float hi) { f32x2_t v = {lo, hi}; bf16x2_t b = __builtin_convertvector(v, bf16x2_t); return __builtin_bit_cast(unsigned, b); }
__device__ __forceinline__ s16x4 vtr(const LAS unsigned char* p) { return __builtin_bit_cast(s16x4, __builtin_amdgcn_ds_read_tr16_b64_v4i16((LAS v4i16_t*)p)); }
constexpr int ATT_VBYTES = 4096;
constexpr int ATT_HS_OFF = NWAVES * ATT_VBYTES;

template <bool DIAG>
__device__ __forceinline__ void sb_block(const bf16x8 (&kf)[4], const bf16x8 (&qf)[4], const LAS unsigned char* vrd, int qlim, float sel, float& carry, f32x16 (&oacc)[2]) {
    f32x16 st;
#pragma unroll
    for (int r = 0; r < 16; ++r) st[r] = 0.f;
#pragma unroll
    for (int ds = 0; ds < 4; ++ds) st = __builtin_amdgcn_mfma_f32_32x32x16_bf16(kf[ds], qf[ds], st, 0, 0, 0);
    float inc[16];
#pragma unroll
    for (int r = 0; r < 16; ++r) { const float z = st[r];
        float l = -(fmaxf(z, 0.f) + __builtin_amdgcn_logf(1.0f + __builtin_amdgcn_exp2f(-fabsf(z))));
        if (DIAG) l = ((r & 3) + 8 * (r >> 2) < qlim) ? l : 0.f;
        inc[r] = l; }
    float T[4], Ghi[4];
#pragma unroll
    for (int g = 0; g < 4; ++g) { inc[4 * g + 2] += inc[4 * g + 3]; inc[4 * g + 1] += inc[4 * g + 2]; inc[4 * g] += inc[4 * g + 1];
        const auto rr = __builtin_amdgcn_permlane32_swap(__float_as_uint(inc[4 * g]), __float_as_uint(inc[4 * g]), false, false);
        Ghi[g] = __uint_as_float(rr[1]); T[g] = __uint_as_float(rr[0]) + Ghi[g]; }
    float U[4]; U[3] = carry; U[2] = U[3] + T[3]; U[1] = U[2] + T[2]; U[0] = U[1] + T[1]; carry = U[0] + T[0];
    unsigned pk[8];
#pragma unroll
    for (int g = 0; g < 4; ++g) { const float base = fmaf(Ghi[g], sel, U[g]); float w[4];
#pragma unroll
        for (int i = 0; i < 4; ++i) { const int r = 4 * g + i; w[i] = __builtin_amdgcn_exp2f(st[r] + (inc[r] + base));
            if (DIAG) w[i] = ((r & 3) + 8 * (r >> 2) < qlim) ? w[i] : 0.f; }
        pk[2 * g] = cvtpk(w[0], w[1]); pk[2 * g + 1] = cvtpk(w[2], w[3]); }
    const bf16x8 pw0 = __builtin_bit_cast(bf16x8, (v4u){pk[0], pk[1], pk[2], pk[3]}), pw1 = __builtin_bit_cast(bf16x8, (v4u){pk[4], pk[5], pk[6], pk[7]});
#pragma unroll
    for (int c = 0; c < 2; ++c) {
        const s16x4 a0 = vtr(vrd + c * 2048), a1 = vtr(vrd + c * 2048 + 512), b0 = vtr(vrd + c * 2048 + 1024), b1 = vtr(vrd + c * 2048 + 1536);
        const bf16x8 v0 = (bf16x8){a0[0], a0[1], a0[2], a0[3], a1[0], a1[1], a1[2], a1[3]}, v1 = (bf16x8){b0[0], b0[1], b0[2], b0[3], b1[0], b1[1], b1[2], b1[3]};
        oacc[c] = __builtin_amdgcn_mfma_f32_32x32x16_bf16(v0, pw0, oacc[c], 0, 0, 0);
        oacc[c] = __builtin_amdgcn_mfma_f32_32x32x16_bf16(v1, pw1, oacc[c], 0, 0, 0); }
}

__device__ __forceinline__ void attn_phase(Frame& F, const bf16* P, bf16* O, const float* ga) {
    PHASE_IDS();
    const int qi = lane & 31, hh = lane >> 5, h = wave;
    LAS unsigned char* const vimg = F.lds + RING_OFF + wave * ATT_VBYTES;
    LAS float* const hs = (LAS float*)(F.lds + RING_OFF + ATT_HS_OFF);
    const int vkey = lane >> 3, vch = lane & 7;
    LAS unsigned char* const vwr = vimg + (vch >> 2) * 2048 + vkey * 64 + (vch & 3) * 16;
    const LAS unsigned char* const vrd = vimg + (4 * hh + ((lane & 15) >> 2)) * 64 + ((lane >> 4) & 1) * 32 + (lane & 3) * 8;
    const float sel = hh ? 0.f : 1.f; const int qlim = qi - 4 * hh;
    for (int u = F.vcu; u < T / 32; u += F.G) {
        const int r0 = u * 32, s0 = r0 % SEQ;
        bf16x8 qf[4], kf[4], kn[4]; v4u vr[4], vn[4];
        const bf16* qp = P + (size_t)(r0 + qi) * INC + PQ + h * 64 + 8 * hh;
#pragma unroll
        for (int ds = 0; ds < 4; ++ds) qf[ds] = *(const bf16x8*)(qp + 16 * ds);
        const bf16* kp = P + (size_t)(r0 + qi) * INC + PK + h * 64 + 8 * hh;
        const bf16* vp = P + (size_t)(r0 + vkey) * INC + PV + h * 64 + 8 * vch;
#pragma unroll
        for (int ds = 0; ds < 4; ++ds) kf[ds] = *(const bf16x8*)(kp + 16 * ds);
#pragma unroll
        for (int i = 0; i < 4; ++i) vr[i] = *(const v4u*)(vp + (size_t)(8 * i) * INC);
        f32x16 oacc[2];
#pragma unroll
        for (int r = 0; r < 16; ++r) { oacc[0][r] = 0.f; oacc[1][r] = 0.f; }
        float carry = 0.f;
        for (int kb = s0; ; kb -= 32) {
#pragma unroll
            for (int i = 0; i < 4; ++i) *(LAS v4u*)(vwr + i * 512) = vr[i];
            if (kb > 0) { kp -= (size_t)32 * INC; vp -= (size_t)32 * INC;
#pragma unroll
                for (int ds = 0; ds < 4; ++ds) kn[ds] = *(const bf16x8*)(kp + 16 * ds);
#pragma unroll
                for (int i = 0; i < 4; ++i) vn[i] = *(const v4u*)(vp + (size_t)(8 * i) * INC); }
            if (kb == s0) sb_block<true>(kf, qf, vrd, qlim, sel, carry, oacc); else sb_block<false>(kf, qf, vrd, qlim, sel, carry, oacc);
            if (kb == 0 || __builtin_amdgcn_ballot_w64(carry >= W_EXIT) == 0ull) break;
#pragma unroll
            for (int ds = 0; ds < 4; ++ds) kf[ds] = kn[ds];
#pragma unroll
            for (int i = 0; i < 4; ++i) vr[i] = vn[i];
        }
        float ss = 0.f;
#pragma unroll
        for (int r = 0; r < 16; ++r) ss += oacc[0][r] * oacc[0][r] + oacc[1][r] * oacc[1][r];
        { const auto rr = __builtin_amdgcn_permlane32_swap(__float_as_uint(ss), __float_as_uint(ss), false, false); ss = __uint_as_float(rr[0]) + __uint_as_float(rr[1]); }
        if (hh == 0) hs[wave * 32 + qi] = ss;
        __syncthreads();
        float tot = 0.f;
#pragma unroll
        for (int w = 0; w < 8; ++w) tot += hs[w * 32 + qi];
        const float rstd = 1.0f / sqrtf(tot * (1.0f / AW) + RMS_EPS);
        bf16* op = O + (size_t)(r0 + qi) * D + h * 64 + 4 * hh; const float* gp = ga + h * 64 + 4 * hh;
#pragma unroll
        for (int c = 0; c < 2; ++c)
#pragma unroll
            for (int g = 0; g < 4; ++g) { const f32x4 gv = *(const f32x4*)(gp + 32 * c + 8 * g);
                *(u32x2*)(op + 32 * c + 8 * g) = (u32x2){cvtpk(oacc[c][4 * g] * rstd * gv.x, oacc[c][4 * g + 1] * rstd * gv.y), cvtpk(oacc[c][4 * g + 2] * rstd * gv.z, oacc[c][4 * g + 3] * rstd * gv.w)}; }
        __syncthreads();
    }
}
constexpr int NPH = 1 + 8 * DEPTH;
struct Args { const float* in[N_IN]; float* out; unsigned char* ws; int ph_lo, ph_hi; };
__global__ void __launch_bounds__(NWAVES * 64, 2) fwd(Args args) {
    extern __shared__ __attribute__((aligned(16))) unsigned char lds[];
    Frame F;
    F.lds = (LAS unsigned char*)lds;
    F.MISC = (volatile LAS unsigned*)(F.lds + MISC_OFF);
    F.G = gridDim.x; { const int bx = blockIdx.x; F.vcu = (F.G % 8 == 0) ? (bx % 8) * (F.G / 8) + bx / 8 : bx; }
    for (int u = threadIdx.x; u < (LDS_BYTES - LDSCTL_OFF) / 4; u += NWAVES * 64) ((LAS unsigned*)(F.lds + LDSCTL_OFF))[u] = 0u;
    __syncthreads();
    const int lo = args.ph_lo, hi = args.ph_hi;
    XcdBarrier bar; bar.bar = (unsigned*)(CTLPTR() + CW_BAR); bar.x = 0; bar.st = nullptr;
    if (hi - lo > 1) bar = xcd_barrier_post((unsigned*)(CTLPTR() + CW_BAR), F.MISC + 8);
#define IN(k) (lo <= (k) && (k) < hi)
#define SEAM(k) do { if ((k) + 1 < hi) xcd_barrier(bar); } while (0)
#define X ((float*)(ws + WS_X))
#define XN ((bf16*)(ws + WS_XN))
#define P ((bf16*)(ws + WS_P))
#define O ((bf16*)(ws + WS_O))
#define ACT ((bf16*)(ws + WS_ACT))
#define AP ((bf16*)(ws + WS_AP))
#define TOK_E ((int*)(ws + WS_TOKE))
#define TOK_R ((int*)(ws + WS_TOKR))
#define TOK_G ((float*)(ws + WS_TOKG))
#define TOK_S ((int*)(ws + WS_TOKS))
    if (F.G != 256) { fail_word(0x7f0u); return; }

    if (IN(0)) {
        unsigned char* const ws = WSPTR();
        p0_weights(F);
        RowArgs A{}; A.xsrc = INP(I_X); A.xws = X; A.gain = INP(I_ANG); A.xn = XN;
        row_phase<8>(F, A);
        SEAM(0);
    }
#pragma unroll 1
    for (int l = 0; l < DEPTH; ++l) {
        const int pb = 1 + 8 * l, li = l >> 1; const bool moe = (l & 1) != 0;
        if (IN(pb + 0)) {
            unsigned char* const ws = WSPTR();
            pg8::Gemm g{XN, (const bf16*)(ws + WS_WIN) + (size_t)l * INC * D, T, INC, D, 0}; pg8::StaticOrder S; S.init(T, INC, F.G, (int)blockIdx.x);
            pg8::EpiBf16<0> E{P, INC, nullptr, 0, 0, 1.f};
            pg8::gemm_phase<pg8::EpiBf16<0>, pg8::StaticOrder, true, true>(F.lds + RING_OFF, g, S, E);
            SEAM(pb + 0);
        }
        if (IN(pb + 1)) {
            unsigned char* const ws = WSPTR();
            attn_phase(F, P, O, INP(I_GNG) + (size_t)l * D);
            PcArgs A{P, O, INP(I_POOLW) + (size_t)l * 4 * 64 * 64, INP(I_POOLS) + (size_t)l * PW, INP(I_CONVW) + (size_t)l * CK * CW, INP(I_CONVB) + (size_t)l * CW,
                     INP(I_LNG) + (size_t)l * CW, INP(I_LNB) + (size_t)l * CW, INP(I_GNG) + (size_t)l * D};
            poolconv_phase(F, A);
            SEAM(pb + 1);
        }
        if (IN(pb + 2)) {
            unsigned char* const ws = WSPTR();
            pg8::Gemm g{O, (const bf16*)(ws + WS_WOUT) + (size_t)l * D * D, T, D, D, 0}; pg8::StaticOrder S; S.init(T, D, F.G, (int)blockIdx.x);
            pg8::EpiResid E{X, D};
            pg8::gemm_phase<pg8::EpiResid, pg8::StaticOrder, true, true>(F.lds + RING_OFF, g, S, E);
            SEAM(pb + 2);
        }
        if (IN(pb + 3)) {
            unsigned char* const ws = WSPTR();
            RowArgs A{}; A.xsrc = X; A.xws = X; A.gain = INP(I_FNG) + (size_t)l * D; A.xn = XN;
            if (moe) { A.wr = INP(I_RW) + (size_t)li * D * NE; A.gcur = CTLPTR() + CW_MOE + li * 1024; A.tok_e = TOK_E; A.tok_r = TOK_R; A.tok_g = TOK_G; row_phase<2>(F, A); }
            else row_phase<0>(F, A);
            SEAM(pb + 3);
        }
        if (moe) {
            if (IN(pb + 4)) { unsigned char* const ws = WSPTR(); gu32* const gcur = CTLPTR() + CW_MOE + li * 1024; gather_phase(F, gcur, XN, AP, TOK_E, TOK_R, TOK_S); SEAM(pb + 4); }
            if (IN(pb + 5)) {
                unsigned char* const ws = WSPTR(); gu32* const gcur = CTLPTR() + CW_MOE + li * 1024;
                int cnt[8], toff[9]; load_toff(gcur, cnt, toff);
                pg8::Gemm g{AP, (const bf16*)(ws + WS_WGUM) + (size_t)li * NE * NGU * D, 0, NGU, D, (size_t)NGU * D * 2}; pg8::GroupedOrder S; S.init(toff, NGU, F.G, (int)blockIdx.x);
                pg8::EpiSwiGLU E{ACT, FF};
                pg8::gemm_phase<pg8::EpiSwiGLU, pg8::GroupedOrder, true, true>(F.lds + RING_OFF, g, S, E);
                SEAM(pb + 5);
            }
            if (IN(pb + 6)) {
                unsigned char* const ws = WSPTR(); gu32* const gcur = CTLPTR() + CW_MOE + li * 1024;
                int cnt[8], toff[9]; load_toff(gcur, cnt, toff);
                pg8::Gemm g{ACT, (const bf16*)(ws + WS_WDM) + (size_t)li * NE * D * FF, 0, D, FF, (size_t)D * FF * 2}; pg8::GroupedOrder S; S.init(toff, D, F.G, (int)blockIdx.x);
                pg8::EpiBf16<0> E{AP, D, nullptr, 0, 0, 1.f};
                pg8::gemm_phase<pg8::EpiBf16<0>, pg8::GroupedOrder, true, true>(F.lds + RING_OFF, g, S, E);
                SEAM(pb + 6);
            }
        } else {
            if (IN(pb + 5)) {
                unsigned char* const ws = WSPTR();
                pg8::Gemm g{XN, (const bf16*)(ws + WS_WGUD) + (size_t)li * NGU * D, T, NGU, D, 0}; pg8::StaticOrder S; S.init(T, NGU, F.G, (int)blockIdx.x);
                pg8::EpiSwiGLU E{ACT, FF};
                pg8::gemm_phase<pg8::EpiSwiGLU, pg8::StaticOrder, true, true>(F.lds + RING_OFF, g, S, E);
                SEAM(pb + 5);
            }
            if (IN(pb + 6)) {
                unsigned char* const ws = WSPTR();
                pg8::Gemm g{ACT, (const bf16*)(ws + WS_WDD) + (size_t)li * D * FF, T, D, FF, 0}; pg8::StaticOrder S; S.init(T, D, F.G, (int)blockIdx.x);
                pg8::EpiResid E{X, D};
                pg8::gemm_phase<pg8::EpiResid, pg8::StaticOrder, true, true>(F.lds + RING_OFF, g, S, E);
                SEAM(pb + 6);
            }
        }
        if (IN(pb + 7)) {
            unsigned char* const ws = WSPTR();
            RowArgs A{}; A.xsrc = X; A.xws = X; A.xn = XN; A.out = OUTPTR(); A.yp = AP; A.tok_g = TOK_G; A.tok_s = TOK_S;
            A.gain = (l == DEPTH - 1) ? INP(I_FING) : INP(I_ANG) + (size_t)(l + 1) * D;
            if (l == DEPTH - 1) row_phase<5>(F, A);
            else if (moe) row_phase<1>(F, A);
            else row_phase<0>(F, A);
            SEAM(pb + 7);
        }
    }
#undef IN
#undef SEAM
#undef X
#undef XN
#undef P
#undef O
#undef ACT
#undef AP
#undef TOK_E
#undef TOK_R
#undef TOK_G
#undef TOK_S
}

#ifndef MK_ONE_LAUNCH
#define MK_ONE_LAUNCH 0
#endif
extern "C" void kernel_launch(void* const* d_in, const int* in_sizes, int n_in, void* d_out, int out_size, void* d_ws, size_t ws_size, hipStream_t stream) {
    static int grid = 0;
    if (grid == 0) {
        if (n_in != N_IN || in_sizes[0] != T * D || out_size != T * D || ws_size < WS_END) { fprintf(stderr, "kernel_launch: unexpected problem shape (n_in %d, in0 %d, out %d, ws %zu); nothing launched\n", n_in, n_in > 0 ? in_sizes[0] : -1, out_size, ws_size); grid = -1; return; }
        if (hipFuncSetAttribute((const void*)fwd, hipFuncAttributeMaxDynamicSharedMemorySize, LDS_BYTES) != hipSuccess) { fprintf(stderr, "kernel_launch: hipFuncSetAttribute failed; nothing launched\n"); grid = -1; return; }
        int per_cu = 0;
        if (hipOccupancyMaxActiveBlocksPerMultiprocessor(&per_cu, (const void*)fwd, NWAVES * 64, LDS_BYTES) != hipSuccess || per_cu < 1)
            fprintf(stderr, "kernel_launch: note: occupancy query reports %d workgroups per CU\n", per_cu);
        (void)hipGetLastError();
        grid = 256;
    }
    if (grid < 0) return;
    if (hipMemsetAsync((char*)d_ws + WS_CTL, 0, CTL_ZERO_BYTES, stream) != hipSuccess) { fprintf(stderr, "kernel_launch: hipMemsetAsync failed; nothing launched\n"); return; }
    Args a{};
    for (int i = 0; i < N_IN; ++i) a.in[i] = (const float*)d_in[i];
    a.out = (float*)d_out; a.ws = (unsigned char*)d_ws;
#if MK_ONE_LAUNCH
    a.ph_lo = 0; a.ph_hi = NPH;
    hipLaunchKernelGGL(fwd, dim3(grid), dim3(NWAVES * 64), LDS_BYTES, stream, a);
#else
    for (int p = 0; p < NPH; ++p) {
        if (p > 0 && ((p - 1) & 7) == 4 && ((((p - 1) >> 3) & 1) == 0)) continue;
        a.ph_lo = p; a.ph_hi = p + 1;
        hipLaunchKernelGGL(fwd, dim3(grid), dim3(NWAVES * 64), LDS_BYTES, stream, a);
    }
#endif
    const hipError_t le = hipPeekAtLastError();
    if (le != hipSuccess) fprintf(stderr, "kernel_launch: launch failed: %s\n", hipGetErrorName(le));
}
```

```cpp
#include <hip/hip_runtime.h>
#include <cstdio>
#include <cstdint>
#include <cmath>
#define MK_ONE_LAUNCH 1
namespace pg8 {
#define PG8_LAS __attribute__((address_space(3)))
typedef unsigned short bf16_t;
typedef short bf16x8 __attribute__((ext_vector_type(8)));
typedef float f32x4 __attribute__((ext_vector_type(4)));
typedef unsigned u32x4 __attribute__((ext_vector_type(4)));
constexpr int BM = 256, BK = 64, HALF = 128, HTB = HALF * BK * 2  , STAGE_BYTES = 8 * HTB, NXCD = 8, WGM = 8;

__host__ __device__ __forceinline__ int lds_byte(int r, int c) { const int st = (r >> 4) * 2 + (c >> 5), rr = r & 15, cc = c & 31, ob = rr * 64 + cc * 2; return st * 1024 + (ob ^ (((ob >> 9) & 1) << 5)); }
__host__ __device__ __forceinline__ void stage_rc(int b, int& R, int& C) { const int st = b / 1024, sb = b % 1024, swz = sb ^ (((sb >> 9) & 1) << 5); R = (st >> 1) * 16 + swz / 64; C = (st & 1) * 32 + (swz % 64) / 2; }
__host__ __device__ __forceinline__ int perm32(int rho) { const int n = rho >> 4, i = rho & 15; return 8 * (i >> 2) + 4 * n + (i & 3); }

struct Unit { int pm, pn, e; };
struct Gemm { const bf16_t* A; const bf16_t* Bt; int M, N, K; size_t estride; };

struct StaticOrder {
    int nM, nN, nwg, G, c;
    __host__ __device__ void init(int M, int N, int G_, int c_) { nM = M / BM; nN = N / BM; nwg = nM * nN; G = G_; c = c_; }
    __host__ __device__ bool next(int i, Unit& u) const {
        const long L = (long)i * G + c; if (L >= nwg) return false;
        int wgid = (int)L; { const int q = nwg / NXCD, r = nwg % NXCD, xcd = wgid % NXCD, off = wgid / NXCD; wgid = (xcd < r ? xcd * (q + 1) : r * (q + 1) + (xcd - r) * q) + off; }
        const int nig = WGM * nN, gid = wgid / nig, fm = gid * WGM, gsz = (nM - fm) < WGM ? (nM - fm) : WGM;
        u.pm = fm + ((wgid % nig) % gsz); u.pn = (wgid % nig) / gsz; u.e = 0; return true;
    }
    __device__ __forceinline__ void a_ready(const Unit&) const {}
    __device__ __forceinline__ void done(const Unit&) const {}
};

__device__ __forceinline__ unsigned cvt_pk_bf16(float lo, float hi) { unsigned r; asm volatile("v_cvt_pk_bf16_f32 %0, %1, %2" : "=v"(r) : "v"(lo), "v"(hi)); return r; }
typedef float f32x2 __attribute__((ext_vector_type(2)));
__device__ __forceinline__ f32x2 gelu_pk(f32x2 v) {
    const f32x2 av = __builtin_elementwise_abs(v), d = av * 0.2316418882f + 1.0f;
    f32x2 t; t.x = __builtin_amdgcn_rcpf(d.x); t.y = __builtin_amdgcn_rcpf(d.y);
    f32x2 q = t * 0.5307027145f + (-0.7265760135f); q = q * t + 0.7107068705f; q = q * t + (-0.142248368f); q = q * t + 0.127414796f; q = q * t;
    const f32x2 s = (v * v) * (-0.72134752044f);
    f32x2 e; e.x = __builtin_amdgcn_exp2f(s.x); e.y = __builtin_amdgcn_exp2f(s.y);
    const f32x2 m = v * (q * e), r = v - m;
    f32x2 o; o.x = v.x < 0.f ? m.x : r.x; o.y = v.y < 0.f ? m.y : r.y; return o;
}

template <int ACT  > struct EpiBf16 {
    static constexpr bool PERM = true, AFTER_DRAIN = false; static_assert(ACT == 0 || ACT == 1, "EpiBf16: ACT is 0 (none) or 1 (gelu_pk)");
    bf16_t* O; int ldc; const float* bias; int split_cols; size_t split_stride; float scale0;
    __device__ __forceinline__ void operator()(const f32x4 (&acc)[2][2][4][2], const Unit& u, int wr, int wc, int fr, int fq) const {
        const int row0 = u.pm * BM + wr * 64 + fr; int colt = u.pn * BM; bf16_t* base = O;
        float sc = 1.f; if (split_cols) { const int t = colt / split_cols; base += (size_t)t * split_stride; colt -= t * split_cols; if (t == 0) sc = scale0; }
        const int col0 = colt + wc * 32 + 8 * fq, bcol0 = u.pn * BM + wc * 32 + 8 * fq;
        f32x4 bv[2][2];
#pragma unroll
        for (int bj = 0; bj < 2; ++bj)
#pragma unroll
            for (int n = 0; n < 2; ++n) bv[bj][n] = bias ? *(const f32x4*)(bias + bcol0 + bj * HALF + 4 * n) : (f32x4){0.f, 0.f, 0.f, 0.f};
#pragma unroll
        for (int ai = 0; ai < 2; ++ai)
#pragma unroll
            for (int m = 0; m < 4; ++m) { bf16_t* rowp = base + (size_t)(row0 + ai * HALF + m * 16) * ldc + col0;
#pragma unroll
                for (int bj = 0; bj < 2; ++bj) { f32x4 v0 = acc[ai][bj][m][0] + bv[bj][0], v1 = acc[ai][bj][m][1] + bv[bj][1];
                    if (ACT == 1) { f32x2 a = gelu_pk((f32x2){v0[0], v0[1]}), b = gelu_pk((f32x2){v0[2], v0[3]}), c = gelu_pk((f32x2){v1[0], v1[1]}), d = gelu_pk((f32x2){v1[2], v1[3]});
                        v0 = (f32x4){a.x, a.y, b.x, b.y}; v1 = (f32x4){c.x, c.y, d.x, d.y}; }
                    v0 = v0 * sc; v1 = v1 * sc; u32x4 w; w.x = cvt_pk_bf16(v0[0], v0[1]); w.y = cvt_pk_bf16(v0[2], v0[3]); w.z = cvt_pk_bf16(v1[0], v1[1]); w.w = cvt_pk_bf16(v1[2], v1[3]);
                    *(u32x4*)(rowp + bj * HALF) = w; } }
    }
};
struct EpiResid {
    static constexpr bool PERM = false, AFTER_DRAIN = false;
    float* X; int ldc;
    __device__ __forceinline__ void operator()(const f32x4 (&acc)[2][2][4][2], const Unit& u, int wr, int wc, int fr, int fq) const {
        const int row0 = u.pm * BM + wr * 64 + fr, col0 = u.pn * BM + wc * 32 + 4 * fq;
#pragma unroll
        for (int ai = 0; ai < 2; ++ai)
#pragma unroll
            for (int m = 0; m < 4; ++m) { float* rowp = X + (size_t)(row0 + ai * HALF + m * 16) * ldc + col0;
                f32x4 old[2][2];
#pragma unroll
                for (int bj = 0; bj < 2; ++bj)
#pragma unroll
                    for (int n = 0; n < 2; ++n) old[bj][n] = *(const f32x4*)(rowp + bj * HALF + n * 16);
#pragma unroll
                for (int bj = 0; bj < 2; ++bj)
#pragma unroll
                    for (int n = 0; n < 2; ++n) *(f32x4*)(rowp + bj * HALF + n * 16) = old[bj][n] + acc[ai][bj][m][n];
                asm volatile("" ::: "memory"); }
    }
};
__device__ __forceinline__ float silu_mul(float g, float u) { return g * __builtin_amdgcn_rcpf(1.0f + __builtin_amdgcn_exp2f(g * -1.4426950408889634f)) * u; }
struct EpiSwiGLU {
    static constexpr bool PERM = true, AFTER_DRAIN = false;
    bf16_t* O; int ldc;
    __device__ __forceinline__ void operator()(const f32x4 (&acc)[2][2][4][2], const Unit& u, int wr, int wc, int fr, int fq) const {
        const int row0 = u.pm * BM + wr * 64 + fr, col0 = u.pn * HALF + wc * 32 + 8 * fq;
#pragma unroll
        for (int ai = 0; ai < 2; ++ai)
#pragma unroll
            for (int m = 0; m < 4; ++m) { bf16_t* rowp = O + (size_t)(row0 + ai * HALF + m * 16) * ldc + col0;
                const f32x4 g0 = acc[ai][0][m][0], g1 = acc[ai][0][m][1], u0 = acc[ai][1][m][0], u1 = acc[ai][1][m][1];
                u32x4 w;
                w.x = cvt_pk_bf16(silu_mul(g0[0], u0[0]), silu_mul(g0[1], u0[1])); w.y = cvt_pk_bf16(silu_mul(g0[2], u0[2]), silu_mul(g0[3], u0[3]));
                w.z = cvt_pk_bf16(silu_mul(g1[0], u1[0]), silu_mul(g1[1], u1[1])); w.w = cvt_pk_bf16(silu_mul(g1[2], u1[2]), silu_mul(g1[3], u1[3]));
                *(u32x4*)rowp = w; }
    }
};
struct GroupedOrder {
    int nM, nN, nwg, G, c; int t1, t2, t3, t4, t5, t6, t7;
    __device__ __forceinline__ void init(const int (&toff)[9], int N, int G_, int c_) { nM = toff[8]; nN = N / BM; nwg = nM * nN; G = G_; c = c_;
        t1 = toff[1]; t2 = toff[2]; t3 = toff[3]; t4 = toff[4]; t5 = toff[5]; t6 = toff[6]; t7 = toff[7]; }
    __device__ __forceinline__ bool next(int i, Unit& u) const {
        const long L = (long)i * G + c; if (L >= nwg) return false;
        int wgid = (int)L; { const int q = nwg / NXCD, r = nwg % NXCD, xcd = wgid % NXCD, off = wgid / NXCD; wgid = (xcd < r ? xcd * (q + 1) : r * (q + 1) + (xcd - r) * q) + off; }
        const int nig = WGM * nN, gid = wgid / nig, fm = gid * WGM, gsz = (nM - fm) < WGM ? (nM - fm) : WGM;
        u.pm = fm + ((wgid % nig) % gsz); u.pn = (wgid % nig) / gsz;
        u.e = (u.pm >= t1) + (u.pm >= t2) + (u.pm >= t3) + (u.pm >= t4) + (u.pm >= t5) + (u.pm >= t6) + (u.pm >= t7); return true;
    }
    __device__ __forceinline__ void a_ready(const Unit&) const {}
    __device__ __forceinline__ void done(const Unit&) const {}
};
template <class Epi, class Sched, bool ALIGN_EPI = false, bool SP2 = false>
__device__ __forceinline__ void gemm_phase(PG8_LAS unsigned char* lds, const Gemm g, const Sched& S, const Epi& E) {
    int tid_ = threadIdx.x; asm volatile("" : "+v"(tid_));
    const int tid = tid_, wid = __builtin_amdgcn_readfirstlane(tid >> 6), lane = tid & 63, wr = wid >> 2, wc = wid & 3, fr = lane & 15, fq = lane >> 4;
    const int K = g.K, nt = K / BK;
    unsigned voffA[2], voffB[2];
#pragma unroll
    for (int i = 0; i < 2; ++i) { int R, C; stage_rc(tid * 16 + i * 8192, R, C); const int Rb = Epi::PERM ? ((R & ~31) + perm32(R & 31)) : R;
        voffA[i] = (unsigned)(R * K + C) * 2u; voffB[i] = (unsigned)(Rb * K + C) * 2u; }
    const size_t kstep = (size_t)(BK * 2);
    const size_t hstep = (size_t)HALF * K * 2;
    const size_t tstep = 2 * hstep;
    const unsigned ldsw = (unsigned)wid * 1024u;
    const int aoff = lds_byte(wr * 64 + fr, fq * 8), boff = lds_byte(wc * 32 + fr, fq * 8);
#define PG8_SA(b, h) (((b) * 2 + (h)) * HTB)
#define PG8_SB(b, h) ((4 + (b) * 2 + (h)) * HTB)
#define PG8_STAGE(bufoff, gbase, voff) do { _Pragma("unroll") for (int _i = 0; _i < 2; ++_i) \
        __builtin_amdgcn_global_load_lds((const unsigned*)((const char*)(gbase) + (voff)[_i]), (PG8_LAS unsigned*)(lds + (bufoff) + ldsw + _i * 8192), 16, 0, 0); } while (0)
#define PG8_LDA(dst, b, h) do { _Pragma("unroll") for (int m = 0; m < 4; ++m) _Pragma("unroll") for (int k = 0; k < 2; ++k) dst[m][k] = *(const PG8_LAS bf16x8*)(lds + PG8_SA(b, h) + aoff + m * 2048 + k * 1024); } while (0)
#define PG8_LDB(dst, b, h) do { _Pragma("unroll") for (int n = 0; n < 2; ++n) _Pragma("unroll") for (int k = 0; k < 2; ++k) dst[n][k] = *(const PG8_LAS bf16x8*)(lds + PG8_SB(b, h) + boff + n * 2048 + k * 1024); } while (0)
#define PG8_MMA(ai, bj, At, Bt) do { __builtin_amdgcn_s_setprio(1); _Pragma("unroll") for (int m = 0; m < 4; ++m) _Pragma("unroll") for (int n = 0; n < 2; ++n) _Pragma("unroll") for (int k = 0; k < 2; ++k) \
        acc[ai][bj][m][n] = __builtin_amdgcn_mfma_f32_16x16x32_bf16(Bt[n][k], At[m][k], acc[ai][bj][m][n], 0, 0, 0); __builtin_amdgcn_s_setprio(0); } while (0)
#define PG8_WAIT_V(n) asm volatile("s_waitcnt vmcnt(" #n ")" ::: "memory")
#define PG8_WAIT_L(n) asm volatile("s_waitcnt lgkmcnt(" #n ")" ::: "memory")
#define PG8_BAR __builtin_amdgcn_s_barrier()
#define PG8_SCHED __builtin_amdgcn_sched_barrier(0)
    Unit cur, nxt; int ui = 0;
    if (!S.next(0, cur)) return;
    f32x4 acc[2][2][4][2];
#pragma unroll
    for (int a = 0; a < 2; ++a)
#pragma unroll
        for (int b = 0; b < 2; ++b)
#pragma unroll
            for (int m = 0; m < 4; ++m)
#pragma unroll
                for (int n = 0; n < 2; ++n) acc[a][b][m][n] = (f32x4){0.f, 0.f, 0.f, 0.f};
    bf16x8 At[4][2], B0[2][2], B1[2][2];
    const char* cA = (const char*)g.A + (size_t)cur.pm * tstep; const char* cB = (const char*)g.Bt + (size_t)cur.e * g.estride + (size_t)cur.pn * tstep;
    S.a_ready(cur);
    if constexpr (SP2) {
        PG8_STAGE(PG8_SB(0, 0), cB, voffB); PG8_STAGE(PG8_SB(0, 1), cB + hstep, voffB); PG8_STAGE(PG8_SA(0, 0), cA, voffA); PG8_STAGE(PG8_SA(0, 1), cA + hstep, voffA);
        if (wr == 1) PG8_BAR;
        PG8_WAIT_V(2); PG8_BAR;
        PG8_STAGE(PG8_SB(1, 0), cB + kstep, voffB); PG8_STAGE(PG8_SA(1, 0), cA + kstep, voffA); PG8_STAGE(PG8_SB(1, 1), cB + hstep + kstep, voffB);
        PG8_WAIT_V(6); PG8_BAR;
    } else {
        PG8_STAGE(PG8_SB(0, 0), cB, voffB); PG8_STAGE(PG8_SA(0, 0), cA, voffA); PG8_STAGE(PG8_SB(0, 1), cB + hstep, voffB); PG8_STAGE(PG8_SA(0, 1), cA + hstep, voffA);
        if (wr == 1) PG8_BAR;
        PG8_WAIT_V(4); PG8_BAR;
        PG8_STAGE(PG8_SB(1, 0), cB + kstep, voffB); PG8_STAGE(PG8_SA(1, 0), cA + kstep, voffA); PG8_STAGE(PG8_SB(1, 1), cB + hstep + kstep, voffB);
        PG8_WAIT_V(6); PG8_BAR;
    }
    for (;;) {
        const bool has_next = S.next(ui + 1, nxt);
        const char* nA = has_next ? (const char*)g.A + (size_t)nxt.pm * tstep : cA; const char* nB = has_next ? (const char*)g.Bt + (size_t)nxt.e * g.estride + (size_t)nxt.pn * tstep : cB;
        for (int t = 0; t < nt; t += 2) {
            const bool last = (t == nt - 2);
            const char* a1 = cA + (size_t)(t + 1) * kstep;
            const char* a2 = last ? nA : cA + (size_t)(t + 2) * kstep; const char* b2 = last ? nB : cB + (size_t)(t + 2) * kstep;
            const char* a3 = a2 + kstep; const char* b3 = b2 + kstep;
            if (last && has_next) S.a_ready(nxt);
            if constexpr (SP2) {
            PG8_LDB(B0, 0, 0); PG8_LDB(B1, 0, 1); PG8_SCHED; PG8_LDA(At, 0, 0); PG8_STAGE(PG8_SA(1, 1), a1 + hstep, voffA);
            PG8_WAIT_V(8); PG8_WAIT_L(0); PG8_BAR; PG8_MMA(0, 0, At, B0); PG8_MMA(0, 1, At, B1); PG8_BAR; PG8_SCHED;
            PG8_LDA(At, 0, 1); PG8_STAGE(PG8_SB(0, 0), b2, voffB); PG8_STAGE(PG8_SB(0, 1), b2 + hstep, voffB); PG8_STAGE(PG8_SA(0, 0), a2, voffA);
            PG8_WAIT_V(8); PG8_WAIT_L(0); PG8_BAR; PG8_MMA(1, 0, At, B0); PG8_MMA(1, 1, At, B1); PG8_BAR; PG8_SCHED;
            PG8_LDB(B0, 1, 0); PG8_LDB(B1, 1, 1); PG8_SCHED; PG8_LDA(At, 1, 0); PG8_STAGE(PG8_SA(0, 1), a2 + hstep, voffA);
            PG8_WAIT_V(8); PG8_WAIT_L(0); PG8_BAR; PG8_MMA(0, 0, At, B0); PG8_MMA(0, 1, At, B1); PG8_BAR; PG8_SCHED;
            PG8_LDA(At, 1, 1); PG8_STAGE(PG8_SB(1, 0), b3, voffB); PG8_STAGE(PG8_SB(1, 1), b3 + hstep, voffB); PG8_STAGE(PG8_SA(1, 0), a3, voffA);
            PG8_WAIT_V(8); PG8_WAIT_L(0); PG8_BAR; PG8_MMA(1, 0, At, B0); PG8_MMA(1, 1, At, B1); PG8_BAR; PG8_SCHED;
            } else {
            PG8_LDB(B0, 0, 0); PG8_SCHED; PG8_LDA(At, 0, 0); PG8_STAGE(PG8_SA(1, 1), a1 + hstep, voffA);
            PG8_WAIT_L(8); PG8_BAR; PG8_WAIT_L(0); PG8_MMA(0, 0, At, B0); PG8_BAR; PG8_SCHED;
            PG8_LDB(B1, 0, 1); PG8_STAGE(PG8_SB(0, 0), b2, voffB);
            PG8_BAR; PG8_WAIT_L(0); PG8_MMA(0, 1, At, B1); PG8_BAR;
            PG8_LDA(At, 0, 1); PG8_STAGE(PG8_SA(0, 0), a2, voffA);
            PG8_BAR; PG8_WAIT_L(0); PG8_MMA(1, 0, At, B0); PG8_BAR; PG8_SCHED;
            PG8_STAGE(PG8_SB(0, 1), b2 + hstep, voffB);
            PG8_WAIT_V(6); PG8_BAR; PG8_MMA(1, 1, At, B1); PG8_BAR;
            PG8_LDB(B0, 1, 0); PG8_SCHED; PG8_LDA(At, 1, 0); PG8_STAGE(PG8_SA(0, 1), a2 + hstep, voffA);
            PG8_WAIT_L(8); PG8_BAR; PG8_WAIT_L(0); PG8_MMA(0, 0, At, B0); PG8_BAR; PG8_SCHED;
            PG8_LDB(B1, 1, 1); PG8_STAGE(PG8_SB(1, 0), b3, voffB);
            PG8_BAR; PG8_WAIT_L(0); PG8_MMA(0, 1, At, B1); PG8_BAR;
            PG8_LDA(At, 1, 1); PG8_STAGE(PG8_SA(1, 0), a3, voffA);
            PG8_BAR; PG8_WAIT_L(0); PG8_MMA(1, 0, At, B0); PG8_BAR; PG8_SCHED;
            PG8_STAGE(PG8_SB(1, 1), b3 + hstep, voffB);
            PG8_WAIT_V(6); PG8_BAR; PG8_MMA(1, 1, At, B1); PG8_BAR;
            }
        }
        if constexpr (ALIGN_EPI) { if (wr == 0) PG8_BAR; }
        if constexpr (!Epi::AFTER_DRAIN) { E(acc, cur, wr, wc, fr, fq); S.done(cur); }
        if (!has_next) break;
#pragma unroll
        for (int a = 0; a < 2; ++a)
#pragma unroll
            for (int b = 0; b < 2; ++b)
#pragma unroll
                for (int m = 0; m < 4; ++m)
#pragma unroll
                    for (int n = 0; n < 2; ++n) acc[a][b][m][n] = (f32x4){0.f, 0.f, 0.f, 0.f};
        cur = nxt; cA = nA; cB = nB; ++ui;
        if constexpr (ALIGN_EPI) { if (wr == 1) PG8_BAR; }
    }
    PG8_WAIT_V(0);
    if constexpr (!ALIGN_EPI) { if (wr == 0) PG8_BAR; }
    PG8_BAR;
    if constexpr (Epi::AFTER_DRAIN) { E.fused(acc, cur, wr, wc, fr, fq, lds, wid, lane); S.done(cur); }
#undef PG8_SA
#undef PG8_SB
#undef PG8_STAGE
#undef PG8_LDA
#undef PG8_LDB
#undef PG8_MMA
#undef PG8_WAIT_V
#undef PG8_WAIT_L
#undef PG8_BAR
#undef PG8_SCHED
}
}
#define GAS __attribute__((address_space(1)))
#define LAS __attribute__((address_space(3)))
typedef unsigned short bf16;
typedef unsigned v4u __attribute__((ext_vector_type(4)));
typedef float f32x4 __attribute__((ext_vector_type(4)));
typedef short bf16x8 __attribute__((ext_vector_type(8)));
typedef GAS unsigned gu32;
typedef GAS unsigned long long gu64;
#define RLX_AGENT __ATOMIC_RELAXED, __HIP_MEMORY_SCOPE_AGENT
#define LDS_WAIT() asm volatile("s_waitcnt lgkmcnt(0)" ::: "memory")
#define VM_WAIT() asm volatile("s_waitcnt vmcnt(0)" ::: "memory")
__device__ __forceinline__ unsigned long long rt() { return __builtin_amdgcn_s_memrealtime(); }
__device__ __forceinline__ unsigned f2bf(float f) { unsigned u = __builtin_bit_cast(unsigned, f); return (u + 0x7fffu + ((u >> 16) & 1u)) >> 16; }
__device__ __forceinline__ unsigned pk2(float lo, float hi) { return f2bf(lo) | (f2bf(hi) << 16); }

#define XB_TMO      128
#define XB_XCNT(j)  (256  + 64 * (j))
#define XB_XSUB(j)  (1280 + 64 * (j))
#define XB_XGEN(j)  (2304 + 64 * (j))
#define XB_TOP      3328
#define XB_TOPGEN   3392
#define XCD_BAR_WORDS 3456
#define XB_SPIN_CAP (1u << 18)

__device__ __forceinline__ unsigned xb_ld(unsigned* p)              { return __hip_atomic_load(p, __ATOMIC_RELAXED, __HIP_MEMORY_SCOPE_AGENT); }
__device__ __forceinline__ unsigned xb_add(unsigned* p, unsigned v) { return __hip_atomic_fetch_add(p, v, __ATOMIC_RELAXED, __HIP_MEMORY_SCOPE_AGENT); }
__device__ __forceinline__ unsigned xb_xcc_id() { return (unsigned)__builtin_amdgcn_s_getreg((3 << 11) | 20) & 0xFu; }
#define XB_SPIN(cond, bar) do { unsigned _sp = 0; while (cond) { __builtin_amdgcn_s_sleep(1); \
    if ((++_sp & 255u) == 0u) { if (xb_ld(&(bar)[XB_TMO])) break; if (_sp > XB_SPIN_CAP) { atomicAdd(&(bar)[XB_TMO], 1u); break; } } } } while (0)

struct XcdBarrier {
    unsigned* bar; unsigned x;
    volatile LAS unsigned* st;
};

__device__ __forceinline__ XcdBarrier xcd_barrier_post(unsigned* bar, volatile LAS unsigned* st) {
    XcdBarrier b; b.bar = bar; b.x = xb_xcc_id(); b.st = st;
    if (threadIdx.x == 0) (void)xb_add(&bar[XB_XCNT(b.x)], 1u);
    return b;
}
__device__ __forceinline__ void xcd_barrier_complete(unsigned* bar, unsigned x, unsigned& nloc, unsigned& nx) {
    const unsigned G = gridDim.x * gridDim.y * gridDim.z;
    unsigned sum, cnt, mine, sp = 0u;
    for (;;) {
        sum = 0u; cnt = 0u; mine = 0u;
#pragma unroll
        for (unsigned j = 0; j < 16; ++j) { const unsigned c = xb_ld(&bar[XB_XCNT(j)]); sum += c; cnt += (c > 0u) ? 1u : 0u; mine = (j == x) ? c : mine; }
        if (sum == G) break;
        __builtin_amdgcn_s_sleep(1);
        if ((++sp & 255u) == 0u) { if (xb_ld(&bar[XB_TMO])) break; if (sp > XB_SPIN_CAP) { atomicAdd(&bar[XB_TMO], 1u); break; } }
    }
    nloc = mine > 0u ? mine : 1u; nx = cnt > 0u ? cnt : 1u;
}

__device__ __forceinline__ void xcd_barrier(const XcdBarrier& b) {
    asm volatile("s_waitcnt vmcnt(0)" ::: "memory");
    __syncthreads();
    if (threadIdx.x == 0) {
        unsigned* bar = b.bar;
        __builtin_amdgcn_s_waitcnt(0);
        unsigned nloc = b.st[0], nx = b.st[1];
        if (nloc == 0u) { xcd_barrier_complete(bar, b.x, nloc, nx); b.st[0] = nloc; b.st[1] = nx; }
        const unsigned old = xb_add(&bar[XB_XSUB(b.x)], 1u);
        const unsigned gen = old / nloc;
        if (old + 1u == (gen + 1u) * nloc) {
            __builtin_amdgcn_fence(__ATOMIC_RELEASE, "agent");
            asm volatile("s_waitcnt vmcnt(0)" ::: "memory");
            const unsigned og = xb_add(&bar[XB_TOP], 1u);
            const unsigned tg = og / nx;
            if (og + 1u == (tg + 1u) * nx) xb_add(&bar[XB_TOPGEN], 1u);
            else XB_SPIN(xb_ld(&bar[XB_TOPGEN]) == tg, bar);
            __builtin_amdgcn_fence(__ATOMIC_ACQUIRE, "agent");
            xb_add(&bar[XB_XGEN(b.x)], 1u);
            asm volatile("s_waitcnt vmcnt(0)" ::: "memory");
        } else {
            XB_SPIN(xb_ld(&bar[XB_XGEN(b.x)]) == gen, bar);
            __builtin_amdgcn_fence(__ATOMIC_ACQUIRE, "agent");
            asm volatile("s_waitcnt vmcnt(0)" ::: "memory");
        }
    }
    __syncthreads();
}
constexpr int NWAVES = 8;
constexpr int BATCH = 8, SEQ = 2048, D = 1024, T = BATCH * SEQ, DEPTH = 4;
constexpr int NH = 8, HD = 64, AW = 512, PW = 256, CW = 256, INC = 2304, CK = 31;
constexpr int FF = 2816, NE = 8, NGU = 2 * FF;
constexpr int MAXSLOT = 2 * T + NE * 256;
constexpr float RMS_EPS = 1e-6f, LN_EPS = 1e-5f;
constexpr float QSCALE = 0.125f * 1.4426950408889634f;
constexpr float W_EXIT = -150.0f;
constexpr int PQ = 0, PK = 512, PV = 1024, PPOOL = 1536, PCV = 1792, PCG = 2048;
enum { I_X = 0, I_ANG, I_WIN, I_POOLW, I_POOLS, I_CONVW, I_CONVB, I_LNG, I_LNB, I_GNG, I_WOUT, I_FNG, I_DWG, I_DWU, I_DWD, I_RW, I_MWG, I_MWU, I_MWD, I_FING, N_IN };

constexpr size_t MiB = 1u << 20;
constexpr size_t WS_CTL = 0, CTL_ZERO_BYTES = 1 * MiB;
constexpr size_t WS_TOKE = 1 * MiB, WS_TOKR = WS_TOKE + 128 * 1024, WS_TOKG = WS_TOKR + 128 * 1024, WS_TOKS = WS_TOKG + 128 * 1024;
constexpr size_t WS_WIN = 4 * MiB;
constexpr size_t WS_WOUT = 22 * MiB;
constexpr size_t WS_WGUD = 30 * MiB;
constexpr size_t WS_WDD = 52 * MiB;
constexpr size_t WS_WGUM = 64 * MiB;
constexpr size_t WS_WDM = 240 * MiB;
constexpr size_t WS_X = 328 * MiB;
constexpr size_t WS_XN = 392 * MiB;
constexpr size_t WS_P = 424 * MiB;
constexpr size_t WS_O = 496 * MiB;
constexpr size_t WS_ACT = 424 * MiB;
constexpr size_t WS_AP = 611 * MiB;
constexpr size_t WS_END = 679 * MiB;
static_assert(WS_WIN + (size_t)4 * INC * D * 2 <= WS_WOUT && WS_WOUT + (size_t)4 * D * D * 2 <= WS_WGUD && WS_WGUD + (size_t)2 * NGU * D * 2 <= WS_WDD && WS_WDD + (size_t)2 * D * FF * 2 <= WS_WGUM, "ws map 1");
static_assert(WS_WGUM + (size_t)16 * NGU * D * 2 <= WS_WDM && WS_WDM + (size_t)16 * D * FF * 2 <= WS_X && WS_X + (size_t)T * D * 4 <= WS_XN && WS_XN + (size_t)T * D * 2 <= WS_P, "ws map 2");
static_assert(WS_P + (size_t)T * INC * 2 <= WS_O && WS_O + (size_t)T * D * 2 <= WS_AP && WS_ACT + (size_t)MAXSLOT * FF * 2 <= WS_AP && WS_AP + (size_t)MAXSLOT * D * 2 <= WS_END, "ws map 3");
constexpr int CW_TMO = 0, CW_CODE = 1;
constexpr int CW_BAR = 4096;
constexpr int CW_MOE = 8192;

constexpr int RING_OFF = 0, RING_BYTES = 131072;
constexpr int LDSCTL_OFF = RING_BYTES, MISC_OFF = LDSCTL_OFF + 320;
constexpr int LDS_BYTES = 147456;
typedef unsigned u32x2 __attribute__((ext_vector_type(2)));
struct Frame {
    LAS unsigned char* lds;
    volatile LAS unsigned* MISC;
    int vcu, G;
};
__device__ __forceinline__ int opaque_int(int n) { asm volatile("" : "+s"(n)); return n; }
__device__ __forceinline__ int opaque_tid() { int t = threadIdx.x; asm volatile("" : "+v"(t)); return t; }
#define PHASE_IDS() const int tid = opaque_tid(), lane = tid & 63, wave = __builtin_amdgcn_readfirstlane(tid >> 6); (void)tid; (void)lane; (void)wave
template <int I> __device__ __forceinline__ const float* inp() { const float* p; asm volatile("s_load_dwordx2 %0, %1, %2\n\ts_waitcnt lgkmcnt(0)" : "=&s"(p) : "s"(__builtin_amdgcn_kernarg_segment_ptr()), "n"(I * 8)); return p; }
#define INP(i) inp<(i)>()
#define OUTPTR() ((float*)const_cast<float*>(inp<N_IN>()))
#define WSPTR() ((unsigned char*)const_cast<float*>(inp<N_IN + 1>()))
#define CTLPTR() ((gu32*)WSPTR())
__device__ __forceinline__ float bf2f(bf16 b) { return __uint_as_float((unsigned)b << 16); }
__device__ __forceinline__ float bflo(unsigned w) { return __uint_as_float(w << 16); }
__device__ __forceinline__ float bfhi(unsigned w) { return __uint_as_float(w & 0xffff0000u); }
__device__ __forceinline__ float wave_sum(float v) {
#pragma unroll
    for (int o = 1; o < 64; o <<= 1) v += __shfl_xor(v, o);
    return v;
}
__device__ __forceinline__ void fail_word(unsigned code) {
    if (threadIdx.x == 0) { gu32* ctl = CTLPTR(); unsigned expect = 0u; __hip_atomic_compare_exchange_strong((unsigned*)(ctl + CW_CODE), &expect, code, __ATOMIC_RELAXED, __ATOMIC_RELAXED, __HIP_MEMORY_SCOPE_AGENT);
        __hip_atomic_store(ctl + CW_TMO, 1u, RLX_AGENT); }
}

__device__ __forceinline__ void transpose_item(const float* W, int K, int N, bf16* WT, int mode, int nscale, int item, int lane) {
    const int nblk = N / 64, kb = item / nblk, nb = item % nblk, k0 = 64 * kb, n0 = 64 * nb, kq = lane >> 4, nq = lane & 15;
    const GAS f32x4* src = (const GAS f32x4*)(W + (size_t)(k0 + 8 * kq) * N + n0 + 4 * nq);
    f32x4 v[16];
#pragma unroll
    for (int i = 0; i < 16; ++i) v[i] = src[(size_t)((i & 7) + 32 * (i >> 3)) * (N / 4)];
    const int r0 = (mode == 0) ? n0 : (256 * (n0 >> 7) + (n0 & 127) + (mode == 2 ? 128 : 0));
    const float sc = (n0 < nscale) ? QSCALE : 1.0f;
#pragma unroll
    for (int j = 0; j < 4; ++j) { GAS v4u* dst = (GAS v4u*)(WT + (size_t)(r0 + 4 * nq + j) * K + k0 + 8 * kq);
#pragma unroll
        for (int hf = 0; hf < 2; ++hf) { v4u o;
            o.x = pk2(v[8 * hf + 0][j] * sc, v[8 * hf + 1][j] * sc); o.y = pk2(v[8 * hf + 2][j] * sc, v[8 * hf + 3][j] * sc);
            o.z = pk2(v[8 * hf + 4][j] * sc, v[8 * hf + 5][j] * sc); o.w = pk2(v[8 * hf + 6][j] * sc, v[8 * hf + 7][j] * sc);
            dst[4 * hf] = o; } }
}
__device__ __forceinline__ void p0_weights(Frame& F) {
    PHASE_IDS(); unsigned char* const ws = WSPTR();
    const int gw = F.vcu * NWAVES + wave, NGW = F.G * NWAVES;
    constexpr int I_IN = (D / 64) * (INC / 64), I_OUT = (D / 64) * (D / 64), I_GU = (D / 64) * (FF / 64), I_DN = (FF / 64) * (D / 64);
    constexpr int N0 = 4 * I_IN, N1 = N0 + 4 * I_OUT, N2 = N1 + 2 * I_GU, N3 = N2 + 2 * I_GU, N4 = N3 + 2 * I_DN, N5 = N4 + 16 * I_GU, N6 = N5 + 16 * I_GU, N7 = N6 + 16 * I_DN;
    bf16* const win = (bf16*)(ws + WS_WIN); bf16* const wout = (bf16*)(ws + WS_WOUT); bf16* const wgud = (bf16*)(ws + WS_WGUD); bf16* const wdd = (bf16*)(ws + WS_WDD);
    bf16* const wgum = (bf16*)(ws + WS_WGUM); bf16* const wdm = (bf16*)(ws + WS_WDM);
#pragma unroll 1
    for (int it = gw; it < N7; it += NGW) {
        if (it < N0) { const int l = it / I_IN, r = it % I_IN; transpose_item(INP(I_WIN) + (size_t)l * D * INC, D, INC, win + (size_t)l * INC * D, 0, 512, r, lane); }
        else if (it < N1) { const int q = it - N0, l = q / I_OUT, r = q % I_OUT; transpose_item(INP(I_WOUT) + (size_t)l * D * D, D, D, wout + (size_t)l * D * D, 0, 0, r, lane); }
        else if (it < N2) { const int q = it - N1, l = q / I_GU, r = q % I_GU; transpose_item(INP(I_DWG) + (size_t)l * D * FF, D, FF, wgud + (size_t)l * NGU * D, 1, 0, r, lane); }
        else if (it < N3) { const int q = it - N2, l = q / I_GU, r = q % I_GU; transpose_item(INP(I_DWU) + (size_t)l * D * FF, D, FF, wgud + (size_t)l * NGU * D, 2, 0, r, lane); }
        else if (it < N4) { const int q = it - N3, l = q / I_DN, r = q % I_DN; transpose_item(INP(I_DWD) + (size_t)l * FF * D, FF, D, wdd + (size_t)l * D * FF, 0, 0, r, lane); }
        else if (it < N5) { const int q = it - N4, l = q / I_GU, r = q % I_GU; transpose_item(INP(I_MWG) + (size_t)l * D * FF, D, FF, wgum + (size_t)l * NGU * D, 1, 0, r, lane); }
        else if (it < N6) { const int q = it - N5, l = q / I_GU, r = q % I_GU; transpose_item(INP(I_MWU) + (size_t)l * D * FF, D, FF, wgum + (size_t)l * NGU * D, 2, 0, r, lane); }
        else { const int q = it - N6, l = q / I_DN, r = q % I_DN; transpose_item(INP(I_MWD) + (size_t)l * FF * D, FF, D, wdm + (size_t)l * D * FF, 0, 0, r, lane); }
    }
}

struct RowArgs { const float* xsrc; float* xws; const float* gain; bf16* xn; float* out; const bf16* yp; const float* wr; gu32* gcur;
                 int* tok_e; int* tok_r; float* tok_g; const int* tok_s; };
template <int MODE>
__device__ __forceinline__ void row_phase(Frame& F, const RowArgs& A) {
    constexpr bool COMBINE = MODE & 1, ROUTER = (MODE & 2) != 0, FINAL = (MODE & 4) != 0, COPYIN = (MODE & 8) != 0;
    LAS int* s_cnt = (LAS int*)(F.lds + RING_OFF);
    LAS int* s_base = s_cnt + 8;
    LAS int* s_e = s_cnt + 16;
    LAS int* s_rk = s_e + 128;
    LAS float* s_g = (LAS float*)(s_rk + 128);
    PHASE_IDS();
    if (ROUTER) { if (tid < 16) s_cnt[tid] = 0; __syncthreads(); }
#pragma unroll 1
    for (int i = 0; i < 8; ++i) {
        const int rl = wave * 8 + i, m = F.vcu * 64 + rl;
        const GAS f32x4* xr = (const GAS f32x4*)(A.xsrc + (size_t)m * D) + lane;
        f32x4 v[4];
#pragma unroll
        for (int j = 0; j < 4; ++j) v[j] = xr[64 * j];
        if (COMBINE) {
            const int s0 = A.tok_s[2 * m], s1 = A.tok_s[2 * m + 1]; const float g0 = A.tok_g[2 * m], g1 = A.tok_g[2 * m + 1];
            const GAS u32x2* y0 = (const GAS u32x2*)(A.yp + (size_t)s0 * D) + lane; const GAS u32x2* y1 = (const GAS u32x2*)(A.yp + (size_t)s1 * D) + lane;
#pragma unroll
            for (int j = 0; j < 4; ++j) { const u32x2 a = y0[64 * j], b = y1[64 * j];
                v[j].x += g0 * bflo(a.x) + g1 * bflo(b.x); v[j].y += g0 * bfhi(a.x) + g1 * bfhi(b.x); v[j].z += g0 * bflo(a.y) + g1 * bflo(b.y); v[j].w += g0 * bfhi(a.y) + g1 * bfhi(b.y); }
        }
        if (COMBINE || COPYIN) { GAS f32x4* xw = (GAS f32x4*)(A.xws + (size_t)m * D) + lane;
#pragma unroll
            for (int j = 0; j < 4; ++j) xw[64 * j] = v[j]; }
        float ss = 0.f;
#pragma unroll
        for (int j = 0; j < 4; ++j) ss += (v[j].x * v[j].x + v[j].y * v[j].y) + (v[j].z * v[j].z + v[j].w * v[j].w);
        const float rstd = 1.0f / sqrtf(wave_sum(ss) * (1.0f / D) + RMS_EPS);
        const GAS f32x4* gr = (const GAS f32x4*)A.gain + lane;
#pragma unroll
        for (int j = 0; j < 4; ++j) v[j] = v[j] * rstd * gr[64 * j];
        if (FINAL) { GAS f32x4* o = (GAS f32x4*)(A.out + (size_t)m * D) + lane;
#pragma unroll
            for (int j = 0; j < 4; ++j) o[64 * j] = v[j]; }
        else { GAS u32x2* o = (GAS u32x2*)(A.xn + (size_t)m * D) + lane;
#pragma unroll
            for (int j = 0; j < 4; ++j) o[64 * j] = (u32x2){pk2(v[j].x, v[j].y), pk2(v[j].z, v[j].w)}; }
        if (ROUTER) {
            float lg[8];
#pragma unroll
            for (int e = 0; e < 8; ++e) lg[e] = 0.f;
#pragma unroll
            for (int j = 0; j < 4; ++j)
#pragma unroll
                for (int q = 0; q < 4; ++q) { const GAS f32x4* w = (const GAS f32x4*)(A.wr + (size_t)(256 * j + 4 * lane + q) * 8); const f32x4 w0 = w[0], w1 = w[1]; const float h = v[j][q];
                    lg[0] += h * w0.x; lg[1] += h * w0.y; lg[2] += h * w0.z; lg[3] += h * w0.w; lg[4] += h * w1.x; lg[5] += h * w1.y; lg[6] += h * w1.z; lg[7] += h * w1.w; }
#pragma unroll
            for (int e = 0; e < 8; ++e) lg[e] = wave_sum(lg[e]);
            int e1 = 0; float v1 = lg[0];
#pragma unroll
            for (int e = 1; e < 8; ++e) if (lg[e] > v1) { v1 = lg[e]; e1 = e; }
            int e2 = -1; float v2 = -INFINITY;
#pragma unroll
            for (int e = 0; e < 8; ++e) if (e != e1 && (e2 < 0 || lg[e] > v2)) { v2 = lg[e]; e2 = e; }
            const float g1 = 1.0f / (1.0f + __expf(v2 - v1)), g2 = 1.0f - g1;
            if (lane == 0) { const int r1 = atomicAdd((int*)(s_cnt + e1), 1), r2 = atomicAdd((int*)(s_cnt + e2), 1);
                s_e[2 * rl] = e1; s_e[2 * rl + 1] = e2; s_rk[2 * rl] = r1; s_rk[2 * rl + 1] = r2; s_g[2 * rl] = g1; s_g[2 * rl + 1] = g2; }
        }
    }
    if (ROUTER) {
        __syncthreads();
        if (tid < 8) s_base[tid] = (int)__hip_atomic_fetch_add(A.gcur + 64 * tid, (unsigned)s_cnt[tid], RLX_AGENT);
        __syncthreads();
        if (tid < 128) { const int m2 = F.vcu * 128 + tid; const int e = s_e[tid]; A.tok_e[m2] = e; A.tok_r[m2] = s_base[e] + s_rk[tid]; A.tok_g[m2] = s_g[tid]; }
        __syncthreads();
    }
}

__device__ __forceinline__ void load_toff(gu32* gcur, int (&cnt)[8], int (&toff)[9]) {
    toff[0] = 0;
#pragma unroll
    for (int e = 0; e < 8; ++e) { cnt[e] = (int)__builtin_amdgcn_readfirstlane(__hip_atomic_load(gcur + 64 * e, RLX_AGENT)); toff[e + 1] = toff[e] + ((cnt[e] + 255) >> 8); }
}
__device__ __forceinline__ void gather_phase(Frame& F, gu32* gcur, const bf16* xn, bf16* ap, const int* tok_e, const int* tok_r, int* tok_s) {
    PHASE_IDS();
    int cnt[8], toff[9]; load_toff(gcur, cnt, toff);
#pragma unroll 1
    for (int i = 0; i < 8; ++i) {
        const int m = F.vcu * 64 + wave * 8 + i;
        const GAS v4u* src = (const GAS v4u*)(xn + (size_t)m * D) + lane; const v4u a = src[0], b = src[64];
#pragma unroll
        for (int k = 0; k < 2; ++k) {
            const int e = tok_e[2 * m + k], r = tok_r[2 * m + k];
            int base = 0;
#pragma unroll
            for (int q = 0; q < 8; ++q) base = (e == q) ? toff[q] : base;
            const int slot = base * 256 + r;
            if (lane == 0) tok_s[2 * m + k] = slot;
            GAS v4u* dst = (GAS v4u*)(ap + (size_t)slot * D) + lane; dst[0] = a; dst[64] = b;
        }
    }
    const int gw = F.vcu * NWAVES + wave, NGW = F.G * NWAVES;
#pragma unroll
    for (int e = 0; e < 8; ++e) {
        for (int r = toff[e] * 256 + cnt[e] + gw; r < toff[e + 1] * 256; r += NGW) { GAS v4u* dst = (GAS v4u*)(ap + (size_t)r * D) + lane; dst[0] = (v4u){0u, 0u, 0u, 0u}; dst[64] = (v4u){0u, 0u, 0u, 0u}; }
    }
}

typedef float f32x16 __attribute__((ext_vector_type(16)));
typedef short s16x4 __attribute__((ext_vector_type(4)));
typedef short v4i16_t __attribute__((ext_vector_type(4)));
typedef float f32x2_t __attribute__((ext_vector_type(2))); typedef __bf16 bf16x2_t __attribute__((ext_vector_type(2)));
__device__ __forceinline__ unsigned cvtpk(float lo, float hi) { f32x2_t v = {lo, hi}; bf16x2_t b = __builtin_convertvector(v, bf16x2_t); return __builtin_bit_cast(unsigned, b); }
__device__ __forceinline__ s16x4 vtr(const LAS unsigned char* p) { return __builtin_bit_cast(s16x4, __builtin_amdgcn_ds_read_tr16_b64_v4i16((LAS v4i16_t*)p)); }
constexpr int ATT_VBYTES = 4096;
constexpr int ATT_HS_OFF = NWAVES * ATT_VBYTES;

template <bool DIAG>
__device__ __forceinline__ void sb_block(const bf16x8 (&kf)[4], const bf16x8 (&qf)[4], const LAS unsigned char* vrd, int qlim, float sel, float& carry, f32x16 (&oacc)[2]) {
    f32x16 st;
#pragma unroll
    for (int r = 0; r < 16; ++r) st[r] = 0.f;
#pragma unroll
    for (int ds = 0; ds < 4; ++ds) st = __builtin_amdgcn_mfma_f32_32x32x16_bf16(kf[ds], qf[ds], st, 0, 0, 0);
    float inc[16];
#pragma unroll
    for (int r = 0; r < 16; ++r) { const float z = st[r];
        float l = -(fmaxf(z, 0.f) + __builtin_amdgcn_logf(1.0f + __builtin_amdgcn_exp2f(-fabsf(z))));
        if (DIAG) l = ((r & 3) + 8 * (r >> 2) < qlim) ? l : 0.f;
        inc[r] = l; }
    float T[4], Ghi[4];
#pragma unroll
    for (int g = 0; g < 4; ++g) { inc[4 * g + 2] += inc[4 * g + 3]; inc[4 * g + 1] += inc[4 * g + 2]; inc[4 * g] += inc[4 * g + 1];
        const auto rr = __builtin_amdgcn_permlane32_swap(__float_as_uint(inc[4 * g]), __float_as_uint(inc[4 * g]), false, false);
        Ghi[g] = __uint_as_float(rr[1]); T[g] = __uint_as_float(rr[0]) + Ghi[g]; }
    float U[4]; U[3] = carry; U[2] = U[3] + T[3]; U[1] = U[2] + T[2]; U[0] = U[1] + T[1]; carry = U[0] + T[0];
    unsigned pk[8];
#pragma unroll
    for (int g = 0; g < 4; ++g) { const float base = fmaf(Ghi[g], sel, U[g]); float w[4];
#pragma unroll
        for (int i = 0; i < 4; ++i) { const int r = 4 * g + i; w[i] = __builtin_amdgcn_exp2f(st[r] + (inc[r] + base));
            if (DIAG) w[i] = ((r & 3) + 8 * (r >> 2) < qlim) ? w[i] : 0.f; }
        pk[2 * g] = cvtpk(w[0], w[1]); pk[2 * g + 1] = cvtpk(w[2], w[3]); }
    const bf16x8 pw0 = __builtin_bit_cast(bf16x8, (v4u){pk[0], pk[1], pk[2], pk[3]}), pw1 = __builtin_bit_cast(bf16x8, (v4u){pk[4], pk[5], pk[6], pk[7]});
#pragma unroll
    for (int c = 0; c < 2; ++c) {
        const s16x4 a0 = vtr(vrd + c * 2048), a1 = vtr(vrd + c * 2048 + 512), b0 = vtr(vrd + c * 2048 + 1024), b1 = vtr(vrd + c * 2048 + 1536);
        const bf16x8 v0 = (bf16x8){a0[0], a0[1], a0[2], a0[3], a1[0], a1[1], a1[2], a1[3]}, v1 = (bf16x8){b0[0], b0[1], b0[2], b0[3], b1[0], b1[1], b1[2], b1[3]};
        oacc[c] = __builtin_amdgcn_mfma_f32_32x32x16_bf16(v0, pw0, oacc[c], 0, 0, 0);
        oacc[c] = __builtin_amdgcn_mfma_f32_32x32x16_bf16(v1, pw1, oacc[c], 0, 0, 0); }
}

constexpr int MX_HS_OFF = NWAVES * ATT_VBYTES, MX_PS_OFF = MX_HS_OFF + 1024, MX_U_OFF = MX_PS_OFF + 1024;
static_assert(MX_U_OFF + 62 * 256 * 4 <= RING_BYTES, "mixer LDS map");
struct PcArgs { const bf16* P; bf16* O; const float* poolw; const float* pools; const float* convw; const float* convb; const float* lng; const float* lnb; const float* gng; };
__device__ __forceinline__ float sigm_mul(float val, float gate) { return val * __builtin_amdgcn_rcpf(1.0f + __builtin_amdgcn_exp2f(gate * -1.4426950408889634f)); }
__device__ __forceinline__ void mixer_phase(Frame& F, const PcArgs& A) {
    PHASE_IDS();
    const bf16* const P = A.P; bf16* const O = A.O;
    const int qi = lane & 31, hh = lane >> 5, h = wave;
    LAS unsigned char* const vimg = F.lds + RING_OFF + wave * ATT_VBYTES;
    LAS float* const hs = (LAS float*)(F.lds + RING_OFF + MX_HS_OFF);
    LAS float* const ps = (LAS float*)(F.lds + RING_OFF + MX_PS_OFF);
    LAS float* const ubuf = (LAS float*)(F.lds + RING_OFF + MX_U_OFF);
    const int vkey = lane >> 3, vch = lane & 7;
    LAS unsigned char* const vwr = vimg + (vch >> 2) * 2048 + vkey * 64 + (vch & 3) * 16;
    const LAS unsigned char* const vrd = vimg + (4 * hh + ((lane & 15) >> 2)) * 64 + ((lane >> 4) & 1) * 32 + (lane & 3) * 8;
    const float sel = hh ? 0.f : 1.f; const int qlim = qi - 4 * hh;
    const int pg = wave & 3, pdt = wave >> 2, pwin = 2 << pg;
    bf16x8 wpf[4];
    { const float* wp = A.poolw + (size_t)pg * 64 * 64 + 32 * pdt + qi; const float psc = A.pools[pg * 64 + 32 * pdt + qi];
#pragma unroll
      for (int ks = 0; ks < 4; ++ks) { float w[8];
#pragma unroll
          for (int j = 0; j < 8; ++j) w[j] = wp[(size_t)(16 * ks + 8 * hh + j) * 64] * psc;
          wpf[ks] = __builtin_bit_cast(bf16x8, (v4u){cvtpk(w[0], w[1]), cvtpk(w[2], w[3]), cvtpk(w[4], w[5]), cvtpk(w[6], w[7])}); } }
    for (int u = F.vcu; u < T / 32; u += F.G) {
        const int r0 = u * 32, s0 = r0 % SEQ;
        bf16x8 qf[4], kf[4], kn[4]; v4u vr[4], vn[4];
        const bf16* qp = P + (size_t)(r0 + qi) * INC + PQ + h * 64 + 8 * hh;
#pragma unroll
        for (int ds = 0; ds < 4; ++ds) qf[ds] = *(const bf16x8*)(qp + 16 * ds);
        const bf16* kp = P + (size_t)(r0 + qi) * INC + PK + h * 64 + 8 * hh;
        const bf16* vp = P + (size_t)(r0 + vkey) * INC + PV + h * 64 + 8 * vch;
#pragma unroll
        for (int ds = 0; ds < 4; ++ds) kf[ds] = *(const bf16x8*)(kp + 16 * ds);
#pragma unroll
        for (int i = 0; i < 4; ++i) vr[i] = *(const v4u*)(vp + (size_t)(8 * i) * INC);
        f32x16 oacc[2];
#pragma unroll
        for (int r = 0; r < 16; ++r) { oacc[0][r] = 0.f; oacc[1][r] = 0.f; }
        float carry = 0.f;
        for (int kb = s0; ; kb -= 32) {
#pragma unroll
            for (int i = 0; i < 4; ++i) *(LAS v4u*)(vwr + i * 512) = vr[i];
            if (kb > 0) { kp -= (size_t)32 * INC; vp -= (size_t)32 * INC;
#pragma unroll
                for (int ds = 0; ds < 4; ++ds) kn[ds] = *(const bf16x8*)(kp + 16 * ds);
#pragma unroll
                for (int i = 0; i < 4; ++i) vn[i] = *(const v4u*)(vp + (size_t)(8 * i) * INC); }
            if (kb == s0) sb_block<true>(kf, qf, vrd, qlim, sel, carry, oacc); else sb_block<false>(kf, qf, vrd, qlim, sel, carry, oacc);
            if (kb == 0 || __builtin_amdgcn_ballot_w64(carry >= W_EXIT) == 0ull) break;
#pragma unroll
            for (int ds = 0; ds < 4; ++ds) kf[ds] = kn[ds];
#pragma unroll
            for (int i = 0; i < 4; ++i) vr[i] = vn[i];
        }
        { float ss = 0.f;
#pragma unroll
          for (int r = 0; r < 16; ++r) ss += oacc[0][r] * oacc[0][r] + oacc[1][r] * oacc[1][r];
          const auto rr = __builtin_amdgcn_permlane32_swap(__float_as_uint(ss), __float_as_uint(ss), false, false); ss = __uint_as_float(rr[0]) + __uint_as_float(rr[1]);
          if (hh == 0) hs[wave * 32 + qi] = ss; }
        f32x16 pacc;
#pragma unroll
        for (int r = 0; r < 16; ++r) pacc[r] = 0.f;
        { const int s = s0 + qi; const int cnt = (s + 1 < pwin) ? s + 1 : pwin; const float rc = 1.0f / (float)cnt;
          const bf16* up = P + (size_t)(r0 + qi) * INC + PPOOL + pg * 64 + 8 * hh;
#pragma unroll
          for (int ks = 0; ks < 4; ++ks) { float sum[8], self[8];
              { const v4u x = *(const v4u*)(up + 16 * ks); self[0] = bflo(x.x); self[1] = bfhi(x.x); self[2] = bflo(x.y); self[3] = bfhi(x.y); self[4] = bflo(x.z); self[5] = bfhi(x.z); self[6] = bflo(x.w); self[7] = bfhi(x.w); }
#pragma unroll
              for (int j = 0; j < 8; ++j) sum[j] = self[j];
              for (int i = 1; i < pwin; ++i) if (i < cnt) { const v4u x = *(const v4u*)(up + 16 * ks - (size_t)i * INC);
                  sum[0] += bflo(x.x); sum[1] += bfhi(x.x); sum[2] += bflo(x.y); sum[3] += bfhi(x.y); sum[4] += bflo(x.z); sum[5] += bfhi(x.z); sum[6] += bflo(x.w); sum[7] += bfhi(x.w); }
#pragma unroll
              for (int j = 0; j < 8; ++j) sum[j] = sum[j] * rc - self[j];
              const bf16x8 yf = __builtin_bit_cast(bf16x8, (v4u){cvtpk(sum[0], sum[1]), cvtpk(sum[2], sum[3]), cvtpk(sum[4], sum[5]), cvtpk(sum[6], sum[7])});
              pacc = __builtin_amdgcn_mfma_f32_32x32x16_bf16(wpf[ks], yf, pacc, 0, 0, 0); } }
        { float ss = 0.f;
#pragma unroll
          for (int r = 0; r < 16; ++r) ss += pacc[r] * pacc[r];
          const auto rr = __builtin_amdgcn_permlane32_swap(__float_as_uint(ss), __float_as_uint(ss), false, false); ss = __uint_as_float(rr[0]) + __uint_as_float(rr[1]);
          if (hh == 0) ps[wave * 32 + qi] = ss; }
#pragma unroll
        for (int i = 0; i < 4; ++i) { const int idx = tid + 512 * i;
            if (idx < 62 * 32) { const int rr = idx >> 5, c8 = idx & 31; f32x4 u0 = {0.f, 0.f, 0.f, 0.f}, u1 = {0.f, 0.f, 0.f, 0.f};
                if (s0 - 30 + rr >= 0) { const bf16* rp = P + (size_t)(r0 - 30 + rr) * INC + 8 * c8; const v4u a = *(const v4u*)(rp + PCV), b = *(const v4u*)(rp + PCG);
                    u0 = (f32x4){sigm_mul(bflo(a.x), bflo(b.x)), sigm_mul(bfhi(a.x), bfhi(b.x)), sigm_mul(bflo(a.y), bflo(b.y)), sigm_mul(bfhi(a.y), bfhi(b.y))};
                    u1 = (f32x4){sigm_mul(bflo(a.z), bflo(b.z)), sigm_mul(bfhi(a.z), bfhi(b.z)), sigm_mul(bflo(a.w), bflo(b.w)), sigm_mul(bfhi(a.w), bfhi(b.w))}; }
                *(LAS f32x4*)(ubuf + rr * 256 + 8 * c8) = u0; *(LAS f32x4*)(ubuf + rr * 256 + 8 * c8 + 4) = u1; } }
        __syncthreads();
        { float tot = 0.f;
#pragma unroll
          for (int w = 0; w < 8; ++w) tot += hs[w * 32 + qi];
          const float rstd = 1.0f / sqrtf(tot * (1.0f / AW) + RMS_EPS);
          bf16* op = O + (size_t)(r0 + qi) * D + h * 64 + 4 * hh; const float* gp = A.gng + h * 64 + 4 * hh;
#pragma unroll
          for (int c = 0; c < 2; ++c)
#pragma unroll
              for (int g = 0; g < 4; ++g) { const f32x4 gv = *(const f32x4*)(gp + 32 * c + 8 * g);
                  *(u32x2*)(op + 32 * c + 8 * g) = (u32x2){cvtpk(oacc[c][4 * g] * rstd * gv.x, oacc[c][4 * g + 1] * rstd * gv.y), cvtpk(oacc[c][4 * g + 2] * rstd * gv.z, oacc[c][4 * g + 3] * rstd * gv.w)}; } }
        { float tot = 0.f;
#pragma unroll
          for (int w = 0; w < 8; ++w) tot += ps[w * 32 + qi];
          const float rstd = 1.0f / sqrtf(tot * (1.0f / PW) + RMS_EPS);
          bf16* op = O + (size_t)(r0 + qi) * D + AW + pg * 64 + 32 * pdt + 4 * hh; const float* gp = A.gng + AW + pg * 64 + 32 * pdt + 4 * hh;
#pragma unroll
          for (int g = 0; g < 4; ++g) { const f32x4 gv = *(const f32x4*)(gp + 8 * g);
              *(u32x2*)(op + 8 * g) = (u32x2){cvtpk(pacc[4 * g] * rstd * gv.x, pacc[4 * g + 1] * rstd * gv.y), cvtpk(pacc[4 * g + 2] * rstd * gv.z, pacc[4 * g + 3] * rstd * gv.w)}; } }
        { f32x4 acc[4]; const f32x4 cb = *(const f32x4*)(A.convb + 4 * lane);
#pragma unroll
          for (int tk = 0; tk < 4; ++tk) acc[tk] = cb;
#pragma unroll 1
          for (int j = 0; j < CK; ++j) { const f32x4 w4 = *(const f32x4*)(A.convw + (size_t)j * CW + 4 * lane);
#pragma unroll
              for (int tk = 0; tk < 4; ++tk) { const f32x4 u4 = *(const LAS f32x4*)(ubuf + (4 * wave + tk + j) * 256 + 4 * lane); acc[tk] += w4 * u4; } }
          const f32x4 lg = *(const f32x4*)(A.lng + 4 * lane), lb = *(const f32x4*)(A.lnb + 4 * lane), gc = *(const f32x4*)(A.gng + AW + PW + 4 * lane);
#pragma unroll
          for (int tk = 0; tk < 4; ++tk) { const int tl = 4 * wave + tk; f32x4 v = acc[tk];
              const float mean = wave_sum((v.x + v.y) + (v.z + v.w)) * (1.0f / CW); v = v - mean;
              const float var = wave_sum((v.x * v.x + v.y * v.y) + (v.z * v.z + v.w * v.w)) * (1.0f / CW); const float rs = 1.0f / sqrtf(var + LN_EPS);
              v = v * rs * lg + lb;
              v.x = sigm_mul(v.x, v.x); v.y = sigm_mul(v.y, v.y); v.z = sigm_mul(v.z, v.z); v.w = sigm_mul(v.w, v.w);
              const float ss = wave_sum((v.x * v.x + v.y * v.y) + (v.z * v.z + v.w * v.w)); const float rstd = 1.0f / sqrtf(ss * (1.0f / CW) + RMS_EPS);
              *(u32x2*)(O + (size_t)(r0 + tl) * D + AW + PW + 4 * lane) = (u32x2){pk2(v.x * rstd * gc.x, v.y * rstd * gc.y), pk2(v.z * rstd * gc.z, v.w * rstd * gc.w)}; } }
        __syncthreads();
    }
}
constexpr int NPH = 1 + 8 * DEPTH;
struct Args { const float* in[N_IN]; float* out; unsigned char* ws; int ph_lo, ph_hi; };
__global__ void __launch_bounds__(NWAVES * 64, 2) fwd(Args args) {
    extern __shared__ __attribute__((aligned(16))) unsigned char lds[];
    Frame F;
    F.lds = (LAS unsigned char*)lds;
    F.MISC = (volatile LAS unsigned*)(F.lds + MISC_OFF);
    F.G = gridDim.x; { const int bx = blockIdx.x; F.vcu = (F.G % 8 == 0) ? (bx % 8) * (F.G / 8) + bx / 8 : bx; }
    for (int u = threadIdx.x; u < (LDS_BYTES - LDSCTL_OFF) / 4; u += NWAVES * 64) ((LAS unsigned*)(F.lds + LDSCTL_OFF))[u] = 0u;
    __syncthreads();
    const int lo = args.ph_lo, hi = args.ph_hi;
    XcdBarrier bar; bar.bar = (unsigned*)(CTLPTR() + CW_BAR); bar.x = 0; bar.st = nullptr;
    if (hi - lo > 1) bar = xcd_barrier_post((unsigned*)(CTLPTR() + CW_BAR), F.MISC + 8);
#ifndef REP_PRO
#define REP_PRO 1
#endif
#ifndef REP_INP
#define REP_INP 1
#endif
#ifndef REP_ATT
#define REP_ATT 1
#endif
#ifndef REP_PC
#define REP_PC 1
#endif
#ifndef REP_MGU
#define REP_MGU 1
#endif
#ifndef REP_MDN
#define REP_MDN 1
#endif
#ifndef REP_DGU
#define REP_DGU 1
#endif
#ifndef REP_NRM
#define REP_NRM 1
#endif
#define REPEAT(n) for (int rep_ = 0, nrep_ = opaque_int(n); rep_ < nrep_; ++rep_)
#define IN(k) (lo <= (k) && (k) < hi)
#define SEAM(k) do { if ((k) + 1 < hi) xcd_barrier(bar); } while (0)
#define X ((float*)(ws + WS_X))
#define XN ((bf16*)(ws + WS_XN))
#define P ((bf16*)(ws + WS_P))
#define O ((bf16*)(ws + WS_O))
#define ACT ((bf16*)(ws + WS_ACT))
#define AP ((bf16*)(ws + WS_AP))
#define TOK_E ((int*)(ws + WS_TOKE))
#define TOK_R ((int*)(ws + WS_TOKR))
#define TOK_G ((float*)(ws + WS_TOKG))
#define TOK_S ((int*)(ws + WS_TOKS))
    if (F.G != 256) { fail_word(0x7f0u); return; }

    if (IN(0)) {
        unsigned char* const ws = WSPTR();
        REPEAT(REP_PRO) p0_weights(F);
        RowArgs A{}; A.xsrc = INP(I_X); A.xws = X; A.gain = INP(I_ANG); A.xn = XN;
        row_phase<8>(F, A);
        SEAM(0);
    }
#pragma unroll 1
    for (int l = 0; l < DEPTH; ++l) {
        const int pb = 1 + 8 * l, li = l >> 1; const bool moe = (l & 1) != 0;
        if (IN(pb + 0)) {
            unsigned char* const ws = WSPTR();
            pg8::Gemm g{XN, (const bf16*)(ws + WS_WIN) + (size_t)l * INC * D, T, INC, D, 0}; pg8::StaticOrder S; S.init(T, INC, F.G, (int)blockIdx.x);
            pg8::EpiBf16<0> E{P, INC, nullptr, 0, 0, 1.f};
            REPEAT(REP_INP) pg8::gemm_phase<pg8::EpiBf16<0>, pg8::StaticOrder, true, true>(F.lds + RING_OFF, g, S, E);
            SEAM(pb + 0);
        }
        if (IN(pb + 1)) {
            unsigned char* const ws = WSPTR();
            PcArgs A{P, O, INP(I_POOLW) + (size_t)l * 4 * 64 * 64, INP(I_POOLS) + (size_t)l * PW, INP(I_CONVW) + (size_t)l * CK * CW, INP(I_CONVB) + (size_t)l * CW,
                     INP(I_LNG) + (size_t)l * CW, INP(I_LNB) + (size_t)l * CW, INP(I_GNG) + (size_t)l * D};
            REPEAT(REP_ATT) mixer_phase(F, A);
            SEAM(pb + 1);
        }
        if (IN(pb + 2)) {
            unsigned char* const ws = WSPTR();
            pg8::Gemm g{O, (const bf16*)(ws + WS_WOUT) + (size_t)l * D * D, T, D, D, 0}; pg8::StaticOrder S; S.init(T, D, F.G, (int)blockIdx.x);
            pg8::EpiResid E{X, D};
            pg8::gemm_phase<pg8::EpiResid, pg8::StaticOrder, true, true>(F.lds + RING_OFF, g, S, E);
            SEAM(pb + 2);
        }
        if (IN(pb + 3)) {
            unsigned char* const ws = WSPTR();
            RowArgs A{}; A.xsrc = X; A.xws = X; A.gain = INP(I_FNG) + (size_t)l * D; A.xn = XN;
            if (moe) { A.wr = INP(I_RW) + (size_t)li * D * NE; A.gcur = CTLPTR() + CW_MOE + li * 1024; A.tok_e = TOK_E; A.tok_r = TOK_R; A.tok_g = TOK_G; row_phase<2>(F, A); }
            else REPEAT(REP_NRM) row_phase<0>(F, A);
            SEAM(pb + 3);
        }
        if (moe) {
            if (IN(pb + 4)) { unsigned char* const ws = WSPTR(); gu32* const gcur = CTLPTR() + CW_MOE + li * 1024; gather_phase(F, gcur, XN, AP, TOK_E, TOK_R, TOK_S); SEAM(pb + 4); }
            if (IN(pb + 5)) {
                unsigned char* const ws = WSPTR(); gu32* const gcur = CTLPTR() + CW_MOE + li * 1024;
                int cnt[8], toff[9]; load_toff(gcur, cnt, toff);
                pg8::Gemm g{AP, (const bf16*)(ws + WS_WGUM) + (size_t)li * NE * NGU * D, 0, NGU, D, (size_t)NGU * D * 2}; pg8::GroupedOrder S; S.init(toff, NGU, F.G, (int)blockIdx.x);
                pg8::EpiSwiGLU E{ACT, FF};
                REPEAT(REP_MGU) pg8::gemm_phase<pg8::EpiSwiGLU, pg8::GroupedOrder, true, true>(F.lds + RING_OFF, g, S, E);
                SEAM(pb + 5);
            }
            if (IN(pb + 6)) {
                unsigned char* const ws = WSPTR(); gu32* const gcur = CTLPTR() + CW_MOE + li * 1024;
                int cnt[8], toff[9]; load_toff(gcur, cnt, toff);
                pg8::Gemm g{ACT, (const bf16*)(ws + WS_WDM) + (size_t)li * NE * D * FF, 0, D, FF, (size_t)D * FF * 2}; pg8::GroupedOrder S; S.init(toff, D, F.G, (int)blockIdx.x);
                pg8::EpiBf16<0> E{AP, D, nullptr, 0, 0, 1.f};
                REPEAT(REP_MDN) pg8::gemm_phase<pg8::EpiBf16<0>, pg8::GroupedOrder, true, true>(F.lds + RING_OFF, g, S, E);
                SEAM(pb + 6);
            }
        } else {
            if (IN(pb + 5)) {
                unsigned char* const ws = WSPTR();
                pg8::Gemm g{XN, (const bf16*)(ws + WS_WGUD) + (size_t)li * NGU * D, T, NGU, D, 0}; pg8::StaticOrder S; S.init(T, NGU, F.G, (int)blockIdx.x);
                pg8::EpiSwiGLU E{ACT, FF};
                REPEAT(REP_DGU) pg8::gemm_phase<pg8::EpiSwiGLU, pg8::StaticOrder, true, true>(F.lds + RING_OFF, g, S, E);
                SEAM(pb + 5);
            }
            if (IN(pb + 6)) {
                unsigned char* const ws = WSPTR();
                pg8::Gemm g{ACT, (const bf16*)(ws + WS_WDD) + (size_t)li * D * FF, T, D, FF, 0}; pg8::StaticOrder S; S.init(T, D, F.G, (int)blockIdx.x);
                pg8::EpiResid E{X, D};
                pg8::gemm_phase<pg8::EpiResid, pg8::StaticOrder, true, true>(F.lds + RING_OFF, g, S, E);
                SEAM(pb + 6);
            }
        }
        if (IN(pb + 7)) {
            unsigned char* const ws = WSPTR();
            RowArgs A{}; A.xsrc = X; A.xws = X; A.xn = XN; A.out = OUTPTR(); A.yp = AP; A.tok_g = TOK_G; A.tok_s = TOK_S;
            A.gain = (l == DEPTH - 1) ? INP(I_FING) : INP(I_ANG) + (size_t)(l + 1) * D;
            if (l == DEPTH - 1) row_phase<5>(F, A);
            else if (moe) row_phase<1>(F, A);
            else row_phase<0>(F, A);
            SEAM(pb + 7);
        }
    }
#undef IN
#undef SEAM
#undef X
#undef XN
#undef P
#undef O
#undef ACT
#undef AP
#undef TOK_E
#undef TOK_R
#undef TOK_G
#undef TOK_S
}

#ifndef MK_ONE_LAUNCH
#define MK_ONE_LAUNCH 0
#endif
extern "C" void kernel_launch(void* const* d_in, const int* in_sizes, int n_in, void* d_out, int out_size, void* d_ws, size_t ws_size, hipStream_t stream) {
    static int grid = 0;
    if (grid == 0) {
        if (n_in != N_IN || in_sizes[0] != T * D || out_size != T * D || ws_size < WS_END) { fprintf(stderr, "kernel_launch: unexpected problem shape (n_in %d, in0 %d, out %d, ws %zu); nothing launched\n", n_in, n_in > 0 ? in_sizes[0] : -1, out_size, ws_size); grid = -1; return; }
        if (hipFuncSetAttribute((const void*)fwd, hipFuncAttributeMaxDynamicSharedMemorySize, LDS_BYTES) != hipSuccess) { fprintf(stderr, "kernel_launch: hipFuncSetAttribute failed; nothing launched\n"); grid = -1; return; }
        int per_cu = 0;
        if (hipOccupancyMaxActiveBlocksPerMultiprocessor(&per_cu, (const void*)fwd, NWAVES * 64, LDS_BYTES) != hipSuccess || per_cu < 1)
            fprintf(stderr, "kernel_launch: note: occupancy query reports %d workgroups per CU\n", per_cu);
        (void)hipGetLastError();
        grid = 256;
    }
    if (grid < 0) return;
    if (hipMemsetAsync((char*)d_ws + WS_CTL, 0, CTL_ZERO_BYTES, stream) != hipSuccess) { fprintf(stderr, "kernel_launch: hipMemsetAsync failed; nothing launched\n"); return; }
    Args a{};
    for (int i = 0; i < N_IN; ++i) a.in[i] = (const float*)d_in[i];
    a.out = (float*)d_out; a.ws = (unsigned char*)d_ws;
#if MK_ONE_LAUNCH
    a.ph_lo = 0; a.ph_hi = NPH;
    hipLaunchKernelGGL(fwd, dim3(grid), dim3(NWAVES * 64), LDS_BYTES, stream, a);
#else
    for (int p = 0; p < NPH; ++p) {
        if (p > 0 && ((p - 1) & 7) == 4 && ((((p - 1) >> 3) & 1) == 0)) continue;
        a.ph_lo = p; a.ph_hi = p + 1;
        hipLaunchKernelGGL(fwd, dim3(grid), dim3(NWAVES * 64), LDS_BYTES, stream, a);
    }
#endif
    const hipError_t le = hipPeekAtLastError();
    if (le != hipSuccess) fprintf(stderr, "kernel_launch: launch failed: %s\n", hipGetErrorName(le));
}
```

```cpp
#include <hip/hip_runtime.h>
#include <cstdio>
#include <cstdint>
#include <cmath>
#define MK_ONE_LAUNCH 1
__device__ __forceinline__ int lane_now() { int l; asm volatile("v_mbcnt_lo_u32_b32 %0, -1, 0\n\tv_mbcnt_hi_u32_b32 %0, -1, %0" : "=v"(l)); return l; }
namespace pg8 {
#define PG8_LAS __attribute__((address_space(3)))
typedef unsigned short bf16_t;
typedef short bf16x8 __attribute__((ext_vector_type(8)));
typedef float f32x4 __attribute__((ext_vector_type(4)));
typedef unsigned u32x4 __attribute__((ext_vector_type(4)));
constexpr int BM = 256, BK = 64, HALF = 128, HTB = HALF * BK * 2  , STAGE_BYTES = 8 * HTB, NXCD = 8, WGM = 8;

__host__ __device__ __forceinline__ int lds_byte(int r, int c) { const int st = (r >> 4) * 2 + (c >> 5), rr = r & 15, cc = c & 31, ob = rr * 64 + cc * 2; return st * 1024 + (ob ^ (((ob >> 9) & 1) << 5)); }
__host__ __device__ __forceinline__ void stage_rc(int b, int& R, int& C) { const int st = b / 1024, sb = b % 1024, swz = sb ^ (((sb >> 9) & 1) << 5); R = (st >> 1) * 16 + swz / 64; C = (st & 1) * 32 + (swz % 64) / 2; }
__host__ __device__ __forceinline__ int perm32(int rho) { const int n = rho >> 4, i = rho & 15; return 8 * (i >> 2) + 4 * n + (i & 3); }

struct Unit { int pm, pn, e; };
struct Gemm { const bf16_t* A; const bf16_t* Bt; int M, N, K; size_t estride; };

struct StaticOrder {
    int nM, nN, nwg, G, c;
    __host__ __device__ void init(int M, int N, int G_, int c_) { nM = M / BM; nN = N / BM; nwg = nM * nN; G = G_; c = c_; }
    __host__ __device__ bool next(int i, Unit& u) const {
        const long L = (long)i * G + c; if (L >= nwg) return false;
        int wgid = (int)L; { const int q = nwg / NXCD, r = nwg % NXCD, xcd = wgid % NXCD, off = wgid / NXCD; wgid = (xcd < r ? xcd * (q + 1) : r * (q + 1) + (xcd - r) * q) + off; }
        const int nig = WGM * nN, gid = wgid / nig, fm = gid * WGM, gsz = (nM - fm) < WGM ? (nM - fm) : WGM;
        u.pm = fm + ((wgid % nig) % gsz); u.pn = (wgid % nig) / gsz; u.e = 0; return true;
    }
    __device__ __forceinline__ void a_ready(const Unit&) const {}
    __device__ __forceinline__ void done(const Unit&) const {}
};

__device__ __forceinline__ unsigned cvt_pk_bf16(float lo, float hi) { unsigned r; asm volatile("v_cvt_pk_bf16_f32 %0, %1, %2" : "=v"(r) : "v"(lo), "v"(hi)); return r; }
typedef float f32x2 __attribute__((ext_vector_type(2)));
__device__ __forceinline__ f32x2 gelu_pk(f32x2 v) {
    const f32x2 av = __builtin_elementwise_abs(v), d = av * 0.2316418882f + 1.0f;
    f32x2 t; t.x = __builtin_amdgcn_rcpf(d.x); t.y = __builtin_amdgcn_rcpf(d.y);
    f32x2 q = t * 0.5307027145f + (-0.7265760135f); q = q * t + 0.7107068705f; q = q * t + (-0.142248368f); q = q * t + 0.127414796f; q = q * t;
    const f32x2 s = (v * v) * (-0.72134752044f);
    f32x2 e; e.x = __builtin_amdgcn_exp2f(s.x); e.y = __builtin_amdgcn_exp2f(s.y);
    const f32x2 m = v * (q * e), r = v - m;
    f32x2 o; o.x = v.x < 0.f ? m.x : r.x; o.y = v.y < 0.f ? m.y : r.y; return o;
}

template <int ACT  > struct EpiBf16 {
    static constexpr bool PERM = true, AFTER_DRAIN = false; static_assert(ACT == 0 || ACT == 1, "EpiBf16: ACT is 0 (none) or 1 (gelu_pk)");
    bf16_t* O; int ldc; const float* bias; int split_cols; size_t split_stride; float scale0;
    __device__ __forceinline__ void operator()(const f32x4 (&acc)[2][2][4][2], const Unit& u, int wr, int wc, int fr, int fq) const {
        const int row0 = u.pm * BM + wr * 64 + fr; int colt = u.pn * BM; bf16_t* base = O;
        float sc = 1.f; if (split_cols) { const int t = colt / split_cols; base += (size_t)t * split_stride; colt -= t * split_cols; if (t == 0) sc = scale0; }
        const int col0 = colt + wc * 32 + 8 * fq, bcol0 = u.pn * BM + wc * 32 + 8 * fq;
        f32x4 bv[2][2];
#pragma unroll
        for (int bj = 0; bj < 2; ++bj)
#pragma unroll
            for (int n = 0; n < 2; ++n) bv[bj][n] = bias ? *(const f32x4*)(bias + bcol0 + bj * HALF + 4 * n) : (f32x4){0.f, 0.f, 0.f, 0.f};
#pragma unroll
        for (int ai = 0; ai < 2; ++ai)
#pragma unroll
            for (int m = 0; m < 4; ++m) { bf16_t* rowp = base + (size_t)(row0 + ai * HALF + m * 16) * ldc + col0;
#pragma unroll
                for (int bj = 0; bj < 2; ++bj) { f32x4 v0 = acc[ai][bj][m][0] + bv[bj][0], v1 = acc[ai][bj][m][1] + bv[bj][1];
                    if (ACT == 1) { f32x2 a = gelu_pk((f32x2){v0[0], v0[1]}), b = gelu_pk((f32x2){v0[2], v0[3]}), c = gelu_pk((f32x2){v1[0], v1[1]}), d = gelu_pk((f32x2){v1[2], v1[3]});
                        v0 = (f32x4){a.x, a.y, b.x, b.y}; v1 = (f32x4){c.x, c.y, d.x, d.y}; }
                    v0 = v0 * sc; v1 = v1 * sc; u32x4 w; w.x = cvt_pk_bf16(v0[0], v0[1]); w.y = cvt_pk_bf16(v0[2], v0[3]); w.z = cvt_pk_bf16(v1[0], v1[1]); w.w = cvt_pk_bf16(v1[2], v1[3]);
                    *(u32x4*)(rowp + bj * HALF) = w; } }
    }
};
struct EpiResid {
    static constexpr bool PERM = false, AFTER_DRAIN = false;
    float* X; int ldc;
    __device__ __forceinline__ void operator()(const f32x4 (&acc)[2][2][4][2], const Unit& u, int wr, int wc, int fr, int fq) const {
        const int row0 = u.pm * BM + wr * 64 + fr, col0 = u.pn * BM + wc * 32 + 4 * fq;
#pragma unroll
        for (int ai = 0; ai < 2; ++ai)
#pragma unroll
            for (int m = 0; m < 4; ++m) { float* rowp = X + (size_t)(row0 + ai * HALF + m * 16) * ldc + col0;
                f32x4 old[2][2];
#pragma unroll
                for (int bj = 0; bj < 2; ++bj)
#pragma unroll
                    for (int n = 0; n < 2; ++n) old[bj][n] = *(const f32x4*)(rowp + bj * HALF + n * 16);
#pragma unroll
                for (int bj = 0; bj < 2; ++bj)
#pragma unroll
                    for (int n = 0; n < 2; ++n) *(f32x4*)(rowp + bj * HALF + n * 16) = old[bj][n] + acc[ai][bj][m][n];
                asm volatile("" ::: "memory"); }
    }
};
__device__ __forceinline__ float silu_mul(float g, float u) { return g * __builtin_amdgcn_rcpf(1.0f + __builtin_amdgcn_exp2f(g * -1.4426950408889634f)) * u; }
struct EpiSwiGLU {
    static constexpr bool PERM = true, AFTER_DRAIN = false;
    bf16_t* O; int ldc;
    __device__ __forceinline__ void operator()(const f32x4 (&acc)[2][2][4][2], const Unit& u, int wr, int wc, int fr, int fq) const {
        const int row0 = u.pm * BM + wr * 64 + fr, col0 = u.pn * HALF + wc * 32 + 8 * fq;
#pragma unroll
        for (int ai = 0; ai < 2; ++ai)
#pragma unroll
            for (int m = 0; m < 4; ++m) { bf16_t* rowp = O + (size_t)(row0 + ai * HALF + m * 16) * ldc + col0;
                const f32x4 g0 = acc[ai][0][m][0], g1 = acc[ai][0][m][1], u0 = acc[ai][1][m][0], u1 = acc[ai][1][m][1];
                u32x4 w;
                w.x = cvt_pk_bf16(silu_mul(g0[0], u0[0]), silu_mul(g0[1], u0[1])); w.y = cvt_pk_bf16(silu_mul(g0[2], u0[2]), silu_mul(g0[3], u0[3]));
                w.z = cvt_pk_bf16(silu_mul(g1[0], u1[0]), silu_mul(g1[1], u1[1])); w.w = cvt_pk_bf16(silu_mul(g1[2], u1[2]), silu_mul(g1[3], u1[3]));
                *(u32x4*)rowp = w; }
    }
};
typedef int v4i_t __attribute__((ext_vector_type(4)));
typedef unsigned u32x2e __attribute__((ext_vector_type(2)));
__device__ __forceinline__ float clamp8(float v) { return __builtin_fminf(__builtin_fmaxf(v, -448.0f), 448.0f); }
__device__ __forceinline__ unsigned pack_fp8x4(float a, float b, float c, float d) { unsigned w = 0u; w = __builtin_amdgcn_cvt_pk_fp8_f32(clamp8(a), clamp8(b), w, false); w = __builtin_amdgcn_cvt_pk_fp8_f32(clamp8(c), clamp8(d), w, true); return w; }
struct EpiSwiGLU8 {
    static constexpr bool PERM = true, AFTER_DRAIN = false;
    unsigned char* O; int ldc; float sin, sout;
    __device__ __forceinline__ void operator()(const f32x4 (&acc)[2][2][4][2], const Unit& u, int wr, int wc, int fr, int fq) const {
        const int row0 = u.pm * BM + wr * 64 + fr, col0 = u.pn * HALF + wc * 32 + 8 * fq;
#pragma unroll
        for (int ai = 0; ai < 2; ++ai)
#pragma unroll
            for (int m = 0; m < 4; ++m) { unsigned char* rowp = O + (size_t)(row0 + ai * HALF + m * 16) * ldc + col0;
                const f32x4 g0 = acc[ai][0][m][0] * sin, g1 = acc[ai][0][m][1] * sin, u0 = acc[ai][1][m][0] * (sin * sout), u1 = acc[ai][1][m][1] * (sin * sout);
                u32x2e w;
                w.x = pack_fp8x4(silu_mul(g0[0], u0[0]), silu_mul(g0[1], u0[1]), silu_mul(g0[2], u0[2]), silu_mul(g0[3], u0[3]));
                w.y = pack_fp8x4(silu_mul(g1[0], u1[0]), silu_mul(g1[1], u1[1]), silu_mul(g1[2], u1[2]), silu_mul(g1[3], u1[3]));
                *(u32x2e*)rowp = w; }
    }
};
struct EpiBf16S {
    static constexpr bool PERM = true, AFTER_DRAIN = false;
    bf16_t* O; int ldc; float s;
    __device__ __forceinline__ void operator()(const f32x4 (&acc)[2][2][4][2], const Unit& u, int wr, int wc, int fr, int fq) const {
        const int row0 = u.pm * BM + wr * 64 + fr, col0 = u.pn * BM + wc * 32 + 8 * fq;
#pragma unroll
        for (int ai = 0; ai < 2; ++ai)
#pragma unroll
            for (int m = 0; m < 4; ++m) { bf16_t* rowp = O + (size_t)(row0 + ai * HALF + m * 16) * ldc + col0;
#pragma unroll
                for (int bj = 0; bj < 2; ++bj) { const f32x4 v0 = acc[ai][bj][m][0] * s, v1 = acc[ai][bj][m][1] * s;
                    u32x4 w; w.x = cvt_pk_bf16(v0[0], v0[1]); w.y = cvt_pk_bf16(v0[2], v0[3]); w.z = cvt_pk_bf16(v1[0], v1[1]); w.w = cvt_pk_bf16(v1[2], v1[3]);
                    *(u32x4*)(rowp + bj * HALF) = w; } }
    }
};
struct GroupedOrder {
    int nM, nN, nwg, G, c; int t1, t2, t3, t4, t5, t6, t7;
    __device__ __forceinline__ void init(const int (&toff)[9], int N, int G_, int c_) { nM = toff[8]; nN = N / BM; nwg = nM * nN; G = G_; c = c_;
        t1 = toff[1]; t2 = toff[2]; t3 = toff[3]; t4 = toff[4]; t5 = toff[5]; t6 = toff[6]; t7 = toff[7]; }
    __device__ __forceinline__ bool next(int i, Unit& u) const {
        const long L = (long)i * G + c; if (L >= nwg) return false;
        int wgid = (int)L; { const int q = nwg / NXCD, r = nwg % NXCD, xcd = wgid % NXCD, off = wgid / NXCD; wgid = (xcd < r ? xcd * (q + 1) : r * (q + 1) + (xcd - r) * q) + off; }
        const int nig = WGM * nN, gid = wgid / nig, fm = gid * WGM, gsz = (nM - fm) < WGM ? (nM - fm) : WGM;
        u.pm = fm + ((wgid % nig) % gsz); u.pn = (wgid % nig) / gsz;
        u.e = __builtin_amdgcn_readfirstlane((u.pm >= t1) + (u.pm >= t2) + (u.pm >= t3) + (u.pm >= t4) + (u.pm >= t5) + (u.pm >= t6) + (u.pm >= t7)); return true;
    }
    __device__ __forceinline__ void a_ready(const Unit&) const {}
    __device__ __forceinline__ void done(const Unit&) const {}
};
template <class Epi, class Sched, bool ALIGN_EPI = false, bool SP2 = false, bool F8 = false>
__device__ __forceinline__ void gemm_phase(PG8_LAS unsigned char* lds, const Gemm g, const Sched& S, const Epi& E, const int wave_u  ) {
    const int tid_ = wave_u * 64 + lane_now();
    const int tid = tid_, wid = wave_u, lane = tid & 63, wr = wid >> 2, wc = wid & 3, fr = lane & 15, fq = lane >> 4;
    const int K = g.K, nt = K / BK;
    unsigned voffA[2], voffB[2];
#pragma unroll
    for (int i = 0; i < 2; ++i) { int R, C; stage_rc(tid * 16 + i * 8192, R, C); const int Rb = Epi::PERM ? ((R & ~31) + perm32(R & 31)) : R;
        voffA[i] = (unsigned)(R * K + C) * 2u; voffB[i] = (unsigned)(Rb * K + C) * 2u; }
    const size_t kstep = (size_t)(BK * 2);
    const size_t hstep = (size_t)HALF * K * 2;
    const size_t tstep = 2 * hstep;
    const unsigned ldsw = (unsigned)wid * 1024u;
    const unsigned ldsbase = (unsigned)(uintptr_t)lds + ldsw;
    const int aoff = lds_byte(wr * 64 + fr, fq * 8), boff = lds_byte(wc * 32 + fr, fq * 8);
#define PG8_SA(b, h) (((b) * 2 + (h)) * HTB)
#define PG8_SB(b, h) ((4 + (b) * 2 + (h)) * HTB)
#define PG8_GLDS(sbase, voff32, ldsdst) do { unsigned keep_; asm volatile("s_mov_b32 %0, m0\n\ts_mov_b32 m0, %3\n\ts_nop 0\n\tglobal_load_lds_dwordx4 %1, %2\n\ts_mov_b32 m0, %0" \
        : "=&s"(keep_) : "v"(voff32), "s"(sbase), "s"(ldsdst) : "memory"); } while (0)
#define PG8_STAGE(bufoff, gbase, voff) do { _Pragma("unroll") for (int _i = 0; _i < 2; ++_i) \
        PG8_GLDS((const char*)(gbase), (voff)[_i], (unsigned)__builtin_amdgcn_readfirstlane((int)(ldsbase + (unsigned)((bufoff) + _i * 8192)))); } while (0)
#define PG8_LDA(dst, b, h) do { _Pragma("unroll") for (int m = 0; m < 4; ++m) _Pragma("unroll") for (int k = 0; k < 2; ++k) dst[m][k] = *(const PG8_LAS bf16x8*)(lds + PG8_SA(b, h) + aoff + m * 2048 + k * 1024); } while (0)
#define PG8_LDB(dst, b, h) do { _Pragma("unroll") for (int n = 0; n < 2; ++n) _Pragma("unroll") for (int k = 0; k < 2; ++k) dst[n][k] = *(const PG8_LAS bf16x8*)(lds + PG8_SB(b, h) + boff + n * 2048 + k * 1024); } while (0)
#define PG8_CAT8(a, b) __builtin_shufflevector(__builtin_bit_cast(v4i_t, (a)), __builtin_bit_cast(v4i_t, (b)), 0, 1, 2, 3, 4, 5, 6, 7)
#define PG8_MMA(ai, bj, At, Bt) do { __builtin_amdgcn_s_setprio(1); if constexpr (F8) { _Pragma("unroll") for (int m = 0; m < 4; ++m) _Pragma("unroll") for (int n = 0; n < 2; ++n) \
        acc[ai][bj][m][n] = __builtin_amdgcn_mfma_scale_f32_16x16x128_f8f6f4(PG8_CAT8(Bt[n][0], Bt[n][1]), PG8_CAT8(At[m][0], At[m][1]), acc[ai][bj][m][n], 0, 0, 0, 0, 0, 0); } else { \
        _Pragma("unroll") for (int m = 0; m < 4; ++m) _Pragma("unroll") for (int n = 0; n < 2; ++n) _Pragma("unroll") for (int k = 0; k < 2; ++k) \
        acc[ai][bj][m][n] = __builtin_amdgcn_mfma_f32_16x16x32_bf16(Bt[n][k], At[m][k], acc[ai][bj][m][n], 0, 0, 0); } __builtin_amdgcn_s_setprio(0); } while (0)
#define PG8_WAIT_V(n) asm volatile("s_waitcnt vmcnt(" #n ")" ::: "memory")
#define PG8_WAIT_L(n) asm volatile("s_waitcnt lgkmcnt(" #n ")" ::: "memory")
#define PG8_BAR __builtin_amdgcn_s_barrier()
#define PG8_SCHED __builtin_amdgcn_sched_barrier(0)
    Unit cur, nxt; int ui = 0;
    if (!S.next(0, cur)) return;
    f32x4 acc[2][2][4][2];
#pragma unroll
    for (int a = 0; a < 2; ++a)
#pragma unroll
        for (int b = 0; b < 2; ++b)
#pragma unroll
            for (int m = 0; m < 4; ++m)
#pragma unroll
                for (int n = 0; n < 2; ++n) acc[a][b][m][n] = (f32x4){0.f, 0.f, 0.f, 0.f};
    bf16x8 At[4][2], B0[2][2], B1[2][2];
    const char* cA = (const char*)g.A + (size_t)cur.pm * tstep; const char* cB = (const char*)g.Bt + (size_t)cur.e * g.estride + (size_t)cur.pn * tstep;
    S.a_ready(cur);
    if constexpr (SP2) {
        PG8_STAGE(PG8_SB(0, 0), cB, voffB); PG8_STAGE(PG8_SB(0, 1), cB + hstep, voffB); PG8_STAGE(PG8_SA(0, 0), cA, voffA); PG8_STAGE(PG8_SA(0, 1), cA + hstep, voffA);
        if (wr == 1) PG8_BAR;
        PG8_WAIT_V(2); PG8_BAR;
        PG8_STAGE(PG8_SB(1, 0), cB + kstep, voffB); PG8_STAGE(PG8_SA(1, 0), cA + kstep, voffA); PG8_STAGE(PG8_SB(1, 1), cB + hstep + kstep, voffB);
        PG8_WAIT_V(6); PG8_BAR;
    } else {
        PG8_STAGE(PG8_SB(0, 0), cB, voffB); PG8_STAGE(PG8_SA(0, 0), cA, voffA); PG8_STAGE(PG8_SB(0, 1), cB + hstep, voffB); PG8_STAGE(PG8_SA(0, 1), cA + hstep, voffA);
        if (wr == 1) PG8_BAR;
        PG8_WAIT_V(4); PG8_BAR;
        PG8_STAGE(PG8_SB(1, 0), cB + kstep, voffB); PG8_STAGE(PG8_SA(1, 0), cA + kstep, voffA); PG8_STAGE(PG8_SB(1, 1), cB + hstep + kstep, voffB);
        PG8_WAIT_V(6); PG8_BAR;
    }
    for (;;) {
        const bool has_next = S.next(ui + 1, nxt);
        const char* nA = has_next ? (const char*)g.A + (size_t)nxt.pm * tstep : cA; const char* nB = has_next ? (const char*)g.Bt + (size_t)nxt.e * g.estride + (size_t)nxt.pn * tstep : cB;
        for (int t = 0; t < nt; t += 2) {
            const bool last = (t == nt - 2);
            const char* a1 = cA + (size_t)(t + 1) * kstep;
            const char* a2 = last ? nA : cA + (size_t)(t + 2) * kstep; const char* b2 = last ? nB : cB + (size_t)(t + 2) * kstep;
            const char* a3 = a2 + kstep; const char* b3 = b2 + kstep;
            if (last && has_next) S.a_ready(nxt);
            if constexpr (SP2) {
            PG8_LDB(B0, 0, 0); PG8_LDB(B1, 0, 1); PG8_SCHED; PG8_LDA(At, 0, 0); PG8_STAGE(PG8_SA(1, 1), a1 + hstep, voffA);
            PG8_WAIT_V(8); PG8_WAIT_L(0); PG8_BAR; PG8_MMA(0, 0, At, B0); PG8_MMA(0, 1, At, B1); PG8_BAR; PG8_SCHED;
            PG8_LDA(At, 0, 1); PG8_STAGE(PG8_SB(0, 0), b2, voffB); PG8_STAGE(PG8_SB(0, 1), b2 + hstep, voffB); PG8_STAGE(PG8_SA(0, 0), a2, voffA);
            PG8_WAIT_V(8); PG8_WAIT_L(0); PG8_BAR; PG8_MMA(1, 0, At, B0); PG8_MMA(1, 1, At, B1); PG8_BAR; PG8_SCHED;
            PG8_LDB(B0, 1, 0); PG8_LDB(B1, 1, 1); PG8_SCHED; PG8_LDA(At, 1, 0); PG8_STAGE(PG8_SA(0, 1), a2 + hstep, voffA);
            PG8_WAIT_V(8); PG8_WAIT_L(0); PG8_BAR; PG8_MMA(0, 0, At, B0); PG8_MMA(0, 1, At, B1); PG8_BAR; PG8_SCHED;
            PG8_LDA(At, 1, 1); PG8_STAGE(PG8_SB(1, 0), b3, voffB); PG8_STAGE(PG8_SB(1, 1), b3 + hstep, voffB); PG8_STAGE(PG8_SA(1, 0), a3, voffA);
            PG8_WAIT_V(8); PG8_WAIT_L(0); PG8_BAR; PG8_MMA(1, 0, At, B0); PG8_MMA(1, 1, At, B1); PG8_BAR; PG8_SCHED;
            } else {
            PG8_LDB(B0, 0, 0); PG8_SCHED; PG8_LDA(At, 0, 0); PG8_STAGE(PG8_SA(1, 1), a1 + hstep, voffA);
            PG8_WAIT_L(8); PG8_BAR; PG8_WAIT_L(0); PG8_MMA(0, 0, At, B0); PG8_BAR; PG8_SCHED;
            PG8_LDB(B1, 0, 1); PG8_STAGE(PG8_SB(0, 0), b2, voffB);
            PG8_BAR; PG8_WAIT_L(0); PG8_MMA(0, 1, At, B1); PG8_BAR;
            PG8_LDA(At, 0, 1); PG8_STAGE(PG8_SA(0, 0), a2, voffA);
            PG8_BAR; PG8_WAIT_L(0); PG8_MMA(1, 0, At, B0); PG8_BAR; PG8_SCHED;
            PG8_STAGE(PG8_SB(0, 1), b2 + hstep, voffB);
            PG8_WAIT_V(6); PG8_BAR; PG8_MMA(1, 1, At, B1); PG8_BAR;
            PG8_LDB(B0, 1, 0); PG8_SCHED; PG8_LDA(At, 1, 0); PG8_STAGE(PG8_SA(0, 1), a2 + hstep, voffA);
            PG8_WAIT_L(8); PG8_BAR; PG8_WAIT_L(0); PG8_MMA(0, 0, At, B0); PG8_BAR; PG8_SCHED;
            PG8_LDB(B1, 1, 1); PG8_STAGE(PG8_SB(1, 0), b3, voffB);
            PG8_BAR; PG8_WAIT_L(0); PG8_MMA(0, 1, At, B1); PG8_BAR;
            PG8_LDA(At, 1, 1); PG8_STAGE(PG8_SA(1, 0), a3, voffA);
            PG8_BAR; PG8_WAIT_L(0); PG8_MMA(1, 0, At, B0); PG8_BAR; PG8_SCHED;
            PG8_STAGE(PG8_SB(1, 1), b3 + hstep, voffB);
            PG8_WAIT_V(6); PG8_BAR; PG8_MMA(1, 1, At, B1); PG8_BAR;
            }
        }
        if constexpr (ALIGN_EPI) { if (wr == 0) PG8_BAR; }
        if constexpr (!Epi::AFTER_DRAIN) { E(acc, cur, wr, wc, fr, fq); S.done(cur); }
        if (!has_next) break;
#pragma unroll
        for (int a = 0; a < 2; ++a)
#pragma unroll
            for (int b = 0; b < 2; ++b)
#pragma unroll
                for (int m = 0; m < 4; ++m)
#pragma unroll
                    for (int n = 0; n < 2; ++n) acc[a][b][m][n] = (f32x4){0.f, 0.f, 0.f, 0.f};
        cur = nxt; cA = nA; cB = nB; ++ui;
        if constexpr (ALIGN_EPI) { if (wr == 1) PG8_BAR; }
    }
    PG8_WAIT_V(0);
    if constexpr (!ALIGN_EPI) { if (wr == 0) PG8_BAR; }
    PG8_BAR;
    if constexpr (Epi::AFTER_DRAIN) { E.fused(acc, cur, wr, wc, fr, fq, lds, wid, lane); S.done(cur); }
#undef PG8_SA
#undef PG8_SB
#undef PG8_STAGE
#undef PG8_GLDS
#undef PG8_LDA
#undef PG8_LDB
#undef PG8_MMA
#undef PG8_CAT8
#undef PG8_WAIT_V
#undef PG8_WAIT_L
#undef PG8_BAR
#undef PG8_SCHED
}
}
#define GAS __attribute__((address_space(1)))
#define LAS __attribute__((address_space(3)))
typedef unsigned short bf16;
typedef unsigned v4u __attribute__((ext_vector_type(4)));
typedef float f32x4 __attribute__((ext_vector_type(4)));
typedef short bf16x8 __attribute__((ext_vector_type(8)));
typedef GAS unsigned gu32;
typedef GAS unsigned long long gu64;
#define RLX_AGENT __ATOMIC_RELAXED, __HIP_MEMORY_SCOPE_AGENT
#define LDS_WAIT() asm volatile("s_waitcnt lgkmcnt(0)" ::: "memory")
#define VM_WAIT() asm volatile("s_waitcnt vmcnt(0)" ::: "memory")
__device__ __forceinline__ unsigned long long rt() { return __builtin_amdgcn_s_memrealtime(); }
__device__ __forceinline__ unsigned f2bf(float f) { unsigned u = __builtin_bit_cast(unsigned, f); return (u + 0x7fffu + ((u >> 16) & 1u)) >> 16; }
__device__ __forceinline__ unsigned pk2(float lo, float hi) { return f2bf(lo) | (f2bf(hi) << 16); }

#define XB_TMO      128
#define XB_XCNT(j)  (256  + 64 * (j))
#define XB_XSUB(j)  (1280 + 64 * (j))
#define XB_XGEN(j)  (2304 + 64 * (j))
#define XB_TOP      3328
#define XB_TOPGEN   3392
#define XCD_BAR_WORDS 3456
#define XB_SPIN_CAP (1u << 18)

__device__ __forceinline__ unsigned xb_ld(unsigned* p)              { return __hip_atomic_load(p, __ATOMIC_RELAXED, __HIP_MEMORY_SCOPE_AGENT); }
__device__ __forceinline__ unsigned xb_add(unsigned* p, unsigned v) { return __hip_atomic_fetch_add(p, v, __ATOMIC_RELAXED, __HIP_MEMORY_SCOPE_AGENT); }
__device__ __forceinline__ unsigned xb_xcc_id() { return (unsigned)__builtin_amdgcn_s_getreg((3 << 11) | 20) & 0xFu; }
#define XB_SPIN(cond, bar) do { unsigned _sp = 0; while (cond) { __builtin_amdgcn_s_sleep(1); \
    if ((++_sp & 255u) == 0u) { if (xb_ld(&(bar)[XB_TMO])) break; if (_sp > XB_SPIN_CAP) { atomicAdd(&(bar)[XB_TMO], 1u); break; } } } } while (0)

struct XcdBarrier {
    int wv;
    unsigned* bar; unsigned x;
    volatile LAS unsigned* st;
};

__device__ __forceinline__ XcdBarrier xcd_barrier_post(unsigned* bar, volatile LAS unsigned* st, int wv) {
    XcdBarrier b; b.bar = bar; b.x = xb_xcc_id(); b.st = st; b.wv = wv;
    if (wv == 0 && lane_now() == 0) (void)xb_add(&bar[XB_XCNT(b.x)], 1u);
    return b;
}
__device__ __forceinline__ void xcd_barrier_complete(unsigned* bar, unsigned x, unsigned& nloc, unsigned& nx) {
    const unsigned G = gridDim.x * gridDim.y * gridDim.z;
    unsigned sum, cnt, mine, sp = 0u;
    for (;;) {
        sum = 0u; cnt = 0u; mine = 0u;
#pragma unroll
        for (unsigned j = 0; j < 16; ++j) { const unsigned c = xb_ld(&bar[XB_XCNT(j)]); sum += c; cnt += (c > 0u) ? 1u : 0u; mine = (j == x) ? c : mine; }
        if (sum == G) break;
        __builtin_amdgcn_s_sleep(1);
        if ((++sp & 255u) == 0u) { if (xb_ld(&bar[XB_TMO])) break; if (sp > XB_SPIN_CAP) { atomicAdd(&bar[XB_TMO], 1u); break; } }
    }
    nloc = mine > 0u ? mine : 1u; nx = cnt > 0u ? cnt : 1u;
}

__device__ __forceinline__ void xcd_barrier(const XcdBarrier& b) {
    asm volatile("s_waitcnt vmcnt(0)" ::: "memory");
    __syncthreads();
    int wv_ = b.wv; asm volatile("" : "+s"(wv_));
    if (wv_ == 0 && lane_now() == 0) {
        unsigned* bar = b.bar;
        __builtin_amdgcn_s_waitcnt(0);
        unsigned nloc = b.st[0], nx = b.st[1];
        if (nloc == 0u) { xcd_barrier_complete(bar, b.x, nloc, nx); b.st[0] = nloc; b.st[1] = nx; }
        const unsigned old = xb_add(&bar[XB_XSUB(b.x)], 1u);
        const unsigned gen = old / nloc;
        if (old + 1u == (gen + 1u) * nloc) {
            __builtin_amdgcn_fence(__ATOMIC_RELEASE, "agent");
            asm volatile("s_waitcnt vmcnt(0)" ::: "memory");
            const unsigned og = xb_add(&bar[XB_TOP], 1u);
            const unsigned tg = og / nx;
            if (og + 1u == (tg + 1u) * nx) xb_add(&bar[XB_TOPGEN], 1u);
            else XB_SPIN(xb_ld(&bar[XB_TOPGEN]) == tg, bar);
            __builtin_amdgcn_fence(__ATOMIC_ACQUIRE, "agent");
            xb_add(&bar[XB_XGEN(b.x)], 1u);
            asm volatile("s_waitcnt vmcnt(0)" ::: "memory");
        } else {
            XB_SPIN(xb_ld(&bar[XB_XGEN(b.x)]) == gen, bar);
            __builtin_amdgcn_fence(__ATOMIC_ACQUIRE, "agent");
            asm volatile("s_waitcnt vmcnt(0)" ::: "memory");
        }
    }
    __syncthreads();
}
constexpr int NWAVES = 8;
constexpr int BATCH = 8, SEQ = 2048, D = 1024, T = BATCH * SEQ, DEPTH = 4;
constexpr int NH = 8, HD = 64, AW = 512, PW = 256, CW = 256, INC = 2304, CK = 31;
constexpr int FF = 2816, NE = 8, NGU = 2 * FF;
constexpr int MAXSLOT = 2 * T + NE * 256;
constexpr float RMS_EPS = 1e-6f, LN_EPS = 1e-5f;
constexpr float QSCALE = 0.125f * 1.4426950408889634f;
constexpr float W_EXIT = -150.0f;
constexpr int PQ = 0, PK = 512, PV = 1024, PPOOL = 1536, PCV = 1792, PCG = 2048;
enum { I_X = 0, I_ANG, I_WIN, I_POOLW, I_POOLS, I_CONVW, I_CONVB, I_LNG, I_LNB, I_GNG, I_WOUT, I_FNG, I_DWG, I_DWU, I_DWD, I_RW, I_MWG, I_MWU, I_MWD, I_FING, N_IN };

constexpr size_t MiB = 1u << 20;
constexpr size_t WS_CTL = 0, CTL_ZERO_BYTES = 1 * MiB;
constexpr size_t WS_TOKE = 1 * MiB, WS_TOKR = WS_TOKE + 128 * 1024, WS_TOKG = WS_TOKR + 128 * 1024, WS_TOKS = WS_TOKG + 128 * 1024;
constexpr size_t WS_WIN = 4 * MiB;
constexpr size_t WS_WOUT = 22 * MiB;
constexpr size_t WS_WGUD = 30 * MiB;
constexpr size_t WS_WDD = 52 * MiB;
constexpr size_t WS_WGUM = 64 * MiB;
constexpr size_t WS_WDM = 240 * MiB;
constexpr size_t WS_X = 328 * MiB;
constexpr size_t WS_XN = 392 * MiB;
constexpr size_t WS_P = 424 * MiB;
constexpr size_t WS_O = 496 * MiB;
constexpr size_t WS_ACT = 424 * MiB;
constexpr size_t WS_AP = 611 * MiB;
constexpr size_t WS_END = 679 * MiB;
static_assert(WS_WIN + (size_t)4 * INC * D * 2 <= WS_WOUT && WS_WOUT + (size_t)4 * D * D * 2 <= WS_WGUD && WS_WGUD + (size_t)2 * NGU * D * 2 <= WS_WDD && WS_WDD + (size_t)2 * D * FF * 2 <= WS_WGUM, "ws map 1");
static_assert(WS_WGUM + (size_t)16 * NGU * D * 2 <= WS_WDM && WS_WDM + (size_t)16 * D * FF * 2 <= WS_X && WS_X + (size_t)T * D * 4 <= WS_XN && WS_XN + (size_t)T * D * 2 <= WS_P, "ws map 2");
static_assert(WS_P + (size_t)T * INC * 2 <= WS_O && WS_O + (size_t)T * D * 2 <= WS_AP && WS_ACT + (size_t)MAXSLOT * FF * 2 <= WS_AP && WS_AP + (size_t)MAXSLOT * D * 2 <= WS_END, "ws map 3");
constexpr int CW_TMO = 0, CW_CODE = 1;
constexpr int CW_BAR = 4096;
constexpr int CW_MOE = 8192;

constexpr int RING_OFF = 0, RING_BYTES = 131072;
constexpr int LDSCTL_OFF = RING_BYTES, MISC_OFF = LDSCTL_OFF + 320;
constexpr int LDS_BYTES = 147456;
typedef unsigned u32x2 __attribute__((ext_vector_type(2)));
struct Frame {
    LAS unsigned char* lds;
    volatile LAS unsigned* MISC;
    int vcu, G, wave;
};
__device__ __forceinline__ int opaque_int(int n) { asm volatile("" : "+s"(n)); return n; }
#define PHASE_IDS() const int wave = opaque_int(F.wave), vcu = opaque_int(F.vcu), G = opaque_int(F.G), lane = lane_now(), tid = wave * 64 + lane; (void)tid; (void)lane; (void)wave; (void)vcu; (void)G
template <int I> __device__ __forceinline__ const float* inp() { unsigned long long v; asm volatile("s_load_dwordx2 %0, %1, %2\n\ts_waitcnt lgkmcnt(0)" : "=&s"(v) : "s"(__builtin_amdgcn_kernarg_segment_ptr()), "n"(I * 8));
    return (const float*)(const GAS float*)v; }
#define INP(i) inp<(i)>()
#define OUTPTR() ((float*)const_cast<float*>(inp<N_IN>()))
#define WSPTR() ((unsigned char*)const_cast<float*>(inp<N_IN + 1>()))
#define CTLPTR() ((gu32*)WSPTR())
__device__ __forceinline__ float bf2f(bf16 b) { return __uint_as_float((unsigned)b << 16); }
__device__ __forceinline__ float bflo(unsigned w) { return __uint_as_float(w << 16); }
__device__ __forceinline__ float bfhi(unsigned w) { return __uint_as_float(w & 0xffff0000u); }
template <int CTRL> __device__ __forceinline__ float dpp_add(float v) { return v + __builtin_bit_cast(float, __builtin_amdgcn_update_dpp(0, __builtin_bit_cast(int, v), CTRL, 0xf, 0xf, true)); }
__device__ __forceinline__ float wave_sum(float v) {
    v = dpp_add<0xB1>(v); v = dpp_add<0x4E>(v); v = dpp_add<0x141>(v); v = dpp_add<0x140>(v);
    v += __builtin_bit_cast(float, __builtin_amdgcn_ds_swizzle(__builtin_bit_cast(int, v), 0x401F));
    const auto rr = __builtin_amdgcn_permlane32_swap(__float_as_uint(v), __float_as_uint(v), false, false); return __uint_as_float(rr[0]) + __uint_as_float(rr[1]);
}
__device__ __forceinline__ void fail_word(int wave, unsigned code) {
    if (wave == 0 && lane_now() == 0) { gu32* ctl = CTLPTR(); unsigned expect = 0u; __hip_atomic_compare_exchange_strong((unsigned*)(ctl + CW_CODE), &expect, code, __ATOMIC_RELAXED, __ATOMIC_RELAXED, __HIP_MEMORY_SCOPE_AGENT);
        __hip_atomic_store(ctl + CW_TMO, 1u, RLX_AGENT); }
}

__device__ __forceinline__ void transpose_item(const float* W, int K, int N, bf16* WT, int mode, int nscale, int item, int lane) {
    const int nblk = N / 64, kb = item / nblk, nb = item % nblk, k0 = 64 * kb, n0 = 64 * nb, kq = lane >> 4, nq = lane & 15;
    const GAS f32x4* src = (const GAS f32x4*)(W + (size_t)(k0 + 8 * kq) * N + n0 + 4 * nq);
    f32x4 v[16];
#pragma unroll
    for (int i = 0; i < 16; ++i) v[i] = src[(size_t)((i & 7) + 32 * (i >> 3)) * (N / 4)];
    const int r0 = (mode == 0) ? n0 : (256 * (n0 >> 7) + (n0 & 127) + (mode == 2 ? 128 : 0));
    const float sc = (n0 < nscale) ? QSCALE : 1.0f;
#pragma unroll
    for (int j = 0; j < 4; ++j) { GAS v4u* dst = (GAS v4u*)(WT + (size_t)(r0 + 4 * nq + j) * K + k0 + 8 * kq);
#pragma unroll
        for (int hf = 0; hf < 2; ++hf) { v4u o;
            o.x = pk2(v[8 * hf + 0][j] * sc, v[8 * hf + 1][j] * sc); o.y = pk2(v[8 * hf + 2][j] * sc, v[8 * hf + 3][j] * sc);
            o.z = pk2(v[8 * hf + 4][j] * sc, v[8 * hf + 5][j] * sc); o.w = pk2(v[8 * hf + 6][j] * sc, v[8 * hf + 7][j] * sc);
            dst[4 * hf] = o; } }
}
constexpr float WSCALE8 = 64.0f, XSCALE8 = 16.0f, ASCALE8 = 16.0f;
__device__ __forceinline__ float clamp8f(float v) { return fminf(fmaxf(v, -448.0f), 448.0f); }
__device__ __forceinline__ unsigned pack8(float a, float b, float c, float d) { unsigned w = 0u; w = __builtin_amdgcn_cvt_pk_fp8_f32(clamp8f(a), clamp8f(b), w, false); w = __builtin_amdgcn_cvt_pk_fp8_f32(clamp8f(c), clamp8f(d), w, true); return w; }
__device__ __forceinline__ void transpose_item8(const float* W, int K, int N, unsigned char* WT, int mode, int item, int lane) {
    const int nblk = N / 64, kb = item / nblk, nb = item % nblk, k0 = 64 * kb, n0 = 64 * nb, kq = lane >> 4, nq = lane & 15;
    const GAS f32x4* src = (const GAS f32x4*)(W + (size_t)(k0 + 16 * kq) * N + n0 + 4 * nq);
    f32x4 v[16];
#pragma unroll
    for (int i = 0; i < 16; ++i) v[i] = src[(size_t)i * (N / 4)];
    const int r0 = (mode == 0) ? n0 : (256 * (n0 >> 7) + (n0 & 127) + (mode == 2 ? 128 : 0));
#pragma unroll
    for (int j = 0; j < 4; ++j) { v4u o;
        o.x = pack8(v[0][j] * WSCALE8, v[1][j] * WSCALE8, v[2][j] * WSCALE8, v[3][j] * WSCALE8); o.y = pack8(v[4][j] * WSCALE8, v[5][j] * WSCALE8, v[6][j] * WSCALE8, v[7][j] * WSCALE8);
        o.z = pack8(v[8][j] * WSCALE8, v[9][j] * WSCALE8, v[10][j] * WSCALE8, v[11][j] * WSCALE8); o.w = pack8(v[12][j] * WSCALE8, v[13][j] * WSCALE8, v[14][j] * WSCALE8, v[15][j] * WSCALE8);
        *(GAS v4u*)(WT + (size_t)(r0 + 4 * nq + j) * K + k0 + 16 * kq) = o; }
}
__device__ __forceinline__ void p0_weights(Frame& F) {
    PHASE_IDS(); unsigned char* const ws = WSPTR();
    const int gw = vcu * NWAVES + wave, NGW = G * NWAVES;
    constexpr int I_IN = (D / 64) * (INC / 64), I_OUT = (D / 64) * (D / 64), I_GU = (D / 64) * (FF / 64), I_DN = (FF / 64) * (D / 64);
    constexpr int N0 = 4 * I_IN, N1 = N0 + 4 * I_OUT, N2 = N1 + 2 * I_GU, N3 = N2 + 2 * I_GU, N4 = N3 + 2 * I_DN, N5 = N4 + 16 * I_GU, N6 = N5 + 16 * I_GU, N7 = N6 + 16 * I_DN;
    bf16* const win = (bf16*)(ws + WS_WIN); bf16* const wout = (bf16*)(ws + WS_WOUT); bf16* const wgud = (bf16*)(ws + WS_WGUD); bf16* const wdd = (bf16*)(ws + WS_WDD);
    unsigned char* const wgum = ws + WS_WGUM; unsigned char* const wdm = ws + WS_WDM;
#pragma unroll 1
    for (int it = gw; it < N7; it += NGW) {
        if (it < N0) { const int l = it / I_IN, r = it % I_IN; transpose_item(INP(I_WIN) + (size_t)l * D * INC, D, INC, win + (size_t)l * INC * D, 0, 512, r, lane); }
        else if (it < N1) { const int q = it - N0, l = q / I_OUT, r = q % I_OUT; transpose_item(INP(I_WOUT) + (size_t)l * D * D, D, D, wout + (size_t)l * D * D, 0, 0, r, lane); }
        else if (it < N2) { const int q = it - N1, l = q / I_GU, r = q % I_GU; transpose_item(INP(I_DWG) + (size_t)l * D * FF, D, FF, wgud + (size_t)l * NGU * D, 1, 0, r, lane); }
        else if (it < N3) { const int q = it - N2, l = q / I_GU, r = q % I_GU; transpose_item(INP(I_DWU) + (size_t)l * D * FF, D, FF, wgud + (size_t)l * NGU * D, 2, 0, r, lane); }
        else if (it < N4) { const int q = it - N3, l = q / I_DN, r = q % I_DN; transpose_item(INP(I_DWD) + (size_t)l * FF * D, FF, D, wdd + (size_t)l * D * FF, 0, 0, r, lane); }
        else if (it < N5) { const int q = it - N4, l = q / I_GU, r = q % I_GU; transpose_item8(INP(I_MWG) + (size_t)l * D * FF, D, FF, wgum + (size_t)l * NGU * D, 1, r, lane); }
        else if (it < N6) { const int q = it - N5, l = q / I_GU, r = q % I_GU; transpose_item8(INP(I_MWU) + (size_t)l * D * FF, D, FF, wgum + (size_t)l * NGU * D, 2, r, lane); }
        else { const int q = it - N6, l = q / I_DN, r = q % I_DN; transpose_item8(INP(I_MWD) + (size_t)l * FF * D, FF, D, wdm + (size_t)l * D * FF, 0, r, lane); }
    }
}

struct RowArgs { const float* xsrc; float* xws; const float* gain; bf16* xn; float* out; const bf16* yp; const float* wr; gu32* gcur;
                 int* tok_e; int* tok_r; float* tok_g; const int* tok_s; };
template <int MODE>
__device__ __forceinline__ void row_phase(Frame& F, const RowArgs& A) {
    constexpr bool COMBINE = MODE & 1, ROUTER = (MODE & 2) != 0, FINAL = (MODE & 4) != 0, COPYIN = (MODE & 8) != 0;
    LAS int* s_cnt = (LAS int*)(F.lds + RING_OFF);
    LAS int* s_base = s_cnt + 8;
    LAS int* s_e = s_cnt + 16;
    LAS int* s_rk = s_e + 128;
    LAS float* s_g = (LAS float*)(s_rk + 128);
    PHASE_IDS();
    if (ROUTER) { if (tid < 16) s_cnt[tid] = 0; __syncthreads(); }
#pragma unroll 1
    for (int i = 0; i < 8; ++i) {
        const int rl = wave * 8 + i, m = vcu * 64 + rl;
        const GAS f32x4* xr = (const GAS f32x4*)(A.xsrc + (size_t)m * D) + lane;
        f32x4 v[4];
#pragma unroll
        for (int j = 0; j < 4; ++j) v[j] = xr[64 * j];
        if (COMBINE) {
            const int s0 = A.tok_s[2 * m], s1 = A.tok_s[2 * m + 1]; const float g0 = A.tok_g[2 * m], g1 = A.tok_g[2 * m + 1];
            const GAS u32x2* y0 = (const GAS u32x2*)(A.yp + (size_t)s0 * D) + lane; const GAS u32x2* y1 = (const GAS u32x2*)(A.yp + (size_t)s1 * D) + lane;
#pragma unroll
            for (int j = 0; j < 4; ++j) { const u32x2 a = y0[64 * j], b = y1[64 * j];
                v[j].x += g0 * bflo(a.x) + g1 * bflo(b.x); v[j].y += g0 * bfhi(a.x) + g1 * bfhi(b.x); v[j].z += g0 * bflo(a.y) + g1 * bflo(b.y); v[j].w += g0 * bfhi(a.y) + g1 * bfhi(b.y); }
        }
        if ((COMBINE && !FINAL) || COPYIN) { GAS f32x4* xw = (GAS f32x4*)(A.xws + (size_t)m * D) + lane;
#pragma unroll
            for (int j = 0; j < 4; ++j) xw[64 * j] = v[j]; }
        float ss = 0.f;
#pragma unroll
        for (int j = 0; j < 4; ++j) ss += (v[j].x * v[j].x + v[j].y * v[j].y) + (v[j].z * v[j].z + v[j].w * v[j].w);
        const float rstd = 1.0f / sqrtf(wave_sum(ss) * (1.0f / D) + RMS_EPS);
        const GAS f32x4* gr = (const GAS f32x4*)A.gain + lane;
#pragma unroll
        for (int j = 0; j < 4; ++j) v[j] = v[j] * rstd * gr[64 * j];
        if (FINAL) { GAS f32x4* o = (GAS f32x4*)(A.out + (size_t)m * D) + lane;
#pragma unroll
            for (int j = 0; j < 4; ++j) o[64 * j] = v[j]; }
        else { GAS u32x2* o = (GAS u32x2*)(A.xn + (size_t)m * D) + lane;
#pragma unroll
            for (int j = 0; j < 4; ++j) o[64 * j] = (u32x2){pk2(v[j].x, v[j].y), pk2(v[j].z, v[j].w)}; }
        if (ROUTER) {
            float lg[8];
#pragma unroll
            for (int e = 0; e < 8; ++e) lg[e] = 0.f;
#pragma unroll
            for (int j = 0; j < 4; ++j)
#pragma unroll
                for (int q = 0; q < 4; ++q) { const GAS f32x4* w = (const GAS f32x4*)(A.wr + (size_t)(256 * j + 4 * lane + q) * 8); const f32x4 w0 = w[0], w1 = w[1]; const float h = v[j][q];
                    lg[0] += h * w0.x; lg[1] += h * w0.y; lg[2] += h * w0.z; lg[3] += h * w0.w; lg[4] += h * w1.x; lg[5] += h * w1.y; lg[6] += h * w1.z; lg[7] += h * w1.w; }
#pragma unroll
            for (int e = 0; e < 8; ++e) lg[e] = wave_sum(lg[e]);
            int e1 = 0; float v1 = lg[0];
#pragma unroll
            for (int e = 1; e < 8; ++e) if (lg[e] > v1) { v1 = lg[e]; e1 = e; }
            int e2 = -1; float v2 = -INFINITY;
#pragma unroll
            for (int e = 0; e < 8; ++e) if (e != e1 && (e2 < 0 || lg[e] > v2)) { v2 = lg[e]; e2 = e; }
            const float g1 = 1.0f / (1.0f + __expf(v2 - v1)), g2 = 1.0f - g1;
            if (lane == 0) { const int r1 = atomicAdd((int*)(s_cnt + e1), 1), r2 = atomicAdd((int*)(s_cnt + e2), 1);
                s_e[2 * rl] = e1; s_e[2 * rl + 1] = e2; s_rk[2 * rl] = r1; s_rk[2 * rl + 1] = r2; s_g[2 * rl] = g1; s_g[2 * rl + 1] = g2; }
        }
    }
    if (ROUTER) {
        __syncthreads();
        if (tid < 8) s_base[tid] = (int)__hip_atomic_fetch_add(A.gcur + 64 * tid, (unsigned)s_cnt[tid], RLX_AGENT);
        __syncthreads();
        if (tid < 128) { const int m2 = vcu * 128 + tid; const int e = s_e[tid]; A.tok_e[m2] = e; A.tok_r[m2] = s_base[e] + s_rk[tid]; A.tok_g[m2] = s_g[tid]; }
        __syncthreads();
    }
}

__device__ __forceinline__ void load_toff(gu32* gcur, int (&cnt)[8], int (&toff)[9]) {
    toff[0] = 0;
#pragma unroll
    for (int e = 0; e < 8; ++e) { cnt[e] = (int)__builtin_amdgcn_readfirstlane(__hip_atomic_load(gcur + 64 * e, RLX_AGENT)); toff[e + 1] = toff[e] + ((cnt[e] + 255) >> 8); }
}
__device__ __forceinline__ void gather_phase(Frame& F, gu32* gcur, const bf16* xn, unsigned char* ap, const int* tok_e, const int* tok_r, int* tok_s) {
    PHASE_IDS();
    int cnt[8], toff[9]; load_toff(gcur, cnt, toff);
#pragma unroll 1
    for (int i = 0; i < 8; ++i) {
        const int m = vcu * 64 + wave * 8 + i;
        const GAS v4u* src = (const GAS v4u*)(xn + (size_t)m * D) + 2 * lane; const v4u a = src[0], b = src[1];
        v4u o;
        o.x = pack8(bflo(a.x) * XSCALE8, bfhi(a.x) * XSCALE8, bflo(a.y) * XSCALE8, bfhi(a.y) * XSCALE8); o.y = pack8(bflo(a.z) * XSCALE8, bfhi(a.z) * XSCALE8, bflo(a.w) * XSCALE8, bfhi(a.w) * XSCALE8);
        o.z = pack8(bflo(b.x) * XSCALE8, bfhi(b.x) * XSCALE8, bflo(b.y) * XSCALE8, bfhi(b.y) * XSCALE8); o.w = pack8(bflo(b.z) * XSCALE8, bfhi(b.z) * XSCALE8, bflo(b.w) * XSCALE8, bfhi(b.w) * XSCALE8);
#pragma unroll
        for (int k = 0; k < 2; ++k) {
            const int e = tok_e[2 * m + k], r = tok_r[2 * m + k];
            int base = 0;
#pragma unroll
            for (int q = 0; q < 8; ++q) base = (e == q) ? toff[q] : base;
            const int slot = base * 256 + r;
            if (lane == 0) tok_s[2 * m + k] = slot;
            *((GAS v4u*)(ap + (size_t)slot * D) + lane) = o;
        }
    }
    const int gw = vcu * NWAVES + wave, NGW = G * NWAVES;
#pragma unroll
    for (int e = 0; e < 8; ++e) {
        for (int r = toff[e] * 256 + cnt[e] + gw; r < toff[e + 1] * 256; r += NGW) { unsigned z = 0u; asm volatile("" : "+v"(z)); *((GAS v4u*)(ap + (size_t)r * D) + lane) = (v4u){z, z, z, z}; }
    }
}

typedef float f32x16 __attribute__((ext_vector_type(16)));
typedef short s16x4 __attribute__((ext_vector_type(4)));
typedef short v4i16_t __attribute__((ext_vector_type(4)));
typedef float f32x2_t __attribute__((ext_vector_type(2))); typedef __bf16 bf16x2_t __attribute__((ext_vector_type(2)));
__device__ __forceinline__ unsigned cvtpk(float lo, float hi) { f32x2_t v = {lo, hi}; bf16x2_t b = __builtin_convertvector(v, bf16x2_t); return __builtin_bit_cast(unsigned, b); }
__device__ __forceinline__ s16x4 vtr(const LAS unsigned char* p) { return __builtin_bit_cast(s16x4, __builtin_amdgcn_ds_read_tr16_b64_v4i16((LAS v4i16_t*)p)); }
constexpr int ATT_VBYTES = 4096;
constexpr int ATT_HS_OFF = NWAVES * ATT_VBYTES;

template <bool DIAG>
__device__ __forceinline__ void sb_block(const bf16x8 (&kf)[4], const bf16x8 (&qf)[4], const LAS unsigned char* vrd, int qlim, float sel, float& carry, f32x16 (&oacc)[2]) {
    f32x16 st;
#pragma unroll
    for (int r = 0; r < 16; ++r) st[r] = 0.f;
#pragma unroll
    for (int ds = 0; ds < 4; ++ds) st = __builtin_amdgcn_mfma_f32_32x32x16_bf16(kf[ds], qf[ds], st, 0, 0, 0);
    float inc[16];
#pragma unroll
    for (int r = 0; r < 16; ++r) { const float z = st[r];
        float l = -(fmaxf(z, 0.f) + __builtin_amdgcn_logf(1.0f + __builtin_amdgcn_exp2f(-fabsf(z))));
        if (DIAG) l = ((r & 3) + 8 * (r >> 2) < qlim) ? l : 0.f;
        inc[r] = l; }
    float T[4], Ghi[4];
#pragma unroll
    for (int g = 0; g < 4; ++g) { inc[4 * g + 2] += inc[4 * g + 3]; inc[4 * g + 1] += inc[4 * g + 2]; inc[4 * g] += inc[4 * g + 1];
        const auto rr = __builtin_amdgcn_permlane32_swap(__float_as_uint(inc[4 * g]), __float_as_uint(inc[4 * g]), false, false);
        Ghi[g] = __uint_as_float(rr[1]); T[g] = __uint_as_float(rr[0]) + Ghi[g]; }
    float U[4]; U[3] = carry; U[2] = U[3] + T[3]; U[1] = U[2] + T[2]; U[0] = U[1] + T[1]; carry = U[0] + T[0];
    unsigned pk[8];
#pragma unroll
    for (int g = 0; g < 4; ++g) { const float base = fmaf(Ghi[g], sel, U[g]); float w[4];
#pragma unroll
        for (int i = 0; i < 4; ++i) { const int r = 4 * g + i; w[i] = __builtin_amdgcn_exp2f(st[r] + (inc[r] + base));
            if (DIAG) w[i] = ((r & 3) + 8 * (r >> 2) < qlim) ? w[i] : 0.f; }
        pk[2 * g] = cvtpk(w[0], w[1]); pk[2 * g + 1] = cvtpk(w[2], w[3]); }
    const bf16x8 pw0 = __builtin_bit_cast(bf16x8, (v4u){pk[0], pk[1], pk[2], pk[3]}), pw1 = __builtin_bit_cast(bf16x8, (v4u){pk[4], pk[5], pk[6], pk[7]});
#pragma unroll
    for (int c = 0; c < 2; ++c) {
        const s16x4 a0 = vtr(vrd + c * 2048), a1 = vtr(vrd + c * 2048 + 512), b0 = vtr(vrd + c * 2048 + 1024), b1 = vtr(vrd + c * 2048 + 1536);
        const bf16x8 v0 = (bf16x8){a0[0], a0[1], a0[2], a0[3], a1[0], a1[1], a1[2], a1[3]}, v1 = (bf16x8){b0[0], b0[1], b0[2], b0[3], b1[0], b1[1], b1[2], b1[3]};
        oacc[c] = __builtin_amdgcn_mfma_f32_32x32x16_bf16(v0, pw0, oacc[c], 0, 0, 0);
        oacc[c] = __builtin_amdgcn_mfma_f32_32x32x16_bf16(v1, pw1, oacc[c], 0, 0, 0); }
}

constexpr int MX_HS_OFF = NWAVES * ATT_VBYTES, MX_PS_OFF = MX_HS_OFF + 1024, MX_U_OFF = MX_PS_OFF + 1024;
static_assert(MX_U_OFF + 62 * 256 * 4 <= RING_BYTES, "mixer LDS map");
struct PcArgs { const bf16* P; bf16* O; const float* poolw; const float* pools; const float* convw; const float* convb; const float* lng; const float* lnb; const float* gng; };
__device__ __forceinline__ float sigm_mul(float val, float gate) { return val * __builtin_amdgcn_rcpf(1.0f + __builtin_amdgcn_exp2f(gate * -1.4426950408889634f)); }
__device__ __forceinline__ void mixer_phase(Frame& F, const PcArgs& A) {
    PHASE_IDS();
    const bf16* const P = A.P; bf16* const O = A.O;
    const int qi = lane & 31, hh = lane >> 5, h = wave;
    LAS unsigned char* const vimg = F.lds + RING_OFF + wave * ATT_VBYTES;
    LAS float* const hs = (LAS float*)(F.lds + RING_OFF + MX_HS_OFF);
    LAS float* const ps = (LAS float*)(F.lds + RING_OFF + MX_PS_OFF);
    LAS float* const ubuf = (LAS float*)(F.lds + RING_OFF + MX_U_OFF);
    const int vkey = lane >> 3, vch = lane & 7;
    LAS unsigned char* const vwr = vimg + (vch >> 2) * 2048 + vkey * 64 + (vch & 3) * 16;
    const LAS unsigned char* const vrd = vimg + (4 * hh + ((lane & 15) >> 2)) * 64 + ((lane >> 4) & 1) * 32 + (lane & 3) * 8;
    const float sel = hh ? 0.f : 1.f; const int qlim = qi - 4 * hh;
    const int pg = wave & 3, pdt = wave >> 2, pwin = 2 << pg;
    bf16x8 wpf[4];
    { const float* wp = A.poolw + (size_t)pg * 64 * 64 + 32 * pdt + qi; const float psc = A.pools[pg * 64 + 32 * pdt + qi];
#pragma unroll
      for (int ks = 0; ks < 4; ++ks) { float w[8];
#pragma unroll
          for (int j = 0; j < 8; ++j) w[j] = wp[(size_t)(16 * ks + 8 * hh + j) * 64] * psc;
          wpf[ks] = __builtin_bit_cast(bf16x8, (v4u){cvtpk(w[0], w[1]), cvtpk(w[2], w[3]), cvtpk(w[4], w[5]), cvtpk(w[6], w[7])}); } }
    for (int u = vcu; u < T / 32; u += G) {
        const int r0 = u * 32, s0 = r0 % SEQ;
        bf16x8 qf[4], kf[4], kn[4]; v4u vr[4], vn[4];
        const bf16* qp = P + (size_t)(r0 + qi) * INC + PQ + h * 64 + 8 * hh;
#pragma unroll
        for (int ds = 0; ds < 4; ++ds) qf[ds] = *(const bf16x8*)(qp + 16 * ds);
        const bf16* kp = P + (size_t)(r0 + qi) * INC + PK + h * 64 + 8 * hh;
        const bf16* vp = P + (size_t)(r0 + vkey) * INC + PV + h * 64 + 8 * vch;
#pragma unroll
        for (int ds = 0; ds < 4; ++ds) kf[ds] = *(const bf16x8*)(kp + 16 * ds);
#pragma unroll
        for (int i = 0; i < 4; ++i) vr[i] = *(const v4u*)(vp + (size_t)(8 * i) * INC);
        f32x16 oacc[2];
#pragma unroll
        for (int r = 0; r < 16; ++r) { oacc[0][r] = 0.f; oacc[1][r] = 0.f; }
        float carry = 0.f;
        for (int kb = s0; ; kb -= 32) {
#pragma unroll
            for (int i = 0; i < 4; ++i) *(LAS v4u*)(vwr + i * 512) = vr[i];
            if (kb > 0) { kp -= (size_t)32 * INC; vp -= (size_t)32 * INC;
#pragma unroll
                for (int ds = 0; ds < 4; ++ds) kn[ds] = *(const bf16x8*)(kp + 16 * ds);
#pragma unroll
                for (int i = 0; i < 4; ++i) vn[i] = *(const v4u*)(vp + (size_t)(8 * i) * INC); }
            if (kb == s0) sb_block<true>(kf, qf, vrd, qlim, sel, carry, oacc); else sb_block<false>(kf, qf, vrd, qlim, sel, carry, oacc);
            if (kb == 0 || __builtin_amdgcn_ballot_w64(carry >= W_EXIT) == 0ull) break;
#pragma unroll
            for (int ds = 0; ds < 4; ++ds) kf[ds] = kn[ds];
#pragma unroll
            for (int i = 0; i < 4; ++i) vr[i] = vn[i];
        }
        { float ss = 0.f;
#pragma unroll
          for (int r = 0; r < 16; ++r) ss += oacc[0][r] * oacc[0][r] + oacc[1][r] * oacc[1][r];
          const auto rr = __builtin_amdgcn_permlane32_swap(__float_as_uint(ss), __float_as_uint(ss), false, false); ss = __uint_as_float(rr[0]) + __uint_as_float(rr[1]);
          if (hh == 0) hs[wave * 32 + qi] = ss; }
        f32x16 pacc;
#pragma unroll
        for (int r = 0; r < 16; ++r) pacc[r] = 0.f;
        { const int s = s0 + qi; const int cnt = (s + 1 < pwin) ? s + 1 : pwin; const float rc = 1.0f / (float)cnt;
          const bf16* up = P + (size_t)(r0 + qi) * INC + PPOOL + pg * 64 + 8 * hh;
#pragma unroll
          for (int ks = 0; ks < 4; ++ks) { float sum[8], self[8];
              { const v4u x = *(const v4u*)(up + 16 * ks); self[0] = bflo(x.x); self[1] = bfhi(x.x); self[2] = bflo(x.y); self[3] = bfhi(x.y); self[4] = bflo(x.z); self[5] = bfhi(x.z); self[6] = bflo(x.w); self[7] = bfhi(x.w); }
#pragma unroll
              for (int j = 0; j < 8; ++j) sum[j] = self[j];
              for (int i = 1; i < pwin; ++i) if (i < cnt) { const v4u x = *(const v4u*)(up + 16 * ks - (size_t)i * INC);
                  sum[0] += bflo(x.x); sum[1] += bfhi(x.x); sum[2] += bflo(x.y); sum[3] += bfhi(x.y); sum[4] += bflo(x.z); sum[5] += bfhi(x.z); sum[6] += bflo(x.w); sum[7] += bfhi(x.w); }
#pragma unroll
              for (int j = 0; j < 8; ++j) sum[j] = sum[j] * rc - self[j];
              const bf16x8 yf = __builtin_bit_cast(bf16x8, (v4u){cvtpk(sum[0], sum[1]), cvtpk(sum[2], sum[3]), cvtpk(sum[4], sum[5]), cvtpk(sum[6], sum[7])});
              pacc = __builtin_amdgcn_mfma_f32_32x32x16_bf16(wpf[ks], yf, pacc, 0, 0, 0); } }
        { float ss = 0.f;
#pragma unroll
          for (int r = 0; r < 16; ++r) ss += pacc[r] * pacc[r];
          const auto rr = __builtin_amdgcn_permlane32_swap(__float_as_uint(ss), __float_as_uint(ss), false, false); ss = __uint_as_float(rr[0]) + __uint_as_float(rr[1]);
          if (hh == 0) ps[wave * 32 + qi] = ss; }
#pragma unroll
        for (int i = 0; i < 4; ++i) { const int idx = tid + 512 * i;
            if (idx < 62 * 32) { const int rr = idx >> 5, c8 = idx & 31; f32x4 u0 = {0.f, 0.f, 0.f, 0.f}, u1 = {0.f, 0.f, 0.f, 0.f};
                if (s0 - 30 + rr >= 0) { const bf16* rp = P + (size_t)(r0 - 30 + rr) * INC + 8 * c8; const v4u a = *(const v4u*)(rp + PCV), b = *(const v4u*)(rp + PCG);
                    u0 = (f32x4){sigm_mul(bflo(a.x), bflo(b.x)), sigm_mul(bfhi(a.x), bfhi(b.x)), sigm_mul(bflo(a.y), bflo(b.y)), sigm_mul(bfhi(a.y), bfhi(b.y))};
                    u1 = (f32x4){sigm_mul(bflo(a.z), bflo(b.z)), sigm_mul(bfhi(a.z), bfhi(b.z)), sigm_mul(bflo(a.w), bflo(b.w)), sigm_mul(bfhi(a.w), bfhi(b.w))}; }
                *(LAS f32x4*)(ubuf + rr * 256 + 8 * c8) = u0; *(LAS f32x4*)(ubuf + rr * 256 + 8 * c8 + 4) = u1; } }
        __syncthreads();
        { float tot = 0.f;
#pragma unroll
          for (int w = 0; w < 8; ++w) tot += hs[w * 32 + qi];
          const float rstd = 1.0f / sqrtf(tot * (1.0f / AW) + RMS_EPS);
          bf16* op = O + (size_t)(r0 + qi) * D + h * 64 + 4 * hh; const float* gp = A.gng + h * 64 + 4 * hh;
#pragma unroll
          for (int c = 0; c < 2; ++c)
#pragma unroll
              for (int g = 0; g < 4; ++g) { const f32x4 gv = *(const f32x4*)(gp + 32 * c + 8 * g);
                  *(u32x2*)(op + 32 * c + 8 * g) = (u32x2){cvtpk(oacc[c][4 * g] * rstd * gv.x, oacc[c][4 * g + 1] * rstd * gv.y), cvtpk(oacc[c][4 * g + 2] * rstd * gv.z, oacc[c][4 * g + 3] * rstd * gv.w)}; } }
        { float tot = 0.f;
#pragma unroll
          for (int w = 0; w < 8; ++w) tot += ps[w * 32 + qi];
          const float rstd = 1.0f / sqrtf(tot * (1.0f / PW) + RMS_EPS);
          bf16* op = O + (size_t)(r0 + qi) * D + AW + pg * 64 + 32 * pdt + 4 * hh; const float* gp = A.gng + AW + pg * 64 + 32 * pdt + 4 * hh;
#pragma unroll
          for (int g = 0; g < 4; ++g) { const f32x4 gv = *(const f32x4*)(gp + 8 * g);
              *(u32x2*)(op + 8 * g) = (u32x2){cvtpk(pacc[4 * g] * rstd * gv.x, pacc[4 * g + 1] * rstd * gv.y), cvtpk(pacc[4 * g + 2] * rstd * gv.z, pacc[4 * g + 3] * rstd * gv.w)}; } }
        { f32x4 acc[4]; const f32x4 cb = *(const f32x4*)(A.convb + 4 * lane);
#pragma unroll
          for (int tk = 0; tk < 4; ++tk) acc[tk] = cb;
#pragma unroll 1
          for (int j = 0; j < CK; ++j) { const f32x4 w4 = *(const f32x4*)(A.convw + (size_t)j * CW + 4 * lane);
#pragma unroll
              for (int tk = 0; tk < 4; ++tk) { const f32x4 u4 = *(const LAS f32x4*)(ubuf + (4 * wave + tk + j) * 256 + 4 * lane); acc[tk] += w4 * u4; } }
          const f32x4 lg = *(const f32x4*)(A.lng + 4 * lane), lb = *(const f32x4*)(A.lnb + 4 * lane), gc = *(const f32x4*)(A.gng + AW + PW + 4 * lane);
#pragma unroll
          for (int tk = 0; tk < 4; ++tk) { const int tl = 4 * wave + tk; f32x4 v = acc[tk];
              const float mean = wave_sum((v.x + v.y) + (v.z + v.w)) * (1.0f / CW); v = v - mean;
              const float var = wave_sum((v.x * v.x + v.y * v.y) + (v.z * v.z + v.w * v.w)) * (1.0f / CW); const float rs = 1.0f / sqrtf(var + LN_EPS);
              v = v * rs * lg + lb;
              v.x = sigm_mul(v.x, v.x); v.y = sigm_mul(v.y, v.y); v.z = sigm_mul(v.z, v.z); v.w = sigm_mul(v.w, v.w);
              const float ss = wave_sum((v.x * v.x + v.y * v.y) + (v.z * v.z + v.w * v.w)); const float rstd = 1.0f / sqrtf(ss * (1.0f / CW) + RMS_EPS);
              *(u32x2*)(O + (size_t)(r0 + tl) * D + AW + PW + 4 * lane) = (u32x2){pk2(v.x * rstd * gc.x, v.y * rstd * gc.y), pk2(v.z * rstd * gc.z, v.w * rstd * gc.w)}; } }
        __syncthreads();
    }
}
constexpr int NPH = 1 + 8 * DEPTH;
struct Args { const float* in[N_IN]; float* out; unsigned char* ws; int ph_lo, ph_hi; };
__global__ void __launch_bounds__(NWAVES * 64, 2) fwd(Args args) {
    extern __shared__ __attribute__((aligned(16))) unsigned char lds[];
    Frame F;
    F.lds = (LAS unsigned char*)lds;
    F.MISC = (volatile LAS unsigned*)(F.lds + MISC_OFF);
    F.wave = __builtin_amdgcn_readfirstlane((int)(threadIdx.x >> 6));
    F.G = gridDim.x; { const int bx = blockIdx.x; F.vcu = (F.G % 8 == 0) ? (bx % 8) * (F.G / 8) + bx / 8 : bx; }
    for (int u = F.wave * 64 + lane_now(); u < (LDS_BYTES - LDSCTL_OFF) / 4; u += NWAVES * 64) ((LAS unsigned*)(F.lds + LDSCTL_OFF))[u] = 0u;
    __syncthreads();
    XcdBarrier bar; bar.bar = (unsigned*)(CTLPTR() + CW_BAR); bar.x = 0; bar.st = nullptr; bar.wv = F.wave;
    bar = xcd_barrier_post((unsigned*)(CTLPTR() + CW_BAR), F.MISC + 8, F.wave);
#ifndef REP_PRO
#define REP_PRO 1
#endif
#ifndef REP_INP
#define REP_INP 1
#endif
#ifndef REP_ATT
#define REP_ATT 1
#endif
#ifndef REP_PC
#define REP_PC 1
#endif
#ifndef REP_MGU
#define REP_MGU 1
#endif
#ifndef REP_MDN
#define REP_MDN 1
#endif
#ifndef REP_DGU
#define REP_DGU 1
#endif
#ifndef REP_NRM
#define REP_NRM 1
#endif
#ifndef REP_BAR
#define REP_BAR 1
#endif
#ifndef REP_ROW8
#define REP_ROW8 1
#endif
#ifndef REP_GAT
#define REP_GAT 1
#endif
#ifndef REP_FIN
#define REP_FIN 1
#endif
#define REPEAT(n) for (int rep_ = 0, nrep_ = opaque_int(n); rep_ < nrep_; ++rep_)
#define IN(k) true
#define SEAM(k) do { if ((k) + 1 < NPH) { REPEAT(REP_BAR) xcd_barrier(bar); } } while (0)
#define X ((float*)(ws + WS_X))
#define XN ((bf16*)(ws + WS_XN))
#define P ((bf16*)(ws + WS_P))
#define O ((bf16*)(ws + WS_O))
#define ACT ((bf16*)(ws + WS_ACT))
#define AP ((bf16*)(ws + WS_AP))
#define TOK_E ((int*)(ws + WS_TOKE))
#define TOK_R ((int*)(ws + WS_TOKR))
#define TOK_G ((float*)(ws + WS_TOKG))
#define TOK_S ((int*)(ws + WS_TOKS))
    if (F.G != 256) { fail_word(F.wave, 0x7f0u); return; }

    if (IN(0)) {
        unsigned char* const ws = WSPTR();
        REPEAT(REP_PRO) p0_weights(F);
        RowArgs A{}; A.xsrc = INP(I_X); A.xws = X; A.gain = INP(I_ANG); A.xn = XN;
        REPEAT(REP_ROW8) row_phase<8>(F, A);
        SEAM(0);
    }
#pragma unroll 1
    for (int l = 0; l < DEPTH; ++l) {
        const int pb = 1 + 8 * l, li = l >> 1; const bool moe = (l & 1) != 0;
        if (IN(pb + 0)) {
            unsigned char* const ws = WSPTR();
            pg8::Gemm g{XN, (const bf16*)(ws + WS_WIN) + (size_t)l * INC * D, T, INC, D, 0}; pg8::StaticOrder S; S.init(T, INC, opaque_int(F.G), opaque_int((int)blockIdx.x));
            pg8::EpiBf16<0> E{P, INC, nullptr, 0, 0, 1.f};
            REPEAT(REP_INP) pg8::gemm_phase<pg8::EpiBf16<0>, pg8::StaticOrder, true, true>(F.lds + RING_OFF, g, S, E, opaque_int(F.wave));
            SEAM(pb + 0);
        }
        if (IN(pb + 1)) {
            unsigned char* const ws = WSPTR();
            PcArgs A{P, O, INP(I_POOLW) + (size_t)l * 4 * 64 * 64, INP(I_POOLS) + (size_t)l * PW, INP(I_CONVW) + (size_t)l * CK * CW, INP(I_CONVB) + (size_t)l * CW,
                     INP(I_LNG) + (size_t)l * CW, INP(I_LNB) + (size_t)l * CW, INP(I_GNG) + (size_t)l * D};
            REPEAT(REP_ATT) mixer_phase(F, A);
            SEAM(pb + 1);
        }
        if (IN(pb + 2)) {
            unsigned char* const ws = WSPTR();
            pg8::Gemm g{O, (const bf16*)(ws + WS_WOUT) + (size_t)l * D * D, T, D, D, 0}; pg8::StaticOrder S; S.init(T, D, opaque_int(F.G), opaque_int((int)blockIdx.x));
            pg8::EpiResid E{X, D};
            pg8::gemm_phase<pg8::EpiResid, pg8::StaticOrder, true, true>(F.lds + RING_OFF, g, S, E, opaque_int(F.wave));
            SEAM(pb + 2);
        }
        if (IN(pb + 3)) {
            unsigned char* const ws = WSPTR();
            RowArgs A{}; A.xsrc = X; A.xws = X; A.gain = INP(I_FNG) + (size_t)l * D; A.xn = XN;
            if (moe) { A.wr = INP(I_RW) + (size_t)li * D * NE; A.gcur = CTLPTR() + CW_MOE + li * 1024; A.tok_e = TOK_E; A.tok_r = TOK_R; A.tok_g = TOK_G; row_phase<2>(F, A); }
            else REPEAT(REP_NRM) row_phase<0>(F, A);
            SEAM(pb + 3);
        }
        if (moe) {
            if (IN(pb + 4)) { unsigned char* const ws = WSPTR(); gu32* const gcur = CTLPTR() + CW_MOE + li * 1024; REPEAT(REP_GAT) gather_phase(F, gcur, XN, (unsigned char*)AP, TOK_E, TOK_R, TOK_S); SEAM(pb + 4); }
            if (IN(pb + 5)) {
                unsigned char* const ws = WSPTR(); gu32* const gcur = CTLPTR() + CW_MOE + li * 1024;
                int cnt[8], toff[9]; load_toff(gcur, cnt, toff);
                pg8::Gemm g{AP, (const bf16*)(ws + WS_WGUM + (size_t)li * NE * NGU * D), 0, NGU, D / 2, (size_t)NGU * D}; pg8::GroupedOrder S; S.init(toff, NGU, opaque_int(F.G), opaque_int((int)blockIdx.x));
                pg8::EpiSwiGLU8 E{(unsigned char*)ACT, FF, 1.0f / (WSCALE8 * XSCALE8), ASCALE8};
                REPEAT(REP_MGU) pg8::gemm_phase<pg8::EpiSwiGLU8, pg8::GroupedOrder, true, true, true>(F.lds + RING_OFF, g, S, E, opaque_int(F.wave));
                SEAM(pb + 5);
            }
            if (IN(pb + 6)) {
                unsigned char* const ws = WSPTR(); gu32* const gcur = CTLPTR() + CW_MOE + li * 1024;
                int cnt[8], toff[9]; load_toff(gcur, cnt, toff);
                pg8::Gemm g{ACT, (const bf16*)(ws + WS_WDM + (size_t)li * NE * D * FF), 0, D, FF / 2, (size_t)D * FF}; pg8::GroupedOrder S; S.init(toff, D, opaque_int(F.G), opaque_int((int)blockIdx.x));
                pg8::EpiBf16S E{AP, D, 1.0f / (WSCALE8 * ASCALE8)};
                REPEAT(REP_MDN) pg8::gemm_phase<pg8::EpiBf16S, pg8::GroupedOrder, true, true, true>(F.lds + RING_OFF, g, S, E, opaque_int(F.wave));
                SEAM(pb + 6);
            }
        } else {
            if (IN(pb + 5)) {
                unsigned char* const ws = WSPTR();
                pg8::Gemm g{XN, (const bf16*)(ws + WS_WGUD) + (size_t)li * NGU * D, T, NGU, D, 0}; pg8::StaticOrder S; S.init(T, NGU, opaque_int(F.G), opaque_int((int)blockIdx.x));
                pg8::EpiSwiGLU E{ACT, FF};
                REPEAT(REP_DGU) pg8::gemm_phase<pg8::EpiSwiGLU, pg8::StaticOrder, true, true>(F.lds + RING_OFF, g, S, E, opaque_int(F.wave));
                SEAM(pb + 5);
            }
            if (IN(pb + 6)) {
                unsigned char* const ws = WSPTR();
                pg8::Gemm g{ACT, (const bf16*)(ws + WS_WDD) + (size_t)li * D * FF, T, D, FF, 0}; pg8::StaticOrder S; S.init(T, D, opaque_int(F.G), opaque_int((int)blockIdx.x));
                pg8::EpiResid E{X, D};
                pg8::gemm_phase<pg8::EpiResid, pg8::StaticOrder, true, true>(F.lds + RING_OFF, g, S, E, opaque_int(F.wave));
                SEAM(pb + 6);
            }
        }
        if (IN(pb + 7)) {
            unsigned char* const ws = WSPTR();
            RowArgs A{}; A.xsrc = X; A.xws = X; A.xn = XN; A.out = OUTPTR(); A.yp = AP; A.tok_g = TOK_G; A.tok_s = TOK_S;
            A.gain = (l == DEPTH - 1) ? INP(I_FING) : INP(I_ANG) + (size_t)(l + 1) * D;
            if (l == DEPTH - 1) REPEAT(REP_FIN) row_phase<5>(F, A);
            else if (moe) row_phase<1>(F, A);
            else row_phase<0>(F, A);
            SEAM(pb + 7);
        }
    }
#undef IN
#undef SEAM
#undef X
#undef XN
#undef P
#undef O
#undef ACT
#undef AP
#undef TOK_E
#undef TOK_R
#undef TOK_G
#undef TOK_S
}

#ifndef MK_ONE_LAUNCH
#define MK_ONE_LAUNCH 0
#endif
extern "C" void kernel_launch(void* const* d_in, const int* in_sizes, int n_in, void* d_out, int out_size, void* d_ws, size_t ws_size, hipStream_t stream) {
    static int grid = 0;
    if (grid == 0) {
        if (n_in != N_IN || in_sizes[0] != T * D || out_size != T * D || ws_size < WS_END) { fprintf(stderr, "kernel_launch: unexpected problem shape (n_in %d, in0 %d, out %d, ws %zu); nothing launched\n", n_in, n_in > 0 ? in_sizes[0] : -1, out_size, ws_size); grid = -1; return; }
        if (hipFuncSetAttribute((const void*)fwd, hipFuncAttributeMaxDynamicSharedMemorySize, LDS_BYTES) != hipSuccess) { fprintf(stderr, "kernel_launch: hipFuncSetAttribute failed; nothing launched\n"); grid = -1; return; }
        int per_cu = 0;
        if (hipOccupancyMaxActiveBlocksPerMultiprocessor(&per_cu, (const void*)fwd, NWAVES * 64, LDS_BYTES) != hipSuccess || per_cu < 1)
            fprintf(stderr, "kernel_launch: note: occupancy query reports %d workgroups per CU\n", per_cu);
        (void)hipGetLastError();
        grid = 256;
    }
    if (grid < 0) return;
    if (hipMemsetAsync((char*)d_ws + WS_CTL, 0, CTL_ZERO_BYTES, stream) != hipSuccess) { fprintf(stderr, "kernel_launch: hipMemsetAsync failed; nothing launched\n"); return; }
    Args a{};
    for (int i = 0; i < N_IN; ++i) a.in[i] = (const float*)d_in[i];
    a.out = (float*)d_out; a.ws = (unsigned char*)d_ws;
    a.ph_lo = 0; a.ph_hi = NPH;
    hipLaunchKernelGGL(fwd, dim3(grid), dim3(NWAVES * 64), LDS_BYTES, stream, a);
    const hipError_t le = hipPeekAtLastError();
    if (le != hipSuccess) fprintf(stderr, "kernel_launch: launch failed: %s\n", hipGetErrorName(le));
}
```

```cpp
#include <hip/hip_runtime.h>
#include <cstdio>
#include <cstdint>
#include <cmath>
#define MK_ONE_LAUNCH 1
__device__ __forceinline__ int lane_now() { int l; asm volatile("v_mbcnt_lo_u32_b32 %0, -1, 0\n\tv_mbcnt_hi_u32_b32 %0, -1, %0" : "=v"(l)); return l; }
namespace pg8 {
#define PG8_LAS __attribute__((address_space(3)))
typedef unsigned short bf16_t;
typedef short bf16x8 __attribute__((ext_vector_type(8)));
typedef float f32x4 __attribute__((ext_vector_type(4)));
typedef unsigned u32x4 __attribute__((ext_vector_type(4)));
constexpr int BM = 256, BK = 64, HALF = 128, HTB = HALF * BK * 2  , STAGE_BYTES = 8 * HTB, NXCD = 8, WGM = 8;

__host__ __device__ __forceinline__ int lds_byte(int r, int c) { const int st = (r >> 4) * 2 + (c >> 5), rr = r & 15, cc = c & 31, ob = rr * 64 + cc * 2; return st * 1024 + (ob ^ (((ob >> 9) & 1) << 5)); }
__host__ __device__ __forceinline__ void stage_rc(int b, int& R, int& C) { const int st = b / 1024, sb = b % 1024, swz = sb ^ (((sb >> 9) & 1) << 5); R = (st >> 1) * 16 + swz / 64; C = (st & 1) * 32 + (swz % 64) / 2; }
__host__ __device__ __forceinline__ int perm32(int rho) { const int n = rho >> 4, i = rho & 15; return 8 * (i >> 2) + 4 * n + (i & 3); }

struct Unit { int pm, pn, e; };
struct Gemm { const bf16_t* A; const bf16_t* Bt; int M, N, K; size_t estride; };

struct StaticOrder {
    int nM, nN, nwg, G, c;
    __host__ __device__ void init(int M, int N, int G_, int c_) { nM = M / BM; nN = N / BM; nwg = nM * nN; G = G_; c = c_; }
    __host__ __device__ bool next(int i, Unit& u) const {
        const long L = (long)i * G + c; if (L >= nwg) return false;
        int wgid = (int)L; { const int q = nwg / NXCD, r = nwg % NXCD, xcd = wgid % NXCD, off = wgid / NXCD; wgid = (xcd < r ? xcd * (q + 1) : r * (q + 1) + (xcd - r) * q) + off; }
        const int nig = WGM * nN, gid = wgid / nig, fm = gid * WGM, gsz = (nM - fm) < WGM ? (nM - fm) : WGM;
        u.pm = fm + ((wgid % nig) % gsz); u.pn = (wgid % nig) / gsz; u.e = 0; return true;
    }
    __device__ __forceinline__ void a_ready(const Unit&) const {}
    __device__ __forceinline__ void done(const Unit&) const {}
};

__device__ __forceinline__ unsigned cvt_pk_bf16(float lo, float hi) { unsigned r; asm volatile("v_cvt_pk_bf16_f32 %0, %1, %2" : "=v"(r) : "v"(lo), "v"(hi)); return r; }
typedef float f32x2 __attribute__((ext_vector_type(2)));
__device__ __forceinline__ f32x2 gelu_pk(f32x2 v) {
    const f32x2 av = __builtin_elementwise_abs(v), d = av * 0.2316418882f + 1.0f;
    f32x2 t; t.x = __builtin_amdgcn_rcpf(d.x); t.y = __builtin_amdgcn_rcpf(d.y);
    f32x2 q = t * 0.5307027145f + (-0.7265760135f); q = q * t + 0.7107068705f; q = q * t + (-0.142248368f); q = q * t + 0.127414796f; q = q * t;
    const f32x2 s = (v * v) * (-0.72134752044f);
    f32x2 e; e.x = __builtin_amdgcn_exp2f(s.x); e.y = __builtin_amdgcn_exp2f(s.y);
    const f32x2 m = v * (q * e), r = v - m;
    f32x2 o; o.x = v.x < 0.f ? m.x : r.x; o.y = v.y < 0.f ? m.y : r.y; return o;
}

template <int ACT  > struct EpiBf16 {
    static constexpr bool PERM = true, AFTER_DRAIN = false; static_assert(ACT == 0 || ACT == 1, "EpiBf16: ACT is 0 (none) or 1 (gelu_pk)");
    bf16_t* O; int ldc; const float* bias; int split_cols; size_t split_stride; float scale0;
    __device__ __forceinline__ void operator()(const f32x4 (&acc)[2][2][4][2], const Unit& u, int wr, int wc, int fr, int fq) const {
        const int row0 = u.pm * BM + wr * 64 + fr; int colt = u.pn * BM; bf16_t* base = O;
        float sc = 1.f; if (split_cols) { const int t = colt / split_cols; base += (size_t)t * split_stride; colt -= t * split_cols; if (t == 0) sc = scale0; }
        const int col0 = colt + wc * 32 + 8 * fq, bcol0 = u.pn * BM + wc * 32 + 8 * fq;
        f32x4 bv[2][2];
#pragma unroll
        for (int bj = 0; bj < 2; ++bj)
#pragma unroll
            for (int n = 0; n < 2; ++n) bv[bj][n] = bias ? *(const f32x4*)(bias + bcol0 + bj * HALF + 4 * n) : (f32x4){0.f, 0.f, 0.f, 0.f};
#pragma unroll
        for (int ai = 0; ai < 2; ++ai)
#pragma unroll
            for (int m = 0; m < 4; ++m) { bf16_t* rowp = base + (size_t)(row0 + ai * HALF + m * 16) * ldc + col0;
#pragma unroll
                for (int bj = 0; bj < 2; ++bj) { f32x4 v0 = acc[ai][bj][m][0] + bv[bj][0], v1 = acc[ai][bj][m][1] + bv[bj][1];
                    if (ACT == 1) { f32x2 a = gelu_pk((f32x2){v0[0], v0[1]}), b = gelu_pk((f32x2){v0[2], v0[3]}), c = gelu_pk((f32x2){v1[0], v1[1]}), d = gelu_pk((f32x2){v1[2], v1[3]});
                        v0 = (f32x4){a.x, a.y, b.x, b.y}; v1 = (f32x4){c.x, c.y, d.x, d.y}; }
                    v0 = v0 * sc; v1 = v1 * sc; u32x4 w; w.x = cvt_pk_bf16(v0[0], v0[1]); w.y = cvt_pk_bf16(v0[2], v0[3]); w.z = cvt_pk_bf16(v1[0], v1[1]); w.w = cvt_pk_bf16(v1[2], v1[3]);
                    *(u32x4*)(rowp + bj * HALF) = w; } }
    }
};
struct EpiResid {
    static constexpr bool PERM = true, AFTER_DRAIN = false;
    bf16_t* X; int ldc;
    __device__ __forceinline__ void operator()(const f32x4 (&acc)[2][2][4][2], const Unit& u, int wr, int wc, int fr, int fq) const {
        const int row0 = u.pm * BM + wr * 64 + fr, col0 = u.pn * BM + wc * 32 + 8 * fq;
#pragma unroll
        for (int ai = 0; ai < 2; ++ai)
#pragma unroll
            for (int m = 0; m < 4; ++m) { bf16_t* rowp = X + (size_t)(row0 + ai * HALF + m * 16) * ldc + col0;
                u32x4 old[2];
#pragma unroll
                for (int bj = 0; bj < 2; ++bj) old[bj] = *(const u32x4*)(rowp + bj * HALF);
#pragma unroll
                for (int bj = 0; bj < 2; ++bj) { const f32x4 a0 = acc[ai][bj][m][0], a1 = acc[ai][bj][m][1]; const u32x4 o = old[bj]; u32x4 w;
                    w.x = cvt_pk_bf16(__builtin_bit_cast(float, o.x << 16) + a0[0], __builtin_bit_cast(float, o.x & 0xffff0000u) + a0[1]);
                    w.y = cvt_pk_bf16(__builtin_bit_cast(float, o.y << 16) + a0[2], __builtin_bit_cast(float, o.y & 0xffff0000u) + a0[3]);
                    w.z = cvt_pk_bf16(__builtin_bit_cast(float, o.z << 16) + a1[0], __builtin_bit_cast(float, o.z & 0xffff0000u) + a1[1]);
                    w.w = cvt_pk_bf16(__builtin_bit_cast(float, o.w << 16) + a1[2], __builtin_bit_cast(float, o.w & 0xffff0000u) + a1[3]);
                    *(u32x4*)(rowp + bj * HALF) = w; }
                asm volatile("" ::: "memory"); }
    }
};
__device__ __forceinline__ float silu_mul(float g, float u) { return g * __builtin_amdgcn_rcpf(1.0f + __builtin_amdgcn_exp2f(g * -1.4426950408889634f)) * u; }
struct EpiSwiGLU {
    static constexpr bool PERM = true, AFTER_DRAIN = false;
    bf16_t* O; int ldc;
    __device__ __forceinline__ void operator()(const f32x4 (&acc)[2][2][4][2], const Unit& u, int wr, int wc, int fr, int fq) const {
        const int row0 = u.pm * BM + wr * 64 + fr, col0 = u.pn * HALF + wc * 32 + 8 * fq;
#pragma unroll
        for (int ai = 0; ai < 2; ++ai)
#pragma unroll
            for (int m = 0; m < 4; ++m) { bf16_t* rowp = O + (size_t)(row0 + ai * HALF + m * 16) * ldc + col0;
                const f32x4 g0 = acc[ai][0][m][0], g1 = acc[ai][0][m][1], u0 = acc[ai][1][m][0], u1 = acc[ai][1][m][1];
                u32x4 w;
                w.x = cvt_pk_bf16(silu_mul(g0[0], u0[0]), silu_mul(g0[1], u0[1])); w.y = cvt_pk_bf16(silu_mul(g0[2], u0[2]), silu_mul(g0[3], u0[3]));
                w.z = cvt_pk_bf16(silu_mul(g1[0], u1[0]), silu_mul(g1[1], u1[1])); w.w = cvt_pk_bf16(silu_mul(g1[2], u1[2]), silu_mul(g1[3], u1[3]));
                *(u32x4*)rowp = w; }
    }
};
typedef int v4i_t __attribute__((ext_vector_type(4)));
typedef unsigned u32x2e __attribute__((ext_vector_type(2)));
__device__ __forceinline__ float clamp8(float v) { return __builtin_fminf(__builtin_fmaxf(v, -448.0f), 448.0f); }
__device__ __forceinline__ unsigned pack_fp8x4(float a, float b, float c, float d) { unsigned w = 0u; w = __builtin_amdgcn_cvt_pk_fp8_f32(clamp8(a), clamp8(b), w, false); w = __builtin_amdgcn_cvt_pk_fp8_f32(clamp8(c), clamp8(d), w, true); return w; }
struct EpiSwiGLU8 {
    static constexpr bool PERM = true, AFTER_DRAIN = false;
    unsigned char* O; int ldc; float sin, sout;
    __device__ __forceinline__ void operator()(const f32x4 (&acc)[2][2][4][2], const Unit& u, int wr, int wc, int fr, int fq) const {
        const int row0 = u.pm * BM + wr * 64 + fr, col0 = u.pn * HALF + wc * 32 + 8 * fq;
#pragma unroll
        for (int ai = 0; ai < 2; ++ai)
#pragma unroll
            for (int m = 0; m < 4; ++m) { unsigned char* rowp = O + (size_t)(row0 + ai * HALF + m * 16) * ldc + col0;
                const f32x4 g0 = acc[ai][0][m][0] * sin, g1 = acc[ai][0][m][1] * sin, u0 = acc[ai][1][m][0] * (sin * sout), u1 = acc[ai][1][m][1] * (sin * sout);
                u32x2e w;
                w.x = pack_fp8x4(silu_mul(g0[0], u0[0]), silu_mul(g0[1], u0[1]), silu_mul(g0[2], u0[2]), silu_mul(g0[3], u0[3]));
                w.y = pack_fp8x4(silu_mul(g1[0], u1[0]), silu_mul(g1[1], u1[1]), silu_mul(g1[2], u1[2]), silu_mul(g1[3], u1[3]));
                *(u32x2e*)rowp = w; }
    }
};
struct EpiBf16S {
    static constexpr bool PERM = true, AFTER_DRAIN = false;
    bf16_t* O; int ldc; float s;
    __device__ __forceinline__ void operator()(const f32x4 (&acc)[2][2][4][2], const Unit& u, int wr, int wc, int fr, int fq) const {
        const int row0 = u.pm * BM + wr * 64 + fr, col0 = u.pn * BM + wc * 32 + 8 * fq;
#pragma unroll
        for (int ai = 0; ai < 2; ++ai)
#pragma unroll
            for (int m = 0; m < 4; ++m) { bf16_t* rowp = O + (size_t)(row0 + ai * HALF + m * 16) * ldc + col0;
#pragma unroll
                for (int bj = 0; bj < 2; ++bj) { const f32x4 v0 = acc[ai][bj][m][0] * s, v1 = acc[ai][bj][m][1] * s;
                    u32x4 w; w.x = cvt_pk_bf16(v0[0], v0[1]); w.y = cvt_pk_bf16(v0[2], v0[3]); w.z = cvt_pk_bf16(v1[0], v1[1]); w.w = cvt_pk_bf16(v1[2], v1[3]);
                    *(u32x4*)(rowp + bj * HALF) = w; } }
    }
};
struct GroupedOrder {
    int nM, nN, nwg, G, c; int t1, t2, t3, t4, t5, t6, t7;
    __device__ __forceinline__ void init(const int (&toff)[9], int N, int G_, int c_) { nM = toff[8]; nN = N / BM; nwg = nM * nN; G = G_; c = c_;
        t1 = toff[1]; t2 = toff[2]; t3 = toff[3]; t4 = toff[4]; t5 = toff[5]; t6 = toff[6]; t7 = toff[7]; }
    __device__ __forceinline__ bool next(int i, Unit& u) const {
        const long L = (long)i * G + c; if (L >= nwg) return false;
        int wgid = (int)L; { const int q = nwg / NXCD, r = nwg % NXCD, xcd = wgid % NXCD, off = wgid / NXCD; wgid = (xcd < r ? xcd * (q + 1) : r * (q + 1) + (xcd - r) * q) + off; }
        const int nig = WGM * nN, gid = wgid / nig, fm = gid * WGM, gsz = (nM - fm) < WGM ? (nM - fm) : WGM;
        u.pm = fm + ((wgid % nig) % gsz); u.pn = (wgid % nig) / gsz;
        int e_ = 0; e_ = (u.pm >= t1) ? 1 : e_; e_ = (u.pm >= t2) ? 2 : e_; e_ = (u.pm >= t3) ? 3 : e_; e_ = (u.pm >= t4) ? 4 : e_; e_ = (u.pm >= t5) ? 5 : e_; e_ = (u.pm >= t6) ? 6 : e_; e_ = (u.pm >= t7) ? 7 : e_;
        u.e = e_; return true;
    }
    __device__ __forceinline__ void a_ready(const Unit&) const {}
    __device__ __forceinline__ void done(const Unit&) const {}
};
template <class Epi, class Sched, bool ALIGN_EPI = false, bool SP2 = false, bool F8 = false>
__device__ __forceinline__ void gemm_phase(PG8_LAS unsigned char* lds, const Gemm g, const Sched& S, const Epi& E, const int wave_u  ) {
    const int tid_ = wave_u * 64 + lane_now();
    const int tid = tid_, wid = wave_u, lane = tid & 63, wr = wid >> 2, wc = wid & 3, fr = lane & 15, fq = lane >> 4;
    const int K = g.K, nt = K / BK;
    unsigned voffA[2], voffB[2];
#pragma unroll
    for (int i = 0; i < 2; ++i) { int R, C; stage_rc(tid * 16 + i * 8192, R, C); const int Rb = Epi::PERM ? ((R & ~31) + perm32(R & 31)) : R;
        voffA[i] = (unsigned)(R * K + C) * 2u; voffB[i] = (unsigned)(Rb * K + C) * 2u; }
    const size_t kstep = (size_t)(BK * 2);
    const size_t hstep = (size_t)HALF * K * 2;
    const size_t tstep = 2 * hstep;
    const unsigned ldsw = (unsigned)wid * 1024u;
    const unsigned ldsbase = (unsigned)(uintptr_t)lds + ldsw;
    const int aoff = lds_byte(wr * 64 + fr, fq * 8), boff = lds_byte(wc * 32 + fr, fq * 8);
#define PG8_SA(b, h) (((b) * 2 + (h)) * HTB)
#define PG8_SB(b, h) ((4 + (b) * 2 + (h)) * HTB)
#define PG8_GLDS(sbase, voff32, ldsdst) do { unsigned keep_; asm volatile("s_mov_b32 %0, m0\n\ts_mov_b32 m0, %3\n\ts_nop 0\n\tglobal_load_lds_dwordx4 %1, %2\n\ts_mov_b32 m0, %0" \
        : "=&s"(keep_) : "v"(voff32), "s"(sbase), "s"(ldsdst) : "memory"); } while (0)
#define PG8_STAGE(bufoff, gbase, voff) do { _Pragma("unroll") for (int _i = 0; _i < 2; ++_i) \
        PG8_GLDS((const char*)(gbase), (voff)[_i], (unsigned)__builtin_amdgcn_readfirstlane((int)(ldsbase + (unsigned)((bufoff) + _i * 8192)))); } while (0)
#define PG8_LDA(dst, b, h) do { _Pragma("unroll") for (int m = 0; m < 4; ++m) _Pragma("unroll") for (int k = 0; k < 2; ++k) dst[m][k] = *(const PG8_LAS bf16x8*)(lds + PG8_SA(b, h) + aoff + m * 2048 + k * 1024); } while (0)
#define PG8_LDB(dst, b, h) do { _Pragma("unroll") for (int n = 0; n < 2; ++n) _Pragma("unroll") for (int k = 0; k < 2; ++k) dst[n][k] = *(const PG8_LAS bf16x8*)(lds + PG8_SB(b, h) + boff + n * 2048 + k * 1024); } while (0)
#define PG8_CAT8(a, b) __builtin_shufflevector(__builtin_bit_cast(v4i_t, (a)), __builtin_bit_cast(v4i_t, (b)), 0, 1, 2, 3, 4, 5, 6, 7)
#define PG8_MMA(ai, bj, At, Bt) do { __builtin_amdgcn_s_setprio(1); if constexpr (F8) { _Pragma("unroll") for (int m = 0; m < 4; ++m) _Pragma("unroll") for (int n = 0; n < 2; ++n) \
        acc[ai][bj][m][n] = __builtin_amdgcn_mfma_scale_f32_16x16x128_f8f6f4(PG8_CAT8(Bt[n][0], Bt[n][1]), PG8_CAT8(At[m][0], At[m][1]), acc[ai][bj][m][n], 0, 0, 0, 0, 0, 0); } else { \
        _Pragma("unroll") for (int m = 0; m < 4; ++m) _Pragma("unroll") for (int n = 0; n < 2; ++n) _Pragma("unroll") for (int k = 0; k < 2; ++k) \
        acc[ai][bj][m][n] = __builtin_amdgcn_mfma_f32_16x16x32_bf16(Bt[n][k], At[m][k], acc[ai][bj][m][n], 0, 0, 0); } __builtin_amdgcn_s_setprio(0); } while (0)
#define PG8_WAIT_V(n) asm volatile("s_waitcnt vmcnt(" #n ")" ::: "memory")
#define PG8_WAIT_L(n) asm volatile("s_waitcnt lgkmcnt(" #n ")" ::: "memory")
#define PG8_BAR __builtin_amdgcn_s_barrier()
#define PG8_SCHED __builtin_amdgcn_sched_barrier(0)
    Unit cur, nxt; int ui = 0;
    if (!S.next(0, cur)) return;
    f32x4 acc[2][2][4][2];
#pragma unroll
    for (int a = 0; a < 2; ++a)
#pragma unroll
        for (int b = 0; b < 2; ++b)
#pragma unroll
            for (int m = 0; m < 4; ++m)
#pragma unroll
                for (int n = 0; n < 2; ++n) acc[a][b][m][n] = (f32x4){0.f, 0.f, 0.f, 0.f};
    bf16x8 At[4][2], B0[2][2], B1[2][2];
    const char* cA = (const char*)g.A + (size_t)cur.pm * tstep; const char* cB = (const char*)g.Bt + (size_t)cur.e * g.estride + (size_t)cur.pn * tstep;
    S.a_ready(cur);
    if constexpr (SP2) {
        PG8_STAGE(PG8_SB(0, 0), cB, voffB); PG8_STAGE(PG8_SB(0, 1), cB + hstep, voffB); PG8_STAGE(PG8_SA(0, 0), cA, voffA); PG8_STAGE(PG8_SA(0, 1), cA + hstep, voffA);
        if (wr == 1) PG8_BAR;
        PG8_WAIT_V(2); PG8_BAR;
        PG8_STAGE(PG8_SB(1, 0), cB + kstep, voffB); PG8_STAGE(PG8_SA(1, 0), cA + kstep, voffA); PG8_STAGE(PG8_SB(1, 1), cB + hstep + kstep, voffB);
        PG8_WAIT_V(6); PG8_BAR;
    } else {
        PG8_STAGE(PG8_SB(0, 0), cB, voffB); PG8_STAGE(PG8_SA(0, 0), cA, voffA); PG8_STAGE(PG8_SB(0, 1), cB + hstep, voffB); PG8_STAGE(PG8_SA(0, 1), cA + hstep, voffA);
        if (wr == 1) PG8_BAR;
        PG8_WAIT_V(4); PG8_BAR;
        PG8_STAGE(PG8_SB(1, 0), cB + kstep, voffB); PG8_STAGE(PG8_SA(1, 0), cA + kstep, voffA); PG8_STAGE(PG8_SB(1, 1), cB + hstep + kstep, voffB);
        PG8_WAIT_V(6); PG8_BAR;
    }
    for (;;) {
        const bool has_next = S.next(ui + 1, nxt);
        const char* nA = has_next ? (const char*)g.A + (size_t)nxt.pm * tstep : cA; const char* nB = has_next ? (const char*)g.Bt + (size_t)nxt.e * g.estride + (size_t)nxt.pn * tstep : cB;
        for (int t = 0; t < nt; t += 2) {
            const bool last = (t == nt - 2);
            const char* a1 = cA + (size_t)(t + 1) * kstep;
            const char* a2 = last ? nA : cA + (size_t)(t + 2) * kstep; const char* b2 = last ? nB : cB + (size_t)(t + 2) * kstep;
            const char* a3 = a2 + kstep; const char* b3 = b2 + kstep;
            if (last && has_next) S.a_ready(nxt);
            if constexpr (SP2) {
            PG8_LDB(B0, 0, 0); PG8_LDB(B1, 0, 1); PG8_SCHED; PG8_LDA(At, 0, 0); PG8_STAGE(PG8_SA(1, 1), a1 + hstep, voffA);
            PG8_WAIT_V(8); PG8_WAIT_L(0); PG8_BAR; PG8_MMA(0, 0, At, B0); PG8_MMA(0, 1, At, B1); PG8_BAR; PG8_SCHED;
            PG8_LDA(At, 0, 1); PG8_STAGE(PG8_SB(0, 0), b2, voffB); PG8_STAGE(PG8_SB(0, 1), b2 + hstep, voffB); PG8_STAGE(PG8_SA(0, 0), a2, voffA);
            PG8_WAIT_V(8); PG8_WAIT_L(0); PG8_BAR; PG8_MMA(1, 0, At, B0); PG8_MMA(1, 1, At, B1); PG8_BAR; PG8_SCHED;
            PG8_LDB(B0, 1, 0); PG8_LDB(B1, 1, 1); PG8_SCHED; PG8_LDA(At, 1, 0); PG8_STAGE(PG8_SA(0, 1), a2 + hstep, voffA);
            PG8_WAIT_V(8); PG8_WAIT_L(0); PG8_BAR; PG8_MMA(0, 0, At, B0); PG8_MMA(0, 1, At, B1); PG8_BAR; PG8_SCHED;
            PG8_LDA(At, 1, 1); PG8_STAGE(PG8_SB(1, 0), b3, voffB); PG8_STAGE(PG8_SB(1, 1), b3 + hstep, voffB); PG8_STAGE(PG8_SA(1, 0), a3, voffA);
            PG8_WAIT_V(8); PG8_WAIT_L(0); PG8_BAR; PG8_MMA(1, 0, At, B0); PG8_MMA(1, 1, At, B1); PG8_BAR; PG8_SCHED;
            } else {
            PG8_LDB(B0, 0, 0); PG8_SCHED; PG8_LDA(At, 0, 0); PG8_STAGE(PG8_SA(1, 1), a1 + hstep, voffA);
            PG8_WAIT_L(8); PG8_BAR; PG8_WAIT_L(0); PG8_MMA(0, 0, At, B0); PG8_BAR; PG8_SCHED;
            PG8_LDB(B1, 0, 1); PG8_STAGE(PG8_SB(0, 0), b2, voffB);
            PG8_BAR; PG8_WAIT_L(0); PG8_MMA(0, 1, At, B1); PG8_BAR;
            PG8_LDA(At, 0, 1); PG8_STAGE(PG8_SA(0, 0), a2, voffA);
            PG8_BAR; PG8_WAIT_L(0); PG8_MMA(1, 0, At, B0); PG8_BAR; PG8_SCHED;
            PG8_STAGE(PG8_SB(0, 1), b2 + hstep, voffB);
            PG8_WAIT_V(6); PG8_BAR; PG8_MMA(1, 1, At, B1); PG8_BAR;
            PG8_LDB(B0, 1, 0); PG8_SCHED; PG8_LDA(At, 1, 0); PG8_STAGE(PG8_SA(0, 1), a2 + hstep, voffA);
            PG8_WAIT_L(8); PG8_BAR; PG8_WAIT_L(0); PG8_MMA(0, 0, At, B0); PG8_BAR; PG8_SCHED;
            PG8_LDB(B1, 1, 1); PG8_STAGE(PG8_SB(1, 0), b3, voffB);
            PG8_BAR; PG8_WAIT_L(0); PG8_MMA(0, 1, At, B1); PG8_BAR;
            PG8_LDA(At, 1, 1); PG8_STAGE(PG8_SA(1, 0), a3, voffA);
            PG8_BAR; PG8_WAIT_L(0); PG8_MMA(1, 0, At, B0); PG8_BAR; PG8_SCHED;
            PG8_STAGE(PG8_SB(1, 1), b3 + hstep, voffB);
            PG8_WAIT_V(6); PG8_BAR; PG8_MMA(1, 1, At, B1); PG8_BAR;
            }
        }
        if constexpr (ALIGN_EPI) { if (wr == 0) PG8_BAR; }
        if constexpr (!Epi::AFTER_DRAIN) { const int le_ = lane_now(); E(acc, cur, wr, wc, le_ & 15, le_ >> 4); S.done(cur); }
        if (!has_next) break;
#pragma unroll
        for (int a = 0; a < 2; ++a)
#pragma unroll
            for (int b = 0; b < 2; ++b)
#pragma unroll
                for (int m = 0; m < 4; ++m)
#pragma unroll
                    for (int n = 0; n < 2; ++n) acc[a][b][m][n] = (f32x4){0.f, 0.f, 0.f, 0.f};
        cur = nxt; cA = nA; cB = nB; ++ui;
        if constexpr (ALIGN_EPI) { if (wr == 1) PG8_BAR; }
    }
    PG8_WAIT_V(0);
    if constexpr (!ALIGN_EPI) { if (wr == 0) PG8_BAR; }
    PG8_BAR;
    if constexpr (Epi::AFTER_DRAIN) { E.fused(acc, cur, wr, wc, fr, fq, lds, wid, lane); S.done(cur); }
#undef PG8_SA
#undef PG8_SB
#undef PG8_STAGE
#undef PG8_GLDS
#undef PG8_LDA
#undef PG8_LDB
#undef PG8_MMA
#undef PG8_CAT8
#undef PG8_WAIT_V
#undef PG8_WAIT_L
#undef PG8_BAR
#undef PG8_SCHED
}
}
#define GAS __attribute__((address_space(1)))
#define LAS __attribute__((address_space(3)))
typedef unsigned short bf16;
typedef unsigned v4u __attribute__((ext_vector_type(4)));
typedef float f32x4 __attribute__((ext_vector_type(4)));
typedef short bf16x8 __attribute__((ext_vector_type(8)));
typedef GAS unsigned gu32;
typedef GAS unsigned long long gu64;
#define RLX_AGENT __ATOMIC_RELAXED, __HIP_MEMORY_SCOPE_AGENT
#define LDS_WAIT() asm volatile("s_waitcnt lgkmcnt(0)" ::: "memory")
#define VM_WAIT() asm volatile("s_waitcnt vmcnt(0)" ::: "memory")
__device__ __forceinline__ unsigned long long rt() { return __builtin_amdgcn_s_memrealtime(); }
__device__ __forceinline__ unsigned f2bf(float f) { unsigned u = __builtin_bit_cast(unsigned, f); return (u + 0x7fffu + ((u >> 16) & 1u)) >> 16; }
__device__ __forceinline__ unsigned pk2(float lo, float hi) { return f2bf(lo) | (f2bf(hi) << 16); }

#define XB_TMO      128
#define XB_XCNT(j)  (256  + 64 * (j))
#define XB_XSUB(j)  (1280 + 64 * (j))
#define XB_XGEN(j)  (2304 + 64 * (j))
#define XB_TOP      3328
#define XB_TOPGEN   3392
#define XCD_BAR_WORDS 3456
#define XB_SPIN_CAP (1u << 18)

__device__ __forceinline__ unsigned xb_ld(unsigned* p)              { return __hip_atomic_load(p, __ATOMIC_RELAXED, __HIP_MEMORY_SCOPE_AGENT); }
__device__ __forceinline__ unsigned xb_add(unsigned* p, unsigned v) { return __hip_atomic_fetch_add(p, v, __ATOMIC_RELAXED, __HIP_MEMORY_SCOPE_AGENT); }
__device__ __forceinline__ unsigned xb_xcc_id() { return (unsigned)__builtin_amdgcn_s_getreg((3 << 11) | 20) & 0xFu; }
#define XB_SPIN(cond, bar) do { unsigned _sp = 0; while (cond) { __builtin_amdgcn_s_sleep(1); \
    if ((++_sp & 255u) == 0u) { if (xb_ld(&(bar)[XB_TMO])) break; if (_sp > XB_SPIN_CAP) { atomicAdd(&(bar)[XB_TMO], 1u); break; } } } } while (0)

struct XcdBarrier {
    int wv;
    unsigned* bar; unsigned x;
    volatile LAS unsigned* st;
};

__device__ __forceinline__ XcdBarrier xcd_barrier_post(unsigned* bar, volatile LAS unsigned* st, int wv) {
    XcdBarrier b; b.bar = bar; b.x = xb_xcc_id(); b.st = st; b.wv = wv;
    if (wv == 0 && lane_now() == 0) (void)xb_add(&bar[XB_XCNT(b.x)], 1u);
    return b;
}
__device__ __forceinline__ void xcd_barrier_complete(unsigned* bar, unsigned x, unsigned& nloc, unsigned& nx) {
    const unsigned G = gridDim.x * gridDim.y * gridDim.z;
    unsigned sum, cnt, mine, sp = 0u;
    for (;;) {
        sum = 0u; cnt = 0u; mine = 0u;
#pragma unroll
        for (unsigned j = 0; j < 16; ++j) { const unsigned c = xb_ld(&bar[XB_XCNT(j)]); sum += c; cnt += (c > 0u) ? 1u : 0u; mine = (j == x) ? c : mine; }
        if (sum == G) break;
        __builtin_amdgcn_s_sleep(1);
        if ((++sp & 255u) == 0u) { if (xb_ld(&bar[XB_TMO])) break; if (sp > XB_SPIN_CAP) { atomicAdd(&bar[XB_TMO], 1u); break; } }
    }
    nloc = mine > 0u ? mine : 1u; nx = cnt > 0u ? cnt : 1u;
}

__device__ __forceinline__ void xcd_barrier(const XcdBarrier& b) {
    asm volatile("s_waitcnt vmcnt(0)" ::: "memory");
    __syncthreads();
    int wv_ = b.wv; asm volatile("" : "+s"(wv_));
    if (wv_ == 0 && lane_now() == 0) {
        unsigned* bar = b.bar;
        __builtin_amdgcn_s_waitcnt(0);
        unsigned nloc = b.st[0], nx = b.st[1];
        if (nloc == 0u) { xcd_barrier_complete(bar, b.x, nloc, nx); b.st[0] = nloc; b.st[1] = nx; }
        const unsigned old = xb_add(&bar[XB_XSUB(b.x)], 1u);
        const unsigned gen = old / nloc;
        if (old + 1u == (gen + 1u) * nloc) {
            __builtin_amdgcn_fence(__ATOMIC_RELEASE, "agent");
            asm volatile("s_waitcnt vmcnt(0)" ::: "memory");
            const unsigned og = xb_add(&bar[XB_TOP], 1u);
            const unsigned tg = og / nx;
            if (og + 1u == (tg + 1u) * nx) xb_add(&bar[XB_TOPGEN], 1u);
            else XB_SPIN(xb_ld(&bar[XB_TOPGEN]) == tg, bar);
            __builtin_amdgcn_fence(__ATOMIC_ACQUIRE, "agent");
            xb_add(&bar[XB_XGEN(b.x)], 1u);
            asm volatile("s_waitcnt vmcnt(0)" ::: "memory");
        } else {
            XB_SPIN(xb_ld(&bar[XB_XGEN(b.x)]) == gen, bar);
            __builtin_amdgcn_fence(__ATOMIC_ACQUIRE, "agent");
            asm volatile("s_waitcnt vmcnt(0)" ::: "memory");
        }
    }
    __syncthreads();
}
constexpr int NWAVES = 8;
constexpr int BATCH = 8, SEQ = 2048, D = 1024, T = BATCH * SEQ, DEPTH = 4;
constexpr int NH = 8, HD = 64, AW = 512, PW = 256, CW = 256, INC = 2304, CK = 31;
constexpr int FF = 2816, NE = 8, NGU = 2 * FF;
constexpr int MAXSLOT = 2 * T + NE * 256;
constexpr float RMS_EPS = 1e-6f, LN_EPS = 1e-5f;
constexpr float QSCALE = 0.125f * 1.4426950408889634f;
constexpr float W_EXIT = -150.0f;
constexpr int PQ = 0, PK = 512, PV = 1024, PPOOL = 1536, PCV = 1792, PCG = 2048;
enum { I_X = 0, I_ANG, I_WIN, I_POOLW, I_POOLS, I_CONVW, I_CONVB, I_LNG, I_LNB, I_GNG, I_WOUT, I_FNG, I_DWG, I_DWU, I_DWD, I_RW, I_MWG, I_MWU, I_MWD, I_FING, N_IN };

constexpr size_t MiB = 1u << 20;
constexpr size_t WS_CTL = 0, CTL_ZERO_BYTES = 1 * MiB;
constexpr size_t WS_TOKE = 1 * MiB, WS_TOKR = WS_TOKE + 128 * 1024, WS_TOKG = WS_TOKR + 128 * 1024, WS_TOKS = WS_TOKG + 128 * 1024;
constexpr size_t WS_WIN = 4 * MiB;
constexpr size_t WS_WOUT = 22 * MiB;
constexpr size_t WS_WGUD = 30 * MiB;
constexpr size_t WS_WDD = 52 * MiB;
constexpr size_t WS_WGUM = 64 * MiB;
constexpr size_t WS_WDM = 240 * MiB;
constexpr size_t WS_X = 328 * MiB;
constexpr size_t WS_XN = 392 * MiB;
constexpr size_t WS_P = 424 * MiB;
constexpr size_t WS_O = 496 * MiB;
constexpr size_t WS_ACT = 424 * MiB;
constexpr size_t WS_AP = 611 * MiB;
constexpr size_t WS_END = 679 * MiB;
static_assert(WS_WIN + (size_t)4 * INC * D * 2 <= WS_WOUT && WS_WOUT + (size_t)4 * D * D * 2 <= WS_WGUD && WS_WGUD + (size_t)2 * NGU * D * 2 <= WS_WDD && WS_WDD + (size_t)2 * D * FF * 2 <= WS_WGUM, "ws map 1");
static_assert(WS_WGUM + (size_t)16 * NGU * D * 2 <= WS_WDM && WS_WDM + (size_t)16 * D * FF * 2 <= WS_X && WS_X + (size_t)T * D * 4 <= WS_XN && WS_XN + (size_t)T * D * 2 <= WS_P, "ws map 2");
static_assert(WS_P + (size_t)T * INC * 2 <= WS_O && WS_O + (size_t)T * D * 2 <= WS_AP && WS_ACT + (size_t)MAXSLOT * FF * 2 <= WS_AP && WS_AP + (size_t)MAXSLOT * D * 2 <= WS_END, "ws map 3");
constexpr int CW_TMO = 0, CW_CODE = 1;
constexpr int CW_BAR = 4096;
constexpr int CW_MOE = 8192;

constexpr int RING_OFF = 0, RING_BYTES = 131072;
constexpr int LDSCTL_OFF = RING_BYTES, MISC_OFF = LDSCTL_OFF + 320;
constexpr int LDS_BYTES = 147456;
typedef unsigned u32x2 __attribute__((ext_vector_type(2)));
struct Frame {
    LAS unsigned char* lds;
    volatile LAS unsigned* MISC;
    int vcu, G, wave;
};
__device__ __forceinline__ int opaque_int(int n) { asm volatile("" : "+s"(n)); return n; }
#define PHASE_IDS() const int wave = opaque_int(F.wave), vcu = opaque_int(F.vcu), G = opaque_int(F.G), lane = lane_now(), tid = wave * 64 + lane; (void)tid; (void)lane; (void)wave; (void)vcu; (void)G
template <int I> __device__ __forceinline__ const float* inp() { unsigned long long v; asm volatile("s_load_dwordx2 %0, %1, %2\n\ts_waitcnt lgkmcnt(0)" : "=&s"(v) : "s"(__builtin_amdgcn_kernarg_segment_ptr()), "n"(I * 8));
    return (const float*)(const GAS float*)v; }
#define INP(i) inp<(i)>()
#define OUTPTR() ((float*)const_cast<float*>(inp<N_IN>()))
#define WSPTR() ((unsigned char*)const_cast<float*>(inp<N_IN + 1>()))
#define CTLPTR() ((gu32*)WSPTR())
__device__ __forceinline__ float bf2f(bf16 b) { return __uint_as_float((unsigned)b << 16); }
__device__ __forceinline__ float bflo(unsigned w) { return __uint_as_float(w << 16); }
__device__ __forceinline__ float bfhi(unsigned w) { return __uint_as_float(w & 0xffff0000u); }
template <int CTRL> __device__ __forceinline__ float dpp_add(float v) { return v + __builtin_bit_cast(float, __builtin_amdgcn_update_dpp(0, __builtin_bit_cast(int, v), CTRL, 0xf, 0xf, true)); }
__device__ __forceinline__ float wave_sum(float v) {
    v = dpp_add<0xB1>(v); v = dpp_add<0x4E>(v); v = dpp_add<0x141>(v); v = dpp_add<0x140>(v);
    v += __builtin_bit_cast(float, __builtin_amdgcn_ds_swizzle(__builtin_bit_cast(int, v), 0x401F));
    const auto rr = __builtin_amdgcn_permlane32_swap(__float_as_uint(v), __float_as_uint(v), false, false); return __uint_as_float(rr[0]) + __uint_as_float(rr[1]);
}
__device__ __forceinline__ void fail_word(int wave, unsigned code) {
    if (wave == 0 && lane_now() == 0) { gu32* ctl = CTLPTR(); unsigned expect = 0u; __hip_atomic_compare_exchange_strong((unsigned*)(ctl + CW_CODE), &expect, code, __ATOMIC_RELAXED, __ATOMIC_RELAXED, __HIP_MEMORY_SCOPE_AGENT);
        __hip_atomic_store(ctl + CW_TMO, 1u, RLX_AGENT); }
}

__device__ __forceinline__ void transpose_item(const float* W, int K, int N, bf16* WT, int mode, int nscale, int item, int lane) {
    const int nblk = N / 64, kb = item / nblk, nb = item % nblk, k0 = 64 * kb, n0 = 64 * nb, kq = lane >> 4, nq = lane & 15;
    const GAS f32x4* src = (const GAS f32x4*)(W + (size_t)(k0 + 8 * kq) * N + n0 + 4 * nq);
    f32x4 v[16];
#pragma unroll
    for (int i = 0; i < 16; ++i) v[i] = src[(size_t)((i & 7) + 32 * (i >> 3)) * (N / 4)];
    const int r0 = (mode == 0) ? n0 : (256 * (n0 >> 7) + (n0 & 127) + (mode == 2 ? 128 : 0));
    const float sc = (n0 < nscale) ? QSCALE : 1.0f;
#pragma unroll
    for (int j = 0; j < 4; ++j) { GAS v4u* dst = (GAS v4u*)(WT + (size_t)(r0 + 4 * nq + j) * K + k0 + 8 * kq);
#pragma unroll
        for (int hf = 0; hf < 2; ++hf) { v4u o;
            o.x = pk2(v[8 * hf + 0][j] * sc, v[8 * hf + 1][j] * sc); o.y = pk2(v[8 * hf + 2][j] * sc, v[8 * hf + 3][j] * sc);
            o.z = pk2(v[8 * hf + 4][j] * sc, v[8 * hf + 5][j] * sc); o.w = pk2(v[8 * hf + 6][j] * sc, v[8 * hf + 7][j] * sc);
            dst[4 * hf] = o; } }
}
constexpr float WSCALE8 = 64.0f, XSCALE8 = 16.0f, ASCALE8 = 16.0f;
__device__ __forceinline__ float clamp8f(float v) { return fminf(fmaxf(v, -448.0f), 448.0f); }
__device__ __forceinline__ unsigned pack8(float a, float b, float c, float d) { unsigned w = 0u; w = __builtin_amdgcn_cvt_pk_fp8_f32(clamp8f(a), clamp8f(b), w, false); w = __builtin_amdgcn_cvt_pk_fp8_f32(clamp8f(c), clamp8f(d), w, true); return w; }
__device__ __forceinline__ void transpose_item8(const float* W, int K, int N, unsigned char* WT, int mode, int item, int lane) {
    const int nblk = N / 64, kb = item / nblk, nb = item % nblk, k0 = 64 * kb, n0 = 64 * nb, kq = lane >> 4, nq = lane & 15;
    const GAS f32x4* src = (const GAS f32x4*)(W + (size_t)(k0 + 16 * kq) * N + n0 + 4 * nq);
    f32x4 v[16];
#pragma unroll
    for (int i = 0; i < 16; ++i) v[i] = src[(size_t)i * (N / 4)];
    const int r0 = (mode == 0) ? n0 : (256 * (n0 >> 7) + (n0 & 127) + (mode == 2 ? 128 : 0));
#pragma unroll
    for (int j = 0; j < 4; ++j) { v4u o;
        o.x = pack8(v[0][j] * WSCALE8, v[1][j] * WSCALE8, v[2][j] * WSCALE8, v[3][j] * WSCALE8); o.y = pack8(v[4][j] * WSCALE8, v[5][j] * WSCALE8, v[6][j] * WSCALE8, v[7][j] * WSCALE8);
        o.z = pack8(v[8][j] * WSCALE8, v[9][j] * WSCALE8, v[10][j] * WSCALE8, v[11][j] * WSCALE8); o.w = pack8(v[12][j] * WSCALE8, v[13][j] * WSCALE8, v[14][j] * WSCALE8, v[15][j] * WSCALE8);
        *(GAS v4u*)(WT + (size_t)(r0 + 4 * nq + j) * K + k0 + 16 * kq) = o; }
}
__device__ __forceinline__ void p0_weights(Frame& F) {
    PHASE_IDS(); unsigned char* const ws = WSPTR();
    const int gw = vcu * NWAVES + wave, NGW = G * NWAVES;
    constexpr int I_IN = (D / 64) * (INC / 64), I_OUT = (D / 64) * (D / 64), I_GU = (D / 64) * (FF / 64), I_DN = (FF / 64) * (D / 64);
    constexpr int N0 = 4 * I_IN, N1 = N0 + 4 * I_OUT, N2 = N1 + 2 * I_GU, N3 = N2 + 2 * I_GU, N4 = N3 + 2 * I_DN, N5 = N4 + 16 * I_GU, N6 = N5 + 16 * I_GU, N7 = N6 + 16 * I_DN;
    bf16* const win = (bf16*)(ws + WS_WIN); bf16* const wout = (bf16*)(ws + WS_WOUT); bf16* const wgud = (bf16*)(ws + WS_WGUD); bf16* const wdd = (bf16*)(ws + WS_WDD);
#pragma unroll 1
    for (int it = gw; it < N4; it += NGW) {
        if (it < N0) { const int l = it / I_IN, r = it % I_IN; transpose_item(INP(I_WIN) + (size_t)l * D * INC, D, INC, win + (size_t)l * INC * D, 0, 512, r, lane); }
        else if (it < N1) { const int q = it - N0, l = q / I_OUT, r = q % I_OUT; transpose_item(INP(I_WOUT) + (size_t)l * D * D, D, D, wout + (size_t)l * D * D, 0, 0, r, lane); }
        else if (it < N2) { const int q = it - N1, l = q / I_GU, r = q % I_GU; transpose_item(INP(I_DWG) + (size_t)l * D * FF, D, FF, wgud + (size_t)l * NGU * D, 1, 0, r, lane); }
        else if (it < N3) { const int q = it - N2, l = q / I_GU, r = q % I_GU; transpose_item(INP(I_DWU) + (size_t)l * D * FF, D, FF, wgud + (size_t)l * NGU * D, 2, 0, r, lane); }
        else { const int q = it - N3, l = q / I_DN, r = q % I_DN; transpose_item(INP(I_DWD) + (size_t)l * FF * D, FF, D, wdd + (size_t)l * D * FF, 0, 0, r, lane); }
    }
}

constexpr int MOE_ITEMS_MAT = (D / 64) * (FF / 64), MOE_ITEMS = 24 * MOE_ITEMS_MAT;
constexpr int CVT_A0 = 0, CVT_A_PER = 35, CVT_B0 = 192 * CVT_A_PER, CVT_B_PER = 35, CVT_C0 = CVT_B0 + 128 * CVT_B_PER, CVT_C_PER = (MOE_ITEMS - CVT_C0 + 191) / 192;
static_assert(CVT_C0 < MOE_ITEMS && CVT_C0 + 192 * CVT_C_PER >= MOE_ITEMS && CVT_C_PER <= 40, "conversion slots cover the list");
__device__ __forceinline__ void moe_convert(Frame& F, int li, int i0, int i1) {
    PHASE_IDS(); unsigned char* const ws = WSPTR();
    unsigned char* const wgum = ws + WS_WGUM + (size_t)li * NE * NGU * D; unsigned char* const wdm = ws + WS_WDM + (size_t)li * NE * D * FF;
    if (i1 > MOE_ITEMS) i1 = MOE_ITEMS;
#pragma unroll 1
    for (int q = i0 + wave; q < i1; q += NWAVES) {
        const int m = q / MOE_ITEMS_MAT, r = q % MOE_ITEMS_MAT, e = m & 7, le = li * NE + e;
        if (m < 8) transpose_item8(INP(I_MWG) + (size_t)le * D * FF, D, FF, wgum + (size_t)e * NGU * D, 1, r, lane);
        else if (m < 16) transpose_item8(INP(I_MWU) + (size_t)le * D * FF, D, FF, wgum + (size_t)e * NGU * D, 2, r, lane);
        else transpose_item8(INP(I_MWD) + (size_t)le * FF * D, FF, D, wdm + (size_t)e * D * FF, 0, r, lane);
    }
}

struct RowArgs { const float* xin; const bf16* xsrc; bf16* xws; const float* gain; bf16* xn; float* out; const bf16* yp; const float* wr; gu32* gcur;
                 int* tok_e; int* tok_r; float* tok_g; const int* tok_s; };
template <int MODE>
__device__ __forceinline__ void row_phase(Frame& F, const RowArgs& A) {
    constexpr bool COMBINE = MODE & 1, ROUTER = (MODE & 2) != 0, FINAL = (MODE & 4) != 0, COPYIN = (MODE & 8) != 0;
    LAS int* s_cnt = (LAS int*)(F.lds + RING_OFF);
    LAS int* s_base = s_cnt + 8;
    LAS int* s_e = s_cnt + 16;
    LAS int* s_rk = s_e + 128;
    LAS float* s_g = (LAS float*)(s_rk + 128);
    PHASE_IDS();
    if (ROUTER) { if (tid < 16) s_cnt[tid] = 0; __syncthreads(); }
#pragma unroll 1
    for (int i = 0; i < 8; ++i) {
        const int rl = wave * 8 + i, m = vcu * 64 + rl;
        f32x4 v[4];
        if (COPYIN) { const GAS f32x4* xr = (const GAS f32x4*)(A.xin + (size_t)m * D) + lane;
#pragma unroll
            for (int j = 0; j < 4; ++j) v[j] = xr[64 * j]; }
        else { const GAS u32x2* xr = (const GAS u32x2*)(A.xsrc + (size_t)m * D) + lane;
#pragma unroll
            for (int j = 0; j < 4; ++j) { const u32x2 w = xr[64 * j]; v[j] = (f32x4){bflo(w.x), bfhi(w.x), bflo(w.y), bfhi(w.y)}; } }
        if (COMBINE) {
            const int s0 = A.tok_s[2 * m], s1 = A.tok_s[2 * m + 1]; const float g0 = A.tok_g[2 * m], g1 = A.tok_g[2 * m + 1];
            const GAS u32x2* y0 = (const GAS u32x2*)(A.yp + (size_t)s0 * D) + lane; const GAS u32x2* y1 = (const GAS u32x2*)(A.yp + (size_t)s1 * D) + lane;
#pragma unroll
            for (int j = 0; j < 4; ++j) { const u32x2 a = y0[64 * j], b = y1[64 * j];
                v[j].x += g0 * bflo(a.x) + g1 * bflo(b.x); v[j].y += g0 * bfhi(a.x) + g1 * bfhi(b.x); v[j].z += g0 * bflo(a.y) + g1 * bflo(b.y); v[j].w += g0 * bfhi(a.y) + g1 * bfhi(b.y); }
        }
        if ((COMBINE && !FINAL) || COPYIN) { GAS u32x2* xw = (GAS u32x2*)(A.xws + (size_t)m * D) + lane;
#pragma unroll
            for (int j = 0; j < 4; ++j) xw[64 * j] = (u32x2){pk2(v[j].x, v[j].y), pk2(v[j].z, v[j].w)}; }
        float ss = 0.f;
#pragma unroll
        for (int j = 0; j < 4; ++j) ss += (v[j].x * v[j].x + v[j].y * v[j].y) + (v[j].z * v[j].z + v[j].w * v[j].w);
        const float rstd = 1.0f / sqrtf(wave_sum(ss) * (1.0f / D) + RMS_EPS);
        const GAS f32x4* gr = (const GAS f32x4*)A.gain + lane;
#pragma unroll
        for (int j = 0; j < 4; ++j) v[j] = v[j] * rstd * gr[64 * j];
        if (FINAL) { GAS f32x4* o = (GAS f32x4*)(A.out + (size_t)m * D) + lane;
#pragma unroll
            for (int j = 0; j < 4; ++j) o[64 * j] = v[j]; }
        else { GAS u32x2* o = (GAS u32x2*)(A.xn + (size_t)m * D) + lane;
#pragma unroll
            for (int j = 0; j < 4; ++j) o[64 * j] = (u32x2){pk2(v[j].x, v[j].y), pk2(v[j].z, v[j].w)}; }
        if (ROUTER) {
            float lg[8];
#pragma unroll
            for (int e = 0; e < 8; ++e) lg[e] = 0.f;
#pragma unroll
            for (int j = 0; j < 4; ++j)
#pragma unroll
                for (int q = 0; q < 4; ++q) { const GAS f32x4* w = (const GAS f32x4*)(A.wr + (size_t)(256 * j + 4 * lane + q) * 8); const f32x4 w0 = w[0], w1 = w[1]; const float h = v[j][q];
                    lg[0] += h * w0.x; lg[1] += h * w0.y; lg[2] += h * w0.z; lg[3] += h * w0.w; lg[4] += h * w1.x; lg[5] += h * w1.y; lg[6] += h * w1.z; lg[7] += h * w1.w; }
#pragma unroll
            for (int e = 0; e < 8; ++e) lg[e] = wave_sum(lg[e]);
            int e1 = 0; float v1 = lg[0];
#pragma unroll
            for (int e = 1; e < 8; ++e) if (lg[e] > v1) { v1 = lg[e]; e1 = e; }
            int e2 = -1; float v2 = -INFINITY;
#pragma unroll
            for (int e = 0; e < 8; ++e) if (e != e1 && (e2 < 0 || lg[e] > v2)) { v2 = lg[e]; e2 = e; }
            const float g1 = 1.0f / (1.0f + __expf(v2 - v1)), g2 = 1.0f - g1;
            if (lane == 0) { const int r1 = atomicAdd((int*)(s_cnt + e1), 1), r2 = atomicAdd((int*)(s_cnt + e2), 1);
                s_e[2 * rl] = e1; s_e[2 * rl + 1] = e2; s_rk[2 * rl] = r1; s_rk[2 * rl + 1] = r2; s_g[2 * rl] = g1; s_g[2 * rl + 1] = g2; }
        }
    }
    if (ROUTER) {
        __syncthreads();
        if (tid < 8) s_base[tid] = (int)__hip_atomic_fetch_add(A.gcur + 64 * tid, (unsigned)s_cnt[tid], RLX_AGENT);
        __syncthreads();
        if (tid < 128) { const int m2 = vcu * 128 + tid; const int e = s_e[tid]; A.tok_e[m2] = e; A.tok_r[m2] = s_base[e] + s_rk[tid]; A.tok_g[m2] = s_g[tid]; }
        __syncthreads();
    }
}

__device__ __forceinline__ void load_toff(gu32* gcur, int (&cnt)[8], int (&toff)[9]) {
    toff[0] = 0;
#pragma unroll
    for (int e = 0; e < 8; ++e) { cnt[e] = (int)__builtin_amdgcn_readfirstlane(__hip_atomic_load(gcur + 64 * e, RLX_AGENT)); toff[e + 1] = toff[e] + ((cnt[e] + 255) >> 8); }
}
__device__ __forceinline__ void gather_phase(Frame& F, gu32* gcur, const bf16* xn, unsigned char* ap, const int* tok_e, const int* tok_r, int* tok_s) {
    PHASE_IDS();
    int cnt[8], toff[9]; load_toff(gcur, cnt, toff);
#pragma unroll 1
    for (int i = 0; i < 8; ++i) {
        const int m = vcu * 64 + wave * 8 + i;
        const GAS v4u* src = (const GAS v4u*)(xn + (size_t)m * D) + 2 * lane; const v4u a = src[0], b = src[1];
        v4u o;
        o.x = pack8(bflo(a.x) * XSCALE8, bfhi(a.x) * XSCALE8, bflo(a.y) * XSCALE8, bfhi(a.y) * XSCALE8); o.y = pack8(bflo(a.z) * XSCALE8, bfhi(a.z) * XSCALE8, bflo(a.w) * XSCALE8, bfhi(a.w) * XSCALE8);
        o.z = pack8(bflo(b.x) * XSCALE8, bfhi(b.x) * XSCALE8, bflo(b.y) * XSCALE8, bfhi(b.y) * XSCALE8); o.w = pack8(bflo(b.z) * XSCALE8, bfhi(b.z) * XSCALE8, bflo(b.w) * XSCALE8, bfhi(b.w) * XSCALE8);
#pragma unroll
        for (int k = 0; k < 2; ++k) {
            const int e = tok_e[2 * m + k], r = tok_r[2 * m + k];
            int base = 0;
#pragma unroll
            for (int q = 0; q < 8; ++q) base = (e == q) ? toff[q] : base;
            const int slot = base * 256 + r;
            if (lane == 0) tok_s[2 * m + k] = slot;
            *((GAS v4u*)(ap + (size_t)slot * D) + lane) = o;
        }
    }
    const int gw = vcu * NWAVES + wave, NGW = G * NWAVES;
#pragma unroll
    for (int e = 0; e < 8; ++e) {
        for (int r = toff[e] * 256 + cnt[e] + gw; r < toff[e + 1] * 256; r += NGW) { unsigned z = 0u; asm volatile("" : "+v"(z)); *((GAS v4u*)(ap + (size_t)r * D) + lane) = (v4u){z, z, z, z}; }
    }
}

typedef float f32x16 __attribute__((ext_vector_type(16)));
typedef short s16x4 __attribute__((ext_vector_type(4)));
typedef short v4i16_t __attribute__((ext_vector_type(4)));
typedef float f32x2_t __attribute__((ext_vector_type(2))); typedef __bf16 bf16x2_t __attribute__((ext_vector_type(2)));
__device__ __forceinline__ unsigned cvtpk(float lo, float hi) { f32x2_t v = {lo, hi}; bf16x2_t b = __builtin_convertvector(v, bf16x2_t); return __builtin_bit_cast(unsigned, b); }
__device__ __forceinline__ s16x4 vtr(const LAS unsigned char* p) { return __builtin_bit_cast(s16x4, __builtin_amdgcn_ds_read_tr16_b64_v4i16((LAS v4i16_t*)p)); }
constexpr int ATT_VBYTES = 4096;
constexpr int ATT_HS_OFF = NWAVES * ATT_VBYTES;

__device__ __forceinline__ f32x16 sb_qk(const bf16x8 (&kf)[4], const bf16x8 (&qf)[4]) {
    f32x16 st;
#pragma unroll
    for (int r = 0; r < 16; ++r) st[r] = 0.f;
#pragma unroll
    for (int ds = 0; ds < 4; ++ds) st = __builtin_amdgcn_mfma_f32_32x32x16_bf16(kf[ds], qf[ds], st, 0, 0, 0);
    return st;
}
template <bool DIAG>
__device__ __forceinline__ void sb_weights(const f32x16& st, int qlim, float sel, float& carry, bf16x8& pw0, bf16x8& pw1) {
    float inc[16];
#pragma unroll
    for (int r = 0; r < 16; ++r) { const float z = st[r];
        float l = -(fmaxf(z, 0.f) + __builtin_amdgcn_logf(1.0f + __builtin_amdgcn_exp2f(-fabsf(z))));
        if (DIAG) l = ((r & 3) + 8 * (r >> 2) < qlim) ? l : 0.f;
        inc[r] = l; }
    float T[4], Ghi[4];
#pragma unroll
    for (int g = 0; g < 4; ++g) { inc[4 * g + 2] += inc[4 * g + 3]; inc[4 * g + 1] += inc[4 * g + 2]; inc[4 * g] += inc[4 * g + 1];
        const auto rr = __builtin_amdgcn_permlane32_swap(__float_as_uint(inc[4 * g]), __float_as_uint(inc[4 * g]), false, false);
        Ghi[g] = __uint_as_float(rr[1]); T[g] = __uint_as_float(rr[0]) + Ghi[g]; }
    float U[4]; U[3] = carry; U[2] = U[3] + T[3]; U[1] = U[2] + T[2]; U[0] = U[1] + T[1]; carry = U[0] + T[0];
    unsigned pk[8];
#pragma unroll
    for (int g = 0; g < 4; ++g) { const float base = fmaf(Ghi[g], sel, U[g]); float w[4];
#pragma unroll
        for (int i = 0; i < 4; ++i) { const int r = 4 * g + i; w[i] = __builtin_amdgcn_exp2f(st[r] + (inc[r] + base));
            if (DIAG) w[i] = ((r & 3) + 8 * (r >> 2) < qlim) ? w[i] : 0.f; }
        pk[2 * g] = cvtpk(w[0], w[1]); pk[2 * g + 1] = cvtpk(w[2], w[3]); }
    pw0 = __builtin_bit_cast(bf16x8, (v4u){pk[0], pk[1], pk[2], pk[3]}); pw1 = __builtin_bit_cast(bf16x8, (v4u){pk[4], pk[5], pk[6], pk[7]});
}
__device__ __forceinline__ void sb_pv(const LAS unsigned char* vrd, const bf16x8 pw0, const bf16x8 pw1, f32x16 (&oacc)[2]) {
#pragma unroll
    for (int c = 0; c < 2; ++c) {
        const s16x4 a0 = vtr(vrd + c * 2048), a1 = vtr(vrd + c * 2048 + 512), b0 = vtr(vrd + c * 2048 + 1024), b1 = vtr(vrd + c * 2048 + 1536);
        const bf16x8 v0 = (bf16x8){a0[0], a0[1], a0[2], a0[3], a1[0], a1[1], a1[2], a1[3]}, v1 = (bf16x8){b0[0], b0[1], b0[2], b0[3], b1[0], b1[1], b1[2], b1[3]};
        oacc[c] = __builtin_amdgcn_mfma_f32_32x32x16_bf16(v0, pw0, oacc[c], 0, 0, 0);
        oacc[c] = __builtin_amdgcn_mfma_f32_32x32x16_bf16(v1, pw1, oacc[c], 0, 0, 0); }
}

constexpr int MX_HS_OFF = NWAVES * ATT_VBYTES, MX_PS_OFF = MX_HS_OFF + 1024, MX_U_OFF = MX_PS_OFF + 1024;
static_assert(MX_U_OFF + 62 * 256 * 4 <= RING_BYTES, "mixer LDS map");
struct PcArgs { const bf16* P; bf16* O; const float* poolw; const float* pools; const float* convw; const float* convb; const float* lng; const float* lnb; const float* gng; };
__device__ __forceinline__ float sigm_mul(float val, float gate) { return val * __builtin_amdgcn_rcpf(1.0f + __builtin_amdgcn_exp2f(gate * -1.4426950408889634f)); }
__device__ __forceinline__ void mixer_phase(Frame& F, const PcArgs& A) {
    PHASE_IDS();
    const bf16* const P = A.P; bf16* const O = A.O;
    const int qi = lane & 31, hh = lane >> 5, h = wave;
    LAS unsigned char* const vimg = F.lds + RING_OFF + wave * ATT_VBYTES;
    LAS float* const hs = (LAS float*)(F.lds + RING_OFF + MX_HS_OFF);
    LAS float* const ps = (LAS float*)(F.lds + RING_OFF + MX_PS_OFF);
    LAS float* const ubuf = (LAS float*)(F.lds + RING_OFF + MX_U_OFF);
    const int vkey = lane >> 3, vch = lane & 7;
    LAS unsigned char* const vwr = vimg + (vch >> 2) * 2048 + vkey * 64 + (vch & 3) * 16;
    const LAS unsigned char* const vrd = vimg + (4 * hh + ((lane & 15) >> 2)) * 64 + ((lane >> 4) & 1) * 32 + (lane & 3) * 8;
    const float sel = hh ? 0.f : 1.f; const int qlim = qi - 4 * hh;
    const int pg = wave & 3, pdt = wave >> 2;
    bf16x8 wpf[4];
    { const float* wp = A.poolw + (size_t)pg * 64 * 64 + 32 * pdt + qi; const float psc = A.pools[pg * 64 + 32 * pdt + qi];
#pragma unroll
      for (int ks = 0; ks < 4; ++ks) { float w[8];
#pragma unroll
          for (int j = 0; j < 8; ++j) w[j] = wp[(size_t)(16 * ks + 8 * hh + j) * 64] * psc;
          wpf[ks] = __builtin_bit_cast(bf16x8, (v4u){cvtpk(w[0], w[1]), cvtpk(w[2], w[3]), cvtpk(w[4], w[5]), cvtpk(w[6], w[7])}); } }
    for (int u = vcu; u < T / 32; u += G) {
        const int r0 = u * 32, s0 = r0 % SEQ, nb1 = s0 >> 5;
        int ln = lane; asm volatile("" : "+v"(ln));
        const int hhu = ln >> 5;
        bf16x8 qf[4]; bf16x8 kA[4], kB[4]; v4u vA[4], vB[4];
        const bf16* qp = P + (size_t)(r0 + qi) * INC + PQ + h * 64 + 8 * hh;
#pragma unroll
        for (int ds = 0; ds < 4; ++ds) qf[ds] = *(const bf16x8*)(qp + 16 * ds);
        const bf16* const kp0 = P + (size_t)(r0 + qi) * INC + PK + h * 64 + 8 * hh;
        const bf16* const vp0 = P + (size_t)(r0 + vkey) * INC + PV + h * 64 + 8 * vch;
#define K_LOAD(KB, jj) do { asm volatile("" ::: "memory"); const int j_ = (jj) < nb1 ? (jj) : nb1; const bf16* kp_ = kp0 - (size_t)(32 * j_) * INC; \
        _Pragma("unroll") for (int ds = 0; ds < 4; ++ds) KB[ds] = *(const bf16x8*)(kp_ + 16 * ds); asm volatile("" ::: "memory"); } while (0)
#define V_LOAD(VB, jj) do { asm volatile("" ::: "memory"); const int j_ = (jj) < nb1 ? (jj) : nb1; const bf16* vp_ = vp0 - (size_t)(32 * j_) * INC; \
        _Pragma("unroll") for (int i = 0; i < 4; ++i) VB[i] = *(const v4u*)(vp_ + (size_t)(8 * i) * INC); asm volatile("" ::: "memory"); } while (0)
        K_LOAD(kA, 0); V_LOAD(vA, 0); K_LOAD(kB, 1); V_LOAD(vB, 1);
#pragma unroll
        for (int i = 0; i < 4; ++i) { const int idx = tid + 512 * i;
            if (idx < 62 * 32) { const int rr = idx >> 5, c8 = idx & 31; f32x4 u0 = {0.f, 0.f, 0.f, 0.f}, u1 = {0.f, 0.f, 0.f, 0.f};
                if (s0 - 30 + rr >= 0) { const bf16* rp = P + (size_t)(r0 - 30 + rr) * INC + 8 * c8; const v4u a = *(const v4u*)(rp + PCV), b = *(const v4u*)(rp + PCG);
                    u0 = (f32x4){sigm_mul(bflo(a.x), bflo(b.x)), sigm_mul(bfhi(a.x), bfhi(b.x)), sigm_mul(bflo(a.y), bflo(b.y)), sigm_mul(bfhi(a.y), bfhi(b.y))};
                    u1 = (f32x4){sigm_mul(bflo(a.z), bflo(b.z)), sigm_mul(bfhi(a.z), bfhi(b.z)), sigm_mul(bflo(a.w), bflo(b.w)), sigm_mul(bfhi(a.w), bfhi(b.w))}; }
                *(LAS f32x4*)(ubuf + rr * 256 + 8 * c8) = u0; *(LAS f32x4*)(ubuf + rr * 256 + 8 * c8 + 4) = u1; } }
        f32x16 oacc[2];
#pragma unroll
        for (int r = 0; r < 16; ++r) { oacc[0][r] = 0.f; oacc[1][r] = 0.f; }
        float carry = 0.f;
#define ATT_DONE(jj) ((jj) >= nb1 || __builtin_amdgcn_ballot_w64(carry >= W_EXIT) == 0ull)
#define ATT_BLOCK(KB, VB, jj, DIAGV) do { const f32x16 st_ = sb_qk(KB, qf); K_LOAD(KB, (jj) + 2); bf16x8 pw0_, pw1_; \
        if (DIAGV) sb_weights<true>(st_, qlim, sel, carry, pw0_, pw1_); else sb_weights<false>(st_, qlim, sel, carry, pw0_, pw1_); \
        _Pragma("unroll") for (int i = 0; i < 4; ++i) *(LAS v4u*)(vwr + i * 512) = VB[i]; V_LOAD(VB, (jj) + 2); \
        sb_pv(vrd, pw0_, pw1_, oacc); } while (0)
        for (int j = 0;; j += 2) {
            ATT_BLOCK(kA, vA, j, j == 0);
            if (ATT_DONE(j)) break;
            ATT_BLOCK(kB, vB, j + 1, false);
            if (ATT_DONE(j + 1)) break;
        }
#undef K_LOAD
#undef V_LOAD
#undef ATT_DONE
#undef ATT_BLOCK
        { float ss = 0.f;
#pragma unroll
          for (int r = 0; r < 16; ++r) ss += oacc[0][r] * oacc[0][r] + oacc[1][r] * oacc[1][r];
          const auto rr = __builtin_amdgcn_permlane32_swap(__float_as_uint(ss), __float_as_uint(ss), false, false); ss = __uint_as_float(rr[0]) + __uint_as_float(rr[1]);
          if (hh == 0) hs[wave * 32 + qi] = ss; }
        f32x16 pacc;
#pragma unroll
        for (int r = 0; r < 16; ++r) pacc[r] = 0.f;
        { const int s = s0 + qi, pwin = 2 << pg; const bf16* up = P + (size_t)(r0 + qi) * INC + PPOOL + pg * 64 + 8 * hh;
          float self[4][8], sum[4][8];
#pragma unroll
          for (int ks = 0; ks < 4; ++ks) { const v4u x = *(const v4u*)(up + 16 * ks);
              self[ks][0] = bflo(x.x); self[ks][1] = bfhi(x.x); self[ks][2] = bflo(x.y); self[ks][3] = bfhi(x.y); self[ks][4] = bflo(x.z); self[ks][5] = bfhi(x.z); self[ks][6] = bflo(x.w); self[ks][7] = bfhi(x.w);
#pragma unroll
              for (int j = 0; j < 8; ++j) sum[ks][j] = self[ks][j]; }
#pragma unroll 1
          for (int i0 = 1; i0 < pwin; i0 += 4) {
              v4u x[4][4];
#pragma unroll
              for (int d = 0; d < 4; ++d) { const int i = i0 + d; const int back = (i < pwin && i <= s) ? i : 0; const bf16* rp = up - (size_t)back * INC;
#pragma unroll
                  for (int ks = 0; ks < 4; ++ks) x[d][ks] = *(const v4u*)(rp + 16 * ks); }
#pragma unroll
              for (int d = 0; d < 4; ++d) { const int i = i0 + d; const float wg = (i < pwin && i <= s) ? 1.0f : 0.0f;
#pragma unroll
                  for (int ks = 0; ks < 4; ++ks) { const v4u y = x[d][ks];
                      sum[ks][0] += wg * bflo(y.x); sum[ks][1] += wg * bfhi(y.x); sum[ks][2] += wg * bflo(y.y); sum[ks][3] += wg * bfhi(y.y); sum[ks][4] += wg * bflo(y.z); sum[ks][5] += wg * bfhi(y.z); sum[ks][6] += wg * bflo(y.w); sum[ks][7] += wg * bfhi(y.w); } }
          }
          const int cnt = (s + 1 < pwin) ? s + 1 : pwin; const float rc = 1.0f / (float)cnt;
#pragma unroll
          for (int ks = 0; ks < 4; ++ks) {
#pragma unroll
              for (int j = 0; j < 8; ++j) sum[ks][j] = sum[ks][j] * rc - self[ks][j];
              const bf16x8 yf = __builtin_bit_cast(bf16x8, (v4u){cvtpk(sum[ks][0], sum[ks][1]), cvtpk(sum[ks][2], sum[ks][3]), cvtpk(sum[ks][4], sum[ks][5]), cvtpk(sum[ks][6], sum[ks][7])});
              pacc = __builtin_amdgcn_mfma_f32_32x32x16_bf16(wpf[ks], yf, pacc, 0, 0, 0); } }
        { float ss = 0.f;
#pragma unroll
          for (int r = 0; r < 16; ++r) ss += pacc[r] * pacc[r];
          const auto rr = __builtin_amdgcn_permlane32_swap(__float_as_uint(ss), __float_as_uint(ss), false, false); ss = __uint_as_float(rr[0]) + __uint_as_float(rr[1]);
          if (hh == 0) ps[wave * 32 + qi] = ss; }
        __syncthreads();
        { float tot = 0.f;
#pragma unroll
          for (int w = 0; w < 8; ++w) tot += hs[w * 32 + qi];
          const float rstd = 1.0f / sqrtf(tot * (1.0f / AW) + RMS_EPS);
          bf16* op = O + (size_t)(r0 + qi) * D + h * 64 + 4 * hh; const float* gp = A.gng + h * 64 + 4 * hhu;
#pragma unroll
          for (int c = 0; c < 2; ++c)
#pragma unroll
              for (int g = 0; g < 4; ++g) { const f32x4 gv = *(const f32x4*)(gp + 32 * c + 8 * g);
                  *(u32x2*)(op + 32 * c + 8 * g) = (u32x2){cvtpk(oacc[c][4 * g] * rstd * gv.x, oacc[c][4 * g + 1] * rstd * gv.y), cvtpk(oacc[c][4 * g + 2] * rstd * gv.z, oacc[c][4 * g + 3] * rstd * gv.w)}; } }
        { float tot = 0.f;
#pragma unroll
          for (int w = 0; w < 8; ++w) tot += ps[w * 32 + qi];
          const float rstd = 1.0f / sqrtf(tot * (1.0f / PW) + RMS_EPS);
          bf16* op = O + (size_t)(r0 + qi) * D + AW + pg * 64 + 32 * pdt + 4 * hh; const float* gp = A.gng + AW + pg * 64 + 32 * pdt + 4 * hhu;
#pragma unroll
          for (int g = 0; g < 4; ++g) { const f32x4 gv = *(const f32x4*)(gp + 8 * g);
              *(u32x2*)(op + 8 * g) = (u32x2){cvtpk(pacc[4 * g] * rstd * gv.x, pacc[4 * g + 1] * rstd * gv.y), cvtpk(pacc[4 * g + 2] * rstd * gv.z, pacc[4 * g + 3] * rstd * gv.w)}; } }
        { const unsigned loff16 = 16u * (unsigned)ln;
          f32x4 acc[4]; const f32x4 cb = *(const f32x4*)(A.convb + 4 * ln);
#pragma unroll
          for (int tk = 0; tk < 4; ++tk) acc[tk] = cb;
#pragma unroll
          for (int j0 = 0; j0 < 32; j0 += 8) { f32x4 w4[8];
#pragma unroll
              for (int jj = 0; jj < 8; ++jj) if (j0 + jj < CK) w4[jj] = *(const f32x4*)((const char*)(A.convw + (size_t)(j0 + jj) * CW) + loff16);
#pragma unroll
              for (int jj = 0; jj < 8; ++jj) if (j0 + jj < CK) {
#pragma unroll
                  for (int tk = 0; tk < 4; ++tk) { const f32x4 u4 = *(const LAS f32x4*)(ubuf + (4 * wave + tk + j0 + jj) * 256 + 4 * lane); acc[tk] += w4[jj] * u4; } }
              asm volatile("" ::: "memory"); }
          const f32x4 lg = *(const f32x4*)(A.lng + 4 * ln), lb = *(const f32x4*)(A.lnb + 4 * ln), gc = *(const f32x4*)(A.gng + AW + PW + 4 * ln);
#pragma unroll
          for (int tk = 0; tk < 4; ++tk) { const int tl = 4 * wave + tk; f32x4 v = acc[tk];
              const float mean = wave_sum((v.x + v.y) + (v.z + v.w)) * (1.0f / CW); v = v - mean;
              const float var = wave_sum((v.x * v.x + v.y * v.y) + (v.z * v.z + v.w * v.w)) * (1.0f / CW); const float rs = 1.0f / sqrtf(var + LN_EPS);
              v = v * rs * lg + lb;
              v.x = sigm_mul(v.x, v.x); v.y = sigm_mul(v.y, v.y); v.z = sigm_mul(v.z, v.z); v.w = sigm_mul(v.w, v.w);
              const float ss = wave_sum((v.x * v.x + v.y * v.y) + (v.z * v.z + v.w * v.w)); const float rstd = 1.0f / sqrtf(ss * (1.0f / CW) + RMS_EPS);
              *(u32x2*)(O + (size_t)(r0 + tl) * D + AW + PW + 4 * lane) = (u32x2){pk2(v.x * rstd * gc.x, v.y * rstd * gc.y), pk2(v.z * rstd * gc.z, v.w * rstd * gc.w)}; } }
        __syncthreads();
    }
}
constexpr int NPH = 1 + 8 * DEPTH;
struct Args { const float* in[N_IN]; float* out; unsigned char* ws; int ph_lo, ph_hi; };
__global__ void __launch_bounds__(NWAVES * 64, 2) fwd(Args args) {
    extern __shared__ __attribute__((aligned(16))) unsigned char lds[];
    Frame F;
    F.lds = (LAS unsigned char*)lds;
    F.MISC = (volatile LAS unsigned*)(F.lds + MISC_OFF);
    F.wave = __builtin_amdgcn_readfirstlane((int)(threadIdx.x >> 6));
    F.G = gridDim.x; { const int bx = blockIdx.x; F.vcu = (F.G % 8 == 0) ? (bx % 8) * (F.G / 8) + bx / 8 : bx; }
    for (int u = F.wave * 64 + lane_now(); u < (LDS_BYTES - LDSCTL_OFF) / 4; u += NWAVES * 64) ((LAS unsigned*)(F.lds + LDSCTL_OFF))[u] = 0u;
    __syncthreads();
    XcdBarrier bar; bar.bar = (unsigned*)(CTLPTR() + CW_BAR); bar.x = 0; bar.st = nullptr; bar.wv = F.wave;
    bar = xcd_barrier_post((unsigned*)(CTLPTR() + CW_BAR), F.MISC + 8, F.wave);
#ifndef REP_PRO
#define REP_PRO 1
#endif
#ifndef REP_INP
#define REP_INP 1
#endif
#ifndef REP_ATT
#define REP_ATT 1
#endif
#ifndef REP_PC
#define REP_PC 1
#endif
#ifndef REP_MGU
#define REP_MGU 1
#endif
#ifndef REP_MDN
#define REP_MDN 1
#endif
#ifndef REP_DGU
#define REP_DGU 1
#endif
#ifndef REP_NRM
#define REP_NRM 1
#endif
#ifndef REP_OUT
#define REP_OUT 1
#endif
#ifndef REP_DDN
#define REP_DDN 1
#endif
#ifndef REP_BAR
#define REP_BAR 1
#endif
#ifndef REP_ROW8
#define REP_ROW8 1
#endif
#ifndef REP_GAT
#define REP_GAT 1
#endif
#ifndef REP_FIN
#define REP_FIN 1
#endif
#define REPEAT(n) for (int rep_ = 0, nrep_ = opaque_int(n); rep_ < nrep_; ++rep_)
#define IN(k) true
#define SEAM(k) do { if ((k) + 1 < NPH) { REPEAT(REP_BAR) xcd_barrier(bar); } } while (0)
#define X ((bf16*)(ws + WS_X))
#define XN ((bf16*)(ws + WS_XN))
#define P ((bf16*)(ws + WS_P))
#define O ((bf16*)(ws + WS_O))
#define ACT ((bf16*)(ws + WS_ACT))
#define AP ((bf16*)(ws + WS_AP))
#define TOK_E ((int*)(ws + WS_TOKE))
#define TOK_R ((int*)(ws + WS_TOKR))
#define TOK_G ((float*)(ws + WS_TOKG))
#define TOK_S ((int*)(ws + WS_TOKS))
    if (F.G != 256) { fail_word(F.wave, 0x7f0u); return; }

    if (IN(0)) {
        unsigned char* const ws = WSPTR();
        REPEAT(REP_PRO) p0_weights(F);
        RowArgs A{}; A.xin = INP(I_X); A.xws = X; A.gain = INP(I_ANG); A.xn = XN;
        REPEAT(REP_ROW8) row_phase<8>(F, A);
        SEAM(0);
    }
#pragma unroll 1
    for (int l = 0; l < DEPTH; ++l) {
        const int pb = 1 + 8 * l, li = l >> 1; const bool moe = (l & 1) != 0;
        if (IN(pb + 0)) {
            unsigned char* const ws = WSPTR();
            pg8::Gemm g{XN, (const bf16*)(ws + WS_WIN) + (size_t)l * INC * D, T, INC, D, 0}; pg8::StaticOrder S; S.init(T, INC, opaque_int(F.G), opaque_int((int)blockIdx.x));
            pg8::EpiBf16<0> E{P, INC, nullptr, 0, 0, 1.f};
            REPEAT(REP_INP) pg8::gemm_phase<pg8::EpiBf16<0>, pg8::StaticOrder, true, true>(F.lds + RING_OFF, g, S, E, opaque_int(F.wave));
            { const int bx = opaque_int((int)blockIdx.x);
              if (bx >= 64) { const int rk = bx - 64; if (moe) moe_convert(F, li, CVT_C0 + CVT_C_PER * rk, CVT_C0 + CVT_C_PER * (rk + 1)); else moe_convert(F, li, CVT_A0 + CVT_A_PER * rk, CVT_A0 + CVT_A_PER * (rk + 1)); } }
            SEAM(pb + 0);
        }
        if (IN(pb + 1)) {
            unsigned char* const ws = WSPTR();
            PcArgs A{P, O, INP(I_POOLW) + (size_t)l * 4 * 64 * 64, INP(I_POOLS) + (size_t)l * PW, INP(I_CONVW) + (size_t)l * CK * CW, INP(I_CONVB) + (size_t)l * CW,
                     INP(I_LNG) + (size_t)l * CW, INP(I_LNB) + (size_t)l * CW, INP(I_GNG) + (size_t)l * D};
            REPEAT(REP_ATT) mixer_phase(F, A);
            SEAM(pb + 1);
        }
        if (IN(pb + 2)) {
            unsigned char* const ws = WSPTR();
            pg8::Gemm g{O, (const bf16*)(ws + WS_WOUT) + (size_t)l * D * D, T, D, D, 0}; pg8::StaticOrder S; S.init(T, D, opaque_int(F.G), opaque_int((int)blockIdx.x));
            pg8::EpiResid E{X, D};
            pg8::EpiResid Edummy{AP, D};
            REPEAT(REP_OUT) pg8::gemm_phase<pg8::EpiResid, pg8::StaticOrder, true, true>(F.lds + RING_OFF, g, S, rep_ + 1 < nrep_ ? Edummy : E, opaque_int(F.wave));
            SEAM(pb + 2);
        }
        if (IN(pb + 3)) {
            unsigned char* const ws = WSPTR();
            RowArgs A{}; A.xsrc = X; A.xws = X; A.gain = INP(I_FNG) + (size_t)l * D; A.xn = XN;
            if (moe) { A.wr = INP(I_RW) + (size_t)li * D * NE; A.gcur = CTLPTR() + CW_MOE + li * 1024; A.tok_e = TOK_E; A.tok_r = TOK_R; A.tok_g = TOK_G; row_phase<2>(F, A); }
            else REPEAT(REP_NRM) row_phase<0>(F, A);
            SEAM(pb + 3);
        }
        if (moe) {
            if (IN(pb + 4)) { unsigned char* const ws = WSPTR(); gu32* const gcur = CTLPTR() + CW_MOE + li * 1024; REPEAT(REP_GAT) gather_phase(F, gcur, XN, (unsigned char*)AP, TOK_E, TOK_R, TOK_S); SEAM(pb + 4); }
            if (IN(pb + 5)) {
                unsigned char* const ws = WSPTR(); gu32* const gcur = CTLPTR() + CW_MOE + li * 1024;
                int cnt[8], toff[9]; load_toff(gcur, cnt, toff);
                pg8::Gemm g{AP, (const bf16*)(ws + WS_WGUM + (size_t)li * NE * NGU * D), 0, NGU, D / 2, (size_t)NGU * D}; pg8::GroupedOrder S; S.init(toff, NGU, opaque_int(F.G), opaque_int((int)blockIdx.x));
                pg8::EpiSwiGLU8 E{(unsigned char*)ACT, FF, 1.0f / (WSCALE8 * XSCALE8), ASCALE8};
                REPEAT(REP_MGU) pg8::gemm_phase<pg8::EpiSwiGLU8, pg8::GroupedOrder, true, true, true>(F.lds + RING_OFF, g, S, E, opaque_int(F.wave));
                SEAM(pb + 5);
            }
            if (IN(pb + 6)) {
                unsigned char* const ws = WSPTR(); gu32* const gcur = CTLPTR() + CW_MOE + li * 1024;
                int cnt[8], toff[9]; load_toff(gcur, cnt, toff);
                pg8::Gemm g{ACT, (const bf16*)(ws + WS_WDM + (size_t)li * NE * D * FF), 0, D, FF / 2, (size_t)D * FF}; pg8::GroupedOrder S; S.init(toff, D, opaque_int(F.G), opaque_int((int)blockIdx.x));
                pg8::EpiBf16S E{AP, D, 1.0f / (WSCALE8 * ASCALE8)};
                REPEAT(REP_MDN) pg8::gemm_phase<pg8::EpiBf16S, pg8::GroupedOrder, true, true, true>(F.lds + RING_OFF, g, S, E, opaque_int(F.wave));
                SEAM(pb + 6);
            }
        } else {
            if (IN(pb + 5)) {
                unsigned char* const ws = WSPTR();
                pg8::Gemm g{XN, (const bf16*)(ws + WS_WGUD) + (size_t)li * NGU * D, T, NGU, D, 0}; pg8::StaticOrder S; S.init(T, NGU, opaque_int(F.G), opaque_int((int)blockIdx.x));
                pg8::EpiSwiGLU E{ACT, FF};
                REPEAT(REP_DGU) pg8::gemm_phase<pg8::EpiSwiGLU, pg8::StaticOrder, true, true>(F.lds + RING_OFF, g, S, E, opaque_int(F.wave));
                { const int bx = opaque_int((int)blockIdx.x);
                  if (bx >= 128) { const int rk = bx - 128; moe_convert(F, li, CVT_B0 + CVT_B_PER * rk, CVT_B0 + CVT_B_PER * (rk + 1)); } }
                SEAM(pb + 5);
            }
            if (IN(pb + 6)) {
                unsigned char* const ws = WSPTR();
                pg8::Gemm g{ACT, (const bf16*)(ws + WS_WDD) + (size_t)li * D * FF, T, D, FF, 0}; pg8::StaticOrder S; S.init(T, D, opaque_int(F.G), opaque_int((int)blockIdx.x));
                pg8::EpiResid E{X, D};
                pg8::EpiResid Edummy{AP, D};
                REPEAT(REP_DDN) pg8::gemm_phase<pg8::EpiResid, pg8::StaticOrder, true, true>(F.lds + RING_OFF, g, S, rep_ + 1 < nrep_ ? Edummy : E, opaque_int(F.wave));
                SEAM(pb + 6);
            }
        }
        if (IN(pb + 7)) {
            unsigned char* const ws = WSPTR();
            RowArgs A{}; A.xsrc = X; A.xws = X; A.xn = XN; A.out = OUTPTR(); A.yp = AP; A.tok_g = TOK_G; A.tok_s = TOK_S;
            A.gain = (l == DEPTH - 1) ? INP(I_FING) : INP(I_ANG) + (size_t)(l + 1) * D;
            if (l == DEPTH - 1) REPEAT(REP_FIN) row_phase<5>(F, A);
            else if (moe) row_phase<1>(F, A);
            else row_phase<0>(F, A);
            SEAM(pb + 7);
        }
    }
#undef IN
#undef SEAM
#undef X
#undef XN
#undef P
#undef O
#undef ACT
#undef AP
#undef TOK_E
#undef TOK_R
#undef TOK_G
#undef TOK_S
}

#ifndef MK_ONE_LAUNCH
#define MK_ONE_LAUNCH 0
#endif
extern "C" void kernel_launch(void* const* d_in, const int* in_sizes, int n_in, void* d_out, int out_size, void* d_ws, size_t ws_size, hipStream_t stream) {
    static int grid = 0;
    if (grid == 0) {
        if (n_in != N_IN || in_sizes[0] != T * D || out_size != T * D || ws_size < WS_END) { fprintf(stderr, "kernel_launch: unexpected problem shape (n_in %d, in0 %d, out %d, ws %zu); nothing launched\n", n_in, n_in > 0 ? in_sizes[0] : -1, out_size, ws_size); grid = -1; return; }
        if (hipFuncSetAttribute((const void*)fwd, hipFuncAttributeMaxDynamicSharedMemorySize, LDS_BYTES) != hipSuccess) { fprintf(stderr, "kernel_launch: hipFuncSetAttribute failed; nothing launched\n"); grid = -1; return; }
        int per_cu = 0;
        if (hipOccupancyMaxActiveBlocksPerMultiprocessor(&per_cu, (const void*)fwd, NWAVES * 64, LDS_BYTES) != hipSuccess || per_cu < 1)
            fprintf(stderr, "kernel_launch: note: occupancy query reports %d workgroups per CU\n", per_cu);
        (void)hipGetLastError();
        grid = 256;
    }
    if (grid < 0) return;
    if (hipMemsetAsync((char*)d_ws + WS_CTL, 0, CTL_ZERO_BYTES, stream) != hipSuccess) { fprintf(stderr, "kernel_launch: hipMemsetAsync failed; nothing launched\n"); return; }
    Args a{};
    for (int i = 0; i < N_IN; ++i) a.in[i] = (const float*)d_in[i];
    a.out = (float*)d_out; a.ws = (unsigned char*)d_ws;
    a.ph_lo = 0; a.ph_hi = NPH;
    hipLaunchKernelGGL(fwd, dim3(grid), dim3(NWAVES * 64), LDS_BYTES, stream, a);
    const hipError_t le = hipPeekAtLastError();
    if (le != hipSuccess) fprintf(stderr, "kernel_launch: launch failed: %s\n", hipGetErrorName(le));
}
```

```cpp
#include <hip/hip_runtime.h>
#include <cstdio>
#include <cstdint>
#include <cmath>
#define MK_ONE_LAUNCH 1
__device__ __forceinline__ int lane_now() { int l; asm volatile("v_mbcnt_lo_u32_b32 %0, -1, 0\n\tv_mbcnt_hi_u32_b32 %0, -1, %0" : "=v"(l)); return l; }
namespace pg8 {
#define PG8_LAS __attribute__((address_space(3)))
typedef unsigned short bf16_t;
typedef short bf16x8 __attribute__((ext_vector_type(8)));
typedef float f32x4 __attribute__((ext_vector_type(4)));
typedef unsigned u32x4 __attribute__((ext_vector_type(4)));
constexpr int BM = 256, BK = 64, HALF = 128, HTB = HALF * BK * 2  , STAGE_BYTES = 8 * HTB, NXCD = 8, WGM = 8;

__host__ __device__ __forceinline__ int lds_byte(int r, int c) { const int st = (r >> 4) * 2 + (c >> 5), rr = r & 15, cc = c & 31, ob = rr * 64 + cc * 2; return st * 1024 + (ob ^ (((ob >> 9) & 1) << 5)); }
__host__ __device__ __forceinline__ void stage_rc(int b, int& R, int& C) { const int st = b / 1024, sb = b % 1024, swz = sb ^ (((sb >> 9) & 1) << 5); R = (st >> 1) * 16 + swz / 64; C = (st & 1) * 32 + (swz % 64) / 2; }
__host__ __device__ __forceinline__ int perm32(int rho) { const int n = rho >> 4, i = rho & 15; return 8 * (i >> 2) + 4 * n + (i & 3); }

struct Unit { int pm, pn, e; };
struct Gemm { const bf16_t* A; const bf16_t* Bt; int M, N, K; size_t estride; };

struct StaticOrder {
    int nM, nN, nwg, G, c;
    __host__ __device__ void init(int M, int N, int G_, int c_) { nM = M / BM; nN = N / BM; nwg = nM * nN; G = G_; c = c_; }
    __host__ __device__ bool next(int i, Unit& u) const {
        const long L = (long)i * G + c; if (L >= nwg) return false;
        int wgid = (int)L; { const int q = nwg / NXCD, r = nwg % NXCD, xcd = wgid % NXCD, off = wgid / NXCD; wgid = (xcd < r ? xcd * (q + 1) : r * (q + 1) + (xcd - r) * q) + off; }
        const int nig = WGM * nN, gid = wgid / nig, fm = gid * WGM, gsz = (nM - fm) < WGM ? (nM - fm) : WGM;
        u.pm = fm + ((wgid % nig) % gsz); u.pn = (wgid % nig) / gsz; u.e = 0; return true;
    }
    __device__ __forceinline__ void a_ready(const Unit&) const {}
    __device__ __forceinline__ void done(const Unit&) const {}
};

__device__ __forceinline__ unsigned cvt_pk_bf16(float lo, float hi) { unsigned r; asm volatile("v_cvt_pk_bf16_f32 %0, %1, %2" : "=v"(r) : "v"(lo), "v"(hi)); return r; }
typedef float f32x2 __attribute__((ext_vector_type(2)));
__device__ __forceinline__ f32x2 gelu_pk(f32x2 v) {
    const f32x2 av = __builtin_elementwise_abs(v), d = av * 0.2316418882f + 1.0f;
    f32x2 t; t.x = __builtin_amdgcn_rcpf(d.x); t.y = __builtin_amdgcn_rcpf(d.y);
    f32x2 q = t * 0.5307027145f + (-0.7265760135f); q = q * t + 0.7107068705f; q = q * t + (-0.142248368f); q = q * t + 0.127414796f; q = q * t;
    const f32x2 s = (v * v) * (-0.72134752044f);
    f32x2 e; e.x = __builtin_amdgcn_exp2f(s.x); e.y = __builtin_amdgcn_exp2f(s.y);
    const f32x2 m = v * (q * e), r = v - m;
    f32x2 o; o.x = v.x < 0.f ? m.x : r.x; o.y = v.y < 0.f ? m.y : r.y; return o;
}

template <int ACT  > struct EpiBf16 {
    static constexpr bool PERM = true, AFTER_DRAIN = false; static_assert(ACT == 0 || ACT == 1, "EpiBf16: ACT is 0 (none) or 1 (gelu_pk)");
    bf16_t* O; int ldc; const float* bias; int split_cols; size_t split_stride; float scale0;
    __device__ __forceinline__ void operator()(const f32x4 (&acc)[2][2][4][2], const Unit& u, int wr, int wc, int fr, int fq) const {
        const int row0 = u.pm * BM + wr * 64 + fr; int colt = u.pn * BM; bf16_t* base = O;
        float sc = 1.f; if (split_cols) { const int t = colt / split_cols; base += (size_t)t * split_stride; colt -= t * split_cols; if (t == 0) sc = scale0; }
        const int col0 = colt + wc * 32 + 8 * fq, bcol0 = u.pn * BM + wc * 32 + 8 * fq;
        f32x4 bv[2][2];
#pragma unroll
        for (int bj = 0; bj < 2; ++bj)
#pragma unroll
            for (int n = 0; n < 2; ++n) bv[bj][n] = bias ? *(const f32x4*)(bias + bcol0 + bj * HALF + 4 * n) : (f32x4){0.f, 0.f, 0.f, 0.f};
#pragma unroll
        for (int ai = 0; ai < 2; ++ai)
#pragma unroll
            for (int m = 0; m < 4; ++m) { bf16_t* rowp = base + (size_t)(row0 + ai * HALF + m * 16) * ldc + col0;
#pragma unroll
                for (int bj = 0; bj < 2; ++bj) { f32x4 v0 = acc[ai][bj][m][0] + bv[bj][0], v1 = acc[ai][bj][m][1] + bv[bj][1];
                    if (ACT == 1) { f32x2 a = gelu_pk((f32x2){v0[0], v0[1]}), b = gelu_pk((f32x2){v0[2], v0[3]}), c = gelu_pk((f32x2){v1[0], v1[1]}), d = gelu_pk((f32x2){v1[2], v1[3]});
                        v0 = (f32x4){a.x, a.y, b.x, b.y}; v1 = (f32x4){c.x, c.y, d.x, d.y}; }
                    v0 = v0 * sc; v1 = v1 * sc; u32x4 w; w.x = cvt_pk_bf16(v0[0], v0[1]); w.y = cvt_pk_bf16(v0[2], v0[3]); w.z = cvt_pk_bf16(v1[0], v1[1]); w.w = cvt_pk_bf16(v1[2], v1[3]);
                    *(u32x4*)(rowp + bj * HALF) = w; } }
    }
};
struct EpiResid {
    static constexpr bool PERM = true, AFTER_DRAIN = false;
    bf16_t* X; int ldc;
    __device__ __forceinline__ void operator()(const f32x4 (&acc)[2][2][4][2], const Unit& u, int wr, int wc, int fr, int fq) const {
        const int row0 = u.pm * BM + wr * 64 + fr, col0 = u.pn * BM + wc * 32 + 8 * fq;
#pragma unroll
        for (int ai = 0; ai < 2; ++ai)
#pragma unroll
            for (int m = 0; m < 4; ++m) { bf16_t* rowp = X + (size_t)(row0 + ai * HALF + m * 16) * ldc + col0;
                u32x4 old[2];
#pragma unroll
                for (int bj = 0; bj < 2; ++bj) old[bj] = *(const u32x4*)(rowp + bj * HALF);
#pragma unroll
                for (int bj = 0; bj < 2; ++bj) { const f32x4 a0 = acc[ai][bj][m][0], a1 = acc[ai][bj][m][1]; const u32x4 o = old[bj]; u32x4 w;
                    w.x = cvt_pk_bf16(__builtin_bit_cast(float, o.x << 16) + a0[0], __builtin_bit_cast(float, o.x & 0xffff0000u) + a0[1]);
                    w.y = cvt_pk_bf16(__builtin_bit_cast(float, o.y << 16) + a0[2], __builtin_bit_cast(float, o.y & 0xffff0000u) + a0[3]);
                    w.z = cvt_pk_bf16(__builtin_bit_cast(float, o.z << 16) + a1[0], __builtin_bit_cast(float, o.z & 0xffff0000u) + a1[1]);
                    w.w = cvt_pk_bf16(__builtin_bit_cast(float, o.w << 16) + a1[2], __builtin_bit_cast(float, o.w & 0xffff0000u) + a1[3]);
                    *(u32x4*)(rowp + bj * HALF) = w; }
                asm volatile("" ::: "memory"); }
    }
};
__device__ __forceinline__ float silu_mul(float g, float u) { return g * __builtin_amdgcn_rcpf(1.0f + __builtin_amdgcn_exp2f(g * -1.4426950408889634f)) * u; }
struct EpiSwiGLU {
    static constexpr bool PERM = true, AFTER_DRAIN = false;
    bf16_t* O; int ldc;
    __device__ __forceinline__ void operator()(const f32x4 (&acc)[2][2][4][2], const Unit& u, int wr, int wc, int fr, int fq) const {
        const int row0 = u.pm * BM + wr * 64 + fr, col0 = u.pn * HALF + wc * 32 + 8 * fq;
#pragma unroll
        for (int ai = 0; ai < 2; ++ai)
#pragma unroll
            for (int m = 0; m < 4; ++m) { bf16_t* rowp = O + (size_t)(row0 + ai * HALF + m * 16) * ldc + col0;
                const f32x4 g0 = acc[ai][0][m][0], g1 = acc[ai][0][m][1], u0 = acc[ai][1][m][0], u1 = acc[ai][1][m][1];
                u32x4 w;
                w.x = cvt_pk_bf16(silu_mul(g0[0], u0[0]), silu_mul(g0[1], u0[1])); w.y = cvt_pk_bf16(silu_mul(g0[2], u0[2]), silu_mul(g0[3], u0[3]));
                w.z = cvt_pk_bf16(silu_mul(g1[0], u1[0]), silu_mul(g1[1], u1[1])); w.w = cvt_pk_bf16(silu_mul(g1[2], u1[2]), silu_mul(g1[3], u1[3]));
                *(u32x4*)rowp = w; }
    }
};
typedef int v4i_t __attribute__((ext_vector_type(4)));
typedef unsigned u32x2e __attribute__((ext_vector_type(2)));
__device__ __forceinline__ float clamp8(float v) { return __builtin_fminf(__builtin_fmaxf(v, -448.0f), 448.0f); }
__device__ __forceinline__ unsigned pack_fp8x4(float a, float b, float c, float d) { unsigned w = 0u; w = __builtin_amdgcn_cvt_pk_fp8_f32(clamp8(a), clamp8(b), w, false); w = __builtin_amdgcn_cvt_pk_fp8_f32(clamp8(c), clamp8(d), w, true); return w; }
struct EpiSwiGLU8 {
    static constexpr bool PERM = true, AFTER_DRAIN = false;
    unsigned char* O; int ldc; float sin, sout;
    __device__ __forceinline__ void operator()(const f32x4 (&acc)[2][2][4][2], const Unit& u, int wr, int wc, int fr, int fq) const {
        const int row0 = u.pm * BM + wr * 64 + fr, col0 = u.pn * HALF + wc * 32 + 8 * fq;
#pragma unroll
        for (int ai = 0; ai < 2; ++ai)
#pragma unroll
            for (int m = 0; m < 4; ++m) { unsigned char* rowp = O + (size_t)(row0 + ai * HALF + m * 16) * ldc + col0;
                const f32x4 g0 = acc[ai][0][m][0] * sin, g1 = acc[ai][0][m][1] * sin, u0 = acc[ai][1][m][0] * (sin * sout), u1 = acc[ai][1][m][1] * (sin * sout);
                u32x2e w;
                w.x = pack_fp8x4(silu_mul(g0[0], u0[0]), silu_mul(g0[1], u0[1]), silu_mul(g0[2], u0[2]), silu_mul(g0[3], u0[3]));
                w.y = pack_fp8x4(silu_mul(g1[0], u1[0]), silu_mul(g1[1], u1[1]), silu_mul(g1[2], u1[2]), silu_mul(g1[3], u1[3]));
                *(u32x2e*)rowp = w; }
    }
};
struct EpiBf16S {
    static constexpr bool PERM = true, AFTER_DRAIN = false;
    bf16_t* O; int ldc; float s;
    __device__ __forceinline__ void operator()(const f32x4 (&acc)[2][2][4][2], const Unit& u, int wr, int wc, int fr, int fq) const {
        const int row0 = u.pm * BM + wr * 64 + fr, col0 = u.pn * BM + wc * 32 + 8 * fq;
#pragma unroll
        for (int ai = 0; ai < 2; ++ai)
#pragma unroll
            for (int m = 0; m < 4; ++m) { bf16_t* rowp = O + (size_t)(row0 + ai * HALF + m * 16) * ldc + col0;
#pragma unroll
                for (int bj = 0; bj < 2; ++bj) { const f32x4 v0 = acc[ai][bj][m][0] * s, v1 = acc[ai][bj][m][1] * s;
                    u32x4 w; w.x = cvt_pk_bf16(v0[0], v0[1]); w.y = cvt_pk_bf16(v0[2], v0[3]); w.z = cvt_pk_bf16(v1[0], v1[1]); w.w = cvt_pk_bf16(v1[2], v1[3]);
                    *(u32x4*)(rowp + bj * HALF) = w; } }
    }
};
struct GroupedOrder {
    int nM, nN, nwg, G, c; int t1, t2, t3, t4, t5, t6, t7;
    __device__ __forceinline__ void init(const int (&toff)[9], int N, int G_, int c_) { nM = toff[8]; nN = N / BM; nwg = nM * nN; G = G_; c = c_;
        t1 = toff[1]; t2 = toff[2]; t3 = toff[3]; t4 = toff[4]; t5 = toff[5]; t6 = toff[6]; t7 = toff[7]; }
    __device__ __forceinline__ bool next(int i, Unit& u) const {
        const long L = (long)i * G + c; if (L >= nwg) return false;
        int wgid = (int)L; { const int q = nwg / NXCD, r = nwg % NXCD, xcd = wgid % NXCD, off = wgid / NXCD; wgid = (xcd < r ? xcd * (q + 1) : r * (q + 1) + (xcd - r) * q) + off; }
        const int nig = WGM * nN, gid = wgid / nig, fm = gid * WGM, gsz = (nM - fm) < WGM ? (nM - fm) : WGM;
        u.pm = fm + ((wgid % nig) % gsz); u.pn = (wgid % nig) / gsz;
        int e_ = 0; e_ = (u.pm >= t1) ? 1 : e_; e_ = (u.pm >= t2) ? 2 : e_; e_ = (u.pm >= t3) ? 3 : e_; e_ = (u.pm >= t4) ? 4 : e_; e_ = (u.pm >= t5) ? 5 : e_; e_ = (u.pm >= t6) ? 6 : e_; e_ = (u.pm >= t7) ? 7 : e_;
        u.e = e_; return true;
    }
    __device__ __forceinline__ void a_ready(const Unit&) const {}
    __device__ __forceinline__ void done(const Unit&) const {}
};
template <class Epi, class Sched, bool ALIGN_EPI = false, bool SP2 = false, bool F8 = false>
__device__ __forceinline__ void gemm_phase(PG8_LAS unsigned char* lds, const Gemm g, const Sched& S, const Epi& E, const int wave_u  ) {
    const int tid_ = wave_u * 64 + lane_now();
    const int tid = tid_, wid = wave_u, lane = tid & 63, wr = wid >> 2, wc = wid & 3, fr = lane & 15, fq = lane >> 4;
    const int K = g.K, nt = K / BK;
    unsigned voffA[2], voffB[2];
#pragma unroll
    for (int i = 0; i < 2; ++i) { int R, C; stage_rc(tid * 16 + i * 8192, R, C); const int Rb = Epi::PERM ? ((R & ~31) + perm32(R & 31)) : R;
        voffA[i] = (unsigned)(R * K + C) * 2u; voffB[i] = (unsigned)(Rb * K + C) * 2u; }
    const size_t kstep = (size_t)(BK * 2);
    const size_t hstep = (size_t)HALF * K * 2;
    const size_t tstep = 2 * hstep;
    const unsigned ldsw = (unsigned)wid * 1024u;
    const unsigned ldsbase = (unsigned)(uintptr_t)lds + ldsw;
    const int aoff = lds_byte(wr * 64 + fr, fq * 8), boff = lds_byte(wc * 32 + fr, fq * 8);
#define PG8_SA(b, h) (((b) * 2 + (h)) * HTB)
#define PG8_SB(b, h) ((4 + (b) * 2 + (h)) * HTB)
#define PG8_GLDS(sbase, voff32, ldsdst) do { unsigned keep_; asm volatile("s_mov_b32 %0, m0\n\ts_mov_b32 m0, %3\n\ts_nop 0\n\tglobal_load_lds_dwordx4 %1, %2\n\ts_mov_b32 m0, %0" \
        : "=&s"(keep_) : "v"(voff32), "s"(sbase), "s"(ldsdst) : "memory"); } while (0)
#define PG8_STAGE(bufoff, gbase, voff) do { _Pragma("unroll") for (int _i = 0; _i < 2; ++_i) \
        PG8_GLDS((const char*)(gbase), (voff)[_i], (unsigned)__builtin_amdgcn_readfirstlane((int)(ldsbase + (unsigned)((bufoff) + _i * 8192)))); } while (0)
#define PG8_LDA(dst, b, h) do { _Pragma("unroll") for (int m = 0; m < 4; ++m) _Pragma("unroll") for (int k = 0; k < 2; ++k) dst[m][k] = *(const PG8_LAS bf16x8*)(lds + PG8_SA(b, h) + aoff + m * 2048 + k * 1024); } while (0)
#define PG8_LDB(dst, b, h) do { _Pragma("unroll") for (int n = 0; n < 2; ++n) _Pragma("unroll") for (int k = 0; k < 2; ++k) dst[n][k] = *(const PG8_LAS bf16x8*)(lds + PG8_SB(b, h) + boff + n * 2048 + k * 1024); } while (0)
#define PG8_CAT8(a, b) __builtin_shufflevector(__builtin_bit_cast(v4i_t, (a)), __builtin_bit_cast(v4i_t, (b)), 0, 1, 2, 3, 4, 5, 6, 7)
#define PG8_MMA(ai, bj, At, Bt) do { __builtin_amdgcn_s_setprio(1); if constexpr (F8) { _Pragma("unroll") for (int m = 0; m < 4; ++m) _Pragma("unroll") for (int n = 0; n < 2; ++n) \
        acc[ai][bj][m][n] = __builtin_amdgcn_mfma_scale_f32_16x16x128_f8f6f4(PG8_CAT8(Bt[n][0], Bt[n][1]), PG8_CAT8(At[m][0], At[m][1]), acc[ai][bj][m][n], 0, 0, 0, 0, 0, 0); } else { \
        _Pragma("unroll") for (int m = 0; m < 4; ++m) _Pragma("unroll") for (int n = 0; n < 2; ++n) _Pragma("unroll") for (int k = 0; k < 2; ++k) \
        acc[ai][bj][m][n] = __builtin_amdgcn_mfma_f32_16x16x32_bf16(Bt[n][k], At[m][k], acc[ai][bj][m][n], 0, 0, 0); } __builtin_amdgcn_s_setprio(0); } while (0)
#define PG8_WAIT_V(n) asm volatile("s_waitcnt vmcnt(" #n ")" ::: "memory")
#define PG8_WAIT_L(n) asm volatile("s_waitcnt lgkmcnt(" #n ")" ::: "memory")
#define PG8_BAR __builtin_amdgcn_s_barrier()
#define PG8_SCHED __builtin_amdgcn_sched_barrier(0)
    Unit cur, nxt; int ui = 0;
    if (!S.next(0, cur)) return;
    f32x4 acc[2][2][4][2];
#pragma unroll
    for (int a = 0; a < 2; ++a)
#pragma unroll
        for (int b = 0; b < 2; ++b)
#pragma unroll
            for (int m = 0; m < 4; ++m)
#pragma unroll
                for (int n = 0; n < 2; ++n) acc[a][b][m][n] = (f32x4){0.f, 0.f, 0.f, 0.f};
    bf16x8 At[4][2], B0[2][2], B1[2][2];
    const char* cA = (const char*)g.A + (size_t)cur.pm * tstep; const char* cB = (const char*)g.Bt + (size_t)cur.e * g.estride + (size_t)cur.pn * tstep;
    S.a_ready(cur);
    if constexpr (SP2) {
        PG8_STAGE(PG8_SB(0, 0), cB, voffB); PG8_STAGE(PG8_SB(0, 1), cB + hstep, voffB); PG8_STAGE(PG8_SA(0, 0), cA, voffA); PG8_STAGE(PG8_SA(0, 1), cA + hstep, voffA);
        if (wr == 1) PG8_BAR;
        PG8_WAIT_V(2); PG8_BAR;
        PG8_STAGE(PG8_SB(1, 0), cB + kstep, voffB); PG8_STAGE(PG8_SA(1, 0), cA + kstep, voffA); PG8_STAGE(PG8_SB(1, 1), cB + hstep + kstep, voffB);
        PG8_WAIT_V(6); PG8_BAR;
    } else {
        PG8_STAGE(PG8_SB(0, 0), cB, voffB); PG8_STAGE(PG8_SA(0, 0), cA, voffA); PG8_STAGE(PG8_SB(0, 1), cB + hstep, voffB); PG8_STAGE(PG8_SA(0, 1), cA + hstep, voffA);
        if (wr == 1) PG8_BAR;
        PG8_WAIT_V(4); PG8_BAR;
        PG8_STAGE(PG8_SB(1, 0), cB + kstep, voffB); PG8_STAGE(PG8_SA(1, 0), cA + kstep, voffA); PG8_STAGE(PG8_SB(1, 1), cB + hstep + kstep, voffB);
        PG8_WAIT_V(6); PG8_BAR;
    }
    for (;;) {
        const bool has_next = S.next(ui + 1, nxt);
        const char* nA = has_next ? (const char*)g.A + (size_t)nxt.pm * tstep : cA; const char* nB = has_next ? (const char*)g.Bt + (size_t)nxt.e * g.estride + (size_t)nxt.pn * tstep : cB;
        for (int t = 0; t < nt; t += 2) {
            const bool last = (t == nt - 2);
            const char* a1 = cA + (size_t)(t + 1) * kstep;
            const char* a2 = last ? nA : cA + (size_t)(t + 2) * kstep; const char* b2 = last ? nB : cB + (size_t)(t + 2) * kstep;
            const char* a3 = a2 + kstep; const char* b3 = b2 + kstep;
            if (last && has_next) S.a_ready(nxt);
            if constexpr (SP2) {
            PG8_LDB(B0, 0, 0); PG8_LDB(B1, 0, 1); PG8_SCHED; PG8_LDA(At, 0, 0); PG8_STAGE(PG8_SA(1, 1), a1 + hstep, voffA);
            PG8_WAIT_V(8); PG8_WAIT_L(0); PG8_BAR; PG8_MMA(0, 0, At, B0); PG8_MMA(0, 1, At, B1); PG8_BAR; PG8_SCHED;
            PG8_LDA(At, 0, 1); PG8_STAGE(PG8_SB(0, 0), b2, voffB); PG8_STAGE(PG8_SB(0, 1), b2 + hstep, voffB); PG8_STAGE(PG8_SA(0, 0), a2, voffA);
            PG8_WAIT_V(8); PG8_WAIT_L(0); PG8_BAR; PG8_MMA(1, 0, At, B0); PG8_MMA(1, 1, At, B1); PG8_BAR; PG8_SCHED;
            PG8_LDB(B0, 1, 0); PG8_LDB(B1, 1, 1); PG8_SCHED; PG8_LDA(At, 1, 0); PG8_STAGE(PG8_SA(0, 1), a2 + hstep, voffA);
            PG8_WAIT_V(8); PG8_WAIT_L(0); PG8_BAR; PG8_MMA(0, 0, At, B0); PG8_MMA(0, 1, At, B1); PG8_BAR; PG8_SCHED;
            PG8_LDA(At, 1, 1); PG8_STAGE(PG8_SB(1, 0), b3, voffB); PG8_STAGE(PG8_SB(1, 1), b3 + hstep, voffB); PG8_STAGE(PG8_SA(1, 0), a3, voffA);
            PG8_WAIT_V(8); PG8_WAIT_L(0); PG8_BAR; PG8_MMA(1, 0, At, B0); PG8_MMA(1, 1, At, B1); PG8_BAR; PG8_SCHED;
            } else {
            PG8_LDB(B0, 0, 0); PG8_SCHED; PG8_LDA(At, 0, 0); PG8_STAGE(PG8_SA(1, 1), a1 + hstep, voffA);
            PG8_WAIT_L(8); PG8_BAR; PG8_WAIT_L(0); PG8_MMA(0, 0, At, B0); PG8_BAR; PG8_SCHED;
            PG8_LDB(B1, 0, 1); PG8_STAGE(PG8_SB(0, 0), b2, voffB);
            PG8_BAR; PG8_WAIT_L(0); PG8_MMA(0, 1, At, B1); PG8_BAR;
            PG8_LDA(At, 0, 1); PG8_STAGE(PG8_SA(0, 0), a2, voffA);
            PG8_BAR; PG8_WAIT_L(0); PG8_MMA(1, 0, At, B0); PG8_BAR; PG8_SCHED;
            PG8_STAGE(PG8_SB(0, 1), b2 + hstep, voffB);
            PG8_WAIT_V(6); PG8_BAR; PG8_MMA(1, 1, At, B1); PG8_BAR;
            PG8_LDB(B0, 1, 0); PG8_SCHED; PG8_LDA(At, 1, 0); PG8_STAGE(PG8_SA(0, 1), a2 + hstep, voffA);
            PG8_WAIT_L(8); PG8_BAR; PG8_WAIT_L(0); PG8_MMA(0, 0, At, B0); PG8_BAR; PG8_SCHED;
            PG8_LDB(B1, 1, 1); PG8_STAGE(PG8_SB(1, 0), b3, voffB);
            PG8_BAR; PG8_WAIT_L(0); PG8_MMA(0, 1, At, B1); PG8_BAR;
            PG8_LDA(At, 1, 1); PG8_STAGE(PG8_SA(1, 0), a3, voffA);
            PG8_BAR; PG8_WAIT_L(0); PG8_MMA(1, 0, At, B0); PG8_BAR; PG8_SCHED;
            PG8_STAGE(PG8_SB(1, 1), b3 + hstep, voffB);
            PG8_WAIT_V(6); PG8_BAR; PG8_MMA(1, 1, At, B1); PG8_BAR;
            }
        }
        if constexpr (ALIGN_EPI) { if (wr == 0) PG8_BAR; }
        if constexpr (!Epi::AFTER_DRAIN) { const int le_ = lane_now(); E(acc, cur, wr, wc, le_ & 15, le_ >> 4); S.done(cur); }
        if (!has_next) break;
#pragma unroll
        for (int a = 0; a < 2; ++a)
#pragma unroll
            for (int b = 0; b < 2; ++b)
#pragma unroll
                for (int m = 0; m < 4; ++m)
#pragma unroll
                    for (int n = 0; n < 2; ++n) acc[a][b][m][n] = (f32x4){0.f, 0.f, 0.f, 0.f};
        cur = nxt; cA = nA; cB = nB; ++ui;
        if constexpr (ALIGN_EPI) { if (wr == 1) PG8_BAR; }
    }
    PG8_WAIT_V(0);
    if constexpr (!ALIGN_EPI) { if (wr == 0) PG8_BAR; }
    PG8_BAR;
    if constexpr (Epi::AFTER_DRAIN) { E.fused(acc, cur, wr, wc, fr, fq, lds, wid, lane); S.done(cur); }
#undef PG8_SA
#undef PG8_SB
#undef PG8_STAGE
#undef PG8_GLDS
#undef PG8_LDA
#undef PG8_LDB
#undef PG8_MMA
#undef PG8_CAT8
#undef PG8_WAIT_V
#undef PG8_WAIT_L
#undef PG8_BAR
#undef PG8_SCHED
}
}
#define GAS __attribute__((address_space(1)))
#define LAS __attribute__((address_space(3)))
typedef unsigned short bf16;
typedef unsigned v4u __attribute__((ext_vector_type(4)));
typedef float f32x4 __attribute__((ext_vector_type(4)));
typedef short bf16x8 __attribute__((ext_vector_type(8)));
typedef GAS unsigned gu32;
typedef GAS unsigned long long gu64;
#define RLX_AGENT __ATOMIC_RELAXED, __HIP_MEMORY_SCOPE_AGENT
#define LDS_WAIT() asm volatile("s_waitcnt lgkmcnt(0)" ::: "memory")
#define VM_WAIT() asm volatile("s_waitcnt vmcnt(0)" ::: "memory")
__device__ __forceinline__ unsigned long long rt() { return __builtin_amdgcn_s_memrealtime(); }
__device__ __forceinline__ unsigned f2bf(float f) { unsigned u = __builtin_bit_cast(unsigned, f); return (u + 0x7fffu + ((u >> 16) & 1u)) >> 16; }
__device__ __forceinline__ unsigned pk2(float lo, float hi) { return f2bf(lo) | (f2bf(hi) << 16); }

#define XB_TMO      128
#define XB_XCNT(j)  (256  + 64 * (j))
#define XB_XSUB(j)  (1280 + 64 * (j))
#define XB_XGEN(j)  (2304 + 64 * (j))
#define XB_TOP      3328
#define XB_TOPGEN   3392
#define XCD_BAR_WORDS 3456
#define XB_SPIN_CAP (1u << 18)

__device__ __forceinline__ unsigned xb_ld(unsigned* p)              { return __hip_atomic_load(p, __ATOMIC_RELAXED, __HIP_MEMORY_SCOPE_AGENT); }
__device__ __forceinline__ unsigned xb_add(unsigned* p, unsigned v) { return __hip_atomic_fetch_add(p, v, __ATOMIC_RELAXED, __HIP_MEMORY_SCOPE_AGENT); }
__device__ __forceinline__ unsigned xb_xcc_id() { return (unsigned)__builtin_amdgcn_s_getreg((3 << 11) | 20) & 0xFu; }
#define XB_SPIN(cond, bar) do { unsigned _sp = 0; while (cond) { __builtin_amdgcn_s_sleep(1); \
    if ((++_sp & 255u) == 0u) { if (xb_ld(&(bar)[XB_TMO])) break; if (_sp > XB_SPIN_CAP) { atomicAdd(&(bar)[XB_TMO], 1u); break; } } } } while (0)

struct XcdBarrier {
    int wv;
    unsigned* bar; unsigned x;
    volatile LAS unsigned* st;
};

__device__ __forceinline__ XcdBarrier xcd_barrier_post(unsigned* bar, volatile LAS unsigned* st, int wv) {
    XcdBarrier b; b.bar = bar; b.x = xb_xcc_id(); b.st = st; b.wv = wv;
    if (wv == 0 && lane_now() == 0) (void)xb_add(&bar[XB_XCNT(b.x)], 1u);
    return b;
}
__device__ __forceinline__ void xcd_barrier_complete(unsigned* bar, unsigned x, unsigned& nloc, unsigned& nx) {
    const unsigned G = gridDim.x * gridDim.y * gridDim.z;
    unsigned sum, cnt, mine, sp = 0u;
    for (;;) {
        sum = 0u; cnt = 0u; mine = 0u;
#pragma unroll
        for (unsigned j = 0; j < 16; ++j) { const unsigned c = xb_ld(&bar[XB_XCNT(j)]); sum += c; cnt += (c > 0u) ? 1u : 0u; mine = (j == x) ? c : mine; }
        if (sum == G) break;
        __builtin_amdgcn_s_sleep(1);
        if ((++sp & 255u) == 0u) { if (xb_ld(&bar[XB_TMO])) break; if (sp > XB_SPIN_CAP) { atomicAdd(&bar[XB_TMO], 1u); break; } }
    }
    nloc = mine > 0u ? mine : 1u; nx = cnt > 0u ? cnt : 1u;
}

__device__ __forceinline__ void xcd_barrier(const XcdBarrier& b) {
    asm volatile("s_waitcnt vmcnt(0)" ::: "memory");
    __syncthreads();
    int wv_ = b.wv; asm volatile("" : "+s"(wv_));
    if (wv_ == 0 && lane_now() == 0) {
        unsigned* bar = b.bar;
        __builtin_amdgcn_s_waitcnt(0);
        unsigned nloc = b.st[0], nx = b.st[1];
        if (nloc == 0u) { xcd_barrier_complete(bar, b.x, nloc, nx); b.st[0] = nloc; b.st[1] = nx; }
        const unsigned old = xb_add(&bar[XB_XSUB(b.x)], 1u);
        const unsigned gen = old / nloc;
        if (old + 1u == (gen + 1u) * nloc) {
            __builtin_amdgcn_fence(__ATOMIC_RELEASE, "agent");
            asm volatile("s_waitcnt vmcnt(0)" ::: "memory");
            const unsigned og = xb_add(&bar[XB_TOP], 1u);
            const unsigned tg = og / nx;
            if (og + 1u == (tg + 1u) * nx) xb_add(&bar[XB_TOPGEN], 1u);
            else XB_SPIN(xb_ld(&bar[XB_TOPGEN]) == tg, bar);
            __builtin_amdgcn_fence(__ATOMIC_ACQUIRE, "agent");
            xb_add(&bar[XB_XGEN(b.x)], 1u);
            asm volatile("s_waitcnt vmcnt(0)" ::: "memory");
        } else {
            XB_SPIN(xb_ld(&bar[XB_XGEN(b.x)]) == gen, bar);
            __builtin_amdgcn_fence(__ATOMIC_ACQUIRE, "agent");
            asm volatile("s_waitcnt vmcnt(0)" ::: "memory");
        }
    }
    __syncthreads();
}
constexpr int NWAVES = 8;
constexpr int BATCH = 8, SEQ = 2048, D = 1024, T = BATCH * SEQ, DEPTH = 4;
constexpr int NH = 8, HD = 64, AW = 512, PW = 256, CW = 256, INC = 2304, CK = 31;
constexpr int FF = 2816, NE = 8, NGU = 2 * FF;
constexpr int MAXSLOT = 2 * T + NE * 256;
constexpr float RMS_EPS = 1e-6f, LN_EPS = 1e-5f;
constexpr float QSCALE = 0.125f * 1.4426950408889634f;
#ifndef W_EXIT_V
#define W_EXIT_V -40.0f
#endif
constexpr float W_EXIT = W_EXIT_V;
constexpr int PQ = 0, PK = 512, PV = 1024, PPOOL = 1536, PCV = 1792, PCG = 2048;
enum { I_X = 0, I_ANG, I_WIN, I_POOLW, I_POOLS, I_CONVW, I_CONVB, I_LNG, I_LNB, I_GNG, I_WOUT, I_FNG, I_DWG, I_DWU, I_DWD, I_RW, I_MWG, I_MWU, I_MWD, I_FING, N_IN };

constexpr size_t MiB = 1u << 20;
constexpr size_t WS_CTL = 0, CTL_ZERO_BYTES = 1 * MiB;
constexpr size_t WS_TOKE = 1 * MiB, WS_TOKR = WS_TOKE + 128 * 1024, WS_TOKG = WS_TOKR + 128 * 1024, WS_TOKS = WS_TOKG + 128 * 1024;
constexpr size_t WS_WIN = 4 * MiB;
constexpr size_t WS_WOUT = 22 * MiB;
constexpr size_t WS_WGUD = 30 * MiB;
constexpr size_t WS_WDD = 52 * MiB;
constexpr size_t WS_WGUM = 64 * MiB;
constexpr size_t WS_WDM = 240 * MiB;
constexpr size_t WS_X = 328 * MiB;
constexpr size_t WS_XN = 392 * MiB;
constexpr size_t WS_P = 424 * MiB;
constexpr size_t WS_O = 496 * MiB;
constexpr size_t WS_ACT = 424 * MiB;
constexpr size_t WS_AP = 611 * MiB;
constexpr size_t WS_END = 679 * MiB;
static_assert(WS_WIN + (size_t)4 * INC * D * 2 <= WS_WOUT && WS_WOUT + (size_t)4 * D * D * 2 <= WS_WGUD && WS_WGUD + (size_t)2 * NGU * D * 2 <= WS_WDD && WS_WDD + (size_t)2 * D * FF * 2 <= WS_WGUM, "ws map 1");
static_assert(WS_WGUM + (size_t)16 * NGU * D * 2 <= WS_WDM && WS_WDM + (size_t)16 * D * FF * 2 <= WS_X && WS_X + (size_t)T * D * 4 <= WS_XN && WS_XN + (size_t)T * D * 2 <= WS_P, "ws map 2");
static_assert(WS_P + (size_t)T * INC * 2 <= WS_O && WS_O + (size_t)T * D * 2 <= WS_AP && WS_ACT + (size_t)MAXSLOT * FF * 2 <= WS_AP && WS_AP + (size_t)MAXSLOT * D * 2 <= WS_END, "ws map 3");
constexpr int CW_TMO = 0, CW_CODE = 1;
constexpr int CW_BAR = 4096;
constexpr int CW_MOE = 8192;

constexpr int RING_OFF = 0, RING_BYTES = 131072;
constexpr int LDSCTL_OFF = RING_BYTES, MISC_OFF = LDSCTL_OFF + 320;
constexpr int LDS_BYTES = 147456;
typedef unsigned u32x2 __attribute__((ext_vector_type(2)));
struct Frame {
    LAS unsigned char* lds;
    volatile LAS unsigned* MISC;
    int vcu, G, wave;
};
__device__ __forceinline__ int opaque_int(int n) { asm volatile("" : "+s"(n)); return n; }
#define PHASE_IDS() const int wave = opaque_int(F.wave), vcu = opaque_int(F.vcu), G = opaque_int(F.G), lane = lane_now(), tid = wave * 64 + lane; (void)tid; (void)lane; (void)wave; (void)vcu; (void)G
template <int I> __device__ __forceinline__ const float* inp() { unsigned long long v; asm volatile("s_load_dwordx2 %0, %1, %2\n\ts_waitcnt lgkmcnt(0)" : "=&s"(v) : "s"(__builtin_amdgcn_kernarg_segment_ptr()), "n"(I * 8));
    return (const float*)(const GAS float*)v; }
#define INP(i) inp<(i)>()
#define OUTPTR() ((float*)const_cast<float*>(inp<N_IN>()))
#define WSPTR() ((unsigned char*)const_cast<float*>(inp<N_IN + 1>()))
#define CTLPTR() ((gu32*)WSPTR())
__device__ __forceinline__ float bf2f(bf16 b) { return __uint_as_float((unsigned)b << 16); }
__device__ __forceinline__ float bflo(unsigned w) { return __uint_as_float(w << 16); }
__device__ __forceinline__ float bfhi(unsigned w) { return __uint_as_float(w & 0xffff0000u); }
template <int CTRL> __device__ __forceinline__ float dpp_add(float v) { return v + __builtin_bit_cast(float, __builtin_amdgcn_update_dpp(0, __builtin_bit_cast(int, v), CTRL, 0xf, 0xf, true)); }
__device__ __forceinline__ float wave_sum(float v) {
    v = dpp_add<0xB1>(v); v = dpp_add<0x4E>(v); v = dpp_add<0x141>(v); v = dpp_add<0x140>(v);
    v += __builtin_bit_cast(float, __builtin_amdgcn_ds_swizzle(__builtin_bit_cast(int, v), 0x401F));
    const auto rr = __builtin_amdgcn_permlane32_swap(__float_as_uint(v), __float_as_uint(v), false, false); return __uint_as_float(rr[0]) + __uint_as_float(rr[1]);
}
__device__ __forceinline__ void fail_word(int wave, unsigned code) {
    if (wave == 0 && lane_now() == 0) { gu32* ctl = CTLPTR(); unsigned expect = 0u; __hip_atomic_compare_exchange_strong((unsigned*)(ctl + CW_CODE), &expect, code, __ATOMIC_RELAXED, __ATOMIC_RELAXED, __HIP_MEMORY_SCOPE_AGENT);
        __hip_atomic_store(ctl + CW_TMO, 1u, RLX_AGENT); }
}

__device__ __forceinline__ void transpose_item(const float* W, int K, int N, bf16* WT, int mode, int nscale, int item, int lane) {
    const int nblk = N / 64, kb = item / nblk, nb = item % nblk, k0 = 64 * kb, n0 = 64 * nb, kq = lane >> 4, nq = lane & 15;
    const GAS f32x4* src = (const GAS f32x4*)(W + (size_t)(k0 + 8 * kq) * N + n0 + 4 * nq);
    f32x4 v[16];
#pragma unroll
    for (int i = 0; i < 16; ++i) v[i] = src[(size_t)((i & 7) + 32 * (i >> 3)) * (N / 4)];
    const int r0 = (mode == 0) ? n0 : (256 * (n0 >> 7) + (n0 & 127) + (mode == 2 ? 128 : 0));
    const float sc = (n0 < nscale) ? QSCALE : 1.0f;
#pragma unroll
    for (int j = 0; j < 4; ++j) { GAS v4u* dst = (GAS v4u*)(WT + (size_t)(r0 + 4 * nq + j) * K + k0 + 8 * kq);
#pragma unroll
        for (int hf = 0; hf < 2; ++hf) { v4u o;
            o.x = pk2(v[8 * hf + 0][j] * sc, v[8 * hf + 1][j] * sc); o.y = pk2(v[8 * hf + 2][j] * sc, v[8 * hf + 3][j] * sc);
            o.z = pk2(v[8 * hf + 4][j] * sc, v[8 * hf + 5][j] * sc); o.w = pk2(v[8 * hf + 6][j] * sc, v[8 * hf + 7][j] * sc);
            dst[4 * hf] = o; } }
}
constexpr float WSCALE8 = 64.0f, XSCALE8 = 16.0f, ASCALE8 = 16.0f;
__device__ __forceinline__ float clamp8f(float v) { return fminf(fmaxf(v, -448.0f), 448.0f); }
__device__ __forceinline__ unsigned pack8(float a, float b, float c, float d) { unsigned w = 0u; w = __builtin_amdgcn_cvt_pk_fp8_f32(clamp8f(a), clamp8f(b), w, false); w = __builtin_amdgcn_cvt_pk_fp8_f32(clamp8f(c), clamp8f(d), w, true); return w; }
__device__ __forceinline__ void transpose_item8(const float* W, int K, int N, unsigned char* WT, int mode, int item, int lane) {
    const int nblk = N / 64, kb = item / nblk, nb = item % nblk, k0 = 64 * kb, n0 = 64 * nb, kq = lane >> 4, nq = lane & 15;
    const GAS f32x4* src = (const GAS f32x4*)(W + (size_t)(k0 + 16 * kq) * N + n0 + 4 * nq);
    f32x4 v[16];
#pragma unroll
    for (int i = 0; i < 16; ++i) v[i] = src[(size_t)i * (N / 4)];
    const int r0 = (mode == 0) ? n0 : (256 * (n0 >> 7) + (n0 & 127) + (mode == 2 ? 128 : 0));
#pragma unroll
    for (int j = 0; j < 4; ++j) { v4u o;
        o.x = pack8(v[0][j] * WSCALE8, v[1][j] * WSCALE8, v[2][j] * WSCALE8, v[3][j] * WSCALE8); o.y = pack8(v[4][j] * WSCALE8, v[5][j] * WSCALE8, v[6][j] * WSCALE8, v[7][j] * WSCALE8);
        o.z = pack8(v[8][j] * WSCALE8, v[9][j] * WSCALE8, v[10][j] * WSCALE8, v[11][j] * WSCALE8); o.w = pack8(v[12][j] * WSCALE8, v[13][j] * WSCALE8, v[14][j] * WSCALE8, v[15][j] * WSCALE8);
        *(GAS v4u*)(WT + (size_t)(r0 + 4 * nq + j) * K + k0 + 16 * kq) = o; }
}
__device__ __forceinline__ void p0_weights(Frame& F) {
    PHASE_IDS(); unsigned char* const ws = WSPTR();
    const int gw = vcu * NWAVES + wave, NGW = G * NWAVES;
    constexpr int I_IN = (D / 64) * (INC / 64), I_OUT = (D / 64) * (D / 64), I_GU = (D / 64) * (FF / 64), I_DN = (FF / 64) * (D / 64);
    constexpr int N0 = 4 * I_IN, N1 = N0 + 4 * I_OUT, N2 = N1 + 2 * I_GU, N3 = N2 + 2 * I_GU, N4 = N3 + 2 * I_DN, N5 = N4 + 16 * I_GU, N6 = N5 + 16 * I_GU, N7 = N6 + 16 * I_DN;
    bf16* const win = (bf16*)(ws + WS_WIN); bf16* const wout = (bf16*)(ws + WS_WOUT); bf16* const wgud = (bf16*)(ws + WS_WGUD); bf16* const wdd = (bf16*)(ws + WS_WDD);
#pragma unroll 1
    for (int it = gw; it < N4; it += NGW) {
        if (it < N0) { const int l = it / I_IN, r = it % I_IN; transpose_item(INP(I_WIN) + (size_t)l * D * INC, D, INC, win + (size_t)l * INC * D, 0, 512, r, lane); }
        else if (it < N1) { const int q = it - N0, l = q / I_OUT, r = q % I_OUT; transpose_item(INP(I_WOUT) + (size_t)l * D * D, D, D, wout + (size_t)l * D * D, 0, 0, r, lane); }
        else if (it < N2) { const int q = it - N1, l = q / I_GU, r = q % I_GU; transpose_item(INP(I_DWG) + (size_t)l * D * FF, D, FF, wgud + (size_t)l * NGU * D, 1, 0, r, lane); }
        else if (it < N3) { const int q = it - N2, l = q / I_GU, r = q % I_GU; transpose_item(INP(I_DWU) + (size_t)l * D * FF, D, FF, wgud + (size_t)l * NGU * D, 2, 0, r, lane); }
        else { const int q = it - N3, l = q / I_DN, r = q % I_DN; transpose_item(INP(I_DWD) + (size_t)l * FF * D, FF, D, wdd + (size_t)l * D * FF, 0, 0, r, lane); }
    }
}

constexpr int MOE_ITEMS_MAT = (D / 64) * (FF / 64), MOE_ITEMS = 24 * MOE_ITEMS_MAT;
constexpr int CVT_A0 = 0, CVT_A_PER = 35, CVT_B0 = 192 * CVT_A_PER, CVT_B_PER = 35, CVT_C0 = CVT_B0 + 128 * CVT_B_PER, CVT_C_PER = (MOE_ITEMS - CVT_C0 + 191) / 192;
static_assert(CVT_C0 < MOE_ITEMS && CVT_C0 + 192 * CVT_C_PER >= MOE_ITEMS && CVT_C_PER <= 40, "conversion slots cover the list");
__device__ __forceinline__ void moe_convert(Frame& F, int li, int i0, int i1) {
    PHASE_IDS(); unsigned char* const ws = WSPTR();
    unsigned char* const wgum = ws + WS_WGUM + (size_t)li * NE * NGU * D; unsigned char* const wdm = ws + WS_WDM + (size_t)li * NE * D * FF;
    if (i1 > MOE_ITEMS) i1 = MOE_ITEMS;
#pragma unroll 1
    for (int q = i0 + wave; q < i1; q += NWAVES) {
        const int m = q / MOE_ITEMS_MAT, r = q % MOE_ITEMS_MAT, e = m & 7, le = li * NE + e;
        if (m < 8) transpose_item8(INP(I_MWG) + (size_t)le * D * FF, D, FF, wgum + (size_t)e * NGU * D, 1, r, lane);
        else if (m < 16) transpose_item8(INP(I_MWU) + (size_t)le * D * FF, D, FF, wgum + (size_t)e * NGU * D, 2, r, lane);
        else transpose_item8(INP(I_MWD) + (size_t)le * FF * D, FF, D, wdm + (size_t)e * D * FF, 0, r, lane);
    }
}

struct RowArgs { const float* xin; const bf16* xsrc; bf16* xws; const float* gain; bf16* xn; float* out; const bf16* yp; const float* wr; gu32* gcur;
                 int* tok_e; int* tok_r; float* tok_g; const int* tok_s; };
template <int MODE>
__device__ __forceinline__ void row_phase(Frame& F, const RowArgs& A) {
    constexpr bool COMBINE = MODE & 1, ROUTER = (MODE & 2) != 0, FINAL = (MODE & 4) != 0, COPYIN = (MODE & 8) != 0;
    LAS int* s_cnt = (LAS int*)(F.lds + RING_OFF);
    LAS int* s_base = s_cnt + 8;
    LAS int* s_e = s_cnt + 16;
    LAS int* s_rk = s_e + 128;
    LAS float* s_g = (LAS float*)(s_rk + 128);
    PHASE_IDS();
    if (ROUTER) { if (tid < 16) s_cnt[tid] = 0; __syncthreads(); }
#pragma unroll 1
    for (int i = 0; i < 8; ++i) {
        const int rl = wave * 8 + i, m = vcu * 64 + rl;
        f32x4 v[4];
        if (COPYIN) { const GAS f32x4* xr = (const GAS f32x4*)(A.xin + (size_t)m * D) + lane;
#pragma unroll
            for (int j = 0; j < 4; ++j) v[j] = xr[64 * j]; }
        else { const GAS u32x2* xr = (const GAS u32x2*)(A.xsrc + (size_t)m * D) + lane;
#pragma unroll
            for (int j = 0; j < 4; ++j) { const u32x2 w = xr[64 * j]; v[j] = (f32x4){bflo(w.x), bfhi(w.x), bflo(w.y), bfhi(w.y)}; } }
        if (COMBINE) {
            const int s0 = A.tok_s[2 * m], s1 = A.tok_s[2 * m + 1]; const float g0 = A.tok_g[2 * m], g1 = A.tok_g[2 * m + 1];
            const GAS u32x2* y0 = (const GAS u32x2*)(A.yp + (size_t)s0 * D) + lane; const GAS u32x2* y1 = (const GAS u32x2*)(A.yp + (size_t)s1 * D) + lane;
#pragma unroll
            for (int j = 0; j < 4; ++j) { const u32x2 a = y0[64 * j], b = y1[64 * j];
                v[j].x += g0 * bflo(a.x) + g1 * bflo(b.x); v[j].y += g0 * bfhi(a.x) + g1 * bfhi(b.x); v[j].z += g0 * bflo(a.y) + g1 * bflo(b.y); v[j].w += g0 * bfhi(a.y) + g1 * bfhi(b.y); }
        }
        if ((COMBINE && !FINAL) || COPYIN) { GAS u32x2* xw = (GAS u32x2*)(A.xws + (size_t)m * D) + lane;
#pragma unroll
            for (int j = 0; j < 4; ++j) xw[64 * j] = (u32x2){pk2(v[j].x, v[j].y), pk2(v[j].z, v[j].w)}; }
        float ss = 0.f;
#pragma unroll
        for (int j = 0; j < 4; ++j) ss += (v[j].x * v[j].x + v[j].y * v[j].y) + (v[j].z * v[j].z + v[j].w * v[j].w);
        const float rstd = 1.0f / sqrtf(wave_sum(ss) * (1.0f / D) + RMS_EPS);
        const GAS f32x4* gr = (const GAS f32x4*)A.gain + lane;
#pragma unroll
        for (int j = 0; j < 4; ++j) v[j] = v[j] * rstd * gr[64 * j];
        if (FINAL) { GAS f32x4* o = (GAS f32x4*)(A.out + (size_t)m * D) + lane;
#pragma unroll
            for (int j = 0; j < 4; ++j) o[64 * j] = v[j]; }
        else { GAS u32x2* o = (GAS u32x2*)(A.xn + (size_t)m * D) + lane;
#pragma unroll
            for (int j = 0; j < 4; ++j) o[64 * j] = (u32x2){pk2(v[j].x, v[j].y), pk2(v[j].z, v[j].w)}; }
        if (ROUTER) {
            float lg[8];
#pragma unroll
            for (int e = 0; e < 8; ++e) lg[e] = 0.f;
#pragma unroll
            for (int j = 0; j < 4; ++j)
#pragma unroll
                for (int q = 0; q < 4; ++q) { const GAS f32x4* w = (const GAS f32x4*)(A.wr + (size_t)(256 * j + 4 * lane + q) * 8); const f32x4 w0 = w[0], w1 = w[1]; const float h = v[j][q];
                    lg[0] += h * w0.x; lg[1] += h * w0.y; lg[2] += h * w0.z; lg[3] += h * w0.w; lg[4] += h * w1.x; lg[5] += h * w1.y; lg[6] += h * w1.z; lg[7] += h * w1.w; }
#pragma unroll
            for (int e = 0; e < 8; ++e) lg[e] = wave_sum(lg[e]);
            int e1 = 0; float v1 = lg[0];
#pragma unroll
            for (int e = 1; e < 8; ++e) if (lg[e] > v1) { v1 = lg[e]; e1 = e; }
            int e2 = -1; float v2 = -INFINITY;
#pragma unroll
            for (int e = 0; e < 8; ++e) if (e != e1 && (e2 < 0 || lg[e] > v2)) { v2 = lg[e]; e2 = e; }
            const float g1 = 1.0f / (1.0f + __expf(v2 - v1)), g2 = 1.0f - g1;
            if (lane == 0) { const int r1 = atomicAdd((int*)(s_cnt + e1), 1), r2 = atomicAdd((int*)(s_cnt + e2), 1);
                s_e[2 * rl] = e1; s_e[2 * rl + 1] = e2; s_rk[2 * rl] = r1; s_rk[2 * rl + 1] = r2; s_g[2 * rl] = g1; s_g[2 * rl + 1] = g2; }
        }
    }
    if (ROUTER) {
        __syncthreads();
        if (tid < 8) s_base[tid] = (int)__hip_atomic_fetch_add(A.gcur + 64 * tid, (unsigned)s_cnt[tid], RLX_AGENT);
        __syncthreads();
        if (tid < 128) { const int m2 = vcu * 128 + tid; const int e = s_e[tid]; A.tok_e[m2] = e; A.tok_r[m2] = s_base[e] + s_rk[tid]; A.tok_g[m2] = s_g[tid]; }
        __syncthreads();
    }
}

__device__ __forceinline__ void load_toff(gu32* gcur, int (&cnt)[8], int (&toff)[9]) {
    toff[0] = 0;
#pragma unroll
    for (int e = 0; e < 8; ++e) { cnt[e] = (int)__builtin_amdgcn_readfirstlane(__hip_atomic_load(gcur + 64 * e, RLX_AGENT)); toff[e + 1] = toff[e] + ((cnt[e] + 255) >> 8); }
}
__device__ __forceinline__ void gather_phase(Frame& F, gu32* gcur, const bf16* xn, unsigned char* ap, const int* tok_e, const int* tok_r, int* tok_s) {
    PHASE_IDS();
    int cnt[8], toff[9]; load_toff(gcur, cnt, toff);
#pragma unroll 1
    for (int i = 0; i < 8; ++i) {
        const int m = vcu * 64 + wave * 8 + i;
        const GAS v4u* src = (const GAS v4u*)(xn + (size_t)m * D) + 2 * lane; const v4u a = src[0], b = src[1];
        v4u o;
        o.x = pack8(bflo(a.x) * XSCALE8, bfhi(a.x) * XSCALE8, bflo(a.y) * XSCALE8, bfhi(a.y) * XSCALE8); o.y = pack8(bflo(a.z) * XSCALE8, bfhi(a.z) * XSCALE8, bflo(a.w) * XSCALE8, bfhi(a.w) * XSCALE8);
        o.z = pack8(bflo(b.x) * XSCALE8, bfhi(b.x) * XSCALE8, bflo(b.y) * XSCALE8, bfhi(b.y) * XSCALE8); o.w = pack8(bflo(b.z) * XSCALE8, bfhi(b.z) * XSCALE8, bflo(b.w) * XSCALE8, bfhi(b.w) * XSCALE8);
#pragma unroll
        for (int k = 0; k < 2; ++k) {
            const int e = tok_e[2 * m + k], r = tok_r[2 * m + k];
            int base = 0;
#pragma unroll
            for (int q = 0; q < 8; ++q) base = (e == q) ? toff[q] : base;
            const int slot = base * 256 + r;
            if (lane == 0) tok_s[2 * m + k] = slot;
            *((GAS v4u*)(ap + (size_t)slot * D) + lane) = o;
        }
    }
    const int gw = vcu * NWAVES + wave, NGW = G * NWAVES;
#pragma unroll
    for (int e = 0; e < 8; ++e) {
        for (int r = toff[e] * 256 + cnt[e] + gw; r < toff[e + 1] * 256; r += NGW) { unsigned z = 0u; asm volatile("" : "+v"(z)); *((GAS v4u*)(ap + (size_t)r * D) + lane) = (v4u){z, z, z, z}; }
    }
}

typedef float f32x16 __attribute__((ext_vector_type(16)));
typedef short s16x4 __attribute__((ext_vector_type(4)));
typedef short v4i16_t __attribute__((ext_vector_type(4)));
typedef float f32x2_t __attribute__((ext_vector_type(2))); typedef __bf16 bf16x2_t __attribute__((ext_vector_type(2)));
__device__ __forceinline__ unsigned cvtpk(float lo, float hi) { f32x2_t v = {lo, hi}; bf16x2_t b = __builtin_convertvector(v, bf16x2_t); return __builtin_bit_cast(unsigned, b); }
__device__ __forceinline__ s16x4 vtr(const LAS unsigned char* p) { return __builtin_bit_cast(s16x4, __builtin_amdgcn_ds_read_tr16_b64_v4i16((LAS v4i16_t*)p)); }
constexpr int ATT_VBYTES = 4096;
constexpr int ATT_HS_OFF = NWAVES * ATT_VBYTES;

__device__ __forceinline__ f32x16 sb_qk(const bf16x8 (&kf)[4], const bf16x8 (&qf)[4]) {
    f32x16 st;
#pragma unroll
    for (int r = 0; r < 16; ++r) st[r] = 0.f;
#pragma unroll
    for (int ds = 0; ds < 4; ++ds) st = __builtin_amdgcn_mfma_f32_32x32x16_bf16(kf[ds], qf[ds], st, 0, 0, 0);
    return st;
}
template <bool DIAG>
__device__ __forceinline__ void sb_weights(const f32x16& st, int qlim, float sel, float& carry, bf16x8& pw0, bf16x8& pw1) {
    float inc[16];
#pragma unroll
    for (int r = 0; r < 16; ++r) { const float z = st[r];
        float l = -(fmaxf(z, 0.f) + __builtin_amdgcn_logf(1.0f + __builtin_amdgcn_exp2f(-fabsf(z))));
        if (DIAG) l = ((r & 3) + 8 * (r >> 2) < qlim) ? l : 0.f;
        inc[r] = l; }
    float T[4], Ghi[4];
#pragma unroll
    for (int g = 0; g < 4; ++g) { inc[4 * g + 2] += inc[4 * g + 3]; inc[4 * g + 1] += inc[4 * g + 2]; inc[4 * g] += inc[4 * g + 1];
        const auto rr = __builtin_amdgcn_permlane32_swap(__float_as_uint(inc[4 * g]), __float_as_uint(inc[4 * g]), false, false);
        Ghi[g] = __uint_as_float(rr[1]); T[g] = __uint_as_float(rr[0]) + Ghi[g]; }
    float U[4]; U[3] = carry; U[2] = U[3] + T[3]; U[1] = U[2] + T[2]; U[0] = U[1] + T[1]; carry = U[0] + T[0];
    unsigned pk[8];
#pragma unroll
    for (int g = 0; g < 4; ++g) { const float base = fmaf(Ghi[g], sel, U[g]); float w[4];
#pragma unroll
        for (int i = 0; i < 4; ++i) { const int r = 4 * g + i; w[i] = __builtin_amdgcn_exp2f(st[r] + (inc[r] + base));
            if (DIAG) w[i] = ((r & 3) + 8 * (r >> 2) < qlim) ? w[i] : 0.f; }
        pk[2 * g] = cvtpk(w[0], w[1]); pk[2 * g + 1] = cvtpk(w[2], w[3]); }
    pw0 = __builtin_bit_cast(bf16x8, (v4u){pk[0], pk[1], pk[2], pk[3]}); pw1 = __builtin_bit_cast(bf16x8, (v4u){pk[4], pk[5], pk[6], pk[7]});
}
__device__ __forceinline__ void sb_pv(const LAS unsigned char* vrd, const bf16x8 pw0, const bf16x8 pw1, f32x16 (&oacc)[2]) {
#pragma unroll
    for (int c = 0; c < 2; ++c) {
        const s16x4 a0 = vtr(vrd + c * 2048), a1 = vtr(vrd + c * 2048 + 512), b0 = vtr(vrd + c * 2048 + 1024), b1 = vtr(vrd + c * 2048 + 1536);
        const bf16x8 v0 = (bf16x8){a0[0], a0[1], a0[2], a0[3], a1[0], a1[1], a1[2], a1[3]}, v1 = (bf16x8){b0[0], b0[1], b0[2], b0[3], b1[0], b1[1], b1[2], b1[3]};
        oacc[c] = __builtin_amdgcn_mfma_f32_32x32x16_bf16(v0, pw0, oacc[c], 0, 0, 0);
        oacc[c] = __builtin_amdgcn_mfma_f32_32x32x16_bf16(v1, pw1, oacc[c], 0, 0, 0); }
}

constexpr int MX_KV = 4608, MX_HS_OFF = NWAVES * MX_KV, MX_PS_OFF = MX_HS_OFF + 1024, MX_PT_OFF = MX_PS_OFF + 1024, MX_PT_ROW = 144, MX_PT_G = 47 * MX_PT_ROW, MX_U_OFF = MX_PT_OFF + 4 * MX_PT_G;
static_assert(MX_U_OFF % 16 == 0 && MX_U_OFF + 62 * 256 * 4 <= RING_BYTES, "mixer LDS map");
struct PcArgs { const bf16* P; bf16* O; const float* poolw; const float* pools; const float* convw; const float* convb; const float* lng; const float* lnb; const float* gng; };
__device__ __forceinline__ float sigm_mul(float val, float gate) { return val * __builtin_amdgcn_rcpf(1.0f + __builtin_amdgcn_exp2f(gate * -1.4426950408889634f)); }
__device__ __forceinline__ void mixer_phase(Frame& F, const PcArgs& A) {
    PHASE_IDS();
    const bf16* const P = A.P; bf16* const O = A.O;
    const int qi = lane & 31, hh = lane >> 5, h = wave;
    LAS unsigned char* const vimg = F.lds + RING_OFF + wave * MX_KV;
    LAS float* const hs = (LAS float*)(F.lds + RING_OFF + MX_HS_OFF);
    LAS float* const ps = (LAS float*)(F.lds + RING_OFF + MX_PS_OFF);
    LAS unsigned char* const ptile = F.lds + RING_OFF + MX_PT_OFF;
    LAS float* const ubuf = (LAS float*)(F.lds + RING_OFF + MX_U_OFF);
    const int vkey = lane >> 3, vch = lane & 7;
    LAS unsigned char* const vwr = vimg + (vch >> 2) * 2048 + vkey * 64 + (vch & 3) * 16;
    const LAS unsigned char* const vrd = vimg + (4 * hh + ((lane & 15) >> 2)) * 64 + ((lane >> 4) & 1) * 32 + (lane & 3) * 8;
    LAS unsigned char* const kwr = vimg + vkey * 144 + vch * 16;
    const LAS unsigned char* const krd = vimg + qi * 144 + hh * 16;
    const float sel = hh ? 0.f : 1.f; const int qlim = qi - 4 * hh;
    const int pg = wave & 3, pdt = wave >> 2;
    bf16x8 wpf[4];
    { const float* wp = A.poolw + (size_t)pg * 64 * 64 + 32 * pdt + qi; const float psc = A.pools[pg * 64 + 32 * pdt + qi];
#pragma unroll
      for (int ks = 0; ks < 4; ++ks) { float w[8];
#pragma unroll
          for (int j = 0; j < 8; ++j) w[j] = wp[(size_t)(16 * ks + 8 * hh + j) * 64] * psc;
          wpf[ks] = __builtin_bit_cast(bf16x8, (v4u){cvtpk(w[0], w[1]), cvtpk(w[2], w[3]), cvtpk(w[4], w[5]), cvtpk(w[6], w[7])}); } }
    for (int u = vcu; u < T / 32; u += G) {
        const int r0 = u * 32, s0 = r0 % SEQ, nb1 = s0 >> 5;
        int ln = lane; asm volatile("" : "+v"(ln));
        const int hhu = ln >> 5, tidu = wave * 64 + ln;
        bf16x8 qf[4]; v4u kA[4], kB[4], vA[4], vB[4];
        const bf16* qp = P + (size_t)(r0 + qi) * INC + PQ + h * 64 + 8 * hh;
#pragma unroll
        for (int ds = 0; ds < 4; ++ds) qf[ds] = *(const bf16x8*)(qp + 16 * ds);
        const bf16* const kp0 = P + (size_t)(r0 + vkey) * INC + PK + h * 64 + 8 * vch;
        const bf16* const vp0 = P + (size_t)(r0 + vkey) * INC + PV + h * 64 + 8 * vch;
#define K_LOAD(KB, jj) do { asm volatile("" ::: "memory"); const int j_ = (jj) < nb1 ? (jj) : nb1; const bf16* kp_ = kp0 - (size_t)(32 * j_) * INC; \
        _Pragma("unroll") for (int i = 0; i < 4; ++i) KB[i] = *(const v4u*)(kp_ + (size_t)(8 * i) * INC); asm volatile("" ::: "memory"); } while (0)
#define V_LOAD(VB, jj) do { asm volatile("" ::: "memory"); const int j_ = (jj) < nb1 ? (jj) : nb1; const bf16* vp_ = vp0 - (size_t)(32 * j_) * INC; \
        _Pragma("unroll") for (int i = 0; i < 4; ++i) VB[i] = *(const v4u*)(vp_ + (size_t)(8 * i) * INC); asm volatile("" ::: "memory"); } while (0)
        K_LOAD(kA, 0); V_LOAD(vA, 0); K_LOAD(kB, 1); V_LOAD(vB, 1);
#pragma unroll
        for (int i = 0; i < 4; ++i) { const int idx = tidu + 512 * i;
            if (idx < 62 * 32) { const int rr = idx >> 5, c8 = idx & 31; f32x4 u0 = {0.f, 0.f, 0.f, 0.f}, u1 = {0.f, 0.f, 0.f, 0.f};
                if (s0 - 30 + rr >= 0) { const bf16* rp = P + (size_t)(r0 - 30 + rr) * INC + 8 * c8; const v4u a = *(const v4u*)(rp + PCV), b = *(const v4u*)(rp + PCG);
                    u0 = (f32x4){sigm_mul(bflo(a.x), bflo(b.x)), sigm_mul(bfhi(a.x), bfhi(b.x)), sigm_mul(bflo(a.y), bflo(b.y)), sigm_mul(bfhi(a.y), bfhi(b.y))};
                    u1 = (f32x4){sigm_mul(bflo(a.z), bflo(b.z)), sigm_mul(bfhi(a.z), bfhi(b.z)), sigm_mul(bflo(a.w), bflo(b.w)), sigm_mul(bfhi(a.w), bfhi(b.w))}; }
                *(LAS f32x4*)(ubuf + rr * 256 + 8 * c8) = u0; *(LAS f32x4*)(ubuf + rr * 256 + 8 * c8 + 4) = u1; } }
#pragma unroll
        for (int i = 0; i < 3; ++i) { const int idx = tidu + 512 * i;
            if (idx < 47 * 32) { const int rr = idx >> 5, c32 = idx & 31; v4u x = {0u, 0u, 0u, 0u};
                if (s0 - 15 + rr >= 0) x = *(const v4u*)(P + (size_t)(r0 - 15 + rr) * INC + PPOOL + 8 * c32);
                *(LAS v4u*)(ptile + (c32 >> 3) * MX_PT_G + rr * MX_PT_ROW + (c32 & 7) * 16) = x; } }
        __syncthreads();
        f32x16 oacc[2];
#pragma unroll
        for (int r = 0; r < 16; ++r) { oacc[0][r] = 0.f; oacc[1][r] = 0.f; }
        float carry = 0.f;
#define ATT_DONE(jj) ((jj) >= nb1 || __builtin_amdgcn_ballot_w64(carry >= W_EXIT) == 0ull)
#define ATT_BLOCK(KB, VB, jj, DIAGV) do { _Pragma("unroll") for (int i = 0; i < 4; ++i) *(LAS v4u*)(kwr + i * (8 * 144)) = KB[i]; K_LOAD(KB, (jj) + 2); \
        bf16x8 kf_[4]; _Pragma("unroll") for (int ds = 0; ds < 4; ++ds) kf_[ds] = *(const LAS bf16x8*)(krd + 32 * ds); \
        const f32x16 st_ = sb_qk(kf_, qf); bf16x8 pw0_, pw1_; \
        if (DIAGV) sb_weights<true>(st_, qlim, sel, carry, pw0_, pw1_); else sb_weights<false>(st_, qlim, sel, carry, pw0_, pw1_); \
        _Pragma("unroll") for (int i = 0; i < 4; ++i) *(LAS v4u*)(vwr + i * 512) = VB[i]; V_LOAD(VB, (jj) + 2); \
        sb_pv(vrd, pw0_, pw1_, oacc); } while (0)
        for (int j = 0;; j += 2) {
            ATT_BLOCK(kA, vA, j, j == 0);
            if (ATT_DONE(j)) break;
            ATT_BLOCK(kB, vB, j + 1, false);
            if (ATT_DONE(j + 1)) break;
        }
#undef K_LOAD
#undef V_LOAD
#undef ATT_DONE
#undef ATT_BLOCK
        { float ss = 0.f;
#pragma unroll
          for (int r = 0; r < 16; ++r) ss += oacc[0][r] * oacc[0][r] + oacc[1][r] * oacc[1][r];
          const auto rr = __builtin_amdgcn_permlane32_swap(__float_as_uint(ss), __float_as_uint(ss), false, false); ss = __uint_as_float(rr[0]) + __uint_as_float(rr[1]);
          if (hh == 0) hs[wave * 32 + qi] = ss; }
        f32x16 pacc;
#pragma unroll
        for (int r = 0; r < 16; ++r) pacc[r] = 0.f;
        { const int s = s0 + qi, pwin = 2 << pg; const LAS unsigned char* const tp = ptile + pg * MX_PT_G + (15 + qi) * MX_PT_ROW + hh * 16;
          float self[4][8], sum[4][8];
#pragma unroll
          for (int ks = 0; ks < 4; ++ks) { const v4u x = *(const LAS v4u*)(tp + 32 * ks);
              self[ks][0] = bflo(x.x); self[ks][1] = bfhi(x.x); self[ks][2] = bflo(x.y); self[ks][3] = bfhi(x.y); self[ks][4] = bflo(x.z); self[ks][5] = bfhi(x.z); self[ks][6] = bflo(x.w); self[ks][7] = bfhi(x.w);
#pragma unroll
              for (int j = 0; j < 8; ++j) sum[ks][j] = self[ks][j]; }
#pragma unroll 1
          for (int i = 1; i < pwin; ++i) {
#pragma unroll
              for (int ks = 0; ks < 4; ++ks) { const v4u y = *(const LAS v4u*)(tp - i * MX_PT_ROW + 32 * ks);
                  sum[ks][0] += bflo(y.x); sum[ks][1] += bfhi(y.x); sum[ks][2] += bflo(y.y); sum[ks][3] += bfhi(y.y); sum[ks][4] += bflo(y.z); sum[ks][5] += bfhi(y.z); sum[ks][6] += bflo(y.w); sum[ks][7] += bfhi(y.w); } }
          const int cnt = (s + 1 < pwin) ? s + 1 : pwin; const float rc = 1.0f / (float)cnt;
#pragma unroll
          for (int ks = 0; ks < 4; ++ks) {
#pragma unroll
              for (int j = 0; j < 8; ++j) sum[ks][j] = sum[ks][j] * rc - self[ks][j];
              const bf16x8 yf = __builtin_bit_cast(bf16x8, (v4u){cvtpk(sum[ks][0], sum[ks][1]), cvtpk(sum[ks][2], sum[ks][3]), cvtpk(sum[ks][4], sum[ks][5]), cvtpk(sum[ks][6], sum[ks][7])});
              pacc = __builtin_amdgcn_mfma_f32_32x32x16_bf16(wpf[ks], yf, pacc, 0, 0, 0); } }
        { float ss = 0.f;
#pragma unroll
          for (int r = 0; r < 16; ++r) ss += pacc[r] * pacc[r];
          const auto rr = __builtin_amdgcn_permlane32_swap(__float_as_uint(ss), __float_as_uint(ss), false, false); ss = __uint_as_float(rr[0]) + __uint_as_float(rr[1]);
          if (hh == 0) ps[wave * 32 + qi] = ss; }
        __syncthreads();
        { float tot = 0.f;
#pragma unroll
          for (int w = 0; w < 8; ++w) tot += hs[w * 32 + qi];
          const float rstd = 1.0f / sqrtf(tot * (1.0f / AW) + RMS_EPS);
          bf16* op = O + (size_t)(r0 + qi) * D + h * 64 + 4 * hh; const float* gp = A.gng + h * 64 + 4 * hhu;
#pragma unroll
          for (int c = 0; c < 2; ++c)
#pragma unroll
              for (int g = 0; g < 4; ++g) { const f32x4 gv = *(const f32x4*)(gp + 32 * c + 8 * g);
                  *(u32x2*)(op + 32 * c + 8 * g) = (u32x2){cvtpk(oacc[c][4 * g] * rstd * gv.x, oacc[c][4 * g + 1] * rstd * gv.y), cvtpk(oacc[c][4 * g + 2] * rstd * gv.z, oacc[c][4 * g + 3] * rstd * gv.w)}; } }
        { float tot = 0.f;
#pragma unroll
          for (int w = 0; w < 8; ++w) tot += ps[w * 32 + qi];
          const float rstd = 1.0f / sqrtf(tot * (1.0f / PW) + RMS_EPS);
          bf16* op = O + (size_t)(r0 + qi) * D + AW + pg * 64 + 32 * pdt + 4 * hh; const float* gp = A.gng + AW + pg * 64 + 32 * pdt + 4 * hhu;
#pragma unroll
          for (int g = 0; g < 4; ++g) { const f32x4 gv = *(const f32x4*)(gp + 8 * g);
              *(u32x2*)(op + 8 * g) = (u32x2){cvtpk(pacc[4 * g] * rstd * gv.x, pacc[4 * g + 1] * rstd * gv.y), cvtpk(pacc[4 * g + 2] * rstd * gv.z, pacc[4 * g + 3] * rstd * gv.w)}; } }
#ifndef MXR_CONV
#define MXR_CONV 1
#endif
        for (int mr_ = 0, mn_ = opaque_int(MXR_CONV); mr_ < mn_; ++mr_)
        { const unsigned loff16 = 16u * (unsigned)ln;
          f32x4 acc[4]; const f32x4 cb = *(const f32x4*)(A.convb + 4 * ln);
#pragma unroll
          for (int tk = 0; tk < 4; ++tk) acc[tk] = cb;
#pragma unroll
          for (int j0 = 0; j0 < 32; j0 += 16) { f32x4 w4[16];
#pragma unroll
              for (int jj = 0; jj < 16; ++jj) if (j0 + jj < CK) w4[jj] = *(const f32x4*)((const char*)(A.convw + (size_t)(j0 + jj) * CW) + loff16);
#pragma unroll
              for (int rr = 0; rr < 19; ++rr) { if (j0 + rr < CK + 3) { const f32x4 u4 = *(const LAS f32x4*)(ubuf + (4 * wave + j0 + rr) * 256 + 4 * lane);
#pragma unroll
                  for (int tk = 0; tk < 4; ++tk) { const int jj = rr - tk; if (jj >= 0 && jj < 16 && j0 + jj < CK) acc[tk] += w4[jj] * u4; } } }
              asm volatile("" ::: "memory"); }
          const f32x4 lg = *(const f32x4*)(A.lng + 4 * ln), lb = *(const f32x4*)(A.lnb + 4 * ln), gc = *(const f32x4*)(A.gng + AW + PW + 4 * ln);
#pragma unroll
          for (int tk = 0; tk < 4; ++tk) { const int tl = 4 * wave + tk; f32x4 v = acc[tk];
              const float mean = wave_sum((v.x + v.y) + (v.z + v.w)) * (1.0f / CW); v = v - mean;
              const float var = wave_sum((v.x * v.x + v.y * v.y) + (v.z * v.z + v.w * v.w)) * (1.0f / CW); const float rs = 1.0f / sqrtf(var + LN_EPS);
              v = v * rs * lg + lb;
              v.x = sigm_mul(v.x, v.x); v.y = sigm_mul(v.y, v.y); v.z = sigm_mul(v.z, v.z); v.w = sigm_mul(v.w, v.w);
              const float ss = wave_sum((v.x * v.x + v.y * v.y) + (v.z * v.z + v.w * v.w)); const float rstd = 1.0f / sqrtf(ss * (1.0f / CW) + RMS_EPS);
              *(u32x2*)(O + (size_t)(r0 + tl) * D + AW + PW + 4 * lane) = (u32x2){pk2(v.x * rstd * gc.x, v.y * rstd * gc.y), pk2(v.z * rstd * gc.z, v.w * rstd * gc.w)}; } }
        __syncthreads();
    }
}
constexpr int NPH = 1 + 8 * DEPTH;
struct Args { const float* in[N_IN]; float* out; unsigned char* ws; int ph_lo, ph_hi; };
__global__ void __launch_bounds__(NWAVES * 64, 2) fwd(Args args) {
    extern __shared__ __attribute__((aligned(16))) unsigned char lds[];
    Frame F;
    F.lds = (LAS unsigned char*)lds;
    F.MISC = (volatile LAS unsigned*)(F.lds + MISC_OFF);
    F.wave = __builtin_amdgcn_readfirstlane((int)(threadIdx.x >> 6));
    F.G = gridDim.x; { const int bx = blockIdx.x; F.vcu = (F.G % 8 == 0) ? (bx % 8) * (F.G / 8) + bx / 8 : bx; }
    for (int u = F.wave * 64 + lane_now(); u < (LDS_BYTES - LDSCTL_OFF) / 4; u += NWAVES * 64) ((LAS unsigned*)(F.lds + LDSCTL_OFF))[u] = 0u;
    __syncthreads();
    XcdBarrier bar; bar.bar = (unsigned*)(CTLPTR() + CW_BAR); bar.x = 0; bar.st = nullptr; bar.wv = F.wave;
    bar = xcd_barrier_post((unsigned*)(CTLPTR() + CW_BAR), F.MISC + 8, F.wave);
#ifndef REP_PRO
#define REP_PRO 1
#endif
#ifndef REP_INP
#define REP_INP 1
#endif
#ifndef REP_ATT
#define REP_ATT 1
#endif
#ifndef REP_PC
#define REP_PC 1
#endif
#ifndef REP_MGU
#define REP_MGU 1
#endif
#ifndef REP_MDN
#define REP_MDN 1
#endif
#ifndef REP_DGU
#define REP_DGU 1
#endif
#ifndef REP_NRM
#define REP_NRM 1
#endif
#ifndef GEMM_ALIGN
#define GEMM_ALIGN true
#endif
#ifndef REP_OUT
#define REP_OUT 1
#endif
#ifndef REP_DDN
#define REP_DDN 1
#endif
#ifndef REP_BAR
#define REP_BAR 1
#endif
#ifndef REP_ROW8
#define REP_ROW8 1
#endif
#ifndef REP_GAT
#define REP_GAT 1
#endif
#ifndef REP_FIN
#define REP_FIN 1
#endif
#define REPEAT(n) for (int rep_ = 0, nrep_ = opaque_int(n); rep_ < nrep_; ++rep_)
#define IN(k) true
#define SEAM(k) do { if ((k) + 1 < NPH) { REPEAT(REP_BAR) xcd_barrier(bar); } } while (0)
#define X ((bf16*)(ws + WS_X))
#define XN ((bf16*)(ws + WS_XN))
#define P ((bf16*)(ws + WS_P))
#define O ((bf16*)(ws + WS_O))
#define ACT ((bf16*)(ws + WS_ACT))
#define AP ((bf16*)(ws + WS_AP))
#define TOK_E ((int*)(ws + WS_TOKE))
#define TOK_R ((int*)(ws + WS_TOKR))
#define TOK_G ((float*)(ws + WS_TOKG))
#define TOK_S ((int*)(ws + WS_TOKS))
    if (F.G != 256) { fail_word(F.wave, 0x7f0u); return; }

    if (IN(0)) {
        unsigned char* const ws = WSPTR();
        REPEAT(REP_PRO) p0_weights(F);
        RowArgs A{}; A.xin = INP(I_X); A.xws = X; A.gain = INP(I_ANG); A.xn = XN;
        REPEAT(REP_ROW8) row_phase<8>(F, A);
        SEAM(0);
    }
#pragma unroll 1
    for (int l = 0; l < DEPTH; ++l) {
        const int pb = 1 + 8 * l, li = l >> 1; const bool moe = (l & 1) != 0;
        if (IN(pb + 0)) {
            unsigned char* const ws = WSPTR();
            pg8::Gemm g{XN, (const bf16*)(ws + WS_WIN) + (size_t)l * INC * D, T, INC, D, 0}; pg8::StaticOrder S; S.init(T, INC, opaque_int(F.G), opaque_int((int)blockIdx.x));
            pg8::EpiBf16<0> E{P, INC, nullptr, 0, 0, 1.f};
            REPEAT(REP_INP) pg8::gemm_phase<pg8::EpiBf16<0>, pg8::StaticOrder, GEMM_ALIGN, true>(F.lds + RING_OFF, g, S, E, opaque_int(F.wave));
            { const int bx = opaque_int((int)blockIdx.x);
              if (bx >= 64) { const int rk = bx - 64; if (moe) moe_convert(F, li, CVT_C0 + CVT_C_PER * rk, CVT_C0 + CVT_C_PER * (rk + 1)); else moe_convert(F, li, CVT_A0 + CVT_A_PER * rk, CVT_A0 + CVT_A_PER * (rk + 1)); } }
            SEAM(pb + 0);
        }
        if (IN(pb + 1)) {
            unsigned char* const ws = WSPTR();
            PcArgs A{P, O, INP(I_POOLW) + (size_t)l * 4 * 64 * 64, INP(I_POOLS) + (size_t)l * PW, INP(I_CONVW) + (size_t)l * CK * CW, INP(I_CONVB) + (size_t)l * CW,
                     INP(I_LNG) + (size_t)l * CW, INP(I_LNB) + (size_t)l * CW, INP(I_GNG) + (size_t)l * D};
            REPEAT(REP_ATT) mixer_phase(F, A);
            SEAM(pb + 1);
        }
        if (IN(pb + 2)) {
            unsigned char* const ws = WSPTR();
            pg8::Gemm g{O, (const bf16*)(ws + WS_WOUT) + (size_t)l * D * D, T, D, D, 0}; pg8::StaticOrder S; S.init(T, D, opaque_int(F.G), opaque_int((int)blockIdx.x));
            pg8::EpiResid E{X, D};
            pg8::EpiResid Edummy{AP, D};
            REPEAT(REP_OUT) pg8::gemm_phase<pg8::EpiResid, pg8::StaticOrder, GEMM_ALIGN, true>(F.lds + RING_OFF, g, S, rep_ + 1 < nrep_ ? Edummy : E, opaque_int(F.wave));
            SEAM(pb + 2);
        }
        if (IN(pb + 3)) {
            unsigned char* const ws = WSPTR();
            RowArgs A{}; A.xsrc = X; A.xws = X; A.gain = INP(I_FNG) + (size_t)l * D; A.xn = XN;
            if (moe) { A.wr = INP(I_RW) + (size_t)li * D * NE; A.gcur = CTLPTR() + CW_MOE + li * 1024; A.tok_e = TOK_E; A.tok_r = TOK_R; A.tok_g = TOK_G; row_phase<2>(F, A); }
            else REPEAT(REP_NRM) row_phase<0>(F, A);
            SEAM(pb + 3);
        }
        if (moe) {
            if (IN(pb + 4)) { unsigned char* const ws = WSPTR(); gu32* const gcur = CTLPTR() + CW_MOE + li * 1024; REPEAT(REP_GAT) gather_phase(F, gcur, XN, (unsigned char*)AP, TOK_E, TOK_R, TOK_S); SEAM(pb + 4); }
            if (IN(pb + 5)) {
                unsigned char* const ws = WSPTR(); gu32* const gcur = CTLPTR() + CW_MOE + li * 1024;
                int cnt[8], toff[9]; load_toff(gcur, cnt, toff);
                pg8::Gemm g{AP, (const bf16*)(ws + WS_WGUM + (size_t)li * NE * NGU * D), 0, NGU, D / 2, (size_t)NGU * D}; pg8::GroupedOrder S; S.init(toff, NGU, opaque_int(F.G), opaque_int((int)blockIdx.x));
                pg8::EpiSwiGLU8 E{(unsigned char*)ACT, FF, 1.0f / (WSCALE8 * XSCALE8), ASCALE8};
                REPEAT(REP_MGU) pg8::gemm_phase<pg8::EpiSwiGLU8, pg8::GroupedOrder, GEMM_ALIGN, true, true>(F.lds + RING_OFF, g, S, E, opaque_int(F.wave));
                SEAM(pb + 5);
            }
            if (IN(pb + 6)) {
                unsigned char* const ws = WSPTR(); gu32* const gcur = CTLPTR() + CW_MOE + li * 1024;
                int cnt[8], toff[9]; load_toff(gcur, cnt, toff);
                pg8::Gemm g{ACT, (const bf16*)(ws + WS_WDM + (size_t)li * NE * D * FF), 0, D, FF / 2, (size_t)D * FF}; pg8::GroupedOrder S; S.init(toff, D, opaque_int(F.G), opaque_int((int)blockIdx.x));
                pg8::EpiBf16S E{AP, D, 1.0f / (WSCALE8 * ASCALE8)};
                REPEAT(REP_MDN) pg8::gemm_phase<pg8::EpiBf16S, pg8::GroupedOrder, GEMM_ALIGN, true, true>(F.lds + RING_OFF, g, S, E, opaque_int(F.wave));
                SEAM(pb + 6);
            }
        } else {
            if (IN(pb + 5)) {
                unsigned char* const ws = WSPTR();
                pg8::Gemm g{XN, (const bf16*)(ws + WS_WGUD) + (size_t)li * NGU * D, T, NGU, D, 0}; pg8::StaticOrder S; S.init(T, NGU, opaque_int(F.G), opaque_int((int)blockIdx.x));
                pg8::EpiSwiGLU E{ACT, FF};
                REPEAT(REP_DGU) pg8::gemm_phase<pg8::EpiSwiGLU, pg8::StaticOrder, GEMM_ALIGN, true>(F.lds + RING_OFF, g, S, E, opaque_int(F.wave));
                { const int bx = opaque_int((int)blockIdx.x);
                  if (bx >= 128) { const int rk = bx - 128; moe_convert(F, li, CVT_B0 + CVT_B_PER * rk, CVT_B0 + CVT_B_PER * (rk + 1)); } }
                SEAM(pb + 5);
            }
            if (IN(pb + 6)) {
                unsigned char* const ws = WSPTR();
                pg8::Gemm g{ACT, (const bf16*)(ws + WS_WDD) + (size_t)li * D * FF, T, D, FF, 0}; pg8::StaticOrder S; S.init(T, D, opaque_int(F.G), opaque_int((int)blockIdx.x));
                pg8::EpiResid E{X, D};
                pg8::EpiResid Edummy{AP, D};
                REPEAT(REP_DDN) pg8::gemm_phase<pg8::EpiResid, pg8::StaticOrder, GEMM_ALIGN, true>(F.lds + RING_OFF, g, S, rep_ + 1 < nrep_ ? Edummy : E, opaque_int(F.wave));
                SEAM(pb + 6);
            }
        }
        if (IN(pb + 7)) {
            unsigned char* const ws = WSPTR();
            RowArgs A{}; A.xsrc = X; A.xws = X; A.xn = XN; A.out = OUTPTR(); A.yp = AP; A.tok_g = TOK_G; A.tok_s = TOK_S;
            A.gain = (l == DEPTH - 1) ? INP(I_FING) : INP(I_ANG) + (size_t)(l + 1) * D;
            if (l == DEPTH - 1) REPEAT(REP_FIN) row_phase<5>(F, A);
            else if (moe) row_phase<1>(F, A);
            else row_phase<0>(F, A);
            SEAM(pb + 7);
        }
    }
#undef IN
#undef SEAM
#undef X
#undef XN
#undef P
#undef O
#undef ACT
#undef AP
#undef TOK_E
#undef TOK_R
#undef TOK_G
#undef TOK_S
}

#ifndef MK_ONE_LAUNCH
#define MK_ONE_LAUNCH 0
#endif
extern "C" void kernel_launch(void* const* d_in, const int* in_sizes, int n_in, void* d_out, int out_size, void* d_ws, size_t ws_size, hipStream_t stream) {
    static int grid = 0;
    if (grid == 0) {
        if (n_in != N_IN || in_sizes[0] != T * D || out_size != T * D || ws_size < WS_END) { fprintf(stderr, "kernel_launch: unexpected problem shape (n_in %d, in0 %d, out %d, ws %zu); nothing launched\n", n_in, n_in > 0 ? in_sizes[0] : -1, out_size, ws_size); grid = -1; return; }
        if (hipFuncSetAttribute((const void*)fwd, hipFuncAttributeMaxDynamicSharedMemorySize, LDS_BYTES) != hipSuccess) { fprintf(stderr, "kernel_launch: hipFuncSetAttribute failed; nothing launched\n"); grid = -1; return; }
        int per_cu = 0;
        if (hipOccupancyMaxActiveBlocksPerMultiprocessor(&per_cu, (const void*)fwd, NWAVES * 64, LDS_BYTES) != hipSuccess || per_cu < 1)
            fprintf(stderr, "kernel_launch: note: occupancy query reports %d workgroups per CU\n", per_cu);
        (void)hipGetLastError();
        grid = 256;
    }
    if (grid < 0) return;
    if (hipMemsetAsync((char*)d_ws + WS_CTL, 0, CTL_ZERO_BYTES, stream) != hipSuccess) { fprintf(stderr, "kernel_launch: hipMemsetAsync failed; nothing launched\n"); return; }
    Args a{};
    for (int i = 0; i < N_IN; ++i) a.in[i] = (const float*)d_in[i];
    a.out = (float*)d_out; a.ws = (unsigned char*)d_ws;
    a.ph_lo = 0; a.ph_hi = NPH;
    hipLaunchKernelGGL(fwd, dim3(grid), dim3(NWAVES * 64), LDS_BYTES, stream, a);
    const hipError_t le = hipPeekAtLastError();
    if (le != hipSuccess) fprintf(stderr, "kernel_launch: launch failed: %s\n", hipGetErrorName(le));
}
```

```cpp
#include <hip/hip_runtime.h>
#include <cstdio>
#include <cstdint>
#include <cmath>
#define MK_ONE_LAUNCH 1
__device__ __forceinline__ int lane_now() { int l; asm volatile("v_mbcnt_lo_u32_b32 %0, -1, 0\n\tv_mbcnt_hi_u32_b32 %0, -1, %0" : "=v"(l)); return l; }
namespace pg8 {
#define PG8_LAS __attribute__((address_space(3)))
typedef unsigned short bf16_t;
typedef short bf16x8 __attribute__((ext_vector_type(8)));
typedef float f32x4 __attribute__((ext_vector_type(4)));
typedef unsigned u32x4 __attribute__((ext_vector_type(4)));
constexpr int BM = 256, BK = 64, HALF = 128, HTB = HALF * BK * 2  , STAGE_BYTES = 8 * HTB, NXCD = 8, WGM = 8;

__host__ __device__ __forceinline__ int lds_byte(int r, int c) { const int st = (r >> 4) * 2 + (c >> 5), rr = r & 15, cc = c & 31, ob = rr * 64 + cc * 2; return st * 1024 + (ob ^ (((ob >> 9) & 1) << 5)); }
__host__ __device__ __forceinline__ void stage_rc(int b, int& R, int& C) { const int st = b / 1024, sb = b % 1024, swz = sb ^ (((sb >> 9) & 1) << 5); R = (st >> 1) * 16 + swz / 64; C = (st & 1) * 32 + (swz % 64) / 2; }
__host__ __device__ __forceinline__ int perm32(int rho) { const int n = rho >> 4, i = rho & 15; return 8 * (i >> 2) + 4 * n + (i & 3); }

struct Unit { int pm, pn, e; };
struct Gemm { const bf16_t* A; const bf16_t* Bt; int M, N, K; size_t estride; };

struct StaticOrder {
    int nM, nN, nwg, G, c;
    __host__ __device__ void init(int M, int N, int G_, int c_) { nM = M / BM; nN = N / BM; nwg = nM * nN; G = G_; c = c_; }
    __host__ __device__ bool next(int i, Unit& u) const {
        const long L = (long)i * G + c; if (L >= nwg) return false;
        int wgid = (int)L; { const int q = nwg / NXCD, r = nwg % NXCD, xcd = wgid % NXCD, off = wgid / NXCD; wgid = (xcd < r ? xcd * (q + 1) : r * (q + 1) + (xcd - r) * q) + off; }
        const int nig = WGM * nN, gid = wgid / nig, fm = gid * WGM, gsz = (nM - fm) < WGM ? (nM - fm) : WGM;
        u.pm = fm + ((wgid % nig) % gsz); u.pn = (wgid % nig) / gsz; u.e = 0; return true;
    }
    __device__ __forceinline__ void a_ready(const Unit&) const {}
    __device__ __forceinline__ void done(const Unit&) const {}
};

__device__ __forceinline__ unsigned cvt_pk_bf16(float lo, float hi) { unsigned r; asm volatile("v_cvt_pk_bf16_f32 %0, %1, %2" : "=v"(r) : "v"(lo), "v"(hi)); return r; }
typedef float f32x2 __attribute__((ext_vector_type(2)));
__device__ __forceinline__ f32x2 gelu_pk(f32x2 v) {
    const f32x2 av = __builtin_elementwise_abs(v), d = av * 0.2316418882f + 1.0f;
    f32x2 t; t.x = __builtin_amdgcn_rcpf(d.x); t.y = __builtin_amdgcn_rcpf(d.y);
    f32x2 q = t * 0.5307027145f + (-0.7265760135f); q = q * t + 0.7107068705f; q = q * t + (-0.142248368f); q = q * t + 0.127414796f; q = q * t;
    const f32x2 s = (v * v) * (-0.72134752044f);
    f32x2 e; e.x = __builtin_amdgcn_exp2f(s.x); e.y = __builtin_amdgcn_exp2f(s.y);
    const f32x2 m = v * (q * e), r = v - m;
    f32x2 o; o.x = v.x < 0.f ? m.x : r.x; o.y = v.y < 0.f ? m.y : r.y; return o;
}

template <int ACT  > struct EpiBf16 {
    static constexpr bool PERM = true, AFTER_DRAIN = false; static_assert(ACT == 0 || ACT == 1, "EpiBf16: ACT is 0 (none) or 1 (gelu_pk)");
    bf16_t* O; int ldc; const float* bias; int split_cols; size_t split_stride; float scale0;
    __device__ __forceinline__ void operator()(const f32x4 (&acc)[2][2][4][2], const Unit& u, int wr, int wc, int fr, int fq) const {
        const int row0 = u.pm * BM + wr * 64 + fr; int colt = u.pn * BM; bf16_t* base = O;
        float sc = 1.f; if (split_cols) { const int t = colt / split_cols; base += (size_t)t * split_stride; colt -= t * split_cols; if (t == 0) sc = scale0; }
        const int col0 = colt + wc * 32 + 8 * fq, bcol0 = u.pn * BM + wc * 32 + 8 * fq;
        f32x4 bv[2][2];
#pragma unroll
        for (int bj = 0; bj < 2; ++bj)
#pragma unroll
            for (int n = 0; n < 2; ++n) bv[bj][n] = bias ? *(const f32x4*)(bias + bcol0 + bj * HALF + 4 * n) : (f32x4){0.f, 0.f, 0.f, 0.f};
#pragma unroll
        for (int ai = 0; ai < 2; ++ai)
#pragma unroll
            for (int m = 0; m < 4; ++m) { bf16_t* rowp = base + (size_t)(row0 + ai * HALF + m * 16) * ldc + col0;
#pragma unroll
                for (int bj = 0; bj < 2; ++bj) { f32x4 v0 = acc[ai][bj][m][0] + bv[bj][0], v1 = acc[ai][bj][m][1] + bv[bj][1];
                    if (ACT == 1) { f32x2 a = gelu_pk((f32x2){v0[0], v0[1]}), b = gelu_pk((f32x2){v0[2], v0[3]}), c = gelu_pk((f32x2){v1[0], v1[1]}), d = gelu_pk((f32x2){v1[2], v1[3]});
                        v0 = (f32x4){a.x, a.y, b.x, b.y}; v1 = (f32x4){c.x, c.y, d.x, d.y}; }
                    v0 = v0 * sc; v1 = v1 * sc; u32x4 w; w.x = cvt_pk_bf16(v0[0], v0[1]); w.y = cvt_pk_bf16(v0[2], v0[3]); w.z = cvt_pk_bf16(v1[0], v1[1]); w.w = cvt_pk_bf16(v1[2], v1[3]);
                    *(u32x4*)(rowp + bj * HALF) = w; } }
    }
};
struct EpiResid {
    static constexpr bool PERM = true, AFTER_DRAIN = false;
    bf16_t* X; int ldc; float s;
    __device__ __forceinline__ void operator()(const f32x4 (&acc)[2][2][4][2], const Unit& u, int wr, int wc, int fr, int fq) const {
        const int row0 = u.pm * BM + wr * 64 + fr, col0 = u.pn * BM + wc * 32 + 8 * fq;
#pragma unroll
        for (int ai = 0; ai < 2; ++ai)
#pragma unroll
            for (int m = 0; m < 4; ++m) { bf16_t* rowp = X + (size_t)(row0 + ai * HALF + m * 16) * ldc + col0;
                u32x4 old[2];
#pragma unroll
                for (int bj = 0; bj < 2; ++bj) old[bj] = *(const u32x4*)(rowp + bj * HALF);
#pragma unroll
                for (int bj = 0; bj < 2; ++bj) { const f32x4 a0 = acc[ai][bj][m][0] * s, a1 = acc[ai][bj][m][1] * s; const u32x4 o = old[bj]; u32x4 w;
                    w.x = cvt_pk_bf16(__builtin_bit_cast(float, o.x << 16) + a0[0], __builtin_bit_cast(float, o.x & 0xffff0000u) + a0[1]);
                    w.y = cvt_pk_bf16(__builtin_bit_cast(float, o.y << 16) + a0[2], __builtin_bit_cast(float, o.y & 0xffff0000u) + a0[3]);
                    w.z = cvt_pk_bf16(__builtin_bit_cast(float, o.z << 16) + a1[0], __builtin_bit_cast(float, o.z & 0xffff0000u) + a1[1]);
                    w.w = cvt_pk_bf16(__builtin_bit_cast(float, o.w << 16) + a1[2], __builtin_bit_cast(float, o.w & 0xffff0000u) + a1[3]);
                    *(u32x4*)(rowp + bj * HALF) = w; }
                asm volatile("" ::: "memory"); }
    }
};
__device__ __forceinline__ float silu_mul(float g, float u) { return g * __builtin_amdgcn_rcpf(1.0f + __builtin_amdgcn_exp2f(g * -1.4426950408889634f)) * u; }
struct EpiSwiGLU {
    static constexpr bool PERM = true, AFTER_DRAIN = false;
    bf16_t* O; int ldc;
    __device__ __forceinline__ void operator()(const f32x4 (&acc)[2][2][4][2], const Unit& u, int wr, int wc, int fr, int fq) const {
        const int row0 = u.pm * BM + wr * 64 + fr, col0 = u.pn * HALF + wc * 32 + 8 * fq;
#pragma unroll
        for (int ai = 0; ai < 2; ++ai)
#pragma unroll
            for (int m = 0; m < 4; ++m) { bf16_t* rowp = O + (size_t)(row0 + ai * HALF + m * 16) * ldc + col0;
                const f32x4 g0 = acc[ai][0][m][0], g1 = acc[ai][0][m][1], u0 = acc[ai][1][m][0], u1 = acc[ai][1][m][1];
                u32x4 w;
                w.x = cvt_pk_bf16(silu_mul(g0[0], u0[0]), silu_mul(g0[1], u0[1])); w.y = cvt_pk_bf16(silu_mul(g0[2], u0[2]), silu_mul(g0[3], u0[3]));
                w.z = cvt_pk_bf16(silu_mul(g1[0], u1[0]), silu_mul(g1[1], u1[1])); w.w = cvt_pk_bf16(silu_mul(g1[2], u1[2]), silu_mul(g1[3], u1[3]));
                *(u32x4*)rowp = w; }
    }
};
typedef int v4i_t __attribute__((ext_vector_type(4)));
typedef unsigned u32x2e __attribute__((ext_vector_type(2)));
__device__ __forceinline__ float clamp8(float v) { return __builtin_fminf(__builtin_fmaxf(v, -448.0f), 448.0f); }
__device__ __forceinline__ unsigned pack_fp8x4(float a, float b, float c, float d) { unsigned w = 0u; w = __builtin_amdgcn_cvt_pk_fp8_f32(clamp8(a), clamp8(b), w, false); w = __builtin_amdgcn_cvt_pk_fp8_f32(clamp8(c), clamp8(d), w, true); return w; }
struct EpiSwiGLU8 {
    static constexpr bool PERM = true, AFTER_DRAIN = false;
    unsigned char* O; int ldc; float sin, sout;
    __device__ __forceinline__ void operator()(const f32x4 (&acc)[2][2][4][2], const Unit& u, int wr, int wc, int fr, int fq) const {
        const int row0 = u.pm * BM + wr * 64 + fr, col0 = u.pn * HALF + wc * 32 + 8 * fq;
#pragma unroll
        for (int ai = 0; ai < 2; ++ai)
#pragma unroll
            for (int m = 0; m < 4; ++m) { unsigned char* rowp = O + (size_t)(row0 + ai * HALF + m * 16) * ldc + col0;
                const f32x4 g0 = acc[ai][0][m][0] * sin, g1 = acc[ai][0][m][1] * sin, u0 = acc[ai][1][m][0] * (sin * sout), u1 = acc[ai][1][m][1] * (sin * sout);
                u32x2e w;
                w.x = pack_fp8x4(silu_mul(g0[0], u0[0]), silu_mul(g0[1], u0[1]), silu_mul(g0[2], u0[2]), silu_mul(g0[3], u0[3]));
                w.y = pack_fp8x4(silu_mul(g1[0], u1[0]), silu_mul(g1[1], u1[1]), silu_mul(g1[2], u1[2]), silu_mul(g1[3], u1[3]));
                *(u32x2e*)rowp = w; }
    }
};
struct EpiBf16S {
    static constexpr bool PERM = true, AFTER_DRAIN = false;
    bf16_t* O; int ldc; float s;
    __device__ __forceinline__ void operator()(const f32x4 (&acc)[2][2][4][2], const Unit& u, int wr, int wc, int fr, int fq) const {
        const int row0 = u.pm * BM + wr * 64 + fr, col0 = u.pn * BM + wc * 32 + 8 * fq;
#pragma unroll
        for (int ai = 0; ai < 2; ++ai)
#pragma unroll
            for (int m = 0; m < 4; ++m) { bf16_t* rowp = O + (size_t)(row0 + ai * HALF + m * 16) * ldc + col0;
#pragma unroll
                for (int bj = 0; bj < 2; ++bj) { const f32x4 v0 = acc[ai][bj][m][0] * s, v1 = acc[ai][bj][m][1] * s;
                    u32x4 w; w.x = cvt_pk_bf16(v0[0], v0[1]); w.y = cvt_pk_bf16(v0[2], v0[3]); w.z = cvt_pk_bf16(v1[0], v1[1]); w.w = cvt_pk_bf16(v1[2], v1[3]);
                    *(u32x4*)(rowp + bj * HALF) = w; } }
    }
};
struct GroupedOrder {
    int nM, nN, nwg, G, c; int t1, t2, t3, t4, t5, t6, t7;
    __device__ __forceinline__ void init(const int (&toff)[9], int N, int G_, int c_) { nM = toff[8]; nN = N / BM; nwg = nM * nN; G = G_; c = c_;
        t1 = toff[1]; t2 = toff[2]; t3 = toff[3]; t4 = toff[4]; t5 = toff[5]; t6 = toff[6]; t7 = toff[7]; }
    __device__ __forceinline__ bool next(int i, Unit& u) const {
        const long L = (long)i * G + c; if (L >= nwg) return false;
        int wgid = (int)L; { const int q = nwg / NXCD, r = nwg % NXCD, xcd = wgid % NXCD, off = wgid / NXCD; wgid = (xcd < r ? xcd * (q + 1) : r * (q + 1) + (xcd - r) * q) + off; }
        const int nig = WGM * nN, gid = wgid / nig, fm = gid * WGM, gsz = (nM - fm) < WGM ? (nM - fm) : WGM;
        u.pm = fm + ((wgid % nig) % gsz); u.pn = (wgid % nig) / gsz;
        int e_ = 0; e_ = (u.pm >= t1) ? 1 : e_; e_ = (u.pm >= t2) ? 2 : e_; e_ = (u.pm >= t3) ? 3 : e_; e_ = (u.pm >= t4) ? 4 : e_; e_ = (u.pm >= t5) ? 5 : e_; e_ = (u.pm >= t6) ? 6 : e_; e_ = (u.pm >= t7) ? 7 : e_;
        u.e = e_; return true;
    }
    __device__ __forceinline__ void a_ready(const Unit&) const {}
    __device__ __forceinline__ void done(const Unit&) const {}
};
template <class Epi, class Sched, bool ALIGN_EPI = false, bool SP2 = false, bool F8 = false>
__device__ __forceinline__ void gemm_phase(PG8_LAS unsigned char* lds, const Gemm g, const Sched& S, const Epi& E, const int wave_u  ) {
    const int tid_ = wave_u * 64 + lane_now();
    const int tid = tid_, wid = wave_u, lane = tid & 63, wr = wid >> 2, wc = wid & 3, fr = lane & 15, fq = lane >> 4;
    const int K = g.K, nt = K / BK;
    unsigned voffA[2], voffB[2];
#pragma unroll
    for (int i = 0; i < 2; ++i) { int R, C; stage_rc(tid * 16 + i * 8192, R, C); const int Rb = Epi::PERM ? ((R & ~31) + perm32(R & 31)) : R;
        voffA[i] = (unsigned)(R * K + C) * 2u; voffB[i] = (unsigned)(Rb * K + C) * 2u; }
    const size_t kstep = (size_t)(BK * 2);
    const size_t hstep = (size_t)HALF * K * 2;
    const size_t tstep = 2 * hstep;
    const unsigned ldsw = (unsigned)wid * 1024u;
    const unsigned ldsbase = (unsigned)(uintptr_t)lds + ldsw;
    const int aoff = lds_byte(wr * 64 + fr, fq * 8), boff = lds_byte(wc * 32 + fr, fq * 8);
#define PG8_SA(b, h) (((b) * 2 + (h)) * HTB)
#define PG8_SB(b, h) ((4 + (b) * 2 + (h)) * HTB)
#define PG8_GLDS(sbase, voff32, ldsdst) do { unsigned keep_; asm volatile("s_mov_b32 %0, m0\n\ts_mov_b32 m0, %3\n\ts_nop 0\n\tglobal_load_lds_dwordx4 %1, %2\n\ts_mov_b32 m0, %0" \
        : "=&s"(keep_) : "v"(voff32), "s"(sbase), "s"(ldsdst) : "memory"); } while (0)
#define PG8_STAGE(bufoff, gbase, voff) do { _Pragma("unroll") for (int _i = 0; _i < 2; ++_i) \
        PG8_GLDS((const char*)(gbase), (voff)[_i], (unsigned)__builtin_amdgcn_readfirstlane((int)(ldsbase + (unsigned)((bufoff) + _i * 8192)))); } while (0)
#define PG8_LDA(dst, b, h) do { _Pragma("unroll") for (int m = 0; m < 4; ++m) _Pragma("unroll") for (int k = 0; k < 2; ++k) dst[m][k] = *(const PG8_LAS bf16x8*)(lds + PG8_SA(b, h) + aoff + m * 2048 + k * 1024); } while (0)
#define PG8_LDB(dst, b, h) do { _Pragma("unroll") for (int n = 0; n < 2; ++n) _Pragma("unroll") for (int k = 0; k < 2; ++k) dst[n][k] = *(const PG8_LAS bf16x8*)(lds + PG8_SB(b, h) + boff + n * 2048 + k * 1024); } while (0)
#define PG8_CAT8(a, b) __builtin_shufflevector(__builtin_bit_cast(v4i_t, (a)), __builtin_bit_cast(v4i_t, (b)), 0, 1, 2, 3, 4, 5, 6, 7)
#define PG8_MMA(ai, bj, At, Bt) do { __builtin_amdgcn_s_setprio(1); if constexpr (F8) { _Pragma("unroll") for (int m = 0; m < 4; ++m) _Pragma("unroll") for (int n = 0; n < 2; ++n) \
        acc[ai][bj][m][n] = __builtin_amdgcn_mfma_scale_f32_16x16x128_f8f6f4(PG8_CAT8(Bt[n][0], Bt[n][1]), PG8_CAT8(At[m][0], At[m][1]), acc[ai][bj][m][n], 0, 0, 0, 0, 0, 0); } else { \
        _Pragma("unroll") for (int m = 0; m < 4; ++m) _Pragma("unroll") for (int n = 0; n < 2; ++n) _Pragma("unroll") for (int k = 0; k < 2; ++k) \
        acc[ai][bj][m][n] = __builtin_amdgcn_mfma_f32_16x16x32_bf16(Bt[n][k], At[m][k], acc[ai][bj][m][n], 0, 0, 0); } __builtin_amdgcn_s_setprio(0); } while (0)
#define PG8_WAIT_V(n) asm volatile("s_waitcnt vmcnt(" #n ")" ::: "memory")
#define PG8_WAIT_L(n) asm volatile("s_waitcnt lgkmcnt(" #n ")" ::: "memory")
#define PG8_BAR __builtin_amdgcn_s_barrier()
#define PG8_SCHED __builtin_amdgcn_sched_barrier(0)
    Unit cur, nxt; int ui = 0;
    if (!S.next(0, cur)) return;
    f32x4 acc[2][2][4][2];
#pragma unroll
    for (int a = 0; a < 2; ++a)
#pragma unroll
        for (int b = 0; b < 2; ++b)
#pragma unroll
            for (int m = 0; m < 4; ++m)
#pragma unroll
                for (int n = 0; n < 2; ++n) acc[a][b][m][n] = (f32x4){0.f, 0.f, 0.f, 0.f};
    bf16x8 At[4][2], B0[2][2], B1[2][2];
    const char* cA = (const char*)g.A + (size_t)cur.pm * tstep; const char* cB = (const char*)g.Bt + (size_t)cur.e * g.estride + (size_t)cur.pn * tstep;
    S.a_ready(cur);
    if constexpr (SP2) {
        PG8_STAGE(PG8_SB(0, 0), cB, voffB); PG8_STAGE(PG8_SB(0, 1), cB + hstep, voffB); PG8_STAGE(PG8_SA(0, 0), cA, voffA); PG8_STAGE(PG8_SA(0, 1), cA + hstep, voffA);
        if (wr == 1) PG8_BAR;
        PG8_WAIT_V(2); PG8_BAR;
        PG8_STAGE(PG8_SB(1, 0), cB + kstep, voffB); PG8_STAGE(PG8_SA(1, 0), cA + kstep, voffA); PG8_STAGE(PG8_SB(1, 1), cB + hstep + kstep, voffB);
        PG8_WAIT_V(6); PG8_BAR;
    } else {
        PG8_STAGE(PG8_SB(0, 0), cB, voffB); PG8_STAGE(PG8_SA(0, 0), cA, voffA); PG8_STAGE(PG8_SB(0, 1), cB + hstep, voffB); PG8_STAGE(PG8_SA(0, 1), cA + hstep, voffA);
        if (wr == 1) PG8_BAR;
        PG8_WAIT_V(4); PG8_BAR;
        PG8_STAGE(PG8_SB(1, 0), cB + kstep, voffB); PG8_STAGE(PG8_SA(1, 0), cA + kstep, voffA); PG8_STAGE(PG8_SB(1, 1), cB + hstep + kstep, voffB);
        PG8_WAIT_V(6); PG8_BAR;
    }
    for (;;) {
        const bool has_next = S.next(ui + 1, nxt);
        const char* nA = has_next ? (const char*)g.A + (size_t)nxt.pm * tstep : cA; const char* nB = has_next ? (const char*)g.Bt + (size_t)nxt.e * g.estride + (size_t)nxt.pn * tstep : cB;
        for (int t = 0; t < nt; t += 2) {
            const bool last = (t == nt - 2);
            const char* a1 = cA + (size_t)(t + 1) * kstep;
            const char* a2 = last ? nA : cA + (size_t)(t + 2) * kstep; const char* b2 = last ? nB : cB + (size_t)(t + 2) * kstep;
            const char* a3 = a2 + kstep; const char* b3 = b2 + kstep;
            if (last && has_next) S.a_ready(nxt);
            if constexpr (SP2) {
            PG8_LDB(B0, 0, 0); PG8_LDB(B1, 0, 1); PG8_SCHED; PG8_LDA(At, 0, 0); PG8_STAGE(PG8_SA(1, 1), a1 + hstep, voffA);
            PG8_WAIT_V(8); PG8_WAIT_L(0); PG8_BAR; PG8_MMA(0, 0, At, B0); PG8_MMA(0, 1, At, B1); PG8_BAR; PG8_SCHED;
            PG8_LDA(At, 0, 1); PG8_STAGE(PG8_SB(0, 0), b2, voffB); PG8_STAGE(PG8_SB(0, 1), b2 + hstep, voffB); PG8_STAGE(PG8_SA(0, 0), a2, voffA);
            PG8_WAIT_V(8); PG8_WAIT_L(0); PG8_BAR; PG8_MMA(1, 0, At, B0); PG8_MMA(1, 1, At, B1); PG8_BAR; PG8_SCHED;
            PG8_LDB(B0, 1, 0); PG8_LDB(B1, 1, 1); PG8_SCHED; PG8_LDA(At, 1, 0); PG8_STAGE(PG8_SA(0, 1), a2 + hstep, voffA);
            PG8_WAIT_V(8); PG8_WAIT_L(0); PG8_BAR; PG8_MMA(0, 0, At, B0); PG8_MMA(0, 1, At, B1); PG8_BAR; PG8_SCHED;
            PG8_LDA(At, 1, 1); PG8_STAGE(PG8_SB(1, 0), b3, voffB); PG8_STAGE(PG8_SB(1, 1), b3 + hstep, voffB); PG8_STAGE(PG8_SA(1, 0), a3, voffA);
            PG8_WAIT_V(8); PG8_WAIT_L(0); PG8_BAR; PG8_MMA(1, 0, At, B0); PG8_MMA(1, 1, At, B1); PG8_BAR; PG8_SCHED;
            } else {
            PG8_LDB(B0, 0, 0); PG8_SCHED; PG8_LDA(At, 0, 0); PG8_STAGE(PG8_SA(1, 1), a1 + hstep, voffA);
            PG8_WAIT_L(8); PG8_BAR; PG8_WAIT_L(0); PG8_MMA(0, 0, At, B0); PG8_BAR; PG8_SCHED;
            PG8_LDB(B1, 0, 1); PG8_STAGE(PG8_SB(0, 0), b2, voffB);
            PG8_BAR; PG8_WAIT_L(0); PG8_MMA(0, 1, At, B1); PG8_BAR;
            PG8_LDA(At, 0, 1); PG8_STAGE(PG8_SA(0, 0), a2, voffA);
            PG8_BAR; PG8_WAIT_L(0); PG8_MMA(1, 0, At, B0); PG8_BAR; PG8_SCHED;
            PG8_STAGE(PG8_SB(0, 1), b2 + hstep, voffB);
            PG8_WAIT_V(6); PG8_BAR; PG8_MMA(1, 1, At, B1); PG8_BAR;
            PG8_LDB(B0, 1, 0); PG8_SCHED; PG8_LDA(At, 1, 0); PG8_STAGE(PG8_SA(0, 1), a2 + hstep, voffA);
            PG8_WAIT_L(8); PG8_BAR; PG8_WAIT_L(0); PG8_MMA(0, 0, At, B0); PG8_BAR; PG8_SCHED;
            PG8_LDB(B1, 1, 1); PG8_STAGE(PG8_SB(1, 0), b3, voffB);
            PG8_BAR; PG8_WAIT_L(0); PG8_MMA(0, 1, At, B1); PG8_BAR;
            PG8_LDA(At, 1, 1); PG8_STAGE(PG8_SA(1, 0), a3, voffA);
            PG8_BAR; PG8_WAIT_L(0); PG8_MMA(1, 0, At, B0); PG8_BAR; PG8_SCHED;
            PG8_STAGE(PG8_SB(1, 1), b3 + hstep, voffB);
            PG8_WAIT_V(6); PG8_BAR; PG8_MMA(1, 1, At, B1); PG8_BAR;
            }
        }
        if constexpr (ALIGN_EPI) { if (wr == 0) PG8_BAR; }
        if constexpr (!Epi::AFTER_DRAIN) { const int le_ = lane_now(); E(acc, cur, wr, wc, le_ & 15, le_ >> 4); S.done(cur); }
        if (!has_next) break;
#pragma unroll
        for (int a = 0; a < 2; ++a)
#pragma unroll
            for (int b = 0; b < 2; ++b)
#pragma unroll
                for (int m = 0; m < 4; ++m)
#pragma unroll
                    for (int n = 0; n < 2; ++n) acc[a][b][m][n] = (f32x4){0.f, 0.f, 0.f, 0.f};
        cur = nxt; cA = nA; cB = nB; ++ui;
        if constexpr (ALIGN_EPI) { if (wr == 1) PG8_BAR; }
    }
    PG8_WAIT_V(0);
    if constexpr (!ALIGN_EPI) { if (wr == 0) PG8_BAR; }
    PG8_BAR;
    if constexpr (Epi::AFTER_DRAIN) { E.fused(acc, cur, wr, wc, fr, fq, lds, wid, lane); S.done(cur); }
#undef PG8_SA
#undef PG8_SB
#undef PG8_STAGE
#undef PG8_GLDS
#undef PG8_LDA
#undef PG8_LDB
#undef PG8_MMA
#undef PG8_CAT8
#undef PG8_WAIT_V
#undef PG8_WAIT_L
#undef PG8_BAR
#undef PG8_SCHED
}
}
#define GAS __attribute__((address_space(1)))
#define LAS __attribute__((address_space(3)))
typedef unsigned short bf16;
typedef unsigned v4u __attribute__((ext_vector_type(4)));
typedef float f32x4 __attribute__((ext_vector_type(4)));
typedef short bf16x8 __attribute__((ext_vector_type(8)));
typedef GAS unsigned gu32;
typedef GAS unsigned long long gu64;
#define RLX_AGENT __ATOMIC_RELAXED, __HIP_MEMORY_SCOPE_AGENT
#define LDS_WAIT() asm volatile("s_waitcnt lgkmcnt(0)" ::: "memory")
#define VM_WAIT() asm volatile("s_waitcnt vmcnt(0)" ::: "memory")
__device__ __forceinline__ unsigned long long rt() { return __builtin_amdgcn_s_memrealtime(); }
__device__ __forceinline__ unsigned f2bf(float f) { unsigned u = __builtin_bit_cast(unsigned, f); return (u + 0x7fffu + ((u >> 16) & 1u)) >> 16; }
__device__ __forceinline__ unsigned pk2(float lo, float hi) { return f2bf(lo) | (f2bf(hi) << 16); }

#define XB_TMO      128
#define XB_XCNT(j)  (256  + 64 * (j))
#define XB_XSUB(j)  (1280 + 64 * (j))
#define XB_XGEN(j)  (2304 + 64 * (j))
#define XB_TOP      3328
#define XB_TOPGEN   3392
#define XCD_BAR_WORDS 3456
#define XB_SPIN_CAP (1u << 18)

__device__ __forceinline__ unsigned xb_ld(unsigned* p)              { return __hip_atomic_load(p, __ATOMIC_RELAXED, __HIP_MEMORY_SCOPE_AGENT); }
__device__ __forceinline__ unsigned xb_add(unsigned* p, unsigned v) { return __hip_atomic_fetch_add(p, v, __ATOMIC_RELAXED, __HIP_MEMORY_SCOPE_AGENT); }
__device__ __forceinline__ unsigned xb_xcc_id() { return (unsigned)__builtin_amdgcn_s_getreg((3 << 11) | 20) & 0xFu; }
#define XB_SPIN(cond, bar) do { unsigned _sp = 0; while (cond) { __builtin_amdgcn_s_sleep(1); \
    if ((++_sp & 255u) == 0u) { if (xb_ld(&(bar)[XB_TMO])) break; if (_sp > XB_SPIN_CAP) { atomicAdd(&(bar)[XB_TMO], 1u); break; } } } } while (0)

struct XcdBarrier {
    int wv;
    unsigned* bar; unsigned x;
    volatile LAS unsigned* st;
};

__device__ __forceinline__ XcdBarrier xcd_barrier_post(unsigned* bar, volatile LAS unsigned* st, int wv) {
    XcdBarrier b; b.bar = bar; b.x = xb_xcc_id(); b.st = st; b.wv = wv;
    if (wv == 0 && lane_now() == 0) (void)xb_add(&bar[XB_XCNT(b.x)], 1u);
    return b;
}
__device__ __forceinline__ void xcd_barrier_complete(unsigned* bar, unsigned x, unsigned& nloc, unsigned& nx) {
    const unsigned G = gridDim.x * gridDim.y * gridDim.z;
    unsigned sum, cnt, mine, sp = 0u;
    for (;;) {
        sum = 0u; cnt = 0u; mine = 0u;
#pragma unroll
        for (unsigned j = 0; j < 16; ++j) { const unsigned c = xb_ld(&bar[XB_XCNT(j)]); sum += c; cnt += (c > 0u) ? 1u : 0u; mine = (j == x) ? c : mine; }
        if (sum == G) break;
        __builtin_amdgcn_s_sleep(1);
        if ((++sp & 255u) == 0u) { if (xb_ld(&bar[XB_TMO])) break; if (sp > XB_SPIN_CAP) { atomicAdd(&bar[XB_TMO], 1u); break; } }
    }
    nloc = mine > 0u ? mine : 1u; nx = cnt > 0u ? cnt : 1u;
}

__device__ __forceinline__ void xcd_barrier(const XcdBarrier& b) {
    asm volatile("s_waitcnt vmcnt(0)" ::: "memory");
    __syncthreads();
    int wv_ = b.wv; asm volatile("" : "+s"(wv_));
    if (wv_ == 0 && lane_now() == 0) {
        unsigned* bar = b.bar;
        __builtin_amdgcn_s_waitcnt(0);
        unsigned nloc = b.st[0], nx = b.st[1];
        if (nloc == 0u) { xcd_barrier_complete(bar, b.x, nloc, nx); b.st[0] = nloc; b.st[1] = nx; }
        const unsigned old = xb_add(&bar[XB_XSUB(b.x)], 1u);
        const unsigned gen = old / nloc;
        if (old + 1u == (gen + 1u) * nloc) {
            __builtin_amdgcn_fence(__ATOMIC_RELEASE, "agent");
            asm volatile("s_waitcnt vmcnt(0)" ::: "memory");
            const unsigned og = xb_add(&bar[XB_TOP], 1u);
            const unsigned tg = og / nx;
            if (og + 1u == (tg + 1u) * nx) xb_add(&bar[XB_TOPGEN], 1u);
            else XB_SPIN(xb_ld(&bar[XB_TOPGEN]) == tg, bar);
            __builtin_amdgcn_fence(__ATOMIC_ACQUIRE, "agent");
            xb_add(&bar[XB_XGEN(b.x)], 1u);
            asm volatile("s_waitcnt vmcnt(0)" ::: "memory");
        } else {
            XB_SPIN(xb_ld(&bar[XB_XGEN(b.x)]) == gen, bar);
            __builtin_amdgcn_fence(__ATOMIC_ACQUIRE, "agent");
            asm volatile("s_waitcnt vmcnt(0)" ::: "memory");
        }
    }
    __syncthreads();
}
constexpr int NWAVES = 8;
constexpr int BATCH = 8, SEQ = 2048, D = 1024, T = BATCH * SEQ, DEPTH = 4;
constexpr int NH = 8, HD = 64, AW = 512, PW = 256, CW = 256, INC = 2304, CK = 31;
constexpr int FF = 2816, NE = 8, NGU = 2 * FF;
constexpr int MAXSLOT = 2 * T + NE * 256;
constexpr float RMS_EPS = 1e-6f, LN_EPS = 1e-5f;
constexpr float QSCALE = 0.125f * 1.4426950408889634f;
#ifndef W_EXIT_V
#define W_EXIT_V -40.0f
#endif
constexpr float W_EXIT = W_EXIT_V;
constexpr int PQ = 0, PK = 512, PV = 1024, PPOOL = 1536, PCV = 1792, PCG = 2048;
enum { I_X = 0, I_ANG, I_WIN, I_POOLW, I_POOLS, I_CONVW, I_CONVB, I_LNG, I_LNB, I_GNG, I_WOUT, I_FNG, I_DWG, I_DWU, I_DWD, I_RW, I_MWG, I_MWU, I_MWD, I_FING, N_IN };

constexpr size_t MiB = 1u << 20;
constexpr size_t WS_CTL = 0, CTL_ZERO_BYTES = 1 * MiB;
constexpr size_t WS_TOKE = 1 * MiB, WS_TOKR = WS_TOKE + 128 * 1024, WS_TOKG = WS_TOKR + 128 * 1024, WS_TOKS = WS_TOKG + 128 * 1024;
constexpr size_t WS_WIN = 4 * MiB;
constexpr size_t WS_WOUT = 22 * MiB;
constexpr size_t WS_WGUD = 30 * MiB;
constexpr size_t WS_WDD = 52 * MiB;
constexpr size_t WS_WGUM = 64 * MiB;
constexpr size_t WS_WDM = 240 * MiB;
constexpr size_t WS_X = 328 * MiB;
constexpr size_t WS_XN = 392 * MiB;
constexpr size_t WS_P = 424 * MiB;
constexpr size_t WS_O = 496 * MiB;
constexpr size_t WS_ACT = 424 * MiB;
constexpr size_t WS_AP = 611 * MiB;
constexpr size_t WS_END = 679 * MiB;
static_assert(WS_WIN + (size_t)4 * INC * D * 2 <= WS_WOUT && WS_WOUT + (size_t)4 * D * D * 2 <= WS_WGUD && WS_WGUD + (size_t)2 * NGU * D * 2 <= WS_WDD && WS_WDD + (size_t)2 * D * FF * 2 <= WS_WGUM, "ws map 1");
static_assert(WS_WGUM + (size_t)16 * NGU * D * 2 <= WS_WDM && WS_WDM + (size_t)16 * D * FF * 2 <= WS_X && WS_X + (size_t)T * D * 4 <= WS_XN && WS_XN + (size_t)T * D * 2 <= WS_P, "ws map 2");
static_assert(WS_P + (size_t)T * INC * 2 <= WS_O && WS_O + (size_t)T * D * 2 <= WS_AP && WS_ACT + (size_t)MAXSLOT * FF * 2 <= WS_AP && WS_AP + (size_t)MAXSLOT * D * 2 <= WS_END, "ws map 3");
constexpr int CW_TMO = 0, CW_CODE = 1;
constexpr int CW_BAR = 4096;
constexpr int CW_MOE = 8192;

constexpr int RING_OFF = 0, RING_BYTES = 131072;
constexpr int LDSCTL_OFF = RING_BYTES, MISC_OFF = LDSCTL_OFF + 320;
constexpr int LDS_BYTES = 147456;
typedef unsigned u32x2 __attribute__((ext_vector_type(2)));
struct Frame {
    LAS unsigned char* lds;
    volatile LAS unsigned* MISC;
    int vcu, G, wave;
};
__device__ __forceinline__ int opaque_int(int n) { asm volatile("" : "+s"(n)); return n; }
#define PHASE_IDS() const int wave = opaque_int(F.wave), vcu = opaque_int(F.vcu), G = opaque_int(F.G), lane = lane_now(), tid = wave * 64 + lane; (void)tid; (void)lane; (void)wave; (void)vcu; (void)G
template <int I> __device__ __forceinline__ const float* inp() { unsigned long long v; asm volatile("s_load_dwordx2 %0, %1, %2\n\ts_waitcnt lgkmcnt(0)" : "=&s"(v) : "s"(__builtin_amdgcn_kernarg_segment_ptr()), "n"(I * 8));
    return (const float*)(const GAS float*)v; }
#define INP(i) inp<(i)>()
#define OUTPTR() ((float*)const_cast<float*>(inp<N_IN>()))
#define WSPTR() ((unsigned char*)const_cast<float*>(inp<N_IN + 1>()))
#define CTLPTR() ((gu32*)WSPTR())
__device__ __forceinline__ float bf2f(bf16 b) { return __uint_as_float((unsigned)b << 16); }
__device__ __forceinline__ float bflo(unsigned w) { return __uint_as_float(w << 16); }
__device__ __forceinline__ float bfhi(unsigned w) { return __uint_as_float(w & 0xffff0000u); }
template <int CTRL> __device__ __forceinline__ float dpp_add(float v) { return v + __builtin_bit_cast(float, __builtin_amdgcn_update_dpp(0, __builtin_bit_cast(int, v), CTRL, 0xf, 0xf, true)); }
__device__ __forceinline__ float wave_sum(float v) {
    v = dpp_add<0xB1>(v); v = dpp_add<0x4E>(v); v = dpp_add<0x141>(v); v = dpp_add<0x140>(v);
    v += __builtin_bit_cast(float, __builtin_amdgcn_ds_swizzle(__builtin_bit_cast(int, v), 0x401F));
    const auto rr = __builtin_amdgcn_permlane32_swap(__float_as_uint(v), __float_as_uint(v), false, false); return __uint_as_float(rr[0]) + __uint_as_float(rr[1]);
}
__device__ __forceinline__ void fail_word(int wave, unsigned code) {
    if (wave == 0 && lane_now() == 0) { gu32* ctl = CTLPTR(); unsigned expect = 0u; __hip_atomic_compare_exchange_strong((unsigned*)(ctl + CW_CODE), &expect, code, __ATOMIC_RELAXED, __ATOMIC_RELAXED, __HIP_MEMORY_SCOPE_AGENT);
        __hip_atomic_store(ctl + CW_TMO, 1u, RLX_AGENT); }
}

__device__ __forceinline__ void transpose_item(const float* W, int K, int N, bf16* WT, int mode, int nscale, int item, int lane) {
    const int nblk = N / 64, kb = item / nblk, nb = item % nblk, k0 = 64 * kb, n0 = 64 * nb, kq = lane >> 4, nq = lane & 15;
    const GAS f32x4* src = (const GAS f32x4*)(W + (size_t)(k0 + 8 * kq) * N + n0 + 4 * nq);
    f32x4 v[16];
#pragma unroll
    for (int i = 0; i < 16; ++i) v[i] = src[(size_t)((i & 7) + 32 * (i >> 3)) * (N / 4)];
    const int r0 = (mode == 0) ? n0 : (256 * (n0 >> 7) + (n0 & 127) + (mode == 2 ? 128 : 0));
    const float sc = (n0 < nscale) ? QSCALE : 1.0f;
#pragma unroll
    for (int j = 0; j < 4; ++j) { GAS v4u* dst = (GAS v4u*)(WT + (size_t)(r0 + 4 * nq + j) * K + k0 + 8 * kq);
#pragma unroll
        for (int hf = 0; hf < 2; ++hf) { v4u o;
            o.x = pk2(v[8 * hf + 0][j] * sc, v[8 * hf + 1][j] * sc); o.y = pk2(v[8 * hf + 2][j] * sc, v[8 * hf + 3][j] * sc);
            o.z = pk2(v[8 * hf + 4][j] * sc, v[8 * hf + 5][j] * sc); o.w = pk2(v[8 * hf + 6][j] * sc, v[8 * hf + 7][j] * sc);
            dst[4 * hf] = o; } }
}
constexpr float WSCALE8 = 64.0f, XSCALE8 = 16.0f, ASCALE8 = 16.0f;
__device__ __forceinline__ float clamp8f(float v) { return fminf(fmaxf(v, -448.0f), 448.0f); }
__device__ __forceinline__ unsigned pack8(float a, float b, float c, float d) { unsigned w = 0u; w = __builtin_amdgcn_cvt_pk_fp8_f32(clamp8f(a), clamp8f(b), w, false); w = __builtin_amdgcn_cvt_pk_fp8_f32(clamp8f(c), clamp8f(d), w, true); return w; }
__device__ __forceinline__ void transpose_item8(const float* W, int K, int N, unsigned char* WT, int mode, int item, int lane) {
    const int nblk = N / 64, kb = item / nblk, nb = item % nblk, k0 = 64 * kb, n0 = 64 * nb, kq = lane >> 4, nq = lane & 15;
    const GAS f32x4* src = (const GAS f32x4*)(W + (size_t)(k0 + 16 * kq) * N + n0 + 4 * nq);
    f32x4 v[16];
#pragma unroll
    for (int i = 0; i < 16; ++i) v[i] = src[(size_t)i * (N / 4)];
    const int r0 = (mode == 0) ? n0 : (256 * (n0 >> 7) + (n0 & 127) + (mode == 2 ? 128 : 0));
#pragma unroll
    for (int j = 0; j < 4; ++j) { v4u o;
        o.x = pack8(v[0][j] * WSCALE8, v[1][j] * WSCALE8, v[2][j] * WSCALE8, v[3][j] * WSCALE8); o.y = pack8(v[4][j] * WSCALE8, v[5][j] * WSCALE8, v[6][j] * WSCALE8, v[7][j] * WSCALE8);
        o.z = pack8(v[8][j] * WSCALE8, v[9][j] * WSCALE8, v[10][j] * WSCALE8, v[11][j] * WSCALE8); o.w = pack8(v[12][j] * WSCALE8, v[13][j] * WSCALE8, v[14][j] * WSCALE8, v[15][j] * WSCALE8);
        *(GAS v4u*)(WT + (size_t)(r0 + 4 * nq + j) * K + k0 + 16 * kq) = o; }
}
__device__ __forceinline__ void p0_weights(Frame& F) {
    PHASE_IDS(); unsigned char* const ws = WSPTR();
    const int gw = vcu * NWAVES + wave, NGW = G * NWAVES;
    constexpr int I_IN = (D / 64) * (INC / 64), I_OUT = (D / 64) * (D / 64), I_GU = (D / 64) * (FF / 64), I_DN = (FF / 64) * (D / 64);
    constexpr int N0 = 4 * I_IN, N1 = N0 + 4 * I_OUT, N2 = N1 + 2 * I_GU, N3 = N2 + 2 * I_GU, N4 = N3 + 2 * I_DN, N5 = N4 + 16 * I_GU, N6 = N5 + 16 * I_GU, N7 = N6 + 16 * I_DN;
    bf16* const win = (bf16*)(ws + WS_WIN); bf16* const wout = (bf16*)(ws + WS_WOUT); bf16* const wgud = (bf16*)(ws + WS_WGUD); bf16* const wdd = (bf16*)(ws + WS_WDD);
#pragma unroll 1
    for (int it = gw; it < N4; it += NGW) {
        if (it < N0) { const int l = it / I_IN, r = it % I_IN; transpose_item(INP(I_WIN) + (size_t)l * D * INC, D, INC, win + (size_t)l * INC * D, 0, 512, r, lane); }
        else if (it < N1) { const int q = it - N0, l = q / I_OUT, r = q % I_OUT; transpose_item(INP(I_WOUT) + (size_t)l * D * D, D, D, wout + (size_t)l * D * D, 0, 0, r, lane); }
        else if (it < N2) { const int q = it - N1, l = q / I_GU, r = q % I_GU; transpose_item(INP(I_DWG) + (size_t)l * D * FF, D, FF, wgud + (size_t)l * NGU * D, 1, 0, r, lane); }
        else if (it < N3) { const int q = it - N2, l = q / I_GU, r = q % I_GU; transpose_item(INP(I_DWU) + (size_t)l * D * FF, D, FF, wgud + (size_t)l * NGU * D, 2, 0, r, lane); }
        else { const int q = it - N3, l = q / I_DN, r = q % I_DN; transpose_item8(INP(I_DWD) + (size_t)l * FF * D, FF, D, (unsigned char*)wdd + (size_t)l * D * FF, 0, r, lane); }
    }
}

constexpr int MOE_ITEMS_MAT = (D / 64) * (FF / 64), MOE_ITEMS = 24 * MOE_ITEMS_MAT;
constexpr int CVT_A0 = 0, CVT_A_PER = 35, CVT_B0 = 192 * CVT_A_PER, CVT_B_PER = 35, CVT_C0 = CVT_B0 + 128 * CVT_B_PER, CVT_C_PER = (MOE_ITEMS - CVT_C0 + 191) / 192;
static_assert(CVT_C0 < MOE_ITEMS && CVT_C0 + 192 * CVT_C_PER >= MOE_ITEMS && CVT_C_PER <= 40, "conversion slots cover the list");
__device__ __forceinline__ void moe_convert(Frame& F, int li, int i0, int i1) {
    PHASE_IDS(); unsigned char* const ws = WSPTR();
    unsigned char* const wgum = ws + WS_WGUM + (size_t)li * NE * NGU * D; unsigned char* const wdm = ws + WS_WDM + (size_t)li * NE * D * FF;
    if (i1 > MOE_ITEMS) i1 = MOE_ITEMS;
#pragma unroll 1
    for (int q = i0 + wave; q < i1; q += NWAVES) {
        const int m = q / MOE_ITEMS_MAT, r = q % MOE_ITEMS_MAT, e = m & 7, le = li * NE + e;
        if (m < 8) transpose_item8(INP(I_MWG) + (size_t)le * D * FF, D, FF, wgum + (size_t)e * NGU * D, 1, r, lane);
        else if (m < 16) transpose_item8(INP(I_MWU) + (size_t)le * D * FF, D, FF, wgum + (size_t)e * NGU * D, 2, r, lane);
        else transpose_item8(INP(I_MWD) + (size_t)le * FF * D, FF, D, wdm + (size_t)e * D * FF, 0, r, lane);
    }
}

struct RowArgs { const float* xin; const bf16* xsrc; bf16* xws; const float* gain; bf16* xn; float* out; const bf16* yp; const float* wr; gu32* gcur;
                 int* tok_e; int* tok_r; float* tok_g; const int* tok_s; };
template <int MODE>
__device__ __forceinline__ void row_phase(Frame& F, const RowArgs& A) {
    constexpr bool COMBINE = MODE & 1, ROUTER = (MODE & 2) != 0, FINAL = (MODE & 4) != 0, COPYIN = (MODE & 8) != 0;
    constexpr int RB = (COMBINE || COPYIN) ? 4 : 8;
    LAS int* s_cnt = (LAS int*)(F.lds + RING_OFF);
    LAS int* s_base = s_cnt + 8;
    LAS int* s_e = s_cnt + 16;
    LAS int* s_rk = s_e + 128;
    LAS float* s_g = (LAS float*)(s_rk + 128);
    LAS float* s_wr = (LAS float*)(F.lds + RING_OFF + 8192);
    PHASE_IDS();
    if (ROUTER) { if (tid < 16) s_cnt[tid] = 0;
#pragma unroll
        for (int i = 0; i < 4; ++i) *(LAS f32x4*)(s_wr + 4 * (tid + 512 * i)) = *((const GAS f32x4*)A.wr + tid + 512 * i);
        __syncthreads(); }
    f32x4 gn[4];
    { const GAS f32x4* gr = (const GAS f32x4*)A.gain + lane;
#pragma unroll
      for (int j = 0; j < 4; ++j) gn[j] = gr[64 * j]; }
#pragma unroll 1
    for (int b = 0; b < 8 / RB; ++b) {
        const int rl0 = wave * 8 + b * RB, m0 = vcu * 64 + rl0;
        f32x4 xf[COPYIN ? RB : 1][4]; u32x2 xr[COPYIN ? 1 : RB][4]; u32x2 ya[COMBINE ? RB : 1][4], yb[COMBINE ? RB : 1][4]; float cg0[COMBINE ? RB : 1], cg1[COMBINE ? RB : 1];
        int cs0[COMBINE ? RB : 1], cs1[COMBINE ? RB : 1];
        if (COMBINE) {
#pragma unroll
            for (int i = 0; i < RB; ++i) { cs0[i] = A.tok_s[2 * (m0 + i)]; cs1[i] = A.tok_s[2 * (m0 + i) + 1]; cg0[i] = A.tok_g[2 * (m0 + i)]; cg1[i] = A.tok_g[2 * (m0 + i) + 1]; } }
#pragma unroll
        for (int i = 0; i < RB; ++i) {
            if (COPYIN) { const GAS f32x4* x4 = (const GAS f32x4*)(A.xin + (size_t)(m0 + i) * D) + lane;
#pragma unroll
                for (int j = 0; j < 4; ++j) xf[i][j] = x4[64 * j]; }
            else { const GAS u32x2* x2 = (const GAS u32x2*)(A.xsrc + (size_t)(m0 + i) * D) + lane;
#pragma unroll
                for (int j = 0; j < 4; ++j) xr[i][j] = x2[64 * j]; } }
        if (COMBINE) {
#pragma unroll
            for (int i = 0; i < RB; ++i) { const GAS u32x2* y0 = (const GAS u32x2*)(A.yp + (size_t)cs0[i] * D) + lane; const GAS u32x2* y1 = (const GAS u32x2*)(A.yp + (size_t)cs1[i] * D) + lane;
#pragma unroll
                for (int j = 0; j < 4; ++j) { ya[i][j] = y0[64 * j]; yb[i][j] = y1[64 * j]; } } }
#pragma unroll
        for (int i = 0; i < RB; ++i) {
            const int rl = rl0 + i, m = m0 + i;
            f32x4 v[4];
#pragma unroll
            for (int j = 0; j < 4; ++j) { if (COPYIN) v[j] = xf[i][j]; else { const u32x2 w = xr[i][j]; v[j] = (f32x4){bflo(w.x), bfhi(w.x), bflo(w.y), bfhi(w.y)}; } }
            if (COMBINE) { const float g0 = cg0[i], g1 = cg1[i];
#pragma unroll
                for (int j = 0; j < 4; ++j) { const u32x2 a = ya[i][j], bb = yb[i][j];
                    v[j].x += g0 * bflo(a.x) + g1 * bflo(bb.x); v[j].y += g0 * bfhi(a.x) + g1 * bfhi(bb.x); v[j].z += g0 * bflo(a.y) + g1 * bflo(bb.y); v[j].w += g0 * bfhi(a.y) + g1 * bfhi(bb.y); } }
            if ((COMBINE && !FINAL) || COPYIN) { GAS u32x2* xw = (GAS u32x2*)(A.xws + (size_t)m * D) + lane;
#pragma unroll
                for (int j = 0; j < 4; ++j) xw[64 * j] = (u32x2){pk2(v[j].x, v[j].y), pk2(v[j].z, v[j].w)}; }
            float ss = 0.f;
#pragma unroll
            for (int j = 0; j < 4; ++j) ss += (v[j].x * v[j].x + v[j].y * v[j].y) + (v[j].z * v[j].z + v[j].w * v[j].w);
            const float rstd = 1.0f / sqrtf(wave_sum(ss) * (1.0f / D) + RMS_EPS);
#pragma unroll
            for (int j = 0; j < 4; ++j) v[j] = v[j] * rstd * gn[j];
            if (FINAL) { GAS f32x4* o = (GAS f32x4*)(A.out + (size_t)m * D) + lane;
#pragma unroll
                for (int j = 0; j < 4; ++j) o[64 * j] = v[j]; }
            else { GAS u32x2* o = (GAS u32x2*)(A.xn + (size_t)m * D) + lane;
#pragma unroll
                for (int j = 0; j < 4; ++j) o[64 * j] = (u32x2){pk2(v[j].x, v[j].y), pk2(v[j].z, v[j].w)}; }
            if (ROUTER) {
                float lg[8];
#pragma unroll
                for (int e = 0; e < 8; ++e) lg[e] = 0.f;
#pragma unroll
                for (int j = 0; j < 4; ++j)
#pragma unroll
                    for (int q = 0; q < 4; ++q) { const LAS f32x4* w = (const LAS f32x4*)(s_wr + (256 * j + 4 * lane + q) * 8); const f32x4 w0 = w[0], w1 = w[1]; const float h = v[j][q];
                        lg[0] += h * w0.x; lg[1] += h * w0.y; lg[2] += h * w0.z; lg[3] += h * w0.w; lg[4] += h * w1.x; lg[5] += h * w1.y; lg[6] += h * w1.z; lg[7] += h * w1.w; }
#pragma unroll
                for (int e = 0; e < 8; ++e) lg[e] = wave_sum(lg[e]);
                int e1 = 0; float v1 = lg[0];
#pragma unroll
                for (int e = 1; e < 8; ++e) if (lg[e] > v1) { v1 = lg[e]; e1 = e; }
                int e2 = -1; float v2 = -INFINITY;
#pragma unroll
                for (int e = 0; e < 8; ++e) if (e != e1 && (e2 < 0 || lg[e] > v2)) { v2 = lg[e]; e2 = e; }
                const float g1 = 1.0f / (1.0f + __expf(v2 - v1)), g2 = 1.0f - g1;
                if (lane == 0) { const int r1 = atomicAdd((int*)(s_cnt + e1), 1), r2 = atomicAdd((int*)(s_cnt + e2), 1);
                    s_e[2 * rl] = e1; s_e[2 * rl + 1] = e2; s_rk[2 * rl] = r1; s_rk[2 * rl + 1] = r2; s_g[2 * rl] = g1; s_g[2 * rl + 1] = g2; }
            }
        }
    }
    if (ROUTER) {
        __syncthreads();
        if (tid < 8) s_base[tid] = (int)__hip_atomic_fetch_add(A.gcur + 64 * tid, (unsigned)s_cnt[tid], RLX_AGENT);
        __syncthreads();
        if (tid < 128) { const int m2 = vcu * 128 + tid; const int e = s_e[tid]; A.tok_e[m2] = e; A.tok_r[m2] = s_base[e] + s_rk[tid]; A.tok_g[m2] = s_g[tid]; }
        __syncthreads();
    }
}

__device__ __forceinline__ void load_toff(gu32* gcur, int (&cnt)[8], int (&toff)[9]) {
    const int le = lane_now() & 7; const unsigned c = __hip_atomic_load(gcur + 64 * le, RLX_AGENT);
    toff[0] = 0;
#pragma unroll
    for (int e = 0; e < 8; ++e) { cnt[e] = (int)__builtin_amdgcn_readlane((int)c, e); toff[e + 1] = toff[e] + ((cnt[e] + 255) >> 8); }
}
__device__ __forceinline__ void gather_phase(Frame& F, gu32* gcur, const bf16* xn, unsigned char* ap, const int* tok_e, const int* tok_r, int* tok_s) {
    PHASE_IDS();
    int cnt[8], toff[9]; load_toff(gcur, cnt, toff);
    v4u ra[8], rb[8]; int te[8][2], tr[8][2];
#pragma unroll
    for (int i = 0; i < 8; ++i) { const int m = vcu * 64 + wave * 8 + i; const GAS v4u* src = (const GAS v4u*)(xn + (size_t)m * D) + 2 * lane; ra[i] = src[0]; rb[i] = src[1];
        te[i][0] = tok_e[2 * m]; te[i][1] = tok_e[2 * m + 1]; tr[i][0] = tok_r[2 * m]; tr[i][1] = tok_r[2 * m + 1]; }
#pragma unroll
    for (int i = 0; i < 8; ++i) {
        const int m = vcu * 64 + wave * 8 + i; const v4u a = ra[i], b = rb[i];
        v4u o;
        o.x = pack8(bflo(a.x) * XSCALE8, bfhi(a.x) * XSCALE8, bflo(a.y) * XSCALE8, bfhi(a.y) * XSCALE8); o.y = pack8(bflo(a.z) * XSCALE8, bfhi(a.z) * XSCALE8, bflo(a.w) * XSCALE8, bfhi(a.w) * XSCALE8);
        o.z = pack8(bflo(b.x) * XSCALE8, bfhi(b.x) * XSCALE8, bflo(b.y) * XSCALE8, bfhi(b.y) * XSCALE8); o.w = pack8(bflo(b.z) * XSCALE8, bfhi(b.z) * XSCALE8, bflo(b.w) * XSCALE8, bfhi(b.w) * XSCALE8);
#pragma unroll
        for (int k = 0; k < 2; ++k) {
            const int e = te[i][k], r = tr[i][k];
            int base = 0;
#pragma unroll
            for (int q = 0; q < 8; ++q) base = (e == q) ? toff[q] : base;
            const int slot = base * 256 + r;
            if (lane == 0) tok_s[2 * m + k] = slot;
            *((GAS v4u*)(ap + (size_t)slot * D) + lane) = o;
        }
    }
    const int gw = vcu * NWAVES + wave, NGW = G * NWAVES;
#pragma unroll
    for (int e = 0; e < 8; ++e) {
        for (int r = toff[e] * 256 + cnt[e] + gw; r < toff[e + 1] * 256; r += NGW) { unsigned z = 0u; asm volatile("" : "+v"(z)); *((GAS v4u*)(ap + (size_t)r * D) + lane) = (v4u){z, z, z, z}; }
    }
}

typedef float f32x16 __attribute__((ext_vector_type(16)));
typedef short s16x4 __attribute__((ext_vector_type(4)));
typedef short v4i16_t __attribute__((ext_vector_type(4)));
typedef float f32x2_t __attribute__((ext_vector_type(2))); typedef __bf16 bf16x2_t __attribute__((ext_vector_type(2)));
__device__ __forceinline__ unsigned cvtpk(float lo, float hi) { f32x2_t v = {lo, hi}; bf16x2_t b = __builtin_convertvector(v, bf16x2_t); return __builtin_bit_cast(unsigned, b); }
__device__ __forceinline__ s16x4 vtr(const LAS unsigned char* p) { return __builtin_bit_cast(s16x4, __builtin_amdgcn_ds_read_tr16_b64_v4i16((LAS v4i16_t*)p)); }
constexpr int ATT_VBYTES = 4096;
constexpr int ATT_HS_OFF = NWAVES * ATT_VBYTES;

__device__ __forceinline__ f32x16 sb_qk(const bf16x8 (&kf)[4], const bf16x8 (&qf)[4]) {
    f32x16 st;
#pragma unroll
    for (int r = 0; r < 16; ++r) st[r] = 0.f;
#pragma unroll
    for (int ds = 0; ds < 4; ++ds) st = __builtin_amdgcn_mfma_f32_32x32x16_bf16(kf[ds], qf[ds], st, 0, 0, 0);
    return st;
}
template <bool DIAG>
__device__ __forceinline__ void sb_weights(const f32x16& st, int qlim, float sel, float& carry, bf16x8& pw0, bf16x8& pw1) {
    float inc[16];
#pragma unroll
    for (int r = 0; r < 16; ++r) { const float z = st[r];
        float l = -(fmaxf(z, 0.f) + __builtin_amdgcn_logf(1.0f + __builtin_amdgcn_exp2f(-fabsf(z))));
        if (DIAG) l = ((r & 3) + 8 * (r >> 2) < qlim) ? l : 0.f;
        inc[r] = l; }
    float T[4], Ghi[4];
#pragma unroll
    for (int g = 0; g < 4; ++g) { inc[4 * g + 2] += inc[4 * g + 3]; inc[4 * g + 1] += inc[4 * g + 2]; inc[4 * g] += inc[4 * g + 1];
        const auto rr = __builtin_amdgcn_permlane32_swap(__float_as_uint(inc[4 * g]), __float_as_uint(inc[4 * g]), false, false);
        Ghi[g] = __uint_as_float(rr[1]); T[g] = __uint_as_float(rr[0]) + Ghi[g]; }
    float U[4]; U[3] = carry; U[2] = U[3] + T[3]; U[1] = U[2] + T[2]; U[0] = U[1] + T[1]; carry = U[0] + T[0];
    unsigned pk[8];
#pragma unroll
    for (int g = 0; g < 4; ++g) { const float base = fmaf(Ghi[g], sel, U[g]); float w[4];
#pragma unroll
        for (int i = 0; i < 4; ++i) { const int r = 4 * g + i; w[i] = __builtin_amdgcn_exp2f(st[r] + (inc[r] + base));
            if (DIAG) w[i] = ((r & 3) + 8 * (r >> 2) < qlim) ? w[i] : 0.f; }
        pk[2 * g] = cvtpk(w[0], w[1]); pk[2 * g + 1] = cvtpk(w[2], w[3]); }
    pw0 = __builtin_bit_cast(bf16x8, (v4u){pk[0], pk[1], pk[2], pk[3]}); pw1 = __builtin_bit_cast(bf16x8, (v4u){pk[4], pk[5], pk[6], pk[7]});
}
__device__ __forceinline__ void sb_pv(const LAS unsigned char* vrd, const bf16x8 pw0, const bf16x8 pw1, f32x16 (&oacc)[2]) {
#pragma unroll
    for (int c = 0; c < 2; ++c) {
        const s16x4 a0 = vtr(vrd + c * 2048), a1 = vtr(vrd + c * 2048 + 512), b0 = vtr(vrd + c * 2048 + 1024), b1 = vtr(vrd + c * 2048 + 1536);
        const bf16x8 v0 = (bf16x8){a0[0], a0[1], a0[2], a0[3], a1[0], a1[1], a1[2], a1[3]}, v1 = (bf16x8){b0[0], b0[1], b0[2], b0[3], b1[0], b1[1], b1[2], b1[3]};
        oacc[c] = __builtin_amdgcn_mfma_f32_32x32x16_bf16(v0, pw0, oacc[c], 0, 0, 0);
        oacc[c] = __builtin_amdgcn_mfma_f32_32x32x16_bf16(v1, pw1, oacc[c], 0, 0, 0); }
}

constexpr int MX_KV = 4608, MX_HS_OFF = NWAVES * MX_KV, MX_PS_OFF = MX_HS_OFF + 1024, MX_PT_OFF = MX_PS_OFF + 1024, MX_PT_ROW = 144, MX_PT_G = 47 * MX_PT_ROW, MX_U_OFF = MX_PT_OFF + 4 * MX_PT_G;
static_assert(MX_U_OFF % 16 == 0 && MX_U_OFF + 62 * 256 * 4 <= RING_BYTES, "mixer LDS map");
struct PcArgs { const bf16* P; bf16* O; const float* poolw; const float* pools; const float* convw; const float* convb; const float* lng; const float* lnb; const float* gng; };
__device__ __forceinline__ float sigm_mul(float val, float gate) { return val * __builtin_amdgcn_rcpf(1.0f + __builtin_amdgcn_exp2f(gate * -1.4426950408889634f)); }
__device__ __forceinline__ void mixer_phase(Frame& F, const PcArgs& A) {
    PHASE_IDS();
    const bf16* const P = A.P; bf16* const O = A.O;
    const int qi = lane & 31, hh = lane >> 5, h = wave;
    LAS unsigned char* const vimg = F.lds + RING_OFF + wave * MX_KV;
    LAS float* const hs = (LAS float*)(F.lds + RING_OFF + MX_HS_OFF);
    LAS float* const ps = (LAS float*)(F.lds + RING_OFF + MX_PS_OFF);
    LAS unsigned char* const ptile = F.lds + RING_OFF + MX_PT_OFF;
    LAS float* const ubuf = (LAS float*)(F.lds + RING_OFF + MX_U_OFF);
    const int vkey = lane >> 3, vch = lane & 7;
    LAS unsigned char* const vwr = vimg + (vch >> 2) * 2048 + vkey * 64 + (vch & 3) * 16;
    const LAS unsigned char* const vrd = vimg + (4 * hh + ((lane & 15) >> 2)) * 64 + ((lane >> 4) & 1) * 32 + (lane & 3) * 8;
    LAS unsigned char* const kwr = vimg + vkey * 144 + vch * 16;
    const LAS unsigned char* const krd = vimg + qi * 144 + hh * 16;
    const float sel = hh ? 0.f : 1.f; const int qlim = qi - 4 * hh;
    const int pg = wave & 3, pdt = wave >> 2;
    bf16x8 wpf[4];
    { const float* wp = A.poolw + (size_t)pg * 64 * 64 + 32 * pdt + qi; const float psc = A.pools[pg * 64 + 32 * pdt + qi];
#pragma unroll
      for (int ks = 0; ks < 4; ++ks) { float w[8];
#pragma unroll
          for (int j = 0; j < 8; ++j) w[j] = wp[(size_t)(16 * ks + 8 * hh + j) * 64] * psc;
          wpf[ks] = __builtin_bit_cast(bf16x8, (v4u){cvtpk(w[0], w[1]), cvtpk(w[2], w[3]), cvtpk(w[4], w[5]), cvtpk(w[6], w[7])}); } }
    for (int u = vcu; u < T / 32; u += G) {
        const int r0 = u * 32, s0 = r0 % SEQ, nb1 = s0 >> 5;
        int ln = lane; asm volatile("" : "+v"(ln));
        const int hhu = ln >> 5, tidu = wave * 64 + ln;
        bf16x8 qf[4]; v4u kA[4], kB[4], vA[4], vB[4];
        const bf16* qp = P + (size_t)(r0 + qi) * INC + PQ + h * 64 + 8 * hh;
#pragma unroll
        for (int ds = 0; ds < 4; ++ds) qf[ds] = *(const bf16x8*)(qp + 16 * ds);
        const bf16* const kp0 = P + (size_t)(r0 + vkey) * INC + PK + h * 64 + 8 * vch;
        const bf16* const vp0 = P + (size_t)(r0 + vkey) * INC + PV + h * 64 + 8 * vch;
#define K_LOAD(KB, jj) do { asm volatile("" ::: "memory"); const int j_ = (jj) < nb1 ? (jj) : nb1; const bf16* kp_ = kp0 - (size_t)(32 * j_) * INC; \
        _Pragma("unroll") for (int i = 0; i < 4; ++i) KB[i] = *(const v4u*)(kp_ + (size_t)(8 * i) * INC); asm volatile("" ::: "memory"); } while (0)
#define V_LOAD(VB, jj) do { asm volatile("" ::: "memory"); const int j_ = (jj) < nb1 ? (jj) : nb1; const bf16* vp_ = vp0 - (size_t)(32 * j_) * INC; \
        _Pragma("unroll") for (int i = 0; i < 4; ++i) VB[i] = *(const v4u*)(vp_ + (size_t)(8 * i) * INC); asm volatile("" ::: "memory"); } while (0)
        K_LOAD(kA, 0); V_LOAD(vA, 0); K_LOAD(kB, 1); V_LOAD(vB, 1);
#pragma unroll
        for (int i = 0; i < 4; ++i) { const int idx = tidu + 512 * i;
            if (idx < 62 * 32) { const int rr = idx >> 5, c8 = idx & 31; f32x4 u0 = {0.f, 0.f, 0.f, 0.f}, u1 = {0.f, 0.f, 0.f, 0.f};
                if (s0 - 30 + rr >= 0) { const bf16* rp = P + (size_t)(r0 - 30 + rr) * INC + 8 * c8; const v4u a = *(const v4u*)(rp + PCV), b = *(const v4u*)(rp + PCG);
                    u0 = (f32x4){sigm_mul(bflo(a.x), bflo(b.x)), sigm_mul(bfhi(a.x), bfhi(b.x)), sigm_mul(bflo(a.y), bflo(b.y)), sigm_mul(bfhi(a.y), bfhi(b.y))};
                    u1 = (f32x4){sigm_mul(bflo(a.z), bflo(b.z)), sigm_mul(bfhi(a.z), bfhi(b.z)), sigm_mul(bflo(a.w), bflo(b.w)), sigm_mul(bfhi(a.w), bfhi(b.w))}; }
                *(LAS f32x4*)(ubuf + rr * 256 + 8 * c8) = u0; *(LAS f32x4*)(ubuf + rr * 256 + 8 * c8 + 4) = u1; } }
#pragma unroll
        for (int i = 0; i < 3; ++i) { const int idx = tidu + 512 * i;
            if (idx < 47 * 32) { const int rr = idx >> 5, c32 = idx & 31; v4u x = {0u, 0u, 0u, 0u};
                if (s0 - 15 + rr >= 0) x = *(const v4u*)(P + (size_t)(r0 - 15 + rr) * INC + PPOOL + 8 * c32);
                *(LAS v4u*)(ptile + (c32 >> 3) * MX_PT_G + rr * MX_PT_ROW + (c32 & 7) * 16) = x; } }
        __syncthreads();
        f32x16 oacc[2];
#pragma unroll
        for (int r = 0; r < 16; ++r) { oacc[0][r] = 0.f; oacc[1][r] = 0.f; }
        float carry = 0.f;
#define ATT_DONE(jj) ((jj) >= nb1 || __builtin_amdgcn_ballot_w64(carry >= W_EXIT) == 0ull)
#define ATT_BLOCK(KB, VB, jj, DIAGV) do { _Pragma("unroll") for (int i = 0; i < 4; ++i) *(LAS v4u*)(kwr + i * (8 * 144)) = KB[i]; K_LOAD(KB, (jj) + 2); \
        bf16x8 kf_[4]; _Pragma("unroll") for (int ds = 0; ds < 4; ++ds) kf_[ds] = *(const LAS bf16x8*)(krd + 32 * ds); \
        const f32x16 st_ = sb_qk(kf_, qf); bf16x8 pw0_, pw1_; \
        if (DIAGV) sb_weights<true>(st_, qlim, sel, carry, pw0_, pw1_); else sb_weights<false>(st_, qlim, sel, carry, pw0_, pw1_); \
        _Pragma("unroll") for (int i = 0; i < 4; ++i) *(LAS v4u*)(vwr + i * 512) = VB[i]; V_LOAD(VB, (jj) + 2); \
        sb_pv(vrd, pw0_, pw1_, oacc); } while (0)
        for (int j = 0;; j += 2) {
            ATT_BLOCK(kA, vA, j, j == 0);
            if (ATT_DONE(j)) break;
            ATT_BLOCK(kB, vB, j + 1, false);
            if (ATT_DONE(j + 1)) break;
        }
#undef K_LOAD
#undef V_LOAD
#undef ATT_DONE
#undef ATT_BLOCK
        { float ss = 0.f;
#pragma unroll
          for (int r = 0; r < 16; ++r) ss += oacc[0][r] * oacc[0][r] + oacc[1][r] * oacc[1][r];
          const auto rr = __builtin_amdgcn_permlane32_swap(__float_as_uint(ss), __float_as_uint(ss), false, false); ss = __uint_as_float(rr[0]) + __uint_as_float(rr[1]);
          if (hh == 0) hs[wave * 32 + qi] = ss; }
        f32x16 pacc;
#pragma unroll
        for (int r = 0; r < 16; ++r) pacc[r] = 0.f;
        { const int s = s0 + qi, pwin = 2 << pg; const LAS unsigned char* const tp = ptile + pg * MX_PT_G + (15 + qi) * MX_PT_ROW + hh * 16;
          float self[4][8], sum[4][8];
#pragma unroll
          for (int ks = 0; ks < 4; ++ks) { const v4u x = *(const LAS v4u*)(tp + 32 * ks);
              self[ks][0] = bflo(x.x); self[ks][1] = bfhi(x.x); self[ks][2] = bflo(x.y); self[ks][3] = bfhi(x.y); self[ks][4] = bflo(x.z); self[ks][5] = bfhi(x.z); self[ks][6] = bflo(x.w); self[ks][7] = bfhi(x.w);
#pragma unroll
              for (int j = 0; j < 8; ++j) sum[ks][j] = self[ks][j]; }
#pragma unroll 1
          for (int i = 1; i < pwin; ++i) {
#pragma unroll
              for (int ks = 0; ks < 4; ++ks) { const v4u y = *(const LAS v4u*)(tp - i * MX_PT_ROW + 32 * ks);
                  sum[ks][0] += bflo(y.x); sum[ks][1] += bfhi(y.x); sum[ks][2] += bflo(y.y); sum[ks][3] += bfhi(y.y); sum[ks][4] += bflo(y.z); sum[ks][5] += bfhi(y.z); sum[ks][6] += bflo(y.w); sum[ks][7] += bfhi(y.w); } }
          const int cnt = (s + 1 < pwin) ? s + 1 : pwin; const float rc = 1.0f / (float)cnt;
#pragma unroll
          for (int ks = 0; ks < 4; ++ks) {
#pragma unroll
              for (int j = 0; j < 8; ++j) sum[ks][j] = sum[ks][j] * rc - self[ks][j];
              const bf16x8 yf = __builtin_bit_cast(bf16x8, (v4u){cvtpk(sum[ks][0], sum[ks][1]), cvtpk(sum[ks][2], sum[ks][3]), cvtpk(sum[ks][4], sum[ks][5]), cvtpk(sum[ks][6], sum[ks][7])});
              pacc = __builtin_amdgcn_mfma_f32_32x32x16_bf16(wpf[ks], yf, pacc, 0, 0, 0); } }
        { float ss = 0.f;
#pragma unroll
          for (int r = 0; r < 16; ++r) ss += pacc[r] * pacc[r];
          const auto rr = __builtin_amdgcn_permlane32_swap(__float_as_uint(ss), __float_as_uint(ss), false, false); ss = __uint_as_float(rr[0]) + __uint_as_float(rr[1]);
          if (hh == 0) ps[wave * 32 + qi] = ss; }
        __syncthreads();
        { float tot = 0.f;
#pragma unroll
          for (int w = 0; w < 8; ++w) tot += hs[w * 32 + qi];
          const float rstd = 1.0f / sqrtf(tot * (1.0f / AW) + RMS_EPS);
          bf16* op = O + (size_t)(r0 + qi) * D + h * 64 + 4 * hh; const float* gp = A.gng + h * 64 + 4 * hhu;
#pragma unroll
          for (int c = 0; c < 2; ++c)
#pragma unroll
              for (int g = 0; g < 4; ++g) { const f32x4 gv = *(const f32x4*)(gp + 32 * c + 8 * g);
                  *(u32x2*)(op + 32 * c + 8 * g) = (u32x2){cvtpk(oacc[c][4 * g] * rstd * gv.x, oacc[c][4 * g + 1] * rstd * gv.y), cvtpk(oacc[c][4 * g + 2] * rstd * gv.z, oacc[c][4 * g + 3] * rstd * gv.w)}; } }
        { float tot = 0.f;
#pragma unroll
          for (int w = 0; w < 8; ++w) tot += ps[w * 32 + qi];
          const float rstd = 1.0f / sqrtf(tot * (1.0f / PW) + RMS_EPS);
          bf16* op = O + (size_t)(r0 + qi) * D + AW + pg * 64 + 32 * pdt + 4 * hh; const float* gp = A.gng + AW + pg * 64 + 32 * pdt + 4 * hhu;
#pragma unroll
          for (int g = 0; g < 4; ++g) { const f32x4 gv = *(const f32x4*)(gp + 8 * g);
              *(u32x2*)(op + 8 * g) = (u32x2){cvtpk(pacc[4 * g] * rstd * gv.x, pacc[4 * g + 1] * rstd * gv.y), cvtpk(pacc[4 * g + 2] * rstd * gv.z, pacc[4 * g + 3] * rstd * gv.w)}; } }
#ifndef MXR_CONV
#define MXR_CONV 1
#endif
        for (int mr_ = 0, mn_ = opaque_int(MXR_CONV); mr_ < mn_; ++mr_)
        { const unsigned loff16 = 16u * (unsigned)ln;
          f32x4 acc[4]; const f32x4 cb = *(const f32x4*)(A.convb + 4 * ln);
#pragma unroll
          for (int tk = 0; tk < 4; ++tk) acc[tk] = cb;
#pragma unroll
          for (int j0 = 0; j0 < 32; j0 += 16) { f32x4 w4[16];
#pragma unroll
              for (int jj = 0; jj < 16; ++jj) if (j0 + jj < CK) w4[jj] = *(const f32x4*)((const char*)(A.convw + (size_t)(j0 + jj) * CW) + loff16);
#pragma unroll
              for (int rr = 0; rr < 19; ++rr) { if (j0 + rr < CK + 3) { const f32x4 u4 = *(const LAS f32x4*)(ubuf + (4 * wave + j0 + rr) * 256 + 4 * lane);
#pragma unroll
                  for (int tk = 0; tk < 4; ++tk) { const int jj = rr - tk; if (jj >= 0 && jj < 16 && j0 + jj < CK) acc[tk] += w4[jj] * u4; } } }
              asm volatile("" ::: "memory"); }
          const f32x4 lg = *(const f32x4*)(A.lng + 4 * ln), lb = *(const f32x4*)(A.lnb + 4 * ln), gc = *(const f32x4*)(A.gng + AW + PW + 4 * ln);
#pragma unroll
          for (int tk = 0; tk < 4; ++tk) { const int tl = 4 * wave + tk; f32x4 v = acc[tk];
              const float mean = wave_sum((v.x + v.y) + (v.z + v.w)) * (1.0f / CW); v = v - mean;
              const float var = wave_sum((v.x * v.x + v.y * v.y) + (v.z * v.z + v.w * v.w)) * (1.0f / CW); const float rs = 1.0f / sqrtf(var + LN_EPS);
              v = v * rs * lg + lb;
              v.x = sigm_mul(v.x, v.x); v.y = sigm_mul(v.y, v.y); v.z = sigm_mul(v.z, v.z); v.w = sigm_mul(v.w, v.w);
              const float ss = wave_sum((v.x * v.x + v.y * v.y) + (v.z * v.z + v.w * v.w)); const float rstd = 1.0f / sqrtf(ss * (1.0f / CW) + RMS_EPS);
              *(u32x2*)(O + (size_t)(r0 + tl) * D + AW + PW + 4 * lane) = (u32x2){pk2(v.x * rstd * gc.x, v.y * rstd * gc.y), pk2(v.z * rstd * gc.z, v.w * rstd * gc.w)}; } }
        __syncthreads();
    }
}
constexpr int NPH = 1 + 8 * DEPTH;
struct Args { const float* in[N_IN]; float* out; unsigned char* ws; int ph_lo, ph_hi; };
__global__ void __launch_bounds__(NWAVES * 64, 2) fwd(Args args) {
    extern __shared__ __attribute__((aligned(16))) unsigned char lds[];
    Frame F;
    F.lds = (LAS unsigned char*)lds;
    F.MISC = (volatile LAS unsigned*)(F.lds + MISC_OFF);
    F.wave = __builtin_amdgcn_readfirstlane((int)(threadIdx.x >> 6));
    F.G = gridDim.x; { const int bx = blockIdx.x; F.vcu = (F.G % 8 == 0) ? (bx % 8) * (F.G / 8) + bx / 8 : bx; }
    for (int u = F.wave * 64 + lane_now(); u < (LDS_BYTES - LDSCTL_OFF) / 4; u += NWAVES * 64) ((LAS unsigned*)(F.lds + LDSCTL_OFF))[u] = 0u;
    __syncthreads();
    XcdBarrier bar; bar.bar = (unsigned*)(CTLPTR() + CW_BAR); bar.x = 0; bar.st = nullptr; bar.wv = F.wave;
    bar = xcd_barrier_post((unsigned*)(CTLPTR() + CW_BAR), F.MISC + 8, F.wave);
#ifndef REP_PRO
#define REP_PRO 1
#endif
#ifndef REP_INP
#define REP_INP 1
#endif
#ifndef REP_ATT
#define REP_ATT 1
#endif
#ifndef REP_PC
#define REP_PC 1
#endif
#ifndef REP_MGU
#define REP_MGU 1
#endif
#ifndef REP_MDN
#define REP_MDN 1
#endif
#ifndef REP_DGU
#define REP_DGU 1
#endif
#ifndef REP_NRM
#define REP_NRM 1
#endif
#ifndef GEMM_ALIGN
#define GEMM_ALIGN true
#endif
#ifndef REP_OUT
#define REP_OUT 1
#endif
#ifndef REP_DDN
#define REP_DDN 1
#endif
#ifndef REP_BAR
#define REP_BAR 1
#endif
#ifndef REP_ROW8
#define REP_ROW8 1
#endif
#ifndef REP_GAT
#define REP_GAT 1
#endif
#ifndef REP_FIN
#define REP_FIN 1
#endif
#define REPEAT(n) for (int rep_ = 0, nrep_ = opaque_int(n); rep_ < nrep_; ++rep_)
#define IN(k) true
#define SEAM(k) do { if ((k) + 1 < NPH) { REPEAT(REP_BAR) xcd_barrier(bar); } } while (0)
#define X ((bf16*)(ws + WS_X))
#define XN ((bf16*)(ws + WS_XN))
#define P ((bf16*)(ws + WS_P))
#define O ((bf16*)(ws + WS_O))
#define ACT ((bf16*)(ws + WS_ACT))
#define AP ((bf16*)(ws + WS_AP))
#define TOK_E ((int*)(ws + WS_TOKE))
#define TOK_R ((int*)(ws + WS_TOKR))
#define TOK_G ((float*)(ws + WS_TOKG))
#define TOK_S ((int*)(ws + WS_TOKS))
    if (F.G != 256) { fail_word(F.wave, 0x7f0u); return; }

    if (IN(0)) {
        unsigned char* const ws = WSPTR();
        REPEAT(REP_PRO) p0_weights(F);
        RowArgs A{}; A.xin = INP(I_X); A.xws = X; A.gain = INP(I_ANG); A.xn = XN;
        REPEAT(REP_ROW8) row_phase<8>(F, A);
        SEAM(0);
    }
#pragma unroll 1
    for (int l = 0; l < DEPTH; ++l) {
        const int pb = 1 + 8 * l, li = l >> 1; const bool moe = (l & 1) != 0;
        if (IN(pb + 0)) {
            unsigned char* const ws = WSPTR();
            pg8::Gemm g{XN, (const bf16*)(ws + WS_WIN) + (size_t)l * INC * D, T, INC, D, 0}; pg8::StaticOrder S; S.init(T, INC, opaque_int(F.G), opaque_int((int)blockIdx.x));
            pg8::EpiBf16<0> E{P, INC, nullptr, 0, 0, 1.f};
            REPEAT(REP_INP) pg8::gemm_phase<pg8::EpiBf16<0>, pg8::StaticOrder, GEMM_ALIGN, true>(F.lds + RING_OFF, g, S, E, opaque_int(F.wave));
            { const int bx = opaque_int((int)blockIdx.x);
              if (bx >= 64) { const int rk = bx - 64; if (moe) moe_convert(F, li, CVT_C0 + CVT_C_PER * rk, CVT_C0 + CVT_C_PER * (rk + 1)); else moe_convert(F, li, CVT_A0 + CVT_A_PER * rk, CVT_A0 + CVT_A_PER * (rk + 1)); } }
            SEAM(pb + 0);
        }
        if (IN(pb + 1)) {
            unsigned char* const ws = WSPTR();
            PcArgs A{P, O, INP(I_POOLW) + (size_t)l * 4 * 64 * 64, INP(I_POOLS) + (size_t)l * PW, INP(I_CONVW) + (size_t)l * CK * CW, INP(I_CONVB) + (size_t)l * CW,
                     INP(I_LNG) + (size_t)l * CW, INP(I_LNB) + (size_t)l * CW, INP(I_GNG) + (size_t)l * D};
            REPEAT(REP_ATT) mixer_phase(F, A);
            SEAM(pb + 1);
        }
        if (IN(pb + 2)) {
            unsigned char* const ws = WSPTR();
            pg8::Gemm g{O, (const bf16*)(ws + WS_WOUT) + (size_t)l * D * D, T, D, D, 0}; pg8::StaticOrder S; S.init(T, D, opaque_int(F.G), opaque_int((int)blockIdx.x));
            pg8::EpiResid E{X, D, 1.0f};
            pg8::EpiResid Edummy{AP, D, 1.0f};
            REPEAT(REP_OUT) pg8::gemm_phase<pg8::EpiResid, pg8::StaticOrder, GEMM_ALIGN, true>(F.lds + RING_OFF, g, S, rep_ + 1 < nrep_ ? Edummy : E, opaque_int(F.wave));
            SEAM(pb + 2);
        }
        if (IN(pb + 3)) {
            unsigned char* const ws = WSPTR();
            RowArgs A{}; A.xsrc = X; A.xws = X; A.gain = INP(I_FNG) + (size_t)l * D; A.xn = XN;
            if (moe) { A.wr = INP(I_RW) + (size_t)li * D * NE; A.gcur = CTLPTR() + CW_MOE + li * 1024; A.tok_e = TOK_E; A.tok_r = TOK_R; A.tok_g = TOK_G; row_phase<2>(F, A); }
            else REPEAT(REP_NRM) row_phase<0>(F, A);
            SEAM(pb + 3);
        }
        if (moe) {
            if (IN(pb + 4)) { unsigned char* const ws = WSPTR(); gu32* const gcur = CTLPTR() + CW_MOE + li * 1024; REPEAT(REP_GAT) gather_phase(F, gcur, XN, (unsigned char*)AP, TOK_E, TOK_R, TOK_S); SEAM(pb + 4); }
            if (IN(pb + 5)) {
                unsigned char* const ws = WSPTR(); gu32* const gcur = CTLPTR() + CW_MOE + li * 1024;
                int cnt[8], toff[9]; load_toff(gcur, cnt, toff);
                pg8::Gemm g{AP, (const bf16*)(ws + WS_WGUM + (size_t)li * NE * NGU * D), 0, NGU, D / 2, (size_t)NGU * D}; pg8::GroupedOrder S; S.init(toff, NGU, opaque_int(F.G), opaque_int((int)blockIdx.x));
                pg8::EpiSwiGLU8 E{(unsigned char*)ACT, FF, 1.0f / (WSCALE8 * XSCALE8), ASCALE8};
                REPEAT(REP_MGU) pg8::gemm_phase<pg8::EpiSwiGLU8, pg8::GroupedOrder, GEMM_ALIGN, true, true>(F.lds + RING_OFF, g, S, E, opaque_int(F.wave));
                SEAM(pb + 5);
            }
            if (IN(pb + 6)) {
                unsigned char* const ws = WSPTR(); gu32* const gcur = CTLPTR() + CW_MOE + li * 1024;
                int cnt[8], toff[9]; load_toff(gcur, cnt, toff);
                pg8::Gemm g{ACT, (const bf16*)(ws + WS_WDM + (size_t)li * NE * D * FF), 0, D, FF / 2, (size_t)D * FF}; pg8::GroupedOrder S; S.init(toff, D, opaque_int(F.G), opaque_int((int)blockIdx.x));
                pg8::EpiBf16S E{AP, D, 1.0f / (WSCALE8 * ASCALE8)};
                REPEAT(REP_MDN) pg8::gemm_phase<pg8::EpiBf16S, pg8::GroupedOrder, GEMM_ALIGN, true, true>(F.lds + RING_OFF, g, S, E, opaque_int(F.wave));
                SEAM(pb + 6);
            }
        } else {
            if (IN(pb + 5)) {
                unsigned char* const ws = WSPTR();
                pg8::Gemm g{XN, (const bf16*)(ws + WS_WGUD) + (size_t)li * NGU * D, T, NGU, D, 0}; pg8::StaticOrder S; S.init(T, NGU, opaque_int(F.G), opaque_int((int)blockIdx.x));
                pg8::EpiSwiGLU8 E{(unsigned char*)ACT, FF, 1.0f, ASCALE8};
                REPEAT(REP_DGU) pg8::gemm_phase<pg8::EpiSwiGLU8, pg8::StaticOrder, GEMM_ALIGN, true>(F.lds + RING_OFF, g, S, E, opaque_int(F.wave));
                { const int bx = opaque_int((int)blockIdx.x);
                  if (bx >= 128) { const int rk = bx - 128; moe_convert(F, li, CVT_B0 + CVT_B_PER * rk, CVT_B0 + CVT_B_PER * (rk + 1)); } }
                SEAM(pb + 5);
            }
            if (IN(pb + 6)) {
                unsigned char* const ws = WSPTR();
                pg8::Gemm g{ACT, (const bf16*)(ws + WS_WDD + (size_t)li * D * FF), T, D, FF / 2, 0}; pg8::StaticOrder S; S.init(T, D, opaque_int(F.G), opaque_int((int)blockIdx.x));
                pg8::EpiResid E{X, D, 1.0f / (WSCALE8 * ASCALE8)};
                pg8::EpiResid Edummy{AP, D, 1.0f};
                REPEAT(REP_DDN) pg8::gemm_phase<pg8::EpiResid, pg8::StaticOrder, GEMM_ALIGN, true, true>(F.lds + RING_OFF, g, S, rep_ + 1 < nrep_ ? Edummy : E, opaque_int(F.wave));
                SEAM(pb + 6);
            }
        }
        if (IN(pb + 7)) {
            unsigned char* const ws = WSPTR();
            RowArgs A{}; A.xsrc = X; A.xws = X; A.xn = XN; A.out = OUTPTR(); A.yp = AP; A.tok_g = TOK_G; A.tok_s = TOK_S;
            A.gain = (l == DEPTH - 1) ? INP(I_FING) : INP(I_ANG) + (size_t)(l + 1) * D;
            if (l == DEPTH - 1) REPEAT(REP_FIN) row_phase<5>(F, A);
            else if (moe) row_phase<1>(F, A);
            else row_phase<0>(F, A);
            SEAM(pb + 7);
        }
    }
#undef IN
#undef SEAM
#undef X
#undef XN
#undef P
#undef O
#undef ACT
#undef AP
#undef TOK_E
#undef TOK_R
#undef TOK_G
#undef TOK_S
}

#ifndef MK_ONE_LAUNCH
#define MK_ONE_LAUNCH 0
#endif
extern "C" void kernel_launch(void* const* d_in, const int* in_sizes, int n_in, void* d_out, int out_size, void* d_ws, size_t ws_size, hipStream_t stream) {
    static int grid = 0;
    if (grid == 0) {
        if (n_in != N_IN || in_sizes[0] != T * D || out_size != T * D || ws_size < WS_END) { fprintf(stderr, "kernel_launch: unexpected problem shape (n_in %d, in0 %d, out %d, ws %zu); nothing launched\n", n_in, n_in > 0 ? in_sizes[0] : -1, out_size, ws_size); grid = -1; return; }
        if (hipFuncSetAttribute((const void*)fwd, hipFuncAttributeMaxDynamicSharedMemorySize, LDS_BYTES) != hipSuccess) { fprintf(stderr, "kernel_launch: hipFuncSetAttribute failed; nothing launched\n"); grid = -1; return; }
        int per_cu = 0;
        if (hipOccupancyMaxActiveBlocksPerMultiprocessor(&per_cu, (const void*)fwd, NWAVES * 64, LDS_BYTES) != hipSuccess || per_cu < 1)
            fprintf(stderr, "kernel_launch: note: occupancy query reports %d workgroups per CU\n", per_cu);
        (void)hipGetLastError();
        grid = 256;
    }
    if (grid < 0) return;
    if (hipMemsetAsync((char*)d_ws + WS_CTL, 0, CTL_ZERO_BYTES, stream) != hipSuccess) { fprintf(stderr, "kernel_launch: hipMemsetAsync failed; nothing launched\n"); return; }
    Args a{};
    for (int i = 0; i < N_IN; ++i) a.in[i] = (const float*)d_in[i];
    a.out = (float*)d_out; a.ws = (unsigned char*)d_ws;
    a.ph_lo = 0; a.ph_hi = NPH;
    hipLaunchKernelGGL(fwd, dim3(grid), dim3(NWAVES * 64), LDS_BYTES, stream, a);
    const hipError_t le = hipPeekAtLastError();
    if (le != hipSuccess) fprintf(stderr, "kernel_launch: launch failed: %s\n", hipGetErrorName(le));
}
```

```cpp
#include <hip/hip_runtime.h>
#include <cstdio>
#include <cstdint>
#include <cmath>
#define MK_ONE_LAUNCH 1
__device__ __forceinline__ int lane_now() { int l; asm volatile("v_mbcnt_lo_u32_b32 %0, -1, 0\n\tv_mbcnt_hi_u32_b32 %0, -1, %0" : "=v"(l)); return l; }
namespace pg8 {
#define PG8_LAS __attribute__((address_space(3)))
typedef unsigned short bf16_t;
typedef short bf16x8 __attribute__((ext_vector_type(8)));
typedef float f32x4 __attribute__((ext_vector_type(4)));
typedef unsigned u32x4 __attribute__((ext_vector_type(4)));
constexpr int BM = 256, BK = 64, HALF = 128, HTB = HALF * BK * 2  , STAGE_BYTES = 8 * HTB, NXCD = 8, WGM = 8;

__host__ __device__ __forceinline__ int lds_byte(int r, int c) { const int st = (r >> 4) * 2 + (c >> 5), rr = r & 15, cc = c & 31, ob = rr * 64 + cc * 2; return st * 1024 + (ob ^ (((ob >> 9) & 1) << 5)); }
__host__ __device__ __forceinline__ void stage_rc(int b, int& R, int& C) { const int st = b / 1024, sb = b % 1024, swz = sb ^ (((sb >> 9) & 1) << 5); R = (st >> 1) * 16 + swz / 64; C = (st & 1) * 32 + (swz % 64) / 2; }
__host__ __device__ __forceinline__ int perm32(int rho) { const int n = rho >> 4, i = rho & 15; return 8 * (i >> 2) + 4 * n + (i & 3); }

struct Unit { int pm, pn, e; };
struct Gemm { const bf16_t* A; const bf16_t* Bt; int M, N, K; size_t estride; };

struct StaticOrder {
    int nM, nN, nwg, G, c;
    __host__ __device__ void init(int M, int N, int G_, int c_) { nM = M / BM; nN = N / BM; nwg = nM * nN; G = G_; c = c_; }
    __host__ __device__ bool next(int i, Unit& u) const {
        const long L = (long)i * G + c; if (L >= nwg) return false;
        int wgid = (int)L; { const int q = nwg / NXCD, r = nwg % NXCD, xcd = wgid % NXCD, off = wgid / NXCD; wgid = (xcd < r ? xcd * (q + 1) : r * (q + 1) + (xcd - r) * q) + off; }
        const int nig = WGM * nN, gid = wgid / nig, fm = gid * WGM, gsz = (nM - fm) < WGM ? (nM - fm) : WGM;
        u.pm = fm + ((wgid % nig) % gsz); u.pn = (wgid % nig) / gsz; u.e = 0; return true;
    }
    __device__ __forceinline__ void a_ready(const Unit&) const {}
    __device__ __forceinline__ void done(const Unit&) const {}
};

__device__ __forceinline__ unsigned cvt_pk_bf16(float lo, float hi) { unsigned r; asm volatile("v_cvt_pk_bf16_f32 %0, %1, %2" : "=v"(r) : "v"(lo), "v"(hi)); return r; }
typedef float f32x2 __attribute__((ext_vector_type(2)));
__device__ __forceinline__ f32x2 gelu_pk(f32x2 v) {
    const f32x2 av = __builtin_elementwise_abs(v), d = av * 0.2316418882f + 1.0f;
    f32x2 t; t.x = __builtin_amdgcn_rcpf(d.x); t.y = __builtin_amdgcn_rcpf(d.y);
    f32x2 q = t * 0.5307027145f + (-0.7265760135f); q = q * t + 0.7107068705f; q = q * t + (-0.142248368f); q = q * t + 0.127414796f; q = q * t;
    const f32x2 s = (v * v) * (-0.72134752044f);
    f32x2 e; e.x = __builtin_amdgcn_exp2f(s.x); e.y = __builtin_amdgcn_exp2f(s.y);
    const f32x2 m = v * (q * e), r = v - m;
    f32x2 o; o.x = v.x < 0.f ? m.x : r.x; o.y = v.y < 0.f ? m.y : r.y; return o;
}

template <int ACT  > struct EpiBf16 {
    static constexpr bool PERM = true, AFTER_DRAIN = false; static constexpr int NSTORE = 16; static_assert(ACT == 0 || ACT == 1, "EpiBf16: ACT is 0 (none) or 1 (gelu_pk)");
    bf16_t* O; int ldc; const float* bias; int split_cols; size_t split_stride; float scale0;
    __device__ __forceinline__ void operator()(const f32x4 (&acc)[2][2][4][2], const Unit& u, int wr, int wc, int fr, int fq) const {
        const int row0 = u.pm * BM + wr * 64 + fr; int colt = u.pn * BM; bf16_t* base = O;
        float sc = 1.f; if (split_cols) { const int t = colt / split_cols; base += (size_t)t * split_stride; colt -= t * split_cols; if (t == 0) sc = scale0; }
        const int col0 = colt + wc * 32 + 8 * fq, bcol0 = u.pn * BM + wc * 32 + 8 * fq;
        f32x4 bv[2][2];
#pragma unroll
        for (int bj = 0; bj < 2; ++bj)
#pragma unroll
            for (int n = 0; n < 2; ++n) bv[bj][n] = bias ? *(const f32x4*)(bias + bcol0 + bj * HALF + 4 * n) : (f32x4){0.f, 0.f, 0.f, 0.f};
#pragma unroll
        for (int ai = 0; ai < 2; ++ai)
#pragma unroll
            for (int m = 0; m < 4; ++m) { bf16_t* rowp = base + (size_t)(row0 + ai * HALF + m * 16) * ldc + col0;
#pragma unroll
                for (int bj = 0; bj < 2; ++bj) { f32x4 v0 = acc[ai][bj][m][0] + bv[bj][0], v1 = acc[ai][bj][m][1] + bv[bj][1];
                    if (ACT == 1) { f32x2 a = gelu_pk((f32x2){v0[0], v0[1]}), b = gelu_pk((f32x2){v0[2], v0[3]}), c = gelu_pk((f32x2){v1[0], v1[1]}), d = gelu_pk((f32x2){v1[2], v1[3]});
                        v0 = (f32x4){a.x, a.y, b.x, b.y}; v1 = (f32x4){c.x, c.y, d.x, d.y}; }
                    v0 = v0 * sc; v1 = v1 * sc; u32x4 w; w.x = cvt_pk_bf16(v0[0], v0[1]); w.y = cvt_pk_bf16(v0[2], v0[3]); w.z = cvt_pk_bf16(v1[0], v1[1]); w.w = cvt_pk_bf16(v1[2], v1[3]);
                    *(u32x4*)(rowp + bj * HALF) = w; } }
    }
};
struct EpiResid {
    static constexpr bool PERM = true, AFTER_DRAIN = false; static constexpr int NSTORE = 0;
    bf16_t* X; int ldc; float s;
    __device__ __forceinline__ void operator()(const f32x4 (&acc)[2][2][4][2], const Unit& u, int wr, int wc, int fr, int fq) const {
        const int row0 = u.pm * BM + wr * 64 + fr, col0 = u.pn * BM + wc * 32 + 8 * fq;
#pragma unroll
        for (int ai = 0; ai < 2; ++ai)
#pragma unroll
            for (int m = 0; m < 4; ++m) { bf16_t* rowp = X + (size_t)(row0 + ai * HALF + m * 16) * ldc + col0;
                u32x4 old[2];
#pragma unroll
                for (int bj = 0; bj < 2; ++bj) old[bj] = *(const u32x4*)(rowp + bj * HALF);
#pragma unroll
                for (int bj = 0; bj < 2; ++bj) { const f32x4 a0 = acc[ai][bj][m][0] * s, a1 = acc[ai][bj][m][1] * s; const u32x4 o = old[bj]; u32x4 w;
                    w.x = cvt_pk_bf16(__builtin_bit_cast(float, o.x << 16) + a0[0], __builtin_bit_cast(float, o.x & 0xffff0000u) + a0[1]);
                    w.y = cvt_pk_bf16(__builtin_bit_cast(float, o.y << 16) + a0[2], __builtin_bit_cast(float, o.y & 0xffff0000u) + a0[3]);
                    w.z = cvt_pk_bf16(__builtin_bit_cast(float, o.z << 16) + a1[0], __builtin_bit_cast(float, o.z & 0xffff0000u) + a1[1]);
                    w.w = cvt_pk_bf16(__builtin_bit_cast(float, o.w << 16) + a1[2], __builtin_bit_cast(float, o.w & 0xffff0000u) + a1[3]);
                    *(u32x4*)(rowp + bj * HALF) = w; }
                asm volatile("" ::: "memory"); }
    }
};
__device__ __forceinline__ float silu_mul(float g, float u) { return g * __builtin_amdgcn_rcpf(1.0f + __builtin_amdgcn_exp2f(g * -1.4426950408889634f)) * u; }
struct EpiSwiGLU {
    static constexpr bool PERM = true, AFTER_DRAIN = false; static constexpr int NSTORE = 8;
    bf16_t* O; int ldc;
    __device__ __forceinline__ void operator()(const f32x4 (&acc)[2][2][4][2], const Unit& u, int wr, int wc, int fr, int fq) const {
        const int row0 = u.pm * BM + wr * 64 + fr, col0 = u.pn * HALF + wc * 32 + 8 * fq;
#pragma unroll
        for (int ai = 0; ai < 2; ++ai)
#pragma unroll
            for (int m = 0; m < 4; ++m) { bf16_t* rowp = O + (size_t)(row0 + ai * HALF + m * 16) * ldc + col0;
                const f32x4 g0 = acc[ai][0][m][0], g1 = acc[ai][0][m][1], u0 = acc[ai][1][m][0], u1 = acc[ai][1][m][1];
                u32x4 w;
                w.x = cvt_pk_bf16(silu_mul(g0[0], u0[0]), silu_mul(g0[1], u0[1])); w.y = cvt_pk_bf16(silu_mul(g0[2], u0[2]), silu_mul(g0[3], u0[3]));
                w.z = cvt_pk_bf16(silu_mul(g1[0], u1[0]), silu_mul(g1[1], u1[1])); w.w = cvt_pk_bf16(silu_mul(g1[2], u1[2]), silu_mul(g1[3], u1[3]));
                *(u32x4*)rowp = w; }
    }
};
typedef int v4i_t __attribute__((ext_vector_type(4)));
typedef unsigned u32x2e __attribute__((ext_vector_type(2)));
__device__ __forceinline__ float clamp8(float v) { return __builtin_fminf(__builtin_fmaxf(v, -448.0f), 448.0f); }
__device__ __forceinline__ unsigned pack_fp8x4(float a, float b, float c, float d) { unsigned w = 0u; w = __builtin_amdgcn_cvt_pk_fp8_f32(clamp8(a), clamp8(b), w, false); w = __builtin_amdgcn_cvt_pk_fp8_f32(clamp8(c), clamp8(d), w, true); return w; }
struct EpiSwiGLU8 {
    static constexpr bool PERM = true, AFTER_DRAIN = false; static constexpr int NSTORE = 8;
    unsigned char* O; int ldc; float sin, sout;
    __device__ __forceinline__ void operator()(const f32x4 (&acc)[2][2][4][2], const Unit& u, int wr, int wc, int fr, int fq) const {
        const int row0 = u.pm * BM + wr * 64 + fr, col0 = u.pn * HALF + wc * 32 + 8 * fq;
#pragma unroll
        for (int ai = 0; ai < 2; ++ai)
#pragma unroll
            for (int m = 0; m < 4; ++m) { unsigned char* rowp = O + (size_t)(row0 + ai * HALF + m * 16) * ldc + col0;
                const f32x4 g0 = acc[ai][0][m][0] * sin, g1 = acc[ai][0][m][1] * sin, u0 = acc[ai][1][m][0] * (sin * sout), u1 = acc[ai][1][m][1] * (sin * sout);
                u32x2e w;
                w.x = pack_fp8x4(silu_mul(g0[0], u0[0]), silu_mul(g0[1], u0[1]), silu_mul(g0[2], u0[2]), silu_mul(g0[3], u0[3]));
                w.y = pack_fp8x4(silu_mul(g1[0], u1[0]), silu_mul(g1[1], u1[1]), silu_mul(g1[2], u1[2]), silu_mul(g1[3], u1[3]));
                *(u32x2e*)rowp = w; }
    }
};
struct EpiBf16S {
    static constexpr bool PERM = true, AFTER_DRAIN = false; static constexpr int NSTORE = 16;
    bf16_t* O; int ldc; float s;
    __device__ __forceinline__ void operator()(const f32x4 (&acc)[2][2][4][2], const Unit& u, int wr, int wc, int fr, int fq) const {
        const int row0 = u.pm * BM + wr * 64 + fr, col0 = u.pn * BM + wc * 32 + 8 * fq;
#pragma unroll
        for (int ai = 0; ai < 2; ++ai)
#pragma unroll
            for (int m = 0; m < 4; ++m) { bf16_t* rowp = O + (size_t)(row0 + ai * HALF + m * 16) * ldc + col0;
#pragma unroll
                for (int bj = 0; bj < 2; ++bj) { const f32x4 v0 = acc[ai][bj][m][0] * s, v1 = acc[ai][bj][m][1] * s;
                    u32x4 w; w.x = cvt_pk_bf16(v0[0], v0[1]); w.y = cvt_pk_bf16(v0[2], v0[3]); w.z = cvt_pk_bf16(v1[0], v1[1]); w.w = cvt_pk_bf16(v1[2], v1[3]);
                    *(u32x4*)(rowp + bj * HALF) = w; } }
    }
};
struct GroupedOrder {
    int nM, nN, nwg, G, c; int t1, t2, t3, t4, t5, t6, t7;
    __device__ __forceinline__ void init(const int (&toff)[9], int N, int G_, int c_) { nM = toff[8]; nN = N / BM; nwg = nM * nN; G = G_; c = c_;
        t1 = toff[1]; t2 = toff[2]; t3 = toff[3]; t4 = toff[4]; t5 = toff[5]; t6 = toff[6]; t7 = toff[7]; }
    __device__ __forceinline__ bool next(int i, Unit& u) const {
        const long L = (long)i * G + c; if (L >= nwg) return false;
        int wgid = (int)L; { const int q = nwg / NXCD, r = nwg % NXCD, xcd = wgid % NXCD, off = wgid / NXCD; wgid = (xcd < r ? xcd * (q + 1) : r * (q + 1) + (xcd - r) * q) + off; }
        const int nig = WGM * nN, gid = wgid / nig, fm = gid * WGM, gsz = (nM - fm) < WGM ? (nM - fm) : WGM;
        u.pm = fm + ((wgid % nig) % gsz); u.pn = (wgid % nig) / gsz;
        int e_ = 0; e_ = (u.pm >= t1) ? 1 : e_; e_ = (u.pm >= t2) ? 2 : e_; e_ = (u.pm >= t3) ? 3 : e_; e_ = (u.pm >= t4) ? 4 : e_; e_ = (u.pm >= t5) ? 5 : e_; e_ = (u.pm >= t6) ? 6 : e_; e_ = (u.pm >= t7) ? 7 : e_;
        u.e = e_; return true;
    }
    __device__ __forceinline__ void a_ready(const Unit&) const {}
    __device__ __forceinline__ void done(const Unit&) const {}
};
template <class Epi, class Sched, bool ALIGN_EPI = false, bool SP2 = false, bool F8 = false>
__device__ __forceinline__ void gemm_phase(PG8_LAS unsigned char* lds, const Gemm g, const Sched& S, const Epi& E, const int wave_u  ) {
    const int tid_ = wave_u * 64 + lane_now();
    const int tid = tid_, wid = wave_u, lane = tid & 63, wr = wid >> 2, wc = wid & 3, fr = lane & 15, fq = lane >> 4;
    const int K = g.K, nt = K / BK;
    unsigned voffA[2], voffB[2];
#pragma unroll
    for (int i = 0; i < 2; ++i) { int R, C; stage_rc(tid * 16 + i * 8192, R, C); const int Rb = Epi::PERM ? ((R & ~31) + perm32(R & 31)) : R;
        voffA[i] = (unsigned)(R * K + C) * 2u; voffB[i] = (unsigned)(Rb * K + C) * 2u; }
    const size_t kstep = (size_t)(BK * 2);
    const size_t hstep = (size_t)HALF * K * 2;
    const size_t tstep = 2 * hstep;
    const unsigned ldsw = (unsigned)wid * 1024u;
    const unsigned ldsbase = (unsigned)(uintptr_t)lds + ldsw;
    const int aoff = lds_byte(wr * 64 + fr, fq * 8), boff = lds_byte(wc * 32 + fr, fq * 8);
#define PG8_SA(b, h) (((b) * 2 + (h)) * HTB)
#define PG8_SB(b, h) ((4 + (b) * 2 + (h)) * HTB)
#define PG8_GLDS(sbase, voff32, ldsdst) do { unsigned keep_; asm volatile("s_mov_b32 %0, m0\n\ts_mov_b32 m0, %3\n\ts_nop 0\n\tglobal_load_lds_dwordx4 %1, %2\n\ts_mov_b32 m0, %0" \
        : "=&s"(keep_) : "v"(voff32), "s"(sbase), "s"(ldsdst) : "memory"); } while (0)
#define PG8_STAGE(bufoff, gbase, voff) do { _Pragma("unroll") for (int _i = 0; _i < 2; ++_i) \
        PG8_GLDS((const char*)(gbase), (voff)[_i], (unsigned)__builtin_amdgcn_readfirstlane((int)(ldsbase + (unsigned)((bufoff) + _i * 8192)))); } while (0)
#define PG8_LDA(dst, b, h) do { _Pragma("unroll") for (int m = 0; m < 4; ++m) _Pragma("unroll") for (int k = 0; k < 2; ++k) dst[m][k] = *(const PG8_LAS bf16x8*)(lds + PG8_SA(b, h) + aoff + m * 2048 + k * 1024); } while (0)
#define PG8_LDB(dst, b, h) do { _Pragma("unroll") for (int n = 0; n < 2; ++n) _Pragma("unroll") for (int k = 0; k < 2; ++k) dst[n][k] = *(const PG8_LAS bf16x8*)(lds + PG8_SB(b, h) + boff + n * 2048 + k * 1024); } while (0)
#define PG8_CAT8(a, b) __builtin_shufflevector(__builtin_bit_cast(v4i_t, (a)), __builtin_bit_cast(v4i_t, (b)), 0, 1, 2, 3, 4, 5, 6, 7)
#define PG8_MMA(ai, bj, At, Bt) do { __builtin_amdgcn_s_setprio(1); if constexpr (F8) { _Pragma("unroll") for (int m = 0; m < 4; ++m) _Pragma("unroll") for (int n = 0; n < 2; ++n) \
        acc[ai][bj][m][n] = __builtin_amdgcn_mfma_scale_f32_16x16x128_f8f6f4(PG8_CAT8(Bt[n][0], Bt[n][1]), PG8_CAT8(At[m][0], At[m][1]), acc[ai][bj][m][n], 0, 0, 0, 0, 0, 0); } else { \
        _Pragma("unroll") for (int m = 0; m < 4; ++m) _Pragma("unroll") for (int n = 0; n < 2; ++n) _Pragma("unroll") for (int k = 0; k < 2; ++k) \
        acc[ai][bj][m][n] = __builtin_amdgcn_mfma_f32_16x16x32_bf16(Bt[n][k], At[m][k], acc[ai][bj][m][n], 0, 0, 0); } __builtin_amdgcn_s_setprio(0); } while (0)
#define PG8_WAIT_V(n) asm volatile("s_waitcnt vmcnt(" #n ")" ::: "memory")
#define PG8_WAIT_V8F do { if (fresh) { if constexpr (Epi::NSTORE == 16) PG8_WAIT_V(24); else if constexpr (Epi::NSTORE == 8) PG8_WAIT_V(16); else PG8_WAIT_V(8); } else PG8_WAIT_V(8); } while (0)
#define PG8_WAIT_L(n) asm volatile("s_waitcnt lgkmcnt(" #n ")" ::: "memory")
#define PG8_BAR __builtin_amdgcn_s_barrier()
#define PG8_SCHED __builtin_amdgcn_sched_barrier(0)
    Unit cur, nxt; int ui = 0;
    if (!S.next(0, cur)) return;
    f32x4 acc[2][2][4][2];
#pragma unroll
    for (int a = 0; a < 2; ++a)
#pragma unroll
        for (int b = 0; b < 2; ++b)
#pragma unroll
            for (int m = 0; m < 4; ++m)
#pragma unroll
                for (int n = 0; n < 2; ++n) acc[a][b][m][n] = (f32x4){0.f, 0.f, 0.f, 0.f};
    bf16x8 At[4][2], B0[2][2], B1[2][2];
    const char* cA = (const char*)g.A + (size_t)cur.pm * tstep; const char* cB = (const char*)g.Bt + (size_t)cur.e * g.estride + (size_t)cur.pn * tstep;
    S.a_ready(cur);
    if constexpr (SP2) {
        PG8_STAGE(PG8_SB(0, 0), cB, voffB); PG8_STAGE(PG8_SB(0, 1), cB + hstep, voffB); PG8_STAGE(PG8_SA(0, 0), cA, voffA); PG8_STAGE(PG8_SA(0, 1), cA + hstep, voffA);
        if (wr == 1) PG8_BAR;
        PG8_WAIT_V(2); PG8_BAR;
        PG8_STAGE(PG8_SB(1, 0), cB + kstep, voffB); PG8_STAGE(PG8_SA(1, 0), cA + kstep, voffA); PG8_STAGE(PG8_SB(1, 1), cB + hstep + kstep, voffB);
        PG8_WAIT_V(6); PG8_BAR;
    } else {
        PG8_STAGE(PG8_SB(0, 0), cB, voffB); PG8_STAGE(PG8_SA(0, 0), cA, voffA); PG8_STAGE(PG8_SB(0, 1), cB + hstep, voffB); PG8_STAGE(PG8_SA(0, 1), cA + hstep, voffA);
        if (wr == 1) PG8_BAR;
        PG8_WAIT_V(4); PG8_BAR;
        PG8_STAGE(PG8_SB(1, 0), cB + kstep, voffB); PG8_STAGE(PG8_SA(1, 0), cA + kstep, voffA); PG8_STAGE(PG8_SB(1, 1), cB + hstep + kstep, voffB);
        PG8_WAIT_V(6); PG8_BAR;
    }
    for (;;) {
        const bool has_next = S.next(ui + 1, nxt);
        const char* nA = has_next ? (const char*)g.A + (size_t)nxt.pm * tstep : cA; const char* nB = has_next ? (const char*)g.Bt + (size_t)nxt.e * g.estride + (size_t)nxt.pn * tstep : cB;
        for (int t = 0; t < nt; t += 2) {
            const bool last = (t == nt - 2); const bool fresh = (t == 0) && (ui > 0);
            const char* a1 = cA + (size_t)(t + 1) * kstep;
            const char* a2 = last ? nA : cA + (size_t)(t + 2) * kstep; const char* b2 = last ? nB : cB + (size_t)(t + 2) * kstep;
            const char* a3 = a2 + kstep; const char* b3 = b2 + kstep;
            if (last && has_next) S.a_ready(nxt);
            if constexpr (SP2) {
            PG8_LDB(B0, 0, 0); PG8_LDB(B1, 0, 1); PG8_SCHED; PG8_LDA(At, 0, 0); PG8_STAGE(PG8_SA(1, 1), a1 + hstep, voffA);
            PG8_WAIT_V8F; PG8_WAIT_L(0); PG8_BAR; PG8_MMA(0, 0, At, B0); PG8_MMA(0, 1, At, B1); PG8_BAR; PG8_SCHED;
            PG8_LDA(At, 0, 1); PG8_STAGE(PG8_SB(0, 0), b2, voffB); PG8_STAGE(PG8_SB(0, 1), b2 + hstep, voffB); PG8_STAGE(PG8_SA(0, 0), a2, voffA);
            PG8_WAIT_V8F; PG8_WAIT_L(0); PG8_BAR; PG8_MMA(1, 0, At, B0); PG8_MMA(1, 1, At, B1); PG8_BAR; PG8_SCHED;
            PG8_LDB(B0, 1, 0); PG8_LDB(B1, 1, 1); PG8_SCHED; PG8_LDA(At, 1, 0); PG8_STAGE(PG8_SA(0, 1), a2 + hstep, voffA);
            PG8_WAIT_V(8); PG8_WAIT_L(0); PG8_BAR; PG8_MMA(0, 0, At, B0); PG8_MMA(0, 1, At, B1); PG8_BAR; PG8_SCHED;
            PG8_LDA(At, 1, 1); PG8_STAGE(PG8_SB(1, 0), b3, voffB); PG8_STAGE(PG8_SB(1, 1), b3 + hstep, voffB); PG8_STAGE(PG8_SA(1, 0), a3, voffA);
            PG8_WAIT_V(8); PG8_WAIT_L(0); PG8_BAR; PG8_MMA(1, 0, At, B0); PG8_MMA(1, 1, At, B1); PG8_BAR; PG8_SCHED;
            } else {
            PG8_LDB(B0, 0, 0); PG8_SCHED; PG8_LDA(At, 0, 0); PG8_STAGE(PG8_SA(1, 1), a1 + hstep, voffA);
            PG8_WAIT_L(8); PG8_BAR; PG8_WAIT_L(0); PG8_MMA(0, 0, At, B0); PG8_BAR; PG8_SCHED;
            PG8_LDB(B1, 0, 1); PG8_STAGE(PG8_SB(0, 0), b2, voffB);
            PG8_BAR; PG8_WAIT_L(0); PG8_MMA(0, 1, At, B1); PG8_BAR;
            PG8_LDA(At, 0, 1); PG8_STAGE(PG8_SA(0, 0), a2, voffA);
            PG8_BAR; PG8_WAIT_L(0); PG8_MMA(1, 0, At, B0); PG8_BAR; PG8_SCHED;
            PG8_STAGE(PG8_SB(0, 1), b2 + hstep, voffB);
            PG8_WAIT_V(6); PG8_BAR; PG8_MMA(1, 1, At, B1); PG8_BAR;
            PG8_LDB(B0, 1, 0); PG8_SCHED; PG8_LDA(At, 1, 0); PG8_STAGE(PG8_SA(0, 1), a2 + hstep, voffA);
            PG8_WAIT_L(8); PG8_BAR; PG8_WAIT_L(0); PG8_MMA(0, 0, At, B0); PG8_BAR; PG8_SCHED;
            PG8_LDB(B1, 1, 1); PG8_STAGE(PG8_SB(1, 0), b3, voffB);
            PG8_BAR; PG8_WAIT_L(0); PG8_MMA(0, 1, At, B1); PG8_BAR;
            PG8_LDA(At, 1, 1); PG8_STAGE(PG8_SA(1, 0), a3, voffA);
            PG8_BAR; PG8_WAIT_L(0); PG8_MMA(1, 0, At, B0); PG8_BAR; PG8_SCHED;
            PG8_STAGE(PG8_SB(1, 1), b3 + hstep, voffB);
            PG8_WAIT_V(6); PG8_BAR; PG8_MMA(1, 1, At, B1); PG8_BAR;
            }
        }
        if constexpr (ALIGN_EPI) { if (wr == 0) PG8_BAR; }
        if constexpr (!Epi::AFTER_DRAIN) { const int le_ = lane_now(); E(acc, cur, wr, wc, le_ & 15, le_ >> 4); S.done(cur); }
        if (!has_next) break;
#pragma unroll
        for (int a = 0; a < 2; ++a)
#pragma unroll
            for (int b = 0; b < 2; ++b)
#pragma unroll
                for (int m = 0; m < 4; ++m)
#pragma unroll
                    for (int n = 0; n < 2; ++n) acc[a][b][m][n] = (f32x4){0.f, 0.f, 0.f, 0.f};
        cur = nxt; cA = nA; cB = nB; ++ui;
        if constexpr (ALIGN_EPI) { if (wr == 1) PG8_BAR; }
    }
    PG8_WAIT_V(0);
    if constexpr (!ALIGN_EPI) { if (wr == 0) PG8_BAR; }
    PG8_BAR;
    if constexpr (Epi::AFTER_DRAIN) { E.fused(acc, cur, wr, wc, fr, fq, lds, wid, lane); S.done(cur); }
#undef PG8_SA
#undef PG8_SB
#undef PG8_STAGE
#undef PG8_GLDS
#undef PG8_LDA
#undef PG8_LDB
#undef PG8_MMA
#undef PG8_CAT8
#undef PG8_WAIT_V
#undef PG8_WAIT_L
#undef PG8_WAIT_V8F
#undef PG8_BAR
#undef PG8_SCHED
}
}
#define GAS __attribute__((address_space(1)))
#define LAS __attribute__((address_space(3)))
typedef unsigned short bf16;
typedef unsigned v4u __attribute__((ext_vector_type(4)));
typedef float f32x4 __attribute__((ext_vector_type(4)));
typedef short bf16x8 __attribute__((ext_vector_type(8)));
typedef GAS unsigned gu32;
typedef GAS unsigned long long gu64;
#define RLX_AGENT __ATOMIC_RELAXED, __HIP_MEMORY_SCOPE_AGENT
#define LDS_WAIT() asm volatile("s_waitcnt lgkmcnt(0)" ::: "memory")
#define VM_WAIT() asm volatile("s_waitcnt vmcnt(0)" ::: "memory")
__device__ __forceinline__ unsigned long long rt() { return __builtin_amdgcn_s_memrealtime(); }
__device__ __forceinline__ unsigned f2bf(float f) { unsigned u = __builtin_bit_cast(unsigned, f); return (u + 0x7fffu + ((u >> 16) & 1u)) >> 16; }
__device__ __forceinline__ unsigned pk2(float lo, float hi) { return f2bf(lo) | (f2bf(hi) << 16); }

#define XB_TMO      128
#define XB_XCNT(j)  (256  + 64 * (j))
#define XB_XSUB(j)  (1280 + 64 * (j))
#define XB_XGEN(j)  (2304 + 64 * (j))
#define XB_TOP      3328
#define XB_TOPGEN   3392
#define XCD_BAR_WORDS 3456
#define XB_SPIN_CAP (1u << 18)

__device__ __forceinline__ unsigned xb_ld(unsigned* p)              { return __hip_atomic_load(p, __ATOMIC_RELAXED, __HIP_MEMORY_SCOPE_AGENT); }
__device__ __forceinline__ unsigned xb_add(unsigned* p, unsigned v) { return __hip_atomic_fetch_add(p, v, __ATOMIC_RELAXED, __HIP_MEMORY_SCOPE_AGENT); }
__device__ __forceinline__ unsigned xb_xcc_id() { return (unsigned)__builtin_amdgcn_s_getreg((3 << 11) | 20) & 0xFu; }
#define XB_SPIN(cond, bar) do { unsigned _sp = 0; while (cond) { __builtin_amdgcn_s_sleep(1); \
    if ((++_sp & 255u) == 0u) { if (xb_ld(&(bar)[XB_TMO])) break; if (_sp > XB_SPIN_CAP) { atomicAdd(&(bar)[XB_TMO], 1u); break; } } } } while (0)

struct XcdBarrier {
    int wv;
    unsigned* bar; unsigned x;
    volatile LAS unsigned* st;
};

__device__ __forceinline__ XcdBarrier xcd_barrier_post(unsigned* bar, volatile LAS unsigned* st, int wv) {
    XcdBarrier b; b.bar = bar; b.x = xb_xcc_id(); b.st = st; b.wv = wv;
    if (wv == 0 && lane_now() == 0) (void)xb_add(&bar[XB_XCNT(b.x)], 1u);
    return b;
}
__device__ __forceinline__ void xcd_barrier_complete(unsigned* bar, unsigned x, unsigned& nloc, unsigned& nx) {
    const unsigned G = gridDim.x * gridDim.y * gridDim.z;
    unsigned sum, cnt, mine, sp = 0u;
    for (;;) {
        sum = 0u; cnt = 0u; mine = 0u;
#pragma unroll
        for (unsigned j = 0; j < 16; ++j) { const unsigned c = xb_ld(&bar[XB_XCNT(j)]); sum += c; cnt += (c > 0u) ? 1u : 0u; mine = (j == x) ? c : mine; }
        if (sum == G) break;
        __builtin_amdgcn_s_sleep(1);
        if ((++sp & 255u) == 0u) { if (xb_ld(&bar[XB_TMO])) break; if (sp > XB_SPIN_CAP) { atomicAdd(&bar[XB_TMO], 1u); break; } }
    }
    nloc = mine > 0u ? mine : 1u; nx = cnt > 0u ? cnt : 1u;
}

__device__ __forceinline__ void xcd_barrier(const XcdBarrier& b) {
    asm volatile("s_waitcnt vmcnt(0)" ::: "memory");
    __syncthreads();
    int wv_ = b.wv; asm volatile("" : "+s"(wv_));
    if (wv_ == 0 && lane_now() == 0) {
        unsigned* bar = b.bar;
        __builtin_amdgcn_s_waitcnt(0);
        unsigned nloc = b.st[0], nx = b.st[1];
        if (nloc == 0u) { xcd_barrier_complete(bar, b.x, nloc, nx); b.st[0] = nloc; b.st[1] = nx; }
        const unsigned old = xb_add(&bar[XB_XSUB(b.x)], 1u);
        const unsigned gen = old / nloc;
        if (old + 1u == (gen + 1u) * nloc) {
            __builtin_amdgcn_fence(__ATOMIC_RELEASE, "agent");
            asm volatile("s_waitcnt vmcnt(0)" ::: "memory");
            const unsigned og = xb_add(&bar[XB_TOP], 1u);
            const unsigned tg = og / nx;
            if (og + 1u == (tg + 1u) * nx) xb_add(&bar[XB_TOPGEN], 1u);
            else XB_SPIN(xb_ld(&bar[XB_TOPGEN]) == tg, bar);
            __builtin_amdgcn_fence(__ATOMIC_ACQUIRE, "agent");
            xb_add(&bar[XB_XGEN(b.x)], 1u);
            asm volatile("s_waitcnt vmcnt(0)" ::: "memory");
        } else {
            XB_SPIN(xb_ld(&bar[XB_XGEN(b.x)]) == gen, bar);
            __builtin_amdgcn_fence(__ATOMIC_ACQUIRE, "agent");
            asm volatile("s_waitcnt vmcnt(0)" ::: "memory");
        }
    }
    __syncthreads();
}
constexpr int NWAVES = 8;
constexpr int BATCH = 8, SEQ = 2048, D = 1024, T = BATCH * SEQ, DEPTH = 4;
constexpr int NH = 8, HD = 64, AW = 512, PW = 256, CW = 256, INC = 2304, CK = 31;
constexpr int FF = 2816, NE = 8, NGU = 2 * FF;
constexpr int MAXSLOT = 2 * T + NE * 256;
constexpr float RMS_EPS = 1e-6f, LN_EPS = 1e-5f;
constexpr float QSCALE = 0.125f * 1.4426950408889634f;
#ifndef W_EXIT_V
#define W_EXIT_V -40.0f
#endif
constexpr float W_EXIT = W_EXIT_V;
constexpr int PQ = 0, PK = 512, PV = 1024, PPOOL = 1536, PCV = 1792, PCG = 2048;
enum { I_X = 0, I_ANG, I_WIN, I_POOLW, I_POOLS, I_CONVW, I_CONVB, I_LNG, I_LNB, I_GNG, I_WOUT, I_FNG, I_DWG, I_DWU, I_DWD, I_RW, I_MWG, I_MWU, I_MWD, I_FING, N_IN };

constexpr size_t MiB = 1u << 20;
constexpr size_t WS_CTL = 0, CTL_ZERO_BYTES = 1 * MiB;
constexpr size_t WS_TOKE = 1 * MiB, WS_TOKR = WS_TOKE + 128 * 1024, WS_TOKG = WS_TOKR + 128 * 1024, WS_TOKS = WS_TOKG + 128 * 1024;
constexpr size_t WS_WIN = 4 * MiB;
constexpr size_t WS_WOUT = 22 * MiB;
constexpr size_t WS_WGUD = 30 * MiB;
constexpr size_t WS_WDD = 52 * MiB;
constexpr size_t WS_WGUM = 64 * MiB;
constexpr size_t WS_WDM = 240 * MiB;
constexpr size_t WS_X = 328 * MiB;
constexpr size_t WS_XN = 392 * MiB;
constexpr size_t WS_P = 424 * MiB;
constexpr size_t WS_O = 496 * MiB;
constexpr size_t WS_ACT = 424 * MiB;
constexpr size_t WS_AP = 611 * MiB;
constexpr size_t WS_END = 679 * MiB;
static_assert(WS_WIN + (size_t)4 * INC * D * 2 <= WS_WOUT && WS_WOUT + (size_t)4 * D * D * 2 <= WS_WGUD && WS_WGUD + (size_t)2 * NGU * D * 2 <= WS_WDD && WS_WDD + (size_t)2 * D * FF * 2 <= WS_WGUM, "ws map 1");
static_assert(WS_WGUM + (size_t)16 * NGU * D * 2 <= WS_WDM && WS_WDM + (size_t)16 * D * FF * 2 <= WS_X && WS_X + (size_t)T * D * 4 <= WS_XN && WS_XN + (size_t)T * D * 2 <= WS_P, "ws map 2");
static_assert(WS_P + (size_t)T * INC * 2 <= WS_O && WS_O + (size_t)T * D * 2 <= WS_AP && WS_ACT + (size_t)MAXSLOT * FF * 2 <= WS_AP && WS_AP + (size_t)MAXSLOT * D * 2 <= WS_END, "ws map 3");
constexpr int CW_TMO = 0, CW_CODE = 1;
constexpr int CW_BAR = 4096;
constexpr int CW_MOE = 8192;

constexpr int RING_OFF = 0, RING_BYTES = 131072;
constexpr int LDSCTL_OFF = RING_BYTES, MISC_OFF = LDSCTL_OFF + 320;
constexpr int LDS_BYTES = 147456;
typedef unsigned u32x2 __attribute__((ext_vector_type(2)));
struct Frame {
    LAS unsigned char* lds;
    volatile LAS unsigned* MISC;
    int vcu, G, wave;
};
__device__ __forceinline__ int opaque_int(int n) { asm volatile("" : "+s"(n)); return n; }
#define PHASE_IDS() const int wave = opaque_int(F.wave), vcu = opaque_int(F.vcu), G = opaque_int(F.G), lane = lane_now(), tid = wave * 64 + lane; (void)tid; (void)lane; (void)wave; (void)vcu; (void)G
template <int I> __device__ __forceinline__ const float* inp() { unsigned long long v; asm volatile("s_load_dwordx2 %0, %1, %2\n\ts_waitcnt lgkmcnt(0)" : "=&s"(v) : "s"(__builtin_amdgcn_kernarg_segment_ptr()), "n"(I * 8));
    return (const float*)(const GAS float*)v; }
#define INP(i) inp<(i)>()
#define OUTPTR() ((float*)const_cast<float*>(inp<N_IN>()))
#define WSPTR() ((unsigned char*)const_cast<float*>(inp<N_IN + 1>()))
#define CTLPTR() ((gu32*)WSPTR())
__device__ __forceinline__ float bf2f(bf16 b) { return __uint_as_float((unsigned)b << 16); }
__device__ __forceinline__ float bflo(unsigned w) { return __uint_as_float(w << 16); }
__device__ __forceinline__ float bfhi(unsigned w) { return __uint_as_float(w & 0xffff0000u); }
template <int CTRL> __device__ __forceinline__ float dpp_add(float v) { return v + __builtin_bit_cast(float, __builtin_amdgcn_update_dpp(0, __builtin_bit_cast(int, v), CTRL, 0xf, 0xf, true)); }
__device__ __forceinline__ float wave_sum(float v) {
    v = dpp_add<0xB1>(v); v = dpp_add<0x4E>(v); v = dpp_add<0x141>(v); v = dpp_add<0x140>(v);
    v += __builtin_bit_cast(float, __builtin_amdgcn_ds_swizzle(__builtin_bit_cast(int, v), 0x401F));
    const auto rr = __builtin_amdgcn_permlane32_swap(__float_as_uint(v), __float_as_uint(v), false, false); return __uint_as_float(rr[0]) + __uint_as_float(rr[1]);
}
__device__ __forceinline__ void fail_word(int wave, unsigned code) {
    if (wave == 0 && lane_now() == 0) { gu32* ctl = CTLPTR(); unsigned expect = 0u; __hip_atomic_compare_exchange_strong((unsigned*)(ctl + CW_CODE), &expect, code, __ATOMIC_RELAXED, __ATOMIC_RELAXED, __HIP_MEMORY_SCOPE_AGENT);
        __hip_atomic_store(ctl + CW_TMO, 1u, RLX_AGENT); }
}

__device__ __forceinline__ void transpose_item(const float* W, int K, int N, bf16* WT, int mode, int nscale, int item, int lane) {
    const int nblk = N / 64, kb = item / nblk, nb = item % nblk, k0 = 64 * kb, n0 = 64 * nb, kq = lane >> 4, nq = lane & 15;
    const GAS f32x4* src = (const GAS f32x4*)(W + (size_t)(k0 + 8 * kq) * N + n0 + 4 * nq);
    f32x4 v[16];
#pragma unroll
    for (int i = 0; i < 16; ++i) v[i] = src[(size_t)((i & 7) + 32 * (i >> 3)) * (N / 4)];
    const int r0 = (mode == 0) ? n0 : (256 * (n0 >> 7) + (n0 & 127) + (mode == 2 ? 128 : 0));
    const float sc = (n0 < nscale) ? QSCALE : 1.0f;
#pragma unroll
    for (int j = 0; j < 4; ++j) { GAS v4u* dst = (GAS v4u*)(WT + (size_t)(r0 + 4 * nq + j) * K + k0 + 8 * kq);
#pragma unroll
        for (int hf = 0; hf < 2; ++hf) { v4u o;
            o.x = pk2(v[8 * hf + 0][j] * sc, v[8 * hf + 1][j] * sc); o.y = pk2(v[8 * hf + 2][j] * sc, v[8 * hf + 3][j] * sc);
            o.z = pk2(v[8 * hf + 4][j] * sc, v[8 * hf + 5][j] * sc); o.w = pk2(v[8 * hf + 6][j] * sc, v[8 * hf + 7][j] * sc);
            dst[4 * hf] = o; } }
}
constexpr float WSCALE8 = 64.0f, XSCALE8 = 16.0f, ASCALE8 = 16.0f;
__device__ __forceinline__ float clamp8f(float v) { return fminf(fmaxf(v, -448.0f), 448.0f); }
__device__ __forceinline__ unsigned pack8(float a, float b, float c, float d) { unsigned w = 0u; w = __builtin_amdgcn_cvt_pk_fp8_f32(clamp8f(a), clamp8f(b), w, false); w = __builtin_amdgcn_cvt_pk_fp8_f32(clamp8f(c), clamp8f(d), w, true); return w; }
__device__ __forceinline__ void transpose_item8(const float* W, int K, int N, unsigned char* WT, int mode, int item, int lane) {
    const int nblk = N / 64, kb = item / nblk, nb = item % nblk, k0 = 64 * kb, n0 = 64 * nb, kq = lane >> 4, nq = lane & 15;
    const GAS f32x4* src = (const GAS f32x4*)(W + (size_t)(k0 + 16 * kq) * N + n0 + 4 * nq);
    f32x4 v[16];
#pragma unroll
    for (int i = 0; i < 16; ++i) v[i] = src[(size_t)i * (N / 4)];
    const int r0 = (mode == 0) ? n0 : (256 * (n0 >> 7) + (n0 & 127) + (mode == 2 ? 128 : 0));
#pragma unroll
    for (int j = 0; j < 4; ++j) { v4u o;
        o.x = pack8(v[0][j] * WSCALE8, v[1][j] * WSCALE8, v[2][j] * WSCALE8, v[3][j] * WSCALE8); o.y = pack8(v[4][j] * WSCALE8, v[5][j] * WSCALE8, v[6][j] * WSCALE8, v[7][j] * WSCALE8);
        o.z = pack8(v[8][j] * WSCALE8, v[9][j] * WSCALE8, v[10][j] * WSCALE8, v[11][j] * WSCALE8); o.w = pack8(v[12][j] * WSCALE8, v[13][j] * WSCALE8, v[14][j] * WSCALE8, v[15][j] * WSCALE8);
        *(GAS v4u*)(WT + (size_t)(r0 + 4 * nq + j) * K + k0 + 16 * kq) = o; }
}
__device__ __forceinline__ void p0_weights(Frame& F) {
    PHASE_IDS(); unsigned char* const ws = WSPTR();
    const int gw = vcu * NWAVES + wave, NGW = G * NWAVES;
    constexpr int I_IN = (D / 64) * (INC / 64), I_OUT = (D / 64) * (D / 64), I_GU = (D / 64) * (FF / 64), I_DN = (FF / 64) * (D / 64);
    constexpr int N0 = 4 * I_IN, N1 = N0 + 4 * I_OUT, N2 = N1 + 2 * I_GU, N3 = N2 + 2 * I_GU, N4 = N3 + 2 * I_DN, N5 = N4 + 16 * I_GU, N6 = N5 + 16 * I_GU, N7 = N6 + 16 * I_DN;
    bf16* const win = (bf16*)(ws + WS_WIN); bf16* const wout = (bf16*)(ws + WS_WOUT); bf16* const wgud = (bf16*)(ws + WS_WGUD); bf16* const wdd = (bf16*)(ws + WS_WDD);
#pragma unroll 1
    for (int it = gw; it < N4; it += NGW) {
        if (it < N0) { const int l = it / I_IN, r = it % I_IN; transpose_item(INP(I_WIN) + (size_t)l * D * INC, D, INC, win + (size_t)l * INC * D, 0, 512, r, lane); }
        else if (it < N1) { const int q = it - N0, l = q / I_OUT, r = q % I_OUT; transpose_item(INP(I_WOUT) + (size_t)l * D * D, D, D, wout + (size_t)l * D * D, 0, 0, r, lane); }
        else if (it < N2) { const int q = it - N1, l = q / I_GU, r = q % I_GU; transpose_item(INP(I_DWG) + (size_t)l * D * FF, D, FF, wgud + (size_t)l * NGU * D, 1, 0, r, lane); }
        else if (it < N3) { const int q = it - N2, l = q / I_GU, r = q % I_GU; transpose_item(INP(I_DWU) + (size_t)l * D * FF, D, FF, wgud + (size_t)l * NGU * D, 2, 0, r, lane); }
        else { const int q = it - N3, l = q / I_DN, r = q % I_DN; transpose_item8(INP(I_DWD) + (size_t)l * FF * D, FF, D, (unsigned char*)wdd + (size_t)l * D * FF, 0, r, lane); }
    }
}

constexpr int MOE_ITEMS_MAT = (D / 64) * (FF / 64), MOE_ITEMS = 24 * MOE_ITEMS_MAT;
constexpr int CVT_A0 = 0, CVT_A_PER = 35, CVT_B0 = 192 * CVT_A_PER, CVT_B_PER = 35, CVT_C0 = CVT_B0 + 128 * CVT_B_PER, CVT_C_PER = (MOE_ITEMS - CVT_C0 + 191) / 192;
static_assert(CVT_C0 < MOE_ITEMS && CVT_C0 + 192 * CVT_C_PER >= MOE_ITEMS && CVT_C_PER <= 40, "conversion slots cover the list");
__device__ __forceinline__ void moe_convert(Frame& F, int li, int i0, int i1) {
    PHASE_IDS(); unsigned char* const ws = WSPTR();
    unsigned char* const wgum = ws + WS_WGUM + (size_t)li * NE * NGU * D; unsigned char* const wdm = ws + WS_WDM + (size_t)li * NE * D * FF;
    if (i1 > MOE_ITEMS) i1 = MOE_ITEMS;
#pragma unroll 1
    for (int q = i0 + wave; q < i1; q += NWAVES) {
        const int m = q / MOE_ITEMS_MAT, r = q % MOE_ITEMS_MAT, e = m & 7, le = li * NE + e;
        if (m < 8) transpose_item8(INP(I_MWG) + (size_t)le * D * FF, D, FF, wgum + (size_t)e * NGU * D, 1, r, lane);
        else if (m < 16) transpose_item8(INP(I_MWU) + (size_t)le * D * FF, D, FF, wgum + (size_t)e * NGU * D, 2, r, lane);
        else transpose_item8(INP(I_MWD) + (size_t)le * FF * D, FF, D, wdm + (size_t)e * D * FF, 0, r, lane);
    }
}

struct RowArgs { const float* xin; const bf16* xsrc; bf16* xws; const float* gain; bf16* xn; float* out; const bf16* yp; const float* wr; gu32* gcur;
                 int* tok_e; int* tok_r; float* tok_g; const int* tok_s; };
template <int MODE>
__device__ __forceinline__ void row_phase(Frame& F, const RowArgs& A) {
    constexpr bool COMBINE = MODE & 1, ROUTER = (MODE & 2) != 0, FINAL = (MODE & 4) != 0, COPYIN = (MODE & 8) != 0;
    constexpr int RB = (COMBINE || COPYIN) ? 4 : 8;
    LAS int* s_cnt = (LAS int*)(F.lds + RING_OFF);
    LAS int* s_base = s_cnt + 8;
    LAS int* s_e = s_cnt + 16;
    LAS int* s_rk = s_e + 128;
    LAS float* s_g = (LAS float*)(s_rk + 128);
    LAS float* s_wr = (LAS float*)(F.lds + RING_OFF + 8192);
    PHASE_IDS();
    if (ROUTER) { if (tid < 16) s_cnt[tid] = 0;
#pragma unroll
        for (int i = 0; i < 4; ++i) *(LAS f32x4*)(s_wr + 4 * (tid + 512 * i)) = *((const GAS f32x4*)A.wr + tid + 512 * i);
        __syncthreads(); }
    f32x4 gn[4];
    { const GAS f32x4* gr = (const GAS f32x4*)A.gain + lane;
#pragma unroll
      for (int j = 0; j < 4; ++j) gn[j] = gr[64 * j]; }
#pragma unroll 1
    for (int b = 0; b < 8 / RB; ++b) {
        const int rl0 = wave * 8 + b * RB, m0 = vcu * 64 + rl0;
        f32x4 xf[COPYIN ? RB : 1][4]; u32x2 xr[COPYIN ? 1 : RB][4]; u32x2 ya[COMBINE ? RB : 1][4], yb[COMBINE ? RB : 1][4]; float cg0[COMBINE ? RB : 1], cg1[COMBINE ? RB : 1];
        int cs0[COMBINE ? RB : 1], cs1[COMBINE ? RB : 1];
        if (COMBINE) {
#pragma unroll
            for (int i = 0; i < RB; ++i) { cs0[i] = A.tok_s[2 * (m0 + i)]; cs1[i] = A.tok_s[2 * (m0 + i) + 1]; cg0[i] = A.tok_g[2 * (m0 + i)]; cg1[i] = A.tok_g[2 * (m0 + i) + 1]; } }
#pragma unroll
        for (int i = 0; i < RB; ++i) {
            if (COPYIN) { const GAS f32x4* x4 = (const GAS f32x4*)(A.xin + (size_t)(m0 + i) * D) + lane;
#pragma unroll
                for (int j = 0; j < 4; ++j) xf[i][j] = x4[64 * j]; }
            else { const GAS u32x2* x2 = (const GAS u32x2*)(A.xsrc + (size_t)(m0 + i) * D) + lane;
#pragma unroll
                for (int j = 0; j < 4; ++j) xr[i][j] = x2[64 * j]; } }
        if (COMBINE) {
#pragma unroll
            for (int i = 0; i < RB; ++i) { const GAS u32x2* y0 = (const GAS u32x2*)(A.yp + (size_t)cs0[i] * D) + lane; const GAS u32x2* y1 = (const GAS u32x2*)(A.yp + (size_t)cs1[i] * D) + lane;
#pragma unroll
                for (int j = 0; j < 4; ++j) { ya[i][j] = y0[64 * j]; yb[i][j] = y1[64 * j]; } } }
#pragma unroll
        for (int i = 0; i < RB; ++i) {
            const int rl = rl0 + i, m = m0 + i;
            f32x4 v[4];
#pragma unroll
            for (int j = 0; j < 4; ++j) { if (COPYIN) v[j] = xf[i][j]; else { const u32x2 w = xr[i][j]; v[j] = (f32x4){bflo(w.x), bfhi(w.x), bflo(w.y), bfhi(w.y)}; } }
            if (COMBINE) { const float g0 = cg0[i], g1 = cg1[i];
#pragma unroll
                for (int j = 0; j < 4; ++j) { const u32x2 a = ya[i][j], bb = yb[i][j];
                    v[j].x += g0 * bflo(a.x) + g1 * bflo(bb.x); v[j].y += g0 * bfhi(a.x) + g1 * bfhi(bb.x); v[j].z += g0 * bflo(a.y) + g1 * bflo(bb.y); v[j].w += g0 * bfhi(a.y) + g1 * bfhi(bb.y); } }
            if ((COMBINE && !FINAL) || COPYIN) { GAS u32x2* xw = (GAS u32x2*)(A.xws + (size_t)m * D) + lane;
#pragma unroll
                for (int j = 0; j < 4; ++j) xw[64 * j] = (u32x2){pk2(v[j].x, v[j].y), pk2(v[j].z, v[j].w)}; }
            float ss = 0.f;
#pragma unroll
            for (int j = 0; j < 4; ++j) ss += (v[j].x * v[j].x + v[j].y * v[j].y) + (v[j].z * v[j].z + v[j].w * v[j].w);
            const float rstd = 1.0f / sqrtf(wave_sum(ss) * (1.0f / D) + RMS_EPS);
#pragma unroll
            for (int j = 0; j < 4; ++j) v[j] = v[j] * rstd * gn[j];
            if (FINAL) { GAS f32x4* o = (GAS f32x4*)(A.out + (size_t)m * D) + lane;
#pragma unroll
                for (int j = 0; j < 4; ++j) o[64 * j] = v[j]; }
            else { GAS u32x2* o = (GAS u32x2*)(A.xn + (size_t)m * D) + lane;
#pragma unroll
                for (int j = 0; j < 4; ++j) o[64 * j] = (u32x2){pk2(v[j].x, v[j].y), pk2(v[j].z, v[j].w)}; }
            if (ROUTER) {
                float lg[8];
#pragma unroll
                for (int e = 0; e < 8; ++e) lg[e] = 0.f;
#pragma unroll
                for (int j = 0; j < 4; ++j)
#pragma unroll
                    for (int q = 0; q < 4; ++q) { const LAS f32x4* w = (const LAS f32x4*)(s_wr + (256 * j + 4 * lane + q) * 8); const f32x4 w0 = w[0], w1 = w[1]; const float h = v[j][q];
                        lg[0] += h * w0.x; lg[1] += h * w0.y; lg[2] += h * w0.z; lg[3] += h * w0.w; lg[4] += h * w1.x; lg[5] += h * w1.y; lg[6] += h * w1.z; lg[7] += h * w1.w; }
#pragma unroll
                for (int e = 0; e < 8; ++e) lg[e] = wave_sum(lg[e]);
                int e1 = 0; float v1 = lg[0];
#pragma unroll
                for (int e = 1; e < 8; ++e) if (lg[e] > v1) { v1 = lg[e]; e1 = e; }
                int e2 = -1; float v2 = -INFINITY;
#pragma unroll
                for (int e = 0; e < 8; ++e) if (e != e1 && (e2 < 0 || lg[e] > v2)) { v2 = lg[e]; e2 = e; }
                const float g1 = 1.0f / (1.0f + __expf(v2 - v1)), g2 = 1.0f - g1;
                if (lane == 0) { const int r1 = atomicAdd((int*)(s_cnt + e1), 1), r2 = atomicAdd((int*)(s_cnt + e2), 1);
                    s_e[2 * rl] = e1; s_e[2 * rl + 1] = e2; s_rk[2 * rl] = r1; s_rk[2 * rl + 1] = r2; s_g[2 * rl] = g1; s_g[2 * rl + 1] = g2; }
            }
        }
    }
    if (ROUTER) {
        __syncthreads();
        if (tid < 8) s_base[tid] = (int)__hip_atomic_fetch_add(A.gcur + 64 * tid, (unsigned)s_cnt[tid], RLX_AGENT);
        __syncthreads();
        if (tid < 128) { const int m2 = vcu * 128 + tid; const int e = s_e[tid]; A.tok_e[m2] = e; A.tok_r[m2] = s_base[e] + s_rk[tid]; A.tok_g[m2] = s_g[tid]; }
        __syncthreads();
    }
}

__device__ __forceinline__ void load_toff(gu32* gcur, int (&cnt)[8], int (&toff)[9]) {
    const int le = lane_now() & 7; const unsigned c = __hip_atomic_load(gcur + 64 * le, RLX_AGENT);
    toff[0] = 0;
#pragma unroll
    for (int e = 0; e < 8; ++e) { cnt[e] = (int)__builtin_amdgcn_readlane((int)c, e); toff[e + 1] = toff[e] + ((cnt[e] + 255) >> 8); }
}
__device__ __forceinline__ void gather_phase(Frame& F, gu32* gcur, const bf16* xn, unsigned char* ap, const int* tok_e, const int* tok_r, int* tok_s) {
    PHASE_IDS();
    int cnt[8], toff[9]; load_toff(gcur, cnt, toff);
    v4u ra[8], rb[8]; int te[8][2], tr[8][2];
#pragma unroll
    for (int i = 0; i < 8; ++i) { const int m = vcu * 64 + wave * 8 + i; const GAS v4u* src = (const GAS v4u*)(xn + (size_t)m * D) + 2 * lane; ra[i] = src[0]; rb[i] = src[1];
        te[i][0] = tok_e[2 * m]; te[i][1] = tok_e[2 * m + 1]; tr[i][0] = tok_r[2 * m]; tr[i][1] = tok_r[2 * m + 1]; }
#pragma unroll
    for (int i = 0; i < 8; ++i) {
        const int m = vcu * 64 + wave * 8 + i; const v4u a = ra[i], b = rb[i];
        v4u o;
        o.x = pack8(bflo(a.x) * XSCALE8, bfhi(a.x) * XSCALE8, bflo(a.y) * XSCALE8, bfhi(a.y) * XSCALE8); o.y = pack8(bflo(a.z) * XSCALE8, bfhi(a.z) * XSCALE8, bflo(a.w) * XSCALE8, bfhi(a.w) * XSCALE8);
        o.z = pack8(bflo(b.x) * XSCALE8, bfhi(b.x) * XSCALE8, bflo(b.y) * XSCALE8, bfhi(b.y) * XSCALE8); o.w = pack8(bflo(b.z) * XSCALE8, bfhi(b.z) * XSCALE8, bflo(b.w) * XSCALE8, bfhi(b.w) * XSCALE8);
#pragma unroll
        for (int k = 0; k < 2; ++k) {
            const int e = te[i][k], r = tr[i][k];
            int base = 0;
#pragma unroll
            for (int q = 0; q < 8; ++q) base = (e == q) ? toff[q] : base;
            const int slot = base * 256 + r;
            if (lane == 0) tok_s[2 * m + k] = slot;
            *((GAS v4u*)(ap + (size_t)slot * D) + lane) = o;
        }
    }
    const int gw = vcu * NWAVES + wave, NGW = G * NWAVES;
#pragma unroll
    for (int e = 0; e < 8; ++e) {
        for (int r = toff[e] * 256 + cnt[e] + gw; r < toff[e + 1] * 256; r += NGW) { unsigned z = 0u; asm volatile("" : "+v"(z)); *((GAS v4u*)(ap + (size_t)r * D) + lane) = (v4u){z, z, z, z}; }
    }
}

typedef float f32x16 __attribute__((ext_vector_type(16)));
typedef short s16x4 __attribute__((ext_vector_type(4)));
typedef short v4i16_t __attribute__((ext_vector_type(4)));
typedef float f32x2_t __attribute__((ext_vector_type(2))); typedef __bf16 bf16x2_t __attribute__((ext_vector_type(2)));
__device__ __forceinline__ unsigned cvtpk(float lo, float hi) { f32x2_t v = {lo, hi}; bf16x2_t b = __builtin_convertvector(v, bf16x2_t); return __builtin_bit_cast(unsigned, b); }
__device__ __forceinline__ s16x4 vtr(const LAS unsigned char* p) { return __builtin_bit_cast(s16x4, __builtin_amdgcn_ds_read_tr16_b64_v4i16((LAS v4i16_t*)p)); }
constexpr int ATT_VBYTES = 4096;
constexpr int ATT_HS_OFF = NWAVES * ATT_VBYTES;

__device__ __forceinline__ f32x16 sb_qk(const bf16x8 (&kf)[4], const bf16x8 (&qf)[4]) {
    f32x16 st;
#pragma unroll
    for (int r = 0; r < 16; ++r) st[r] = 0.f;
#pragma unroll
    for (int ds = 0; ds < 4; ++ds) st = __builtin_amdgcn_mfma_f32_32x32x16_bf16(kf[ds], qf[ds], st, 0, 0, 0);
    return st;
}
template <bool DIAG>
__device__ __forceinline__ void sb_weights(const f32x16& st, int qlim, float sel, float& carry, bf16x8& pw0, bf16x8& pw1) {
    float inc[16];
#pragma unroll
    for (int r = 0; r < 16; ++r) { const float z = st[r];
        float l = -(fmaxf(z, 0.f) + __builtin_amdgcn_logf(1.0f + __builtin_amdgcn_exp2f(-fabsf(z))));
        if (DIAG) l = ((r & 3) + 8 * (r >> 2) < qlim) ? l : 0.f;
        inc[r] = l; }
    float T[4], Ghi[4];
#pragma unroll
    for (int g = 0; g < 4; ++g) { inc[4 * g + 2] += inc[4 * g + 3]; inc[4 * g + 1] += inc[4 * g + 2]; inc[4 * g] += inc[4 * g + 1];
        const auto rr = __builtin_amdgcn_permlane32_swap(__float_as_uint(inc[4 * g]), __float_as_uint(inc[4 * g]), false, false);
        Ghi[g] = __uint_as_float(rr[1]); T[g] = __uint_as_float(rr[0]) + Ghi[g]; }
    float U[4]; U[3] = carry; U[2] = U[3] + T[3]; U[1] = U[2] + T[2]; U[0] = U[1] + T[1]; carry = U[0] + T[0];
    unsigned pk[8];
#pragma unroll
    for (int g = 0; g < 4; ++g) { const float base = fmaf(Ghi[g], sel, U[g]); float w[4];
#pragma unroll
        for (int i = 0; i < 4; ++i) { const int r = 4 * g + i; w[i] = __builtin_amdgcn_exp2f(st[r] + (inc[r] + base));
            if (DIAG) w[i] = ((r & 3) + 8 * (r >> 2) < qlim) ? w[i] : 0.f; }
        pk[2 * g] = cvtpk(w[0], w[1]); pk[2 * g + 1] = cvtpk(w[2], w[3]); }
    pw0 = __builtin_bit_cast(bf16x8, (v4u){pk[0], pk[1], pk[2], pk[3]}); pw1 = __builtin_bit_cast(bf16x8, (v4u){pk[4], pk[5], pk[6], pk[7]});
}
__device__ __forceinline__ void sb_pv(const LAS unsigned char* vrd, const bf16x8 pw0, const bf16x8 pw1, f32x16 (&oacc)[2]) {
#pragma unroll
    for (int c = 0; c < 2; ++c) {
        const s16x4 a0 = vtr(vrd + c * 2048), a1 = vtr(vrd + c * 2048 + 512), b0 = vtr(vrd + c * 2048 + 1024), b1 = vtr(vrd + c * 2048 + 1536);
        const bf16x8 v0 = (bf16x8){a0[0], a0[1], a0[2], a0[3], a1[0], a1[1], a1[2], a1[3]}, v1 = (bf16x8){b0[0], b0[1], b0[2], b0[3], b1[0], b1[1], b1[2], b1[3]};
        oacc[c] = __builtin_amdgcn_mfma_f32_32x32x16_bf16(v0, pw0, oacc[c], 0, 0, 0);
        oacc[c] = __builtin_amdgcn_mfma_f32_32x32x16_bf16(v1, pw1, oacc[c], 0, 0, 0); }
}

constexpr int MX_KV = 4608, MX_HS_OFF = NWAVES * MX_KV, MX_PS_OFF = MX_HS_OFF + 1024, MX_PT_OFF = MX_PS_OFF + 1024, MX_PT_ROW = 144, MX_PT_G = 47 * MX_PT_ROW, MX_U_OFF = MX_PT_OFF + 4 * MX_PT_G;
static_assert(MX_U_OFF % 16 == 0 && MX_U_OFF + 62 * 256 * 4 <= RING_BYTES, "mixer LDS map");
struct PcArgs { const bf16* P; bf16* O; const float* poolw; const float* pools; const float* convw; const float* convb; const float* lng; const float* lnb; const float* gng; };
__device__ __forceinline__ float sigm_mul(float val, float gate) { return val * __builtin_amdgcn_rcpf(1.0f + __builtin_amdgcn_exp2f(gate * -1.4426950408889634f)); }
__device__ __forceinline__ void mixer_phase(Frame& F, const PcArgs& A) {
    PHASE_IDS();
    const bf16* const P = A.P; bf16* const O = A.O;
    const int qi = lane & 31, hh = lane >> 5, h = wave;
    LAS unsigned char* const vimg = F.lds + RING_OFF + wave * MX_KV;
    LAS float* const hs = (LAS float*)(F.lds + RING_OFF + MX_HS_OFF);
    LAS float* const ps = (LAS float*)(F.lds + RING_OFF + MX_PS_OFF);
    LAS unsigned char* const ptile = F.lds + RING_OFF + MX_PT_OFF;
    LAS float* const ubuf = (LAS float*)(F.lds + RING_OFF + MX_U_OFF);
    const int vkey = lane >> 3, vch = lane & 7;
    LAS unsigned char* const vwr = vimg + (vch >> 2) * 2048 + vkey * 64 + (vch & 3) * 16;
    const LAS unsigned char* const vrd = vimg + (4 * hh + ((lane & 15) >> 2)) * 64 + ((lane >> 4) & 1) * 32 + (lane & 3) * 8;
    LAS unsigned char* const kwr = vimg + vkey * 144 + vch * 16;
    const LAS unsigned char* const krd = vimg + qi * 144 + hh * 16;
    const float sel = hh ? 0.f : 1.f; const int qlim = qi - 4 * hh;
    const int pg = wave & 3, pdt = wave >> 2;
    bf16x8 wpf[4];
    { const float* wp = A.poolw + (size_t)pg * 64 * 64 + 32 * pdt + qi; const float psc = A.pools[pg * 64 + 32 * pdt + qi];
#pragma unroll
      for (int ks = 0; ks < 4; ++ks) { float w[8];
#pragma unroll
          for (int j = 0; j < 8; ++j) w[j] = wp[(size_t)(16 * ks + 8 * hh + j) * 64] * psc;
          wpf[ks] = __builtin_bit_cast(bf16x8, (v4u){cvtpk(w[0], w[1]), cvtpk(w[2], w[3]), cvtpk(w[4], w[5]), cvtpk(w[6], w[7])}); } }
    for (int u = vcu; u < T / 32; u += G) {
        const int r0 = u * 32, s0 = r0 % SEQ, nb1 = s0 >> 5;
        int ln = lane; asm volatile("" : "+v"(ln));
        const int hhu = ln >> 5, tidu = wave * 64 + ln;
        bf16x8 qf[4]; v4u kA[4], kB[4], vA[4], vB[4];
        const bf16* qp = P + (size_t)(r0 + qi) * INC + PQ + h * 64 + 8 * hh;
#pragma unroll
        for (int ds = 0; ds < 4; ++ds) qf[ds] = *(const bf16x8*)(qp + 16 * ds);
        const bf16* const kp0 = P + (size_t)(r0 + vkey) * INC + PK + h * 64 + 8 * vch;
        const bf16* const vp0 = P + (size_t)(r0 + vkey) * INC + PV + h * 64 + 8 * vch;
#define K_LOAD(KB, jj) do { asm volatile("" ::: "memory"); const int j_ = (jj) < nb1 ? (jj) : nb1; const bf16* kp_ = kp0 - (size_t)(32 * j_) * INC; \
        _Pragma("unroll") for (int i = 0; i < 4; ++i) KB[i] = *(const v4u*)(kp_ + (size_t)(8 * i) * INC); asm volatile("" ::: "memory"); } while (0)
#define V_LOAD(VB, jj) do { asm volatile("" ::: "memory"); const int j_ = (jj) < nb1 ? (jj) : nb1; const bf16* vp_ = vp0 - (size_t)(32 * j_) * INC; \
        _Pragma("unroll") for (int i = 0; i < 4; ++i) VB[i] = *(const v4u*)(vp_ + (size_t)(8 * i) * INC); asm volatile("" ::: "memory"); } while (0)
        K_LOAD(kA, 0); V_LOAD(vA, 0); K_LOAD(kB, 1); V_LOAD(vB, 1);
#pragma unroll
        for (int i = 0; i < 4; ++i) { const int idx = tidu + 512 * i;
            if (idx < 62 * 32) { const int rr = idx >> 5, c8 = idx & 31; f32x4 u0 = {0.f, 0.f, 0.f, 0.f}, u1 = {0.f, 0.f, 0.f, 0.f};
                if (s0 - 30 + rr >= 0) { const bf16* rp = P + (size_t)(r0 - 30 + rr) * INC + 8 * c8; const v4u a = *(const v4u*)(rp + PCV), b = *(const v4u*)(rp + PCG);
                    u0 = (f32x4){sigm_mul(bflo(a.x), bflo(b.x)), sigm_mul(bfhi(a.x), bfhi(b.x)), sigm_mul(bflo(a.y), bflo(b.y)), sigm_mul(bfhi(a.y), bfhi(b.y))};
                    u1 = (f32x4){sigm_mul(bflo(a.z), bflo(b.z)), sigm_mul(bfhi(a.z), bfhi(b.z)), sigm_mul(bflo(a.w), bflo(b.w)), sigm_mul(bfhi(a.w), bfhi(b.w))}; }
                *(LAS f32x4*)(ubuf + rr * 256 + 8 * c8) = u0; *(LAS f32x4*)(ubuf + rr * 256 + 8 * c8 + 4) = u1; } }
#pragma unroll
        for (int i = 0; i < 3; ++i) { const int idx = tidu + 512 * i;
            if (idx < 47 * 32) { const int rr = idx >> 5, c32 = idx & 31; v4u x = {0u, 0u, 0u, 0u};
                if (s0 - 15 + rr >= 0) x = *(const v4u*)(P + (size_t)(r0 - 15 + rr) * INC + PPOOL + 8 * c32);
                *(LAS v4u*)(ptile + (c32 >> 3) * MX_PT_G + rr * MX_PT_ROW + (c32 & 7) * 16) = x; } }
        __syncthreads();
        f32x16 oacc[2];
#pragma unroll
        for (int r = 0; r < 16; ++r) { oacc[0][r] = 0.f; oacc[1][r] = 0.f; }
        float carry = 0.f;
#define ATT_DONE(jj) ((jj) >= nb1 || __builtin_amdgcn_ballot_w64(carry >= W_EXIT) == 0ull)
#define ATT_BLOCK(KB, VB, jj, DIAGV) do { _Pragma("unroll") for (int i = 0; i < 4; ++i) *(LAS v4u*)(kwr + i * (8 * 144)) = KB[i]; K_LOAD(KB, (jj) + 2); \
        bf16x8 kf_[4]; _Pragma("unroll") for (int ds = 0; ds < 4; ++ds) kf_[ds] = *(const LAS bf16x8*)(krd + 32 * ds); \
        const f32x16 st_ = sb_qk(kf_, qf); bf16x8 pw0_, pw1_; \
        if (DIAGV) sb_weights<true>(st_, qlim, sel, carry, pw0_, pw1_); else sb_weights<false>(st_, qlim, sel, carry, pw0_, pw1_); \
        _Pragma("unroll") for (int i = 0; i < 4; ++i) *(LAS v4u*)(vwr + i * 512) = VB[i]; V_LOAD(VB, (jj) + 2); \
        sb_pv(vrd, pw0_, pw1_, oacc); } while (0)
        for (int j = 0;; j += 2) {
            ATT_BLOCK(kA, vA, j, j == 0);
            if (ATT_DONE(j)) break;
            ATT_BLOCK(kB, vB, j + 1, false);
            if (ATT_DONE(j + 1)) break;
        }
#undef K_LOAD
#undef V_LOAD
#undef ATT_DONE
#undef ATT_BLOCK
        { float ss = 0.f;
#pragma unroll
          for (int r = 0; r < 16; ++r) ss += oacc[0][r] * oacc[0][r] + oacc[1][r] * oacc[1][r];
          const auto rr = __builtin_amdgcn_permlane32_swap(__float_as_uint(ss), __float_as_uint(ss), false, false); ss = __uint_as_float(rr[0]) + __uint_as_float(rr[1]);
          if (hh == 0) hs[wave * 32 + qi] = ss; }
        f32x16 pacc;
#pragma unroll
        for (int r = 0; r < 16; ++r) pacc[r] = 0.f;
        { const int s = s0 + qi, pwin = 2 << pg; const LAS unsigned char* const tp = ptile + pg * MX_PT_G + (15 + qi) * MX_PT_ROW + hh * 16;
          float self[4][8], sum[4][8];
#pragma unroll
          for (int ks = 0; ks < 4; ++ks) { const v4u x = *(const LAS v4u*)(tp + 32 * ks);
              self[ks][0] = bflo(x.x); self[ks][1] = bfhi(x.x); self[ks][2] = bflo(x.y); self[ks][3] = bfhi(x.y); self[ks][4] = bflo(x.z); self[ks][5] = bfhi(x.z); self[ks][6] = bflo(x.w); self[ks][7] = bfhi(x.w);
#pragma unroll
              for (int j = 0; j < 8; ++j) sum[ks][j] = self[ks][j]; }
#pragma unroll 1
          for (int i = 1; i < pwin; ++i) {
#pragma unroll
              for (int ks = 0; ks < 4; ++ks) { const v4u y = *(const LAS v4u*)(tp - i * MX_PT_ROW + 32 * ks);
                  sum[ks][0] += bflo(y.x); sum[ks][1] += bfhi(y.x); sum[ks][2] += bflo(y.y); sum[ks][3] += bfhi(y.y); sum[ks][4] += bflo(y.z); sum[ks][5] += bfhi(y.z); sum[ks][6] += bflo(y.w); sum[ks][7] += bfhi(y.w); } }
          const int cnt = (s + 1 < pwin) ? s + 1 : pwin; const float rc = 1.0f / (float)cnt;
#pragma unroll
          for (int ks = 0; ks < 4; ++ks) {
#pragma unroll
              for (int j = 0; j < 8; ++j) sum[ks][j] = sum[ks][j] * rc - self[ks][j];
              const bf16x8 yf = __builtin_bit_cast(bf16x8, (v4u){cvtpk(sum[ks][0], sum[ks][1]), cvtpk(sum[ks][2], sum[ks][3]), cvtpk(sum[ks][4], sum[ks][5]), cvtpk(sum[ks][6], sum[ks][7])});
              pacc = __builtin_amdgcn_mfma_f32_32x32x16_bf16(wpf[ks], yf, pacc, 0, 0, 0); } }
        { float ss = 0.f;
#pragma unroll
          for (int r = 0; r < 16; ++r) ss += pacc[r] * pacc[r];
          const auto rr = __builtin_amdgcn_permlane32_swap(__float_as_uint(ss), __float_as_uint(ss), false, false); ss = __uint_as_float(rr[0]) + __uint_as_float(rr[1]);
          if (hh == 0) ps[wave * 32 + qi] = ss; }
        __syncthreads();
        { float tot = 0.f;
#pragma unroll
          for (int w = 0; w < 8; ++w) tot += hs[w * 32 + qi];
          const float rstd = 1.0f / sqrtf(tot * (1.0f / AW) + RMS_EPS);
          bf16* op = O + (size_t)(r0 + qi) * D + h * 64 + 4 * hh; const float* gp = A.gng + h * 64 + 4 * hhu;
#pragma unroll
          for (int c = 0; c < 2; ++c)
#pragma unroll
              for (int g = 0; g < 4; ++g) { const f32x4 gv = *(const f32x4*)(gp + 32 * c + 8 * g);
                  *(u32x2*)(op + 32 * c + 8 * g) = (u32x2){cvtpk(oacc[c][4 * g] * rstd * gv.x, oacc[c][4 * g + 1] * rstd * gv.y), cvtpk(oacc[c][4 * g + 2] * rstd * gv.z, oacc[c][4 * g + 3] * rstd * gv.w)}; } }
        { float tot = 0.f;
#pragma unroll
          for (int w = 0; w < 8; ++w) tot += ps[w * 32 + qi];
          const float rstd = 1.0f / sqrtf(tot * (1.0f / PW) + RMS_EPS);
          bf16* op = O + (size_t)(r0 + qi) * D + AW + pg * 64 + 32 * pdt + 4 * hh; const float* gp = A.gng + AW + pg * 64 + 32 * pdt + 4 * hhu;
#pragma unroll
          for (int g = 0; g < 4; ++g) { const f32x4 gv = *(const f32x4*)(gp + 8 * g);
              *(u32x2*)(op + 8 * g) = (u32x2){cvtpk(pacc[4 * g] * rstd * gv.x, pacc[4 * g + 1] * rstd * gv.y), cvtpk(pacc[4 * g + 2] * rstd * gv.z, pacc[4 * g + 3] * rstd * gv.w)}; } }
#ifndef MXR_CONV
#define MXR_CONV 1
#endif
        for (int mr_ = 0, mn_ = opaque_int(MXR_CONV); mr_ < mn_; ++mr_)
        { const unsigned loff16 = 16u * (unsigned)ln;
          f32x4 acc[4]; const f32x4 cb = *(const f32x4*)(A.convb + 4 * ln);
#pragma unroll
          for (int tk = 0; tk < 4; ++tk) acc[tk] = cb;
#pragma unroll
          for (int j0 = 0; j0 < 32; j0 += 16) { f32x4 w4[16];
#pragma unroll
              for (int jj = 0; jj < 16; ++jj) if (j0 + jj < CK) w4[jj] = *(const f32x4*)((const char*)(A.convw + (size_t)(j0 + jj) * CW) + loff16);
#pragma unroll
              for (int rr = 0; rr < 19; ++rr) { if (j0 + rr < CK + 3) { const f32x4 u4 = *(const LAS f32x4*)(ubuf + (4 * wave + j0 + rr) * 256 + 4 * lane);
#pragma unroll
                  for (int tk = 0; tk < 4; ++tk) { const int jj = rr - tk; if (jj >= 0 && jj < 16 && j0 + jj < CK) acc[tk] += w4[jj] * u4; } } }
              asm volatile("" ::: "memory"); }
          const f32x4 lg = *(const f32x4*)(A.lng + 4 * ln), lb = *(const f32x4*)(A.lnb + 4 * ln), gc = *(const f32x4*)(A.gng + AW + PW + 4 * ln);
#pragma unroll
          for (int tk = 0; tk < 4; ++tk) { const int tl = 4 * wave + tk; f32x4 v = acc[tk];
              const float mean = wave_sum((v.x + v.y) + (v.z + v.w)) * (1.0f / CW); v = v - mean;
              const float var = wave_sum((v.x * v.x + v.y * v.y) + (v.z * v.z + v.w * v.w)) * (1.0f / CW); const float rs = 1.0f / sqrtf(var + LN_EPS);
              v = v * rs * lg + lb;
              v.x = sigm_mul(v.x, v.x); v.y = sigm_mul(v.y, v.y); v.z = sigm_mul(v.z, v.z); v.w = sigm_mul(v.w, v.w);
              const float ss = wave_sum((v.x * v.x + v.y * v.y) + (v.z * v.z + v.w * v.w)); const float rstd = 1.0f / sqrtf(ss * (1.0f / CW) + RMS_EPS);
              *(u32x2*)(O + (size_t)(r0 + tl) * D + AW + PW + 4 * lane) = (u32x2){pk2(v.x * rstd * gc.x, v.y * rstd * gc.y), pk2(v.z * rstd * gc.z, v.w * rstd * gc.w)}; } }
        __syncthreads();
    }
}
constexpr int NPH = 1 + 8 * DEPTH;
struct Args { const float* in[N_IN]; float* out; unsigned char* ws; int ph_lo, ph_hi; };
__global__ void __launch_bounds__(NWAVES * 64, 2) fwd(Args args) {
    extern __shared__ __attribute__((aligned(16))) unsigned char lds[];
    Frame F;
    F.lds = (LAS unsigned char*)lds;
    F.MISC = (volatile LAS unsigned*)(F.lds + MISC_OFF);
    F.wave = __builtin_amdgcn_readfirstlane((int)(threadIdx.x >> 6));
    F.G = gridDim.x; { const int bx = blockIdx.x; F.vcu = (F.G % 8 == 0) ? (bx % 8) * (F.G / 8) + bx / 8 : bx; }
    for (int u = F.wave * 64 + lane_now(); u < (LDS_BYTES - LDSCTL_OFF) / 4; u += NWAVES * 64) ((LAS unsigned*)(F.lds + LDSCTL_OFF))[u] = 0u;
    __syncthreads();
    XcdBarrier bar; bar.bar = (unsigned*)(CTLPTR() + CW_BAR); bar.x = 0; bar.st = nullptr; bar.wv = F.wave;
    bar = xcd_barrier_post((unsigned*)(CTLPTR() + CW_BAR), F.MISC + 8, F.wave);
#ifndef REP_PRO
#define REP_PRO 1
#endif
#ifndef REP_INP
#define REP_INP 1
#endif
#ifndef REP_ATT
#define REP_ATT 1
#endif
#ifndef REP_PC
#define REP_PC 1
#endif
#ifndef REP_MGU
#define REP_MGU 1
#endif
#ifndef REP_MDN
#define REP_MDN 1
#endif
#ifndef REP_DGU
#define REP_DGU 1
#endif
#ifndef REP_NRM
#define REP_NRM 1
#endif
#ifndef GEMM_ALIGN
#define GEMM_ALIGN true
#endif
#ifndef REP_OUT
#define REP_OUT 1
#endif
#ifndef REP_DDN
#define REP_DDN 1
#endif
#ifndef REP_BAR
#define REP_BAR 1
#endif
#ifndef REP_ROW8
#define REP_ROW8 1
#endif
#ifndef REP_GAT
#define REP_GAT 1
#endif
#ifndef REP_FIN
#define REP_FIN 1
#endif
#define REPEAT(n) for (int rep_ = 0, nrep_ = opaque_int(n); rep_ < nrep_; ++rep_)
#define IN(k) true
#define SEAM(k) do { if ((k) + 1 < NPH) { REPEAT(REP_BAR) xcd_barrier(bar); } } while (0)
#define X ((bf16*)(ws + WS_X))
#define XN ((bf16*)(ws + WS_XN))
#define P ((bf16*)(ws + WS_P))
#define O ((bf16*)(ws + WS_O))
#define ACT ((bf16*)(ws + WS_ACT))
#define AP ((bf16*)(ws + WS_AP))
#define TOK_E ((int*)(ws + WS_TOKE))
#define TOK_R ((int*)(ws + WS_TOKR))
#define TOK_G ((float*)(ws + WS_TOKG))
#define TOK_S ((int*)(ws + WS_TOKS))
    if (F.G != 256) { fail_word(F.wave, 0x7f0u); return; }

    if (IN(0)) {
        unsigned char* const ws = WSPTR();
        REPEAT(REP_PRO) p0_weights(F);
        RowArgs A{}; A.xin = INP(I_X); A.xws = X; A.gain = INP(I_ANG); A.xn = XN;
        REPEAT(REP_ROW8) row_phase<8>(F, A);
        SEAM(0);
    }
#pragma unroll 1
    for (int l = 0; l < DEPTH; ++l) {
        const int pb = 1 + 8 * l, li = l >> 1; const bool moe = (l & 1) != 0;
        if (IN(pb + 0)) {
            unsigned char* const ws = WSPTR();
            pg8::Gemm g{XN, (const bf16*)(ws + WS_WIN) + (size_t)l * INC * D, T, INC, D, 0}; pg8::StaticOrder S; S.init(T, INC, opaque_int(F.G), opaque_int((int)blockIdx.x));
            pg8::EpiBf16<0> E{P, INC, nullptr, 0, 0, 1.f};
            REPEAT(REP_INP) pg8::gemm_phase<pg8::EpiBf16<0>, pg8::StaticOrder, GEMM_ALIGN, true>(F.lds + RING_OFF, g, S, E, opaque_int(F.wave));
            { const int bx = opaque_int((int)blockIdx.x);
              if (bx >= 64) { const int rk = bx - 64; if (moe) moe_convert(F, li, CVT_C0 + CVT_C_PER * rk, CVT_C0 + CVT_C_PER * (rk + 1)); else moe_convert(F, li, CVT_A0 + CVT_A_PER * rk, CVT_A0 + CVT_A_PER * (rk + 1)); } }
            SEAM(pb + 0);
        }
        if (IN(pb + 1)) {
            unsigned char* const ws = WSPTR();
            PcArgs A{P, O, INP(I_POOLW) + (size_t)l * 4 * 64 * 64, INP(I_POOLS) + (size_t)l * PW, INP(I_CONVW) + (size_t)l * CK * CW, INP(I_CONVB) + (size_t)l * CW,
                     INP(I_LNG) + (size_t)l * CW, INP(I_LNB) + (size_t)l * CW, INP(I_GNG) + (size_t)l * D};
            REPEAT(REP_ATT) mixer_phase(F, A);
            SEAM(pb + 1);
        }
        if (IN(pb + 2)) {
            unsigned char* const ws = WSPTR();
            pg8::Gemm g{O, (const bf16*)(ws + WS_WOUT) + (size_t)l * D * D, T, D, D, 0}; pg8::StaticOrder S; S.init(T, D, opaque_int(F.G), opaque_int((int)blockIdx.x));
            pg8::EpiResid E{X, D, 1.0f};
            pg8::EpiResid Edummy{AP, D, 1.0f};
            REPEAT(REP_OUT) pg8::gemm_phase<pg8::EpiResid, pg8::StaticOrder, GEMM_ALIGN, true>(F.lds + RING_OFF, g, S, rep_ + 1 < nrep_ ? Edummy : E, opaque_int(F.wave));
            SEAM(pb + 2);
        }
        if (IN(pb + 3)) {
            unsigned char* const ws = WSPTR();
            RowArgs A{}; A.xsrc = X; A.xws = X; A.gain = INP(I_FNG) + (size_t)l * D; A.xn = XN;
            if (moe) { A.wr = INP(I_RW) + (size_t)li * D * NE; A.gcur = CTLPTR() + CW_MOE + li * 1024; A.tok_e = TOK_E; A.tok_r = TOK_R; A.tok_g = TOK_G; row_phase<2>(F, A); }
            else REPEAT(REP_NRM) row_phase<0>(F, A);
            SEAM(pb + 3);
        }
        if (moe) {
            if (IN(pb + 4)) { unsigned char* const ws = WSPTR(); gu32* const gcur = CTLPTR() + CW_MOE + li * 1024; REPEAT(REP_GAT) gather_phase(F, gcur, XN, (unsigned char*)AP, TOK_E, TOK_R, TOK_S); SEAM(pb + 4); }
            if (IN(pb + 5)) {
                unsigned char* const ws = WSPTR(); gu32* const gcur = CTLPTR() + CW_MOE + li * 1024;
                int cnt[8], toff[9]; load_toff(gcur, cnt, toff);
                pg8::Gemm g{AP, (const bf16*)(ws + WS_WGUM + (size_t)li * NE * NGU * D), 0, NGU, D / 2, (size_t)NGU * D}; pg8::GroupedOrder S; S.init(toff, NGU, opaque_int(F.G), opaque_int((int)blockIdx.x));
                pg8::EpiSwiGLU8 E{(unsigned char*)ACT, FF, 1.0f / (WSCALE8 * XSCALE8), ASCALE8};
                REPEAT(REP_MGU) pg8::gemm_phase<pg8::EpiSwiGLU8, pg8::GroupedOrder, GEMM_ALIGN, true, true>(F.lds + RING_OFF, g, S, E, opaque_int(F.wave));
                SEAM(pb + 5);
            }
            if (IN(pb + 6)) {
                unsigned char* const ws = WSPTR(); gu32* const gcur = CTLPTR() + CW_MOE + li * 1024;
                int cnt[8], toff[9]; load_toff(gcur, cnt, toff);
                pg8::Gemm g{ACT, (const bf16*)(ws + WS_WDM + (size_t)li * NE * D * FF), 0, D, FF / 2, (size_t)D * FF}; pg8::GroupedOrder S; S.init(toff, D, opaque_int(F.G), opaque_int((int)blockIdx.x));
                pg8::EpiBf16S E{AP, D, 1.0f / (WSCALE8 * ASCALE8)};
                REPEAT(REP_MDN) pg8::gemm_phase<pg8::EpiBf16S, pg8::GroupedOrder, GEMM_ALIGN, true, true>(F.lds + RING_OFF, g, S, E, opaque_int(F.wave));
                SEAM(pb + 6);
            }
        } else {
            if (IN(pb + 5)) {
                unsigned char* const ws = WSPTR();
                pg8::Gemm g{XN, (const bf16*)(ws + WS_WGUD) + (size_t)li * NGU * D, T, NGU, D, 0}; pg8::StaticOrder S; S.init(T, NGU, opaque_int(F.G), opaque_int((int)blockIdx.x));
                pg8::EpiSwiGLU8 E{(unsigned char*)ACT, FF, 1.0f, ASCALE8};
                REPEAT(REP_DGU) pg8::gemm_phase<pg8::EpiSwiGLU8, pg8::StaticOrder, GEMM_ALIGN, true>(F.lds + RING_OFF, g, S, E, opaque_int(F.wave));
                { const int bx = opaque_int((int)blockIdx.x);
                  if (bx >= 128) { const int rk = bx - 128; moe_convert(F, li, CVT_B0 + CVT_B_PER * rk, CVT_B0 + CVT_B_PER * (rk + 1)); } }
                SEAM(pb + 5);
            }
            if (IN(pb + 6)) {
                unsigned char* const ws = WSPTR();
                pg8::Gemm g{ACT, (const bf16*)(ws + WS_WDD + (size_t)li * D * FF), T, D, FF / 2, 0}; pg8::StaticOrder S; S.init(T, D, opaque_int(F.G), opaque_int((int)blockIdx.x));
                pg8::EpiResid E{X, D, 1.0f / (WSCALE8 * ASCALE8)};
                pg8::EpiResid Edummy{AP, D, 1.0f};
                REPEAT(REP_DDN) pg8::gemm_phase<pg8::EpiResid, pg8::StaticOrder, GEMM_ALIGN, true, true>(F.lds + RING_OFF, g, S, rep_ + 1 < nrep_ ? Edummy : E, opaque_int(F.wave));
                SEAM(pb + 6);
            }
        }
        if (IN(pb + 7)) {
            unsigned char* const ws = WSPTR();
            RowArgs A{}; A.xsrc = X; A.xws = X; A.xn = XN; A.out = OUTPTR(); A.yp = AP; A.tok_g = TOK_G; A.tok_s = TOK_S;
            A.gain = (l == DEPTH - 1) ? INP(I_FING) : INP(I_ANG) + (size_t)(l + 1) * D;
            if (l == DEPTH - 1) REPEAT(REP_FIN) row_phase<5>(F, A);
            else if (moe) row_phase<1>(F, A);
            else row_phase<0>(F, A);
            SEAM(pb + 7);
        }
    }
#undef IN
#undef SEAM
#undef X
#undef XN
#undef P
#undef O
#undef ACT
#undef AP
#undef TOK_E
#undef TOK_R
#undef TOK_G
#undef TOK_S
}

#ifndef MK_ONE_LAUNCH
#define MK_ONE_LAUNCH 0
#endif
extern "C" void kernel_launch(void* const* d_in, const int* in_sizes, int n_in, void* d_out, int out_size, void* d_ws, size_t ws_size, hipStream_t stream) {
    static int grid = 0;
    if (grid == 0) {
        if (n_in != N_IN || in_sizes[0] != T * D || out_size != T * D || ws_size < WS_END) { fprintf(stderr, "kernel_launch: unexpected problem shape (n_in %d, in0 %d, out %d, ws %zu); nothing launched\n", n_in, n_in > 0 ? in_sizes[0] : -1, out_size, ws_size); grid = -1; return; }
        if (hipFuncSetAttribute((const void*)fwd, hipFuncAttributeMaxDynamicSharedMemorySize, LDS_BYTES) != hipSuccess) { fprintf(stderr, "kernel_launch: hipFuncSetAttribute failed; nothing launched\n"); grid = -1; return; }
        int per_cu = 0;
        if (hipOccupancyMaxActiveBlocksPerMultiprocessor(&per_cu, (const void*)fwd, NWAVES * 64, LDS_BYTES) != hipSuccess || per_cu < 1)
            fprintf(stderr, "kernel_launch: note: occupancy query reports %d workgroups per CU\n", per_cu);
        (void)hipGetLastError();
        grid = 256;
    }
    if (grid < 0) return;
    if (hipMemsetAsync((char*)d_ws + WS_CTL, 0, CTL_ZERO_BYTES, stream) != hipSuccess) { fprintf(stderr, "kernel_launch: hipMemsetAsync failed; nothing launched\n"); return; }
    Args a{};
    for (int i = 0; i < N_IN; ++i) a.in[i] = (const float*)d_in[i];
    a.out = (float*)d_out; a.ws = (unsigned char*)d_ws;
    a.ph_lo = 0; a.ph_hi = NPH;
    hipLaunchKernelGGL(fwd, dim3(grid), dim3(NWAVES * 64), LDS_BYTES, stream, a);
    const hipError_t le = hipPeekAtLastError();
    if (le != hipSuccess) fprintf(stderr, "kernel_launch: launch failed: %s\n", hipGetErrorName(le));
}
```
